# Optimizing an MI355X kernel written in HIP

```python
import math
import jax
import jax.numpy as jnp
from jax import lax
import numpy as np

D_MODEL = 1024
BATCH = 2
SEQ = 8192
DEPTH = 2
DEC_BATCH = 128
DEC_SEQ = 8
PAST_LEN = 2048
PAGE_SIZE = 128

MIX = D_MODEL
HEAD_DIM = 64
NSA_WIDTH = D_MODEL // 2
NSA_HEADS = NSA_WIDTH // HEAD_DIM
NSA_KV_HEADS = 2
NSA_GROUP = NSA_HEADS // NSA_KV_HEADS
NSA_BLOCK = 64
NSA_TOPK = 16
WINDOW = 512
N_NSA_KV = 6
DN_WIDTH = D_MODEL // 4
DN_HEADS = DN_WIDTH // HEAD_DIM
DN_DK = HEAD_DIM
DN_DV = HEAD_DIM
DN_CONV_W = 4
DN_CHUNK = 64
DN_CONV_DIM = 3 * DN_WIDTH
S5_WIDTH = D_MODEL - NSA_WIDTH - DN_WIDTH
S5_GROUP_CH = 16
S5_GROUPS = S5_WIDTH // S5_GROUP_CH
S5_STATE = 64
D_FF = 4 * D_MODEL
Q_BLOCK = 128
NORM_EPS = 1e-6
BIG = 1e9
NEG_INF = -1e30
SPLIT_WIDTHS = (NSA_WIDTH, N_NSA_KV * NSA_KV_HEADS * HEAD_DIM, NSA_HEADS * 3,
                3 * DN_WIDTH, DN_HEADS, DN_HEADS, DN_WIDTH, S5_WIDTH)
IN_WIDTH = sum(SPLIT_WIDTHS)

kernel_name = 'hymba_nsa_gdn_s5_decode_step'


def split_cols(a, widths):
    outs, start = [], 0
    for wdt in widths:
        outs.append(a[..., start:start + wdt])
        start += wdt
    return outs


def rmsnorm(x, g):
    xf = x.astype(jnp.float32)
    y = xf * lax.rsqrt(jnp.mean(xf * xf, axis=-1, keepdims=True) + NORM_EPS)
    return (y * g.astype(jnp.float32)).astype(x.dtype)


def l2norm(a):
    return a * lax.rsqrt(jnp.sum(a * a, axis=-1, keepdims=True) + 1e-6)


def masked_softmax(s, mask, axes):
    s = jnp.where(mask, s, NEG_INF)
    m = jnp.max(s, axis=axes, keepdims=True)
    p = jnp.exp(s - m) * mask
    return p / jnp.maximum(jnp.sum(p, axis=axes, keepdims=True), 1e-30)


def alibi_slopes():
    h = jnp.arange(1, NSA_HEADS + 1, dtype=jnp.float32)
    return jnp.exp2(-8.0 * h / NSA_HEADS).reshape(NSA_KV_HEADS, NSA_GROUP)


def nsa_attend(q, k_cmp, v_cmp, k_sel, v_sel, k_win, v_win, gates, w_ck, w_cv, q0, w0):
    B, Lq = q.shape[0], q.shape[1]
    Sk = k_cmp.shape[1]
    G, R, dh = NSA_KV_HEADS, NSA_GROUP, HEAD_DIM
    f32 = jnp.float32
    slopes = alibi_slopes()
    qg = q.reshape(B, Lq, G, R, dh)
    t = q0 + jnp.arange(Lq)
    nb = Sk // NSA_BLOCK
    kcb = k_cmp[:, :nb * NSA_BLOCK].reshape(B, nb, NSA_BLOCK, G, dh)
    vcb = v_cmp[:, :nb * NSA_BLOCK].reshape(B, nb, NSA_BLOCK, G, dh)
    kc = jnp.einsum('bnjgd,gj->bngd', kcb, w_ck)
    vc = jnp.einsum('bnjgd,gj->bngd', vcb, w_cv)
    blk = jnp.arange(nb)
    s_c = jnp.einsum('bqgrd,bngd->bgrqn', qg, kc, preferred_element_type=f32)
    dist_c = t[:, None].astype(f32) - (blk * NSA_BLOCK + (NSA_BLOCK - 1) / 2.0)[None, :]
    ok_c = ((blk + 1) * NSA_BLOCK - 1)[None, :] <= t[:, None]
    p_c = masked_softmax(s_c - slopes[None, :, :, None, None] * dist_c, ok_c, axes=-1)
    o_c = jnp.einsum('bgrqn,bngd->bqgrd', p_c, vc.astype(f32))
    nbs = -(-Sk // NSA_BLOCK)
    imp = jnp.pad(jnp.sum(p_c, axis=2), ((0, 0), (0, 0), (0, 0), (0, nbs - nb)))
    cur = t // NSA_BLOCK
    cand = jnp.arange(nbs)
    forced = (cand[None, :] == 0) | (cand[None, :] == cur[:, None]) | (cand[None, :] == cur[:, None] - 1)
    score = jnp.where(cand[None, :] > cur[:, None], -BIG, jnp.where(forced, BIG, imp))
    n_sel = min(NSA_TOPK, nbs)
    _, idx = lax.top_k(score, n_sel)
    valid = idx <= cur[None, None, :, None]
    pad_k = nbs * NSA_BLOCK - Sk

    def to_blocks(a):
        a = jnp.pad(a, ((0, 0), (0, pad_k), (0, 0), (0, 0)))
        return a.reshape(B, nbs, NSA_BLOCK, G, dh).transpose(0, 3, 1, 2, 4)

    ksb, vsb = to_blocks(k_sel), to_blocks(v_sel)
    kw_pad = jnp.pad(k_win, ((0, 0), (WINDOW, 0), (0, 0), (0, 0)))
    vw_pad = jnp.pad(v_win, ((0, 0), (WINDOW, 0), (0, 0), (0, 0)))
    qb_len = math.gcd(Lq, Q_BLOCK)
    nq = Lq // qb_len
    span = qb_len + WINDOW - 1
    bi = jnp.arange(B)[:, None, None, None]
    gi = jnp.arange(G)[None, :, None, None]

    def body(xs):
        qb, ib, vb, i0 = xs
        tb = q0 + i0 + jnp.arange(qb_len)
        kg = ksb[bi, gi, ib]
        vg = vsb[bi, gi, ib]
        pos = ib[..., None] * NSA_BLOCK + jnp.arange(NSA_BLOCK)
        dist = tb[None, None, :, None, None] - pos
        m_s = (dist >= 0) & vb[..., None]
        s = jnp.einsum('bqgrd,bgqnjd->bgrqnj', qb, kg, preferred_element_type=f32)
        s = s - slopes[None, :, :, None, None, None] * dist[:, :, None].astype(f32)
        p = masked_softmax(s, m_s[:, :, None], axes=(-2, -1))
        o_s = jnp.einsum('bgrqnj,bgqnjd->bqgrd', p, vg.astype(f32))
        start = q0 + i0 - w0 + 1
        kwb = lax.dynamic_slice_in_dim(kw_pad, start, span, axis=1)
        vwb = lax.dynamic_slice_in_dim(vw_pad, start, span, axis=1)
        wpos = q0 + i0 - WINDOW + 1 + jnp.arange(span)
        dist_w = tb[:, None] - wpos[None, :]
        m_w = (dist_w >= 0) & (dist_w < WINDOW) & (wpos >= w0)[None, :]
        s_w = jnp.einsum('bqgrd,bkgd->bgrqk', qb, kwb, preferred_element_type=f32)
        p_w = masked_softmax(s_w - slopes[None, :, :, None, None] * dist_w.astype(f32), m_w, axes=-1)
        o_w = jnp.einsum('bgrqk,bkgd->bqgrd', p_w, vwb.astype(f32))
        return o_s, o_w

    xs = (qg.reshape(B, nq, qb_len, G, R, dh).transpose(1, 0, 2, 3, 4, 5),
          idx.reshape(B, G, nq, qb_len, n_sel).transpose(2, 0, 1, 3, 4),
          valid.reshape(B, G, nq, qb_len, n_sel).transpose(2, 0, 1, 3, 4),
          jnp.arange(nq) * qb_len)
    o_s, o_w = lax.map(body, xs)
    o_s = o_s.transpose(1, 0, 2, 3, 4, 5).reshape(B, Lq, G, R, dh)
    o_w = o_w.transpose(1, 0, 2, 3, 4, 5).reshape(B, Lq, G, R, dh)
    gt = gates.reshape(B, Lq, G, R, 3)
    o = gt[..., 0:1] * o_c + gt[..., 1:2] * o_s + gt[..., 2:3] * o_w
    return o.reshape(B, Lq, NSA_WIDTH)


def short_conv(x, buf, w):
    L = x.shape[1]
    xc = jnp.concatenate([buf.astype(x.dtype), x], axis=1)
    y = sum(xc[:, j:j + L] * w[:, j] for j in range(DN_CONV_W))
    return jax.nn.silu(y), xc[:, xc.shape[1] - (DN_CONV_W - 1):]


def gated_delta_chunked(q, k, v, g, beta, s0):
    B, L, H, dk = q.shape
    dv = v.shape[-1]
    C = min(DN_CHUNK, L)
    n = -(-L // C)
    pad = n * C - L
    if pad:
        pw = ((0, 0), (0, pad), (0, 0), (0, 0))
        q, k, v = jnp.pad(q, pw), jnp.pad(k, pw), jnp.pad(v, pw)
        g, beta = jnp.pad(g, pw[:3]), jnp.pad(beta, pw[:3])
    qc, kc, vc = [a.reshape(B, n, C, H, a.shape[-1]).transpose(1, 0, 3, 2, 4) for a in (q, k, v)]
    gc = jnp.cumsum(g.reshape(B, n, C, H).transpose(1, 0, 3, 2), axis=-1)
    bc = beta.reshape(B, n, C, H).transpose(1, 0, 3, 2)
    tri = jnp.tril(jnp.ones((C, C), dtype=bool))
    strict = jnp.tril(jnp.ones((C, C), dtype=bool), -1)
    diff = gc[..., :, None] - gc[..., None, :]
    decay = jnp.where(tri, jnp.exp(jnp.where(tri, diff, 0.0)), 0.0)
    kb = kc * bc[..., None]
    a_mat = jnp.where(strict, jnp.einsum('nbhid,nbhjd->nbhij', kb, kc) * decay, 0.0)
    eye = jnp.eye(C, dtype=a_mat.dtype)
    rhs = jnp.concatenate([vc * bc[..., None], kb * jnp.exp(gc)[..., None]], axis=-1)
    sol = lax.linalg.triangular_solve(a_mat + eye, rhs, left_side=True, lower=True)
    u, w = sol[..., :dv], sol[..., dv:]
    a_qk = jnp.where(tri, jnp.einsum('nbhid,nbhjd->nbhij', qc, kc) * decay, 0.0)

    def step(S, xs):
        q_i, k_i, u_i, w_i, g_i, aqk_i = xs
        v_new = u_i - jnp.einsum('bhck,bhkv->bhcv', w_i, S)
        o_i = (jnp.einsum('bhck,bhkv->bhcv', q_i * jnp.exp(g_i)[..., None], S)
               + jnp.einsum('bhij,bhjv->bhiv', aqk_i, v_new))
        g_last = g_i[..., -1]
        S = (S * jnp.exp(g_last)[..., None, None]
             + jnp.einsum('bhck,bhcv->bhkv', k_i * jnp.exp(g_last[..., None] - g_i)[..., None], v_new))
        return S, o_i

    s_fin, o = lax.scan(step, s0, (qc, kc, u, w, gc, a_qk))
    o = o.transpose(1, 0, 3, 2, 4).reshape(B, n * C, H, dv)[:, :L]
    return o, s_fin


def deltanet_mix(qkv, a, b, z, conv_buf, s0, conv_w, a_log, dt_bias, norm_w):
    B, L, _ = qkv.shape
    f32 = jnp.float32
    y, new_buf = short_conv(qkv, conv_buf, conv_w)
    y = y.astype(f32)
    q = l2norm(y[..., :DN_WIDTH].reshape(B, L, DN_HEADS, DN_DK)) * DN_DK ** -0.5
    k = l2norm(y[..., DN_WIDTH:2 * DN_WIDTH].reshape(B, L, DN_HEADS, DN_DK))
    v = y[..., 2 * DN_WIDTH:].reshape(B, L, DN_HEADS, DN_DV)
    beta = jax.nn.sigmoid(b.astype(f32))
    g = -jnp.exp(a_log.astype(f32)) * jax.nn.softplus(a.astype(f32) + dt_bias.astype(f32))
    o, s_new = gated_delta_chunked(q, k, v, g, beta, s0.astype(f32))
    o = rmsnorm(o, norm_w) * jax.nn.silu(z.astype(f32).reshape(B, L, DN_HEADS, DN_DV))
    return o.reshape(B, L, DN_WIDTH), new_buf, s_new


def complex_affine_combine(e1, e2):
    a1r, a1i, b1r, b1i = e1
    a2r, a2i, b2r, b2i = e2
    return (a2r * a1r - a2i * a1i, a2r * a1i + a2i * a1r,
            a2r * b1r - a2i * b1i + b2r, a2r * b1i + a2i * b1r + b2i)


def s5_mix(u, h0_re, h0_im, lam_re, lam_im, log_step, b_re, b_im, c_re, c_im, d, w_glu):
    B, L, _ = u.shape
    f32 = jnp.float32
    uf = u.astype(f32)
    ug = uf.reshape(B, L, S5_GROUPS, S5_GROUP_CH)
    lr, li = lam_re.astype(f32), lam_im.astype(f32)
    dt = jnp.exp(log_step.astype(f32))[:, None]
    mag = jnp.exp(lr * dt)
    ar, ai = mag * jnp.cos(li * dt), mag * jnp.sin(li * dt)
    den = lr * lr + li * li
    fr = ((ar - 1.0) * lr + ai * li) / den
    fi = (ai * lr - (ar - 1.0) * li) / den
    br, bi = b_re.astype(f32), b_im.astype(f32)
    bbr = fr[..., None] * br - fi[..., None] * bi
    bbi = fr[..., None] * bi + fi[..., None] * br
    bu_r = jnp.einsum('gpc,blgc->blgp', bbr, ug)
    bu_i = jnp.einsum('gpc,blgc->blgp', bbi, ug)
    a_r = jnp.broadcast_to(ar, bu_r.shape)
    a_i = jnp.broadcast_to(ai, bu_i.shape)
    cum_r, cum_i, hs_r, hs_i = lax.associative_scan(complex_affine_combine, (a_r, a_i, bu_r, bu_i), axis=1)
    h0r = h0_re.astype(f32)[:, None]
    h0i = h0_im.astype(f32)[:, None]
    h_r = cum_r * h0r - cum_i * h0i + hs_r
    h_i = cum_r * h0i + cum_i * h0r + hs_i
    y = (jnp.einsum('gcp,blgp->blgc', c_re.astype(f32), h_r)
         - jnp.einsum('gcp,blgp->blgc', c_im.astype(f32), h_i))
    y = y.reshape(B, L, S5_WIDTH) + d.astype(f32) * uf
    gl = jax.nn.gelu(y)
    out = gl * jax.nn.sigmoid(gl @ w_glu.astype(f32))
    return out, h_r[:, -1], h_i[:, -1]


def trunk_layer(x, past_kv, win_buf, conv_buf, dn_s0, s5_re0, s5_im0, p):
    B, L, _ = x.shape
    f32 = jnp.float32
    q0 = past_kv.shape[1]
    w0 = q0 - win_buf.shape[1]
    h = rmsnorm(x, p['ln1'])
    nsa_q, nsa_kv, nsa_gate, dn_qkv, dn_a, dn_b, dn_z, s5_u = split_cols(h @ p['w_in'], SPLIT_WIDTHS)
    kv = nsa_kv.reshape(B, L, N_NSA_KV, NSA_KV_HEADS, HEAD_DIM)
    new_kv = kv[:, :, :4]
    full = jnp.concatenate([past_kv.astype(kv.dtype), new_kv], axis=1)
    wseq = jnp.concatenate([win_buf.astype(kv.dtype), kv[:, :, 4:]], axis=1)
    q = nsa_q.reshape(B, L, NSA_HEADS, HEAD_DIM) * HEAD_DIM ** -0.5
    gates = jax.nn.sigmoid(nsa_gate.astype(f32)).reshape(B, L, NSA_HEADS, 3)
    o_nsa = nsa_attend(q, full[:, :, 0], full[:, :, 1], full[:, :, 2], full[:, :, 3],
                       wseq[:, :, 0], wseq[:, :, 1], gates, p['nsa_wck'], p['nsa_wcv'], q0, w0)
    new_win = wseq[:, wseq.shape[1] - min(WINDOW, q0 + L):]
    o_dn, new_conv, new_dn = deltanet_mix(dn_qkv, dn_a, dn_b, dn_z, conv_buf, dn_s0, p['dn_conv_w'],
                                          p['dn_a_log'], p['dn_dt_bias'], p['dn_norm_w'])
    o_s5, s5_re, s5_im = s5_mix(s5_u, s5_re0, s5_im0, p['s5_lambda_re'], p['s5_lambda_im'], p['s5_log_step'],
                                p['s5_b_re'], p['s5_b_im'], p['s5_c_re'], p['s5_c_im'], p['s5_d'], p['s5_w_glu'])
    mix = jnp.concatenate([o_nsa, o_dn, o_s5], axis=-1).astype(x.dtype)
    x = x + mix @ p['w_out']
    h2 = rmsnorm(x, p['ln2'])
    x = x + jnp.square(jax.nn.relu(h2 @ p['mlp_up'])) @ p['mlp_down']
    return x, (new_kv, new_win, new_conv, new_dn, s5_re, s5_im)


def setup_inputs(seed: int = 0) -> dict:
    key = jax.random.key(seed)
    ks = iter(jax.random.split(key, 48))
    f32 = jnp.float32

    def nrm(shape, scale):
        return jax.random.normal(next(ks), shape, f32) * scale

    def unif(shape, lo, hi):
        return jax.random.uniform(next(ks), shape, f32, lo, hi)

    n_pages = PAST_LEN // PAGE_SIZE
    n_used = DEC_BATCH * n_pages
    n_phys = n_used + (n_used + 3) // 4
    G, dh = NSA_KV_HEADS, HEAD_DIM
    x_prompt = nrm((BATCH, SEQ, D_MODEL), 1.0)
    x_sample = nrm((DEC_BATCH, DEC_SEQ, D_MODEL), 1.0)
    cache_nsa_kv = nrm((DEPTH, n_phys, PAGE_SIZE, 4, G, dh), 1.0)
    cache_win_kv = nrm((DEPTH, DEC_BATCH, min(WINDOW, PAST_LEN), 2, G, dh), 1.0)
    state_dn_conv = nrm((DEPTH, DEC_BATCH, DN_CONV_W - 1, DN_CONV_DIM), 1.0)
    state_dn = nrm((DEPTH, DEC_BATCH, DN_HEADS, DN_DK, DN_DV), 0.3)
    state_s5_re = nrm((DEPTH, DEC_BATCH, S5_GROUPS, S5_STATE), 0.2)
    state_s5_im = nrm((DEPTH, DEC_BATCH, S5_GROUPS, S5_STATE), 0.2)
    page_table = jax.random.permutation(next(ks), n_phys)[:n_used].reshape(DEC_BATCH, n_pages).astype(jnp.int32)
    ln1 = 1.0 + nrm((DEPTH, D_MODEL), 0.02)
    ln2 = 1.0 + nrm((DEPTH, D_MODEL), 0.02)
    ln_f = 1.0 + nrm((D_MODEL,), 0.02)
    w_in = nrm((DEPTH, D_MODEL, IN_WIDTH), D_MODEL ** -0.5)
    w_out = nrm((DEPTH, MIX, D_MODEL), MIX ** -0.5)
    nsa_wck = 1.0 / NSA_BLOCK + nrm((DEPTH, G, NSA_BLOCK), NSA_BLOCK ** -0.5)
    nsa_wcv = 1.0 / NSA_BLOCK + nrm((DEPTH, G, NSA_BLOCK), NSA_BLOCK ** -0.5)
    dn_conv_w = nrm((DEPTH, DN_CONV_DIM, DN_CONV_W), DN_CONV_W ** -0.5)
    dn_a_log = jnp.log(unif((DEPTH, DN_HEADS), 1.0, 16.0))
    dt = jnp.exp(unif((DEPTH, DN_HEADS), math.log(1e-3), math.log(0.1)))
    dn_dt_bias = dt + jnp.log(-jnp.expm1(-dt))
    dn_norm_w = 1.0 + nrm((DEPTH, DN_DV), 0.02)
    s5_lambda_re = -0.5 + nrm((DEPTH, S5_GROUPS, S5_STATE), 0.01)
    s5_lambda_im = math.pi * jnp.arange(S5_STATE, dtype=f32) + nrm((DEPTH, S5_GROUPS, S5_STATE), 0.01)
    s5_log_step = unif((DEPTH, S5_GROUPS), math.log(1e-3), math.log(0.1))
    s5_b_re = nrm((DEPTH, S5_GROUPS, S5_STATE, S5_GROUP_CH), (2 * S5_GROUP_CH) ** -0.5)
    s5_b_im = nrm((DEPTH, S5_GROUPS, S5_STATE, S5_GROUP_CH), (2 * S5_GROUP_CH) ** -0.5)
    s5_c_re = nrm((DEPTH, S5_GROUPS, S5_GROUP_CH, S5_STATE), S5_STATE ** -0.5)
    s5_c_im = nrm((DEPTH, S5_GROUPS, S5_GROUP_CH, S5_STATE), S5_STATE ** -0.5)
    s5_d = nrm((DEPTH, S5_WIDTH), 1.0)
    s5_w_glu = nrm((DEPTH, S5_WIDTH, S5_WIDTH), S5_WIDTH ** -0.5)
    mlp_up = nrm((DEPTH, D_MODEL, D_FF), D_MODEL ** -0.5)
    mlp_down = nrm((DEPTH, D_FF, D_MODEL), D_FF ** -0.5)
    return {'x_prompt': x_prompt, 'x_sample': x_sample, 'cache_nsa_kv': cache_nsa_kv,
            'cache_win_kv': cache_win_kv, 'state_dn_conv': state_dn_conv, 'state_dn': state_dn,
            'state_s5_re': state_s5_re, 'state_s5_im': state_s5_im, 'page_table': page_table,
            'ln1': ln1, 'ln2': ln2, 'ln_f': ln_f, 'w_in': w_in, 'w_out': w_out,
            'nsa_wck': nsa_wck, 'nsa_wcv': nsa_wcv, 'dn_conv_w': dn_conv_w, 'dn_a_log': dn_a_log,
            'dn_dt_bias': dn_dt_bias, 'dn_norm_w': dn_norm_w, 's5_lambda_re': s5_lambda_re,
            's5_lambda_im': s5_lambda_im, 's5_log_step': s5_log_step, 's5_b_re': s5_b_re,
            's5_b_im': s5_b_im, 's5_c_re': s5_c_re, 's5_c_im': s5_c_im, 's5_d': s5_d,
            's5_w_glu': s5_w_glu, 'mlp_up': mlp_up, 'mlp_down': mlp_down}


def reference(x_prompt, x_sample, cache_nsa_kv, cache_win_kv, state_dn_conv, state_dn, state_s5_re,
              state_s5_im, page_table, ln1, ln2, ln_f, w_in, w_out, nsa_wck, nsa_wcv, dn_conv_w,
              dn_a_log, dn_dt_bias, dn_norm_w, s5_lambda_re, s5_lambda_im, s5_log_step, s5_b_re,
              s5_b_im, s5_c_re, s5_c_im, s5_d, s5_w_glu, mlp_up, mlp_down):
    B = x_prompt.shape[0]
    DB = x_sample.shape[0]
    n_pages = page_table.shape[1]
    page = cache_nsa_kv.shape[2]
    G, dh = NSA_KV_HEADS, HEAD_DIM
    f32 = jnp.float32
    xp, xs = x_prompt, x_sample
    outs_p, outs_s = [], []
    for l in range(DEPTH):
        p = {'ln1': ln1[l], 'ln2': ln2[l], 'w_in': w_in[l], 'w_out': w_out[l],
             'nsa_wck': nsa_wck[l], 'nsa_wcv': nsa_wcv[l], 'dn_conv_w': dn_conv_w[l],
             'dn_a_log': dn_a_log[l], 'dn_dt_bias': dn_dt_bias[l], 'dn_norm_w': dn_norm_w[l],
             's5_lambda_re': s5_lambda_re[l], 's5_lambda_im': s5_lambda_im[l],
             's5_log_step': s5_log_step[l], 's5_b_re': s5_b_re[l], 's5_b_im': s5_b_im[l],
             's5_c_re': s5_c_re[l], 's5_c_im': s5_c_im[l], 's5_d': s5_d[l], 's5_w_glu': s5_w_glu[l],
             'mlp_up': mlp_up[l], 'mlp_down': mlp_down[l]}
        xp, st_p = trunk_layer(
            xp, jnp.zeros((B, 0, 4, G, dh), xp.dtype), jnp.zeros((B, 0, 2, G, dh), xp.dtype),
            jnp.zeros((B, DN_CONV_W - 1, DN_CONV_DIM), xp.dtype),
            jnp.zeros((B, DN_HEADS, DN_DK, DN_DV), f32),
            jnp.zeros((B, S5_GROUPS, S5_STATE), f32), jnp.zeros((B, S5_GROUPS, S5_STATE), f32), p)
        past = cache_nsa_kv[l, page_table].reshape(DB, n_pages * page, 4, G, dh)
        xs, st_s = trunk_layer(xs, past, cache_win_kv[l], state_dn_conv[l], state_dn[l],
                               state_s5_re[l], state_s5_im[l], p)
        outs_p.append(st_p)
        outs_s.append(st_s)
    y_prompt = rmsnorm(xp, ln_f)
    y_sample = rmsnorm(xs, ln_f)

    def stk(outs, i):
        return jnp.stack([o[i] for o in outs], axis=0)

    kv_p, kv_s = stk(outs_p, 0), stk(outs_s, 0)
    win_p, win_s = stk(outs_p, 1), stk(outs_s, 1)
    conv_p, conv_s = stk(outs_p, 2), stk(outs_s, 2)
    dn_p, dn_s = stk(outs_p, 3), stk(outs_s, 3)
    s5re_p, s5re_s = stk(outs_p, 4), stk(outs_s, 4)
    s5im_p, s5im_s = stk(outs_p, 5), stk(outs_s, 5)
    return (y_prompt, y_sample, kv_p, kv_s, win_p, win_s, conv_p, conv_s, dn_p, dn_s,
            s5re_p, s5re_s, s5im_p, s5im_s)
```

```cpp
#include <hip/hip_runtime.h>
#include <cstdio>
#include <cstdint>
#define N_LAUNCH_MODE 1
#define HD __device__ __forceinline__
#ifndef CFG_SEQ
#define CFG_SEQ 8192
#endif
#ifndef CFG_BATCH
#define CFG_BATCH 2
#endif
#ifndef CFG_DB
#define CFG_DB 128
#endif
constexpr int DM = 1024, SEQ = CFG_SEQ, BATCH = CFG_BATCH, DB = CFG_DB, DSEQ = 8, PAST = 2048, PAGE = 128, NPAGES = PAST / PAGE;
constexpr int NUSED = DB * NPAGES, NPHYS = NUSED + (NUSED + 3) / 4;
constexpr int HD_ = 64, NH = 8, NG = 2, NR = 4, NBLK = 64, TOPK = 16, WIN = 512, W0S = PAST - WIN;
constexpr int DNH = 4, DNW = 256, CONVD = 768, S5G = 16, S5P = 64, S5C = 16, DFF = 4096, INW = 2592;
constexpr int TP = BATCH * SEQ, TS = DB * DSEQ, TT = TP + TS;
constexpr int PLD = 2816;
constexpr int C_Q = 0, C_KV = 512, C_GATE = 1280, C_DNQKV = 1304, C_DNA = 2072, C_DNB = 2076, C_DNZ = 2080, C_S5U = 2336;
constexpr int NBP = SEQ / NBLK;
constexpr int NBS_S = 33, NBC_S = 32;
constexpr int NBMAX = (NBP > 64 ? NBP : 64);
constexpr int NSEQ = BATCH + DB;
constexpr int NCH = SEQ / 64;
constexpr int NDU = BATCH * DNH * NCH;
constexpr float NEPS = 1e-6f;
static_assert(NBMAX <= 128, "selection bitmask is 128 bits");

constexpr size_t O_YP = 0, O_YS = O_YP + (size_t)TP * DM, O_KVP = O_YS + (size_t)TS * DM, O_KVS = O_KVP + (size_t)2 * TP * 512,
    O_WINP = O_KVS + (size_t)2 * TS * 512, O_WINS = O_WINP + (size_t)2 * BATCH * 512 * 256, O_CONVP = O_WINS + (size_t)2 * DB * 512 * 256,
    O_CONVS = O_CONVP + (size_t)2 * BATCH * 3 * CONVD, O_DNP = O_CONVS + (size_t)2 * DB * 3 * CONVD, O_DNS = O_DNP + (size_t)2 * BATCH * DNH * 4096,
    O_S5RP = O_DNS + (size_t)2 * DB * DNH * 4096, O_S5RS = O_S5RP + (size_t)2 * BATCH * 1024, O_S5IP = O_S5RS + (size_t)2 * DB * 1024,
    O_S5IS = O_S5IP + (size_t)2 * BATCH * 1024, O_END = O_S5IS + (size_t)2 * DB * 1024;

#ifdef HOST_EMU
typedef float bf16_t;
HD bf16_t tobf(float f) { return f; }
HD float frombf(bf16_t b) { return b; }
#else
typedef unsigned short bf16_t;
HD bf16_t tobf(float f) { unsigned u = __float_as_uint(f); u += 0x7fffu + ((u >> 16) & 1u); return (bf16_t)(u >> 16); }
HD float frombf(bf16_t b) { return __uint_as_float(((unsigned)b) << 16); }
#endif

struct Ctx {
    const float *x_prompt, *x_sample, *cache_nsa, *cache_win, *st_conv, *st_dn, *st_s5re, *st_s5im; const int* page_table;
    const float *ln1, *ln2, *ln_f, *w_in, *w_out, *wck, *wcv, *conv_w, *a_log, *dt_bias, *dn_norm_w, *lam_re, *lam_im, *log_step,
        *b_re, *b_im, *c_re, *c_im, *s5_d, *w_glu, *mlp_up, *mlp_down;
    float* out;
    float* X;
    float* SSQ;
    bf16_t* XN;
    float* PROJ;
    bf16_t* MIXB;
    bf16_t* UPB;
    bf16_t *WIN_T, *WOUT_T, *WUP_T, *WDN_T;
    float *KC, *VC;
    float* PC;
    float* OC;
    int* IDX;
    float *QN, *KN, *VV;
    float *GG, *BETA;
    float* GC;
    float* AM;
    float* AQK;
    float* SOL;
    float* VNEW;
    float* SDN;
    float* ODN;
    float* S5K;
    float* S5BB;
    float* S5E;
    float* S5HIN;
    float* S5HS;
    float* GL;
    bf16_t* GLB;
    bf16_t* WGLU_T;
    unsigned* QCTR;
    float* PART;
};

HD float sigmoidf_(float x) { return 1.0f / (1.0f + expf(-x)); }
HD float siluf_(float x) { return x * sigmoidf_(x); }
HD float softplusf_(float x) { return (x > 0.f ? x : 0.f) + log1pf(expf(-fabsf(x))); }
HD float geluf_(float x) { return 0.5f * x * (1.0f + tanhf(0.7978845608028654f * (x + 0.044715f * x * x * x))); }

#ifdef HOST_EMU
typedef const Ctx& CREF;
#else
typedef const __attribute__((address_space(4))) Ctx& CREF;
#endif
struct Tok { int smp, b, j, t, seq; };
HD Tok tok_of(int r) { Tok k; if (r < TP) { k.smp = 0; k.b = r / SEQ; k.j = r % SEQ; k.t = k.j; k.seq = k.b; } else { r -= TP; k.smp = 1; k.b = r / DSEQ; k.j = r % DSEQ; k.t = PAST + k.j; k.seq = BATCH + k.b; } return k; }

HD const float* kv_ptr(CREF c, int l, int smp, int b, int pos, int slot, int g) {
    if (!smp) return c.PROJ + (size_t)(b * SEQ + pos) * PLD + C_KV + slot * 128 + g * 64;
    if (pos >= PAST) return c.PROJ + (size_t)(TP + b * DSEQ + (pos - PAST)) * PLD + C_KV + slot * 128 + g * 64;
    if (slot < 4) { const int pg = c.page_table[b * NPAGES + pos / PAGE]; return c.cache_nsa + ((((size_t)l * NPHYS + pg) * PAGE + (pos % PAGE)) * 4 + slot) * 128 + g * 64; }
    return c.cache_win + ((((size_t)l * DB + b) * WIN + (pos - W0S)) * 2 + (slot - 4)) * 128 + g * 64;
}

HD void ph_prologue(CREF c, long gtid, long gn) {
    for (long i = gtid; i < (long)2 * PLD * DM; i += gn) { const int l = (int)(i / ((long)PLD * DM)); const long r = i % ((long)PLD * DM); const int n = (int)(r / DM), k = (int)(r % DM);
        c.WIN_T[i] = tobf(n < INW ? c.w_in[((size_t)l * DM + k) * INW + n] : 0.f); }
    for (long i = gtid; i < (long)2 * DM * DM; i += gn) { const int l = (int)(i / ((long)DM * DM)); const long r = i % ((long)DM * DM); const int n = (int)(r / DM), k = (int)(r % DM);
        c.WOUT_T[i] = tobf(c.w_out[((size_t)l * DM + k) * DM + n]); }
    for (long i = gtid; i < (long)2 * DFF * DM; i += gn) { const int l = (int)(i / ((long)DFF * DM)); const long r = i % ((long)DFF * DM); const int n = (int)(r / DM), k = (int)(r % DM);
        c.WUP_T[i] = tobf(c.mlp_up[((size_t)l * DM + k) * DFF + n]); }
    for (long i = gtid; i < (long)2 * DM * DFF; i += gn) { const int l = (int)(i / ((long)DM * DFF)); const long r = i % ((long)DM * DFF); const int n = (int)(r / DFF), k = (int)(r % DFF);
        c.WDN_T[i] = tobf(c.mlp_down[((size_t)l * DFF + k) * DM + n]); }
    for (long i = gtid; i < (long)TT * DM; i += gn) c.X[i] = i < (long)TP * DM ? c.x_prompt[i] : c.x_sample[i - (long)TP * DM];
}
HD void ph_s5_consts(CREF c, long gtid, long gn) {
    for (long i = gtid; i < 2 * S5G * S5P; i += gn) { const int l = (int)(i / (S5G * S5P)), g = (int)((i / S5P) % S5G);
        const double lr = c.lam_re[i], li = c.lam_im[i], dt = exp((double)c.log_step[l * S5G + g]);
        const double mag = exp(lr * dt), ar = mag * cos(li * dt), ai = mag * sin(li * dt), den = lr * lr + li * li;
        const double fr = ((ar - 1.0) * lr + ai * li) / den, fi = (ai * lr - (ar - 1.0) * li) / den;
        double pr = 1.0, pi = 0.0; for (int s = 0; s < 64; ++s) { const double nr = pr * ar - pi * ai, ni = pr * ai + pi * ar; pr = nr; pi = ni; }
        c.S5K[i * 4 + 0] = (float)ar; c.S5K[i * 4 + 1] = (float)ai; c.S5K[i * 4 + 2] = (float)pr; c.S5K[i * 4 + 3] = (float)pi;
        for (int ch = 0; ch < S5C; ++ch) { const double br = c.b_re[i * S5C + ch], bi = c.b_im[i * S5C + ch];
            c.S5BB[(i * S5C + ch) * 2 + 0] = (float)(fr * br - fi * bi); c.S5BB[(i * S5C + ch) * 2 + 1] = (float)(fr * bi + fi * br); } }
}

HD void ph_ssq(CREF c, long gtid, long gn) {
    for (long i = gtid; i < (long)TT * 64; i += gn) { const float* p = c.X + i * 16; float s = 0.f; for (int k = 0; k < 16; ++k) s += p[k] * p[k]; c.SSQ[i] = s; }
}
HD float row_rstd(CREF c, int r) { const float* p = c.SSQ + (size_t)r * 64; float s = 0.f; for (int k = 0; k < 64; ++k) s += p[k]; return 1.0f / sqrtf(s * (1.0f / DM) + NEPS); }
HD void ph_norm(CREF c, const float* gain, long gtid, long gn) {
    for (long i = gtid; i < (long)TT * (DM / 4); i += gn) { const int r = (int)(i / (DM / 4)), c4 = (int)(i % (DM / 4)) * 4; const float rs = row_rstd(c, r);
        for (int k = 0; k < 4; ++k) c.XN[(size_t)r * DM + c4 + k] = tobf(c.X[(size_t)r * DM + c4 + k] * rs * gain[c4 + k]); }
}
HD void ph_final(CREF c, long gtid, long gn) {
    for (long i = gtid; i < (long)TT * (DM / 4); i += gn) { const int r = (int)(i / (DM / 4)), c4 = (int)(i % (DM / 4)) * 4; const float rs = row_rstd(c, r);
        for (int k = 0; k < 4; ++k) c.out[O_YP + (size_t)r * DM + c4 + k] = c.X[(size_t)r * DM + c4 + k] * rs * c.ln_f[c4 + k]; }
}

HD void ph_copy_out(CREF c, int l, long gtid, long gn) {
    for (long i = gtid; i < (long)TT * 512; i += gn) { const int r = (int)(i / 512), k = (int)(i % 512); const float v = c.PROJ[(size_t)r * PLD + C_KV + k];
        if (r < TP) c.out[O_KVP + ((size_t)l * TP + r) * 512 + k] = v; else c.out[O_KVS + ((size_t)l * TS + (r - TP)) * 512 + k] = v; }
    for (long i = gtid; i < (long)BATCH * 512 * 256; i += gn) { const int b = (int)(i / (512 * 256)), w = (int)((i / 256) % 512), k = (int)(i % 256);
        c.out[O_WINP + (size_t)l * BATCH * 512 * 256 + i] = c.PROJ[(size_t)(b * SEQ + SEQ - 512 + w) * PLD + C_KV + 512 + k]; }
    for (long i = gtid; i < (long)DB * 512 * 256; i += gn) { const int b = (int)(i / (512 * 256)), w = (int)((i / 256) % 512), k = (int)(i % 256);
        c.out[O_WINS + (size_t)l * DB * 512 * 256 + i] = (w < 512 - DSEQ) ? c.cache_win[(((size_t)l * DB + b) * 512 + w + DSEQ) * 256 + k]
                                                                          : c.PROJ[(size_t)(TP + b * DSEQ + (w - (512 - DSEQ))) * PLD + C_KV + 512 + k]; }
    for (long i = gtid; i < (long)BATCH * 3 * CONVD; i += gn) { const int b = (int)(i / (3 * CONVD)), w = (int)((i / CONVD) % 3), k = (int)(i % CONVD);
        c.out[O_CONVP + (size_t)l * BATCH * 3 * CONVD + i] = c.PROJ[(size_t)(b * SEQ + SEQ - 3 + w) * PLD + C_DNQKV + k]; }
    for (long i = gtid; i < (long)DB * 3 * CONVD; i += gn) { const int b = (int)(i / (3 * CONVD)), w = (int)((i / CONVD) % 3), k = (int)(i % CONVD);
        c.out[O_CONVS + (size_t)l * DB * 3 * CONVD + i] = c.PROJ[(size_t)(TP + b * DSEQ + DSEQ - 3 + w) * PLD + C_DNQKV + k]; }
}
HD float dn_x(CREF c, int l, const Tok& k, int r, int back, int ch) {
    const int jj = k.j - back;
    if (jj >= 0) return c.PROJ[(size_t)(r - back) * PLD + C_DNQKV + ch];
    if (!k.smp) return 0.f;
    return c.st_conv[(((size_t)l * DB + k.b) * 3 + (3 + jj)) * CONVD + ch];
}
HD float dn_conv1(CREF c, int l, const Tok& k, int r, int ch) {
    const float* w = c.conv_w + ((size_t)l * CONVD + ch) * 4; float y = 0.f;
    for (int j = 0; j < 4; ++j) y += w[j] * dn_x(c, l, k, r, 3 - j, ch);
    return siluf_(y);
}
HD void ph_dn_conv(CREF c, int l, long gtid, long gn, int rbeg = 0) {
    for (long i = gtid + (long)rbeg * 3 * DNH; i < (long)TT * 3 * DNH; i += gn) { const int r = (int)(i / (3 * DNH)), part = (int)((i / DNH) % 3), h = (int)(i % DNH); const Tok k = tok_of(r);
        const int ch0 = part * DNW + h * 64; float ss = 0.f;
        if (part < 2) for (int d = 0; d < 64; ++d) { const float y = dn_conv1(c, l, k, r, ch0 + d); ss += y * y; }
        const float sc = part == 0 ? 0.125f / sqrtf(ss + 1e-6f) : (part == 1 ? 1.0f / sqrtf(ss + 1e-6f) : 1.0f);
        float* dst = (part == 0 ? c.QN : (part == 1 ? c.KN : c.VV)) + ((size_t)r * DNH + h) * 64;
        for (int d = 0; d < 64; ++d) dst[d] = dn_conv1(c, l, k, r, ch0 + d) * sc; }
    for (long i = gtid + (long)rbeg * DNH; i < (long)TT * DNH; i += gn) { const int r = (int)(i / DNH), h = (int)(i % DNH);
        c.BETA[i] = sigmoidf_(c.PROJ[(size_t)r * PLD + C_DNB + h]);
        c.GG[i] = -expf(c.a_log[l * DNH + h]) * softplusf_(c.PROJ[(size_t)r * PLD + C_DNA + h] + c.dt_bias[l * DNH + h]); }
}
HD void ph_pool(CREF c, int l, long gtid, long gn) {
    for (long i = gtid; i < (long)NSEQ * NBMAX * 128; i += gn) { const int seq = (int)(i / (NBMAX * 128)), n = (int)((i / 128) % NBMAX), g = (int)((i / 64) % 2), d = (int)(i % 64);
        const int smp = seq >= BATCH, b = smp ? seq - BATCH : seq; if (n >= (smp ? NBC_S : NBP)) continue;
        float sk = 0.f, sv = 0.f;
        for (int j = 0; j < 64; ++j) { sk += c.wck[(l * 2 + g) * 64 + j] * kv_ptr(c, l, smp, b, n * 64 + j, 0, g)[d]; sv += c.wcv[(l * 2 + g) * 64 + j] * kv_ptr(c, l, smp, b, n * 64 + j, 1, g)[d]; }
        c.KC[i] = sk; c.VC[i] = sv; }
}
HD void s5_scan(CREF c, int l, int g, int p, int r0, int len, float& hr, float& hi, bool store) {
    const float* K = c.S5K + ((size_t)(l * S5G + g) * S5P + p) * 4; const float ar = K[0], ai = K[1];
    const float* bb = c.S5BB + ((size_t)(l * S5G + g) * S5P + p) * S5C * 2;
    for (int t = 0; t < len; ++t) { const float* u = c.PROJ + (size_t)(r0 + t) * PLD + C_S5U + g * S5C; float br = 0.f, bi = 0.f;
        for (int ch = 0; ch < S5C; ++ch) { br += bb[ch * 2] * u[ch]; bi += bb[ch * 2 + 1] * u[ch]; }
        const float nr = ar * hr - ai * hi + br, ni = ar * hi + ai * hr + bi; hr = nr; hi = ni;
        if (store) { float* hs = c.S5HS + (((size_t)(r0 + t) * S5G + g) * S5P + p) * 2; hs[0] = hr; hs[1] = hi; } }
}
HD void ph_s5_passA(CREF c, int l, long gtid, long gn) {
    for (long i = gtid; i < (long)BATCH * NCH * S5G * S5P; i += gn) { const int p = (int)(i % S5P), g = (int)((i / S5P) % S5G), ch = (int)((i / (S5P * S5G)) % NCH), b = (int)(i / ((long)S5P * S5G * NCH));
        float hr = 0.f, hi = 0.f; s5_scan(c, l, g, p, b * SEQ + ch * 64, 64, hr, hi, false); c.S5E[i * 2] = hr; c.S5E[i * 2 + 1] = hi; }
}
HD void ph_dn_gc(CREF c, long gtid, long gn) {
    for (long i = gtid; i < NDU; i += gn) { const int ch = (int)(i % NCH), h = (int)((i / NCH) % DNH), b = (int)(i / (NCH * DNH)); float s = 0.f;
        for (int t = 0; t < 64; ++t) { s += c.GG[(size_t)(b * SEQ + ch * 64 + t) * DNH + h]; c.GC[i * 64 + t] = s; } }
}
HD void ph_cmp(CREF c, int l, long gtid, long gn, int rbeg = 0) {
    for (long i = gtid + (long)rbeg * NH; i < (long)TT * NH; i += gn) { const int r = (int)(i / NH), h = (int)(i % NH), g = h / NR; const Tok k = tok_of(r);
        const float slope = exp2f(-(float)(h + 1)); const int nbv = (k.t + 1) / 64;
        const float* q = c.PROJ + (size_t)r * PLD + C_Q + h * 64; float* pc = c.PC + (size_t)i * NBMAX; float* oc = c.OC + (size_t)i * 64;
        float m = -1e30f;
        for (int n = 0; n < nbv; ++n) { const float* kc = c.KC + (((size_t)k.seq * NBMAX + n) * 2 + g) * 64; float s = 0.f; for (int d = 0; d < 64; ++d) s += q[d] * kc[d];
            s = s * 0.125f - slope * ((float)k.t - ((float)(n * 64) + 31.5f)); pc[n] = s; m = s > m ? s : m; }
        float sum = 0.f; for (int n = 0; n < nbv; ++n) { const float e = expf(pc[n] - m); pc[n] = e; sum += e; }
        const float inv = 1.0f / (sum > 1e-30f ? sum : 1e-30f);
        for (int d = 0; d < 64; ++d) oc[d] = 0.f;
        for (int n = 0; n < nbv; ++n) { const float p = pc[n] * inv; pc[n] = p; const float* vc = c.VC + (((size_t)k.seq * NBMAX + n) * 2 + g) * 64; for (int d = 0; d < 64; ++d) oc[d] += p * vc[d]; }
        for (int n = nbv; n < NBMAX; ++n) pc[n] = 0.f; }
}
HD void ph_s5_carry(CREF c, int l, long gtid, long gn) {
    for (long i = gtid; i < (long)BATCH * S5G * S5P; i += gn) { const int p = (int)(i % S5P), g = (int)((i / S5P) % S5G), b = (int)(i / (S5P * S5G));
        const float* K = c.S5K + ((size_t)(l * S5G + g) * S5P + p) * 4; const float a64r = K[2], a64i = K[3]; float hr = 0.f, hi = 0.f;
        for (int ch = 0; ch < NCH; ++ch) { const size_t e = ((((size_t)b * NCH + ch) * S5G + g) * S5P + p) * 2; c.S5HIN[e] = hr; c.S5HIN[e + 1] = hi;
            const float nr = a64r * hr - a64i * hi + c.S5E[e], ni = a64r * hi + a64i * hr + c.S5E[e + 1]; hr = nr; hi = ni; }
        c.out[O_S5RP + ((size_t)l * BATCH + b) * 1024 + g * S5P + p] = hr; c.out[O_S5IP + ((size_t)l * BATCH + b) * 1024 + g * S5P + p] = hi; }
}
HD void ph_dn_mats(CREF c, long gtid, long gn) {
    for (long i = gtid; i < (long)NDU * 4096; i += gn) { const int u = (int)(i / 4096), ii = (int)((i / 64) % 64), jj = (int)(i % 64);
        const int ch = u % NCH, h = (u / NCH) % DNH, b = u / (NCH * DNH); const int r0 = b * SEQ + ch * 64;
        float am = 0.f, aq = 0.f;
        if (jj <= ii) { const float* ki = c.KN + ((size_t)(r0 + ii) * DNH + h) * 64; const float* kj = c.KN + ((size_t)(r0 + jj) * DNH + h) * 64; const float* qi = c.QN + ((size_t)(r0 + ii) * DNH + h) * 64;
            float kk = 0.f, qk = 0.f; for (int d = 0; d < 64; ++d) { kk += ki[d] * kj[d]; qk += qi[d] * kj[d]; }
            const float dec = expf(c.GC[(size_t)u * 64 + ii] - c.GC[(size_t)u * 64 + jj]);
            aq = qk * dec; if (jj < ii) am = c.BETA[(size_t)(r0 + ii) * DNH + h] * kk * dec; }
        c.AM[i] = am; c.AQK[i] = aq; }
    for (long i = gtid; i < (long)NDU * 64 * 128; i += gn) { const int u = (int)(i / 8192), ii = (int)((i / 128) % 64), col = (int)(i % 128);
        const int ch = u % NCH, h = (u / NCH) % DNH, b = u / (NCH * DNH); const int r = b * SEQ + ch * 64 + ii; const float be = c.BETA[(size_t)r * DNH + h];
        c.SOL[i] = col < 64 ? c.VV[((size_t)r * DNH + h) * 64 + col] * be : c.KN[((size_t)r * DNH + h) * 64 + (col - 64)] * be * expf(c.GC[(size_t)u * 64 + ii]); }
}
HD void ph_topk(CREF c, long gtid, long gn, int rbeg = 0) {
    for (long i = gtid + (long)rbeg * NG; i < (long)TT * NG; i += gn) { const int r = (int)(i / NG), g = (int)(i % NG); const Tok k = tok_of(r);
        const int cur = k.t / 64, nbs = k.smp ? NBS_S : NBP; const float* pc = c.PC + ((size_t)r * NH + g * NR) * NBMAX;
        unsigned long long tk0 = 0ull, tk1 = 0ull; int* idx = c.IDX + (size_t)i * TOPK;
        const int nsel = nbs < TOPK ? nbs : TOPK;
        for (int s = 0; s < TOPK; ++s) { int best = -1; float bv = 0.f;
            if (s < nsel) for (int n = 0; n < nbs; ++n) { const bool taken = n < 64 ? ((tk0 >> n) & 1ull) : ((tk1 >> (n - 64)) & 1ull); if (taken) continue;
                float sc; if (n > cur) sc = -1e9f; else if (n == 0 || n == cur || n == cur - 1) sc = 1e9f; else sc = (pc[n] + pc[NBMAX + n]) + (pc[2 * NBMAX + n] + pc[3 * NBMAX + n]);
                if (best < 0 || sc > bv) { best = n; bv = sc; } }
            if (best >= 0) { if (best < 64) tk0 |= 1ull << best; else tk1 |= 1ull << (best - 64); }
            idx[s] = (best >= 0 && best <= cur) ? best : -1; } }
}
HD void ph_s5_passB(CREF c, int l, long gtid, long gn) {
    for (long i = gtid; i < (long)BATCH * NCH * S5G * S5P; i += gn) { const int p = (int)(i % S5P), g = (int)((i / S5P) % S5G), ch = (int)((i / (S5P * S5G)) % NCH), b = (int)(i / ((long)S5P * S5G * NCH));
        float hr = c.S5HIN[i * 2], hi = c.S5HIN[i * 2 + 1]; s5_scan(c, l, g, p, b * SEQ + ch * 64, 64, hr, hi, true); }
    for (long i = gtid; i < (long)DB * S5G * S5P; i += gn) { const int p = (int)(i % S5P), g = (int)((i / S5P) % S5G), b = (int)(i / (S5P * S5G));
        float hr = c.st_s5re[(size_t)l * DB * 1024 + i], hi = c.st_s5im[(size_t)l * DB * 1024 + i]; s5_scan(c, l, g, p, TP + b * DSEQ, DSEQ, hr, hi, true);
        c.out[O_S5RS + (size_t)l * DB * 1024 + i] = hr; c.out[O_S5IS + (size_t)l * DB * 1024 + i] = hi; }
}
HD void ph_dn_solve(CREF c, long gtid, long gn) {
    for (long i = gtid; i < (long)NDU * 128; i += gn) { const int u = (int)(i / 128), col = (int)(i % 128); float* x = c.SOL + (size_t)u * 8192 + col; const float* A = c.AM + (size_t)u * 4096;
        for (int ii = 1; ii < 64; ++ii) { float s = x[ii * 128]; for (int jj = 0; jj < ii; ++jj) s -= A[ii * 64 + jj] * x[jj * 128]; x[ii * 128] = s; } }
}
HD void ph_attn(CREF c, int l, long gtid, long gn, int rbeg = 0) {
    for (long i = gtid + (long)rbeg * NH; i < (long)TT * NH; i += gn) { const int r = (int)(i / NH), h = (int)(i % NH), g = h / NR; const Tok k = tok_of(r);
        const float slope = exp2f(-(float)(h + 1));
        float q[64];
#pragma unroll
        for (int d = 0; d < 64; ++d) q[d] = c.PROJ[(size_t)r * PLD + C_Q + h * 64 + d] * 0.125f;
        const float* gp = c.PROJ + (size_t)r * PLD + C_GATE + h * 3; const float g0 = sigmoidf_(gp[0]), g1 = sigmoidf_(gp[1]), g2 = sigmoidf_(gp[2]);
        float* oc = c.OC + (size_t)i * 64;
        float o[64]; float m = -1e30f, lsum = 0.f;
#pragma unroll
        for (int d = 0; d < 64; ++d) o[d] = 0.f;
        const int* idx = c.IDX + ((size_t)r * NG + g) * TOPK;
        for (int s = 0; s < TOPK; ++s) { const int n = idx[s]; if (n < 0) continue;
            for (int j = 0; j < 64; ++j) { const int pos = n * 64 + j; if (pos > k.t) break;
                const float* kp = kv_ptr(c, l, k.smp, k.b, pos, 2, g); const float* vp = kv_ptr(c, l, k.smp, k.b, pos, 3, g);
                float sc = 0.f;
#pragma unroll
                for (int d = 0; d < 64; ++d) sc += q[d] * kp[d];
                sc -= slope * (float)(k.t - pos);
                const float mn = sc > m ? sc : m, al = expf(m - mn), p = expf(sc - mn); m = mn; lsum = lsum * al + p;
#pragma unroll
                for (int d = 0; d < 64; ++d) o[d] = o[d] * al + p * vp[d]; } }
        { const float inv = g1 / (lsum > 1e-30f ? lsum : 1e-30f);
#pragma unroll
          for (int d = 0; d < 64; ++d) oc[d] = g0 * oc[d] + inv * o[d]; }
        m = -1e30f; lsum = 0.f;
#pragma unroll
        for (int d = 0; d < 64; ++d) o[d] = 0.f;
        const int w0 = k.smp ? W0S : 0; int p0 = k.t - (WIN - 1); if (p0 < w0) p0 = w0;
        for (int pos = p0; pos <= k.t; ++pos) { const float* kp = kv_ptr(c, l, k.smp, k.b, pos, 4, g); const float* vp = kv_ptr(c, l, k.smp, k.b, pos, 5, g);
            float sc = 0.f;
#pragma unroll
            for (int d = 0; d < 64; ++d) sc += q[d] * kp[d];
            sc -= slope * (float)(k.t - pos);
            const float mn = sc > m ? sc : m, al = expf(m - mn), p = expf(sc - mn); m = mn; lsum = lsum * al + p;
#pragma unroll
            for (int d = 0; d < 64; ++d) o[d] = o[d] * al + p * vp[d]; }
        { const float inv = g2 / (lsum > 1e-30f ? lsum : 1e-30f);
#pragma unroll
          for (int d = 0; d < 64; ++d) c.MIXB[(size_t)r * DM + h * 64 + d] = tobf(oc[d] + inv * o[d]); } }
}
HD void ph_s5_y(CREF c, int l, long gtid, long gn) {
    for (long i = gtid; i < (long)TT * 256; i += gn) { const int r = (int)(i / 256), ch = (int)(i % 256), g = ch / S5C, cc = ch % S5C;
        const float* cr = c.c_re + (((size_t)l * S5G + g) * S5C + cc) * S5P; const float* ci = c.c_im + (((size_t)l * S5G + g) * S5C + cc) * S5P;
        const float* hs = c.S5HS + ((size_t)r * S5G + g) * S5P * 2; float y = 0.f;
        for (int p = 0; p < S5P; ++p) y += cr[p] * hs[2 * p] - ci[p] * hs[2 * p + 1];
        y += c.s5_d[l * 256 + ch] * c.PROJ[(size_t)r * PLD + C_S5U + ch]; c.GL[i] = geluf_(y); }
}
HD void ph_dn_scan_prompt(CREF c, int l, long gtid, long gn) {
    for (long i = gtid; i < (long)BATCH * DNH * 64; i += gn) { const int jc = (int)(i % 64), h = (int)((i / 64) % DNH), b = (int)(i / (64 * DNH));
        float S[64];
#pragma unroll
        for (int kk = 0; kk < 64; ++kk) S[kk] = 0.f;
        float* vn = c.VNEW + (size_t)(b * DNH + h) * 4096 + jc;
        for (int ch = 0; ch < NCH; ++ch) { const int u = (b * DNH + h) * NCH + ch; const int r0 = b * SEQ + ch * 64;
            const float* sol = c.SOL + (size_t)u * 8192; const float* gc = c.GC + (size_t)u * 64; const float* aqk = c.AQK + (size_t)u * 4096;
            for (int t = 0; t < 64; ++t) { const float* w = sol + t * 128 + 64; float s = sol[t * 128 + jc];
#pragma unroll
                for (int kk = 0; kk < 64; ++kk) s -= w[kk] * S[kk];
                vn[t * 64] = s; }
            for (int t = 0; t < 64; ++t) { const float* qq = c.QN + ((size_t)(r0 + t) * DNH + h) * 64; float s = 0.f;
#pragma unroll
                for (int kk = 0; kk < 64; ++kk) s += qq[kk] * S[kk];
                s *= expf(gc[t]);
                for (int t2 = 0; t2 <= t; ++t2) s += aqk[t * 64 + t2] * vn[t2 * 64];
                c.ODN[((size_t)(r0 + t) * DNH + h) * 64 + jc] = s; }
            const float gl = gc[63], eg = expf(gl);
#pragma unroll
            for (int kk = 0; kk < 64; ++kk) S[kk] *= eg;
            for (int t = 0; t < 64; ++t) { const float* kk_ = c.KN + ((size_t)(r0 + t) * DNH + h) * 64; const float f = expf(gl - gc[t]) * vn[t * 64];
#pragma unroll
                for (int kk = 0; kk < 64; ++kk) S[kk] += kk_[kk] * f; } }
#pragma unroll
        for (int kk = 0; kk < 64; ++kk) c.out[O_DNP + (((size_t)l * BATCH + b) * DNH + h) * 4096 + kk * 64 + jc] = S[kk]; }
}
HD void ph_dn_scan_sample(CREF c, int l, long gtid, long gn) {
    for (long i = gtid; i < (long)DB * DNH * 64; i += gn) { const int jc = (int)(i % 64), h = (int)((i / 64) % DNH), b = (int)(i / (64 * DNH));
        float S[64]; const float* s0 = c.st_dn + (((size_t)l * DB + b) * DNH + h) * 4096 + jc;
#pragma unroll
        for (int kk = 0; kk < 64; ++kk) S[kk] = s0[kk * 64];
        for (int t = 0; t < DSEQ; ++t) { const int r = TP + b * DSEQ + t; const float* kv = c.KN + ((size_t)r * DNH + h) * 64; const float* qq = c.QN + ((size_t)r * DNH + h) * 64;
            const float a = expf(c.GG[(size_t)r * DNH + h]), be = c.BETA[(size_t)r * DNH + h]; float ks = 0.f;
#pragma unroll
            for (int kk = 0; kk < 64; ++kk) { S[kk] *= a; ks += kv[kk] * S[kk]; }
            const float vnw = be * (c.VV[((size_t)r * DNH + h) * 64 + jc] - ks); float os = 0.f;
#pragma unroll
            for (int kk = 0; kk < 64; ++kk) { S[kk] += kv[kk] * vnw; os += qq[kk] * S[kk]; }
            c.ODN[((size_t)r * DNH + h) * 64 + jc] = os; }
#pragma unroll
        for (int kk = 0; kk < 64; ++kk) c.out[O_DNS + (((size_t)l * DB + b) * DNH + h) * 4096 + kk * 64 + jc] = S[kk]; }
}
HD void ph_s5_glu(CREF c, int l, long gtid, long gn) {
    for (long i = gtid; i < (long)TT * 256; i += gn) { const int r = (int)(i / 256), ch = (int)(i % 256); const float* gl = c.GL + (size_t)r * 256; const float* w = c.w_glu + (size_t)l * 65536 + ch; float z = 0.f;
        for (int kk = 0; kk < 256; ++kk) z += gl[kk] * w[kk * 256];
        c.MIXB[(size_t)r * DM + 768 + ch] = tobf(gl[ch] * sigmoidf_(z)); }
}
HD void ph_dn_out(CREF c, int l, long gtid, long gn) {
    for (long i = gtid; i < (long)TT * DNH; i += gn) { const int r = (int)(i / DNH), h = (int)(i % DNH); const float* o = c.ODN + (size_t)i * 64; float ss = 0.f;
        for (int d = 0; d < 64; ++d) ss += o[d] * o[d];
        const float rs = 1.0f / sqrtf(ss * (1.0f / 64.0f) + NEPS);
        for (int d = 0; d < 64; ++d) c.MIXB[(size_t)r * DM + 512 + h * 64 + d] = tobf(o[d] * rs * c.dn_norm_w[l * 64 + d] * siluf_(c.PROJ[(size_t)r * PLD + C_DNZ + h * 64 + d])); }
}
namespace pg8 {
#define PG8_LAS __attribute__((address_space(3)))
typedef unsigned short bf16_t;
typedef short bf16x8 __attribute__((ext_vector_type(8)));
typedef float f32x4 __attribute__((ext_vector_type(4)));
typedef unsigned u32x4 __attribute__((ext_vector_type(4)));
constexpr int BM = 256, BK = 64, HALF = 128, HTB = HALF * BK * 2  , STAGE_BYTES = 8 * HTB, NXCD = 8, WGM = 8;

__host__ __device__ __forceinline__ int lds_byte(int r, int c) { const int st = (r >> 4) * 2 + (c >> 5), rr = r & 15, cc = c & 31, ob = rr * 64 + cc * 2; return st * 1024 + (ob ^ (((ob >> 9) & 1) << 5)); }
__host__ __device__ __forceinline__ void stage_rc(int b, int& R, int& C) { const int st = b / 1024, sb = b % 1024, swz = sb ^ (((sb >> 9) & 1) << 5); R = (st >> 1) * 16 + swz / 64; C = (st & 1) * 32 + (swz % 64) / 2; }
__host__ __device__ __forceinline__ int perm32(int rho) { const int n = rho >> 4, i = rho & 15; return 8 * (i >> 2) + 4 * n + (i & 3); }

struct Unit { int pm, pn; };
struct Gemm { const bf16_t* A; const bf16_t* Bt; int M, N, K, ld; };

struct StaticOrder {
    int nM, nN, nwg, G, c;
    __host__ __device__ void init(int M, int N, int G_, int c_) { nM = M / BM; nN = N / BM; nwg = nM * nN; G = G_; c = c_; }
    __host__ __device__ bool next(int i, Unit& u) const {
        const long L = (long)i * G + c; if (L >= nwg) return false;
        int wgid = (int)L; { const int q = nwg / NXCD, r = nwg % NXCD, xcd = wgid % NXCD, off = wgid / NXCD; wgid = (xcd < r ? xcd * (q + 1) : r * (q + 1) + (xcd - r) * q) + off; }
        const int nig = WGM * nN, gid = wgid / nig, fm = gid * WGM, gsz = (nM - fm) < WGM ? (nM - fm) : WGM;
        u.pm = fm + ((wgid % nig) % gsz); u.pn = (wgid % nig) / gsz; return true;
    }
    __device__ __forceinline__ void a_ready(const Unit&) const {}
    __device__ __forceinline__ void done(const Unit&) const {}
};

__device__ __forceinline__ unsigned cvt_pk_bf16(float lo, float hi) { unsigned r; asm volatile("v_cvt_pk_bf16_f32 %0, %1, %2" : "=v"(r) : "v"(lo), "v"(hi)); return r; }
typedef float f32x2 __attribute__((ext_vector_type(2)));
template <class Epi, class Sched, bool ALIGN_EPI = false, bool SP2 = false>
__device__ __forceinline__ void gemm_phase(PG8_LAS unsigned char* lds, const Gemm g, const Sched& S, const Epi& E, int tid_) {
    asm volatile("" : "+v"(tid_));
    const int tid = tid_, wid = __builtin_amdgcn_readfirstlane(tid >> 6), lane = tid & 63, wr = wid >> 2, wc = wid & 3, fr = lane & 15, fq = lane >> 4;
    const int K = g.K, nt = K / BK;
    unsigned voffA[2], voffB[2];
#pragma unroll
    for (int i = 0; i < 2; ++i) { int R, C; stage_rc(tid * 16 + i * 8192, R, C); const int Rb = Epi::PERM ? ((R & ~31) + perm32(R & 31)) : R;
        voffA[i] = (unsigned)(R * g.ld + C) * 2u; voffB[i] = (unsigned)(Rb * g.ld + C) * 2u; }
    const size_t kstep = (size_t)(BK * 2);
    const size_t hstep = (size_t)HALF * g.ld * 2;
    const size_t tstep = 2 * hstep;
    const unsigned ldsw = (unsigned)wid * 1024u;
    const int aoff = lds_byte(wr * 64 + fr, fq * 8), boff = lds_byte(wc * 32 + fr, fq * 8);
#define PG8_SA(b, h) (((b) * 2 + (h)) * HTB)
#define PG8_SB(b, h) ((4 + (b) * 2 + (h)) * HTB)
#define PG8_STAGE(bufoff, gbase, voff) do { _Pragma("unroll") for (int _i = 0; _i < 2; ++_i) \
        __builtin_amdgcn_global_load_lds((const unsigned*)((const char*)(gbase) + (voff)[_i]), (PG8_LAS unsigned*)(lds + (bufoff) + ldsw + _i * 8192), 16, 0, 0); } while (0)
#define PG8_LDA(dst, b, h) do { _Pragma("unroll") for (int m = 0; m < 4; ++m) _Pragma("unroll") for (int k = 0; k < 2; ++k) dst[m][k] = *(const PG8_LAS bf16x8*)(lds + PG8_SA(b, h) + aoff + m * 2048 + k * 1024); } while (0)
#define PG8_LDB(dst, b, h) do { _Pragma("unroll") for (int n = 0; n < 2; ++n) _Pragma("unroll") for (int k = 0; k < 2; ++k) dst[n][k] = *(const PG8_LAS bf16x8*)(lds + PG8_SB(b, h) + boff + n * 2048 + k * 1024); } while (0)
#define PG8_MMA(ai, bj, At, Bt) do { __builtin_amdgcn_s_setprio(1); _Pragma("unroll") for (int m = 0; m < 4; ++m) _Pragma("unroll") for (int n = 0; n < 2; ++n) _Pragma("unroll") for (int k = 0; k < 2; ++k) \
        acc[ai][bj][m][n] = __builtin_amdgcn_mfma_f32_16x16x32_bf16(Bt[n][k], At[m][k], acc[ai][bj][m][n], 0, 0, 0); __builtin_amdgcn_s_setprio(0); } while (0)
#define PG8_WAIT_V(n) asm volatile("s_waitcnt vmcnt(" #n ")" ::: "memory")
#define PG8_WAIT_L(n) asm volatile("s_waitcnt lgkmcnt(" #n ")" ::: "memory")
#define PG8_BAR __builtin_amdgcn_s_barrier()
#define PG8_SCHED __builtin_amdgcn_sched_barrier(0)
    Unit cur, nxt; int ui = 0;
    if (!S.next(0, cur)) return;
    f32x4 acc[2][2][4][2];
#pragma unroll
    for (int a = 0; a < 2; ++a)
#pragma unroll
        for (int b = 0; b < 2; ++b)
#pragma unroll
            for (int m = 0; m < 4; ++m)
#pragma unroll
                for (int n = 0; n < 2; ++n) acc[a][b][m][n] = (f32x4){0.f, 0.f, 0.f, 0.f};
    bf16x8 At[4][2], B0[2][2], B1[2][2];
    const char* cA = (const char*)g.A + (size_t)cur.pm * tstep; const char* cB = (const char*)g.Bt + (size_t)cur.pn * tstep;
    S.a_ready(cur);
    if constexpr (SP2) {
        PG8_STAGE(PG8_SB(0, 0), cB, voffB); PG8_STAGE(PG8_SB(0, 1), cB + hstep, voffB); PG8_STAGE(PG8_SA(0, 0), cA, voffA); PG8_STAGE(PG8_SA(0, 1), cA + hstep, voffA);
        if (wr == 1) PG8_BAR;
        PG8_WAIT_V(2); PG8_BAR;
        PG8_STAGE(PG8_SB(1, 0), cB + kstep, voffB); PG8_STAGE(PG8_SA(1, 0), cA + kstep, voffA); PG8_STAGE(PG8_SB(1, 1), cB + hstep + kstep, voffB);
        PG8_WAIT_V(6); PG8_BAR;
    } else {
        PG8_STAGE(PG8_SB(0, 0), cB, voffB); PG8_STAGE(PG8_SA(0, 0), cA, voffA); PG8_STAGE(PG8_SB(0, 1), cB + hstep, voffB); PG8_STAGE(PG8_SA(0, 1), cA + hstep, voffA);
        if (wr == 1) PG8_BAR;
        PG8_WAIT_V(4); PG8_BAR;
        PG8_STAGE(PG8_SB(1, 0), cB + kstep, voffB); PG8_STAGE(PG8_SA(1, 0), cA + kstep, voffA); PG8_STAGE(PG8_SB(1, 1), cB + hstep + kstep, voffB);
        PG8_WAIT_V(6); PG8_BAR;
    }
    for (;;) {
        const bool has_next = S.next(ui + 1, nxt);
        const char* nA = has_next ? (const char*)g.A + (size_t)nxt.pm * tstep : cA; const char* nB = has_next ? (const char*)g.Bt + (size_t)nxt.pn * tstep : cB;
        for (int t = 0; t < nt; t += 2) {
            const bool last = (t == nt - 2);
            const char* a1 = cA + (size_t)(t + 1) * kstep;
            const char* a2 = last ? nA : cA + (size_t)(t + 2) * kstep; const char* b2 = last ? nB : cB + (size_t)(t + 2) * kstep;
            const char* a3 = a2 + kstep; const char* b3 = b2 + kstep;
            if (last && has_next) S.a_ready(nxt);
            if constexpr (SP2) {
            PG8_LDB(B0, 0, 0); PG8_LDB(B1, 0, 1); PG8_SCHED; PG8_LDA(At, 0, 0); PG8_STAGE(PG8_SA(1, 1), a1 + hstep, voffA);
            PG8_WAIT_V(8); PG8_WAIT_L(0); PG8_BAR; PG8_MMA(0, 0, At, B0); PG8_MMA(0, 1, At, B1); PG8_BAR; PG8_SCHED;
            PG8_LDA(At, 0, 1); PG8_STAGE(PG8_SB(0, 0), b2, voffB); PG8_STAGE(PG8_SB(0, 1), b2 + hstep, voffB); PG8_STAGE(PG8_SA(0, 0), a2, voffA);
            PG8_WAIT_V(8); PG8_WAIT_L(0); PG8_BAR; PG8_MMA(1, 0, At, B0); PG8_MMA(1, 1, At, B1); PG8_BAR; PG8_SCHED;
            PG8_LDB(B0, 1, 0); PG8_LDB(B1, 1, 1); PG8_SCHED; PG8_LDA(At, 1, 0); PG8_STAGE(PG8_SA(0, 1), a2 + hstep, voffA);
            PG8_WAIT_V(8); PG8_WAIT_L(0); PG8_BAR; PG8_MMA(0, 0, At, B0); PG8_MMA(0, 1, At, B1); PG8_BAR; PG8_SCHED;
            PG8_LDA(At, 1, 1); PG8_STAGE(PG8_SB(1, 0), b3, voffB); PG8_STAGE(PG8_SB(1, 1), b3 + hstep, voffB); PG8_STAGE(PG8_SA(1, 0), a3, voffA);
            PG8_WAIT_V(8); PG8_WAIT_L(0); PG8_BAR; PG8_MMA(1, 0, At, B0); PG8_MMA(1, 1, At, B1); PG8_BAR; PG8_SCHED;
            } else {
            PG8_LDB(B0, 0, 0); PG8_SCHED; PG8_LDA(At, 0, 0); PG8_STAGE(PG8_SA(1, 1), a1 + hstep, voffA);
            PG8_WAIT_L(8); PG8_BAR; PG8_WAIT_L(0); PG8_MMA(0, 0, At, B0); PG8_BAR; PG8_SCHED;
            PG8_LDB(B1, 0, 1); PG8_STAGE(PG8_SB(0, 0), b2, voffB);
            PG8_BAR; PG8_WAIT_L(0); PG8_MMA(0, 1, At, B1); PG8_BAR;
            PG8_LDA(At, 0, 1); PG8_STAGE(PG8_SA(0, 0), a2, voffA);
            PG8_BAR; PG8_WAIT_L(0); PG8_MMA(1, 0, At, B0); PG8_BAR; PG8_SCHED;
            PG8_STAGE(PG8_SB(0, 1), b2 + hstep, voffB);
            PG8_WAIT_V(6); PG8_BAR; PG8_MMA(1, 1, At, B1); PG8_BAR;
            PG8_LDB(B0, 1, 0); PG8_SCHED; PG8_LDA(At, 1, 0); PG8_STAGE(PG8_SA(0, 1), a2 + hstep, voffA);
            PG8_WAIT_L(8); PG8_BAR; PG8_WAIT_L(0); PG8_MMA(0, 0, At, B0); PG8_BAR; PG8_SCHED;
            PG8_LDB(B1, 1, 1); PG8_STAGE(PG8_SB(1, 0), b3, voffB);
            PG8_BAR; PG8_WAIT_L(0); PG8_MMA(0, 1, At, B1); PG8_BAR;
            PG8_LDA(At, 1, 1); PG8_STAGE(PG8_SA(1, 0), a3, voffA);
            PG8_BAR; PG8_WAIT_L(0); PG8_MMA(1, 0, At, B0); PG8_BAR; PG8_SCHED;
            PG8_STAGE(PG8_SB(1, 1), b3 + hstep, voffB);
            PG8_WAIT_V(6); PG8_BAR; PG8_MMA(1, 1, At, B1); PG8_BAR;
            }
        }
        if constexpr (ALIGN_EPI) { if (wr == 0) PG8_BAR; }
        if constexpr (!Epi::AFTER_DRAIN) { E(acc, cur, wr, wc, fr, fq); S.done(cur); }
        if (!has_next) break;
#pragma unroll
        for (int a = 0; a < 2; ++a)
#pragma unroll
            for (int b = 0; b < 2; ++b)
#pragma unroll
                for (int m = 0; m < 4; ++m)
#pragma unroll
                    for (int n = 0; n < 2; ++n) acc[a][b][m][n] = (f32x4){0.f, 0.f, 0.f, 0.f};
        cur = nxt; cA = nA; cB = nB; ++ui;
        if constexpr (ALIGN_EPI) { if (wr == 1) PG8_BAR; }
    }
    PG8_WAIT_V(0);
    if constexpr (!ALIGN_EPI) { if (wr == 0) PG8_BAR; }
    PG8_BAR;
    if constexpr (Epi::AFTER_DRAIN) { E.fused(acc, cur, wr, wc, fr, fq, lds, wid, lane); S.done(cur); }
#undef PG8_SA
#undef PG8_SB
#undef PG8_STAGE
#undef PG8_LDA
#undef PG8_LDB
#undef PG8_MMA
#undef PG8_WAIT_V
#undef PG8_WAIT_L
#undef PG8_BAR
#undef PG8_SCHED
}
}
#define LAS __attribute__((address_space(3)))
typedef short bf16x8_t __attribute__((ext_vector_type(8)));
typedef float f32x4_t __attribute__((ext_vector_type(4)));
typedef float f32x2_t __attribute__((ext_vector_type(2)));
typedef __bf16 bf16x2_t __attribute__((ext_vector_type(2)));
typedef unsigned u32x4_t __attribute__((ext_vector_type(4)));
typedef unsigned u32x2_t __attribute__((ext_vector_type(2)));
#define DEV __device__ __forceinline__
DEV unsigned cvtpk(float lo, float hi) { f32x2_t v = {lo, hi}; bf16x2_t b = __builtin_convertvector(v, bf16x2_t); return __builtin_bit_cast(unsigned, b); }
DEV bf16x8_t pack8(const f32x4_t a, const f32x4_t b) { u32x4_t p = {cvtpk(a[0], a[1]), cvtpk(a[2], a[3]), cvtpk(b[0], b[1]), cvtpk(b[2], b[3])}; return __builtin_bit_cast(bf16x8_t, p); }
#define MFMA16(a, b, c) __builtin_amdgcn_mfma_f32_16x16x32_bf16((a), (b), (c), 0, 0, 0)

constexpr int DNS_FB = 8192, DNS_US = 68, DNS_BUF = 4 * DNS_FB + 64 * DNS_US * 4;
struct DnStage { f32x4_t w[4], q[4], a[4], uu[4]; float k[16], gj[16]; float grow, gl; };
DEV void dn_scan_load(CREF c, DnStage& st, int u, int r0, int h, int pt) {
    const int row = pt >> 2, q = pt & 3;
    const float* sol = c.SOL + (size_t)u * 8192; const float* gc = c.GC + (size_t)u * 64;
    const f32x4_t* sw = (const f32x4_t*)(sol + row * 128 + 64 + 16 * q); const f32x4_t* su = (const f32x4_t*)(sol + row * 128 + 16 * q);
    const f32x4_t* sq = (const f32x4_t*)(c.QN + ((size_t)(r0 + row) * DNH + h) * 64 + 16 * q); const f32x4_t* sa = (const f32x4_t*)(c.AQK + (size_t)u * 4096 + row * 64 + 16 * q);
#pragma unroll
    for (int kb = 0; kb < 4; ++kb) { st.w[kb] = sw[kb]; st.uu[kb] = su[kb]; st.q[kb] = sq[kb]; st.a[kb] = sa[kb]; }
#pragma unroll
    for (int e = 0; e < 16; ++e) { const int j = 16 * q + e; st.k[e] = c.KN[((size_t)(r0 + j) * DNH + h) * 64 + row]; st.gj[e] = gc[j]; }
    st.grow = gc[row]; st.gl = gc[63];
}
DEV void dn_scan_store(const DnStage& st, LAS unsigned char* dst, int pt) {
    const int row = pt >> 2, q = pt & 3, ks = q >> 1, jh = q & 1, mt = row >> 4, m = row & 15;
    const int fo = ((mt * 2 + ks) * 64 + m) * 16 + jh * 8;
    const float e = expf(st.grow);
    LAS float* ut = (LAS float*)(dst + 4 * DNS_FB);
#pragma unroll
    for (int kb = 0; kb < 4; ++kb) {
        { const f32x4_t v = st.w[kb]; u32x2_t w = {cvtpk(v[0], v[1]), cvtpk(v[2], v[3])}; *(LAS u32x2_t*)(dst + 0 * DNS_FB + fo + kb * 256) = w; }
        { const f32x4_t v = st.q[kb] * e; u32x2_t w = {cvtpk(v[0], v[1]), cvtpk(v[2], v[3])}; *(LAS u32x2_t*)(dst + 1 * DNS_FB + fo + kb * 256) = w; }
        { const f32x4_t v = st.a[kb]; u32x2_t w = {cvtpk(v[0], v[1]), cvtpk(v[2], v[3])}; *(LAS u32x2_t*)(dst + 2 * DNS_FB + fo + kb * 256) = w; }
        { float v[4];
#pragma unroll
          for (int jl = 0; jl < 4; ++jl) v[jl] = st.k[4 * kb + jl] * expf(st.gl - st.gj[4 * kb + jl]);
          u32x2_t w = {cvtpk(v[0], v[1]), cvtpk(v[2], v[3])}; *(LAS u32x2_t*)(dst + 3 * DNS_FB + fo + kb * 256) = w; }
#pragma unroll
        for (int jl = 0; jl < 4; ++jl) ut[(16 * q + 4 * kb + jl) * DNS_US + row] = st.uu[kb][jl]; }
}
DEV void dn_scan_mfma(CREF c, int l, LAS unsigned char* L, int bh, int tid) {
    asm volatile("" : "+v"(tid));
    const int b = bh / DNH, h = bh % DNH, wid = tid >> 6, lane = tid & 63, n = lane & 15, kb = lane >> 4;
    const bool producer = wid >= 4;
    const int v = 16 * (wid & 3) + n;
    f32x4_t S[4];
#pragma unroll
    for (int mt = 0; mt < 4; ++mt) S[mt] = (f32x4_t){0.f, 0.f, 0.f, 0.f};
    const int u0 = (b * DNH + h) * NCH;
    DnStage st;
    if (producer) { dn_scan_load(c, st, u0, b * SEQ, h, tid - 256); dn_scan_store(st, L, tid - 256); dn_scan_load(c, st, u0 + 1, b * SEQ + 64, h, tid - 256); }
    for (int ch = 0; ch < NCH; ++ch) {
        __syncthreads();
        const int u = u0 + ch, r0 = b * SEQ + ch * 64;
        if (producer) { if (ch + 1 < NCH) { dn_scan_store(st, L + ((ch + 1) & 1) * DNS_BUF, tid - 256);
                                            if (ch + 2 < NCH) dn_scan_load(c, st, u + 2, r0 + 128, h, tid - 256); } }
        else {
            const LAS unsigned char* fb = L + (ch & 1) * DNS_BUF + lane * 16;
            const LAS float* ut = (const LAS float*)(L + (ch & 1) * DNS_BUF + 4 * DNS_FB) + v * DNS_US + 4 * kb;
#define DNS_FR(mat, mt, ks) (*(const LAS bf16x8_t*)(fb + (mat) * DNS_FB + ((mt) * 2 + (ks)) * 1024))
            const float eg = expf(c.GC[(size_t)u * 64 + 63]);
            const bf16x8_t Sb0 = pack8(S[0], S[1]), Sb1 = pack8(S[2], S[3]);
            f32x4_t ws[4], qs[4], ds[4], vn[4];
            const f32x4_t z4 = {0.f, 0.f, 0.f, 0.f};
#pragma unroll
            for (int mt = 0; mt < 4; ++mt) { ws[mt] = MFMA16(DNS_FR(0, mt, 0), Sb0, z4); ws[mt] = MFMA16(DNS_FR(0, mt, 1), Sb1, ws[mt]);
                                             qs[mt] = MFMA16(DNS_FR(1, mt, 0), Sb0, z4); qs[mt] = MFMA16(DNS_FR(1, mt, 1), Sb1, qs[mt]); }
#pragma unroll
            for (int mt = 0; mt < 4; ++mt) vn[mt] = *(const LAS f32x4_t*)(ut + 16 * mt) - ws[mt];
            const bf16x8_t Vb0 = pack8(vn[0], vn[1]), Vb1 = pack8(vn[2], vn[3]);
#pragma unroll
            for (int mt = 0; mt < 4; ++mt) { qs[mt] = MFMA16(DNS_FR(2, mt, 0), Vb0, qs[mt]); qs[mt] = MFMA16(DNS_FR(2, mt, 1), Vb1, qs[mt]);
                                             ds[mt] = MFMA16(DNS_FR(3, mt, 0), Vb0, z4); ds[mt] = MFMA16(DNS_FR(3, mt, 1), Vb1, ds[mt]); }
#pragma unroll
            for (int mt = 0; mt < 4; ++mt) { S[mt] = S[mt] * eg + ds[mt];
#pragma unroll
                for (int i = 0; i < 4; ++i) c.ODN[((size_t)(r0 + 16 * mt + 4 * kb + i) * DNH + h) * 64 + v] = qs[mt][i]; }
#undef DNS_FR
        }
    }
    if (!producer) {
#pragma unroll
        for (int mt = 0; mt < 4; ++mt)
#pragma unroll
            for (int i = 0; i < 4; ++i) c.out[O_DNP + (((size_t)l * BATCH + b) * DNH + h) * 4096 + (16 * mt + 4 * kb + i) * 64 + v] = S[mt][i];
    }
    __syncthreads();
}

DEV float wave_sum(float v) {
#pragma unroll
    for (int o = 1; o < 64; o <<= 1) v += __shfl_xor(v, o);
    return v;
}
DEV void transpose_item(const float* W, int K, int N, bf16_t* WT, LAS float* scr, int item, int lane) {
    const int nblk = N / 32, kb = item / nblk, nb = item % nblk, k0 = 64 * kb, n0 = 32 * nb;
#pragma unroll 8
    for (int i = 0; i < 32; ++i) { const int kk = 2 * i + (lane >> 5); scr[kk * 33 + (lane & 31)] = W[(size_t)(k0 + kk) * N + n0 + (lane & 31)]; }
    asm volatile("s_waitcnt lgkmcnt(0)" ::: "memory");
    const int cch = lane & 7;
#pragma unroll
    for (int j = 0; j < 4; ++j) { const int n = (lane >> 3) + 8 * j; const LAS float* s = scr + (8 * cch) * 33 + n;
        u32x4_t o; o.x = cvtpk(s[0 * 33], s[1 * 33]); o.y = cvtpk(s[2 * 33], s[3 * 33]); o.z = cvtpk(s[4 * 33], s[5 * 33]); o.w = cvtpk(s[6 * 33], s[7 * 33]);
        *(u32x4_t*)(WT + (size_t)(n0 + n) * K + k0 + 8 * cch) = o; }
    asm volatile("s_waitcnt lgkmcnt(0)" ::: "memory");
}
DEV void dev_prologue(CREF c, LAS unsigned char* L, int bx, int tid, long gtid, long gn) {
    const int wave = tid >> 6, lane = tid & 63, gw = bx * 8 + wave, NGW = (int)gridDim.x * 8;
    LAS float* scr = (LAS float*)(L + wave * 16384);
    constexpr int I_IN = (DM / 64) * (INW / 32), I_OUT = (DM / 64) * (DM / 32), I_UP = (DM / 64) * (DFF / 32), I_DN = (DFF / 64) * (DM / 32), I_GL = (256 / 64) * (256 / 32), I_L = I_IN + I_OUT + I_UP + I_DN + I_GL;
    for (int it = gw; it < 2 * I_L; it += NGW) { const int l = it / I_L; int r = it % I_L;
        if (r < I_IN) { transpose_item(c.w_in + (size_t)l * DM * INW, DM, INW, c.WIN_T + (size_t)l * PLD * DM, scr, r, lane); continue; } r -= I_IN;
        if (r < I_OUT) { transpose_item(c.w_out + (size_t)l * DM * DM, DM, DM, c.WOUT_T + (size_t)l * DM * DM, scr, r, lane); continue; } r -= I_OUT;
        if (r < I_UP) { transpose_item(c.mlp_up + (size_t)l * DM * DFF, DM, DFF, c.WUP_T + (size_t)l * DFF * DM, scr, r, lane); continue; } r -= I_UP;
        if (r < I_DN) { transpose_item(c.mlp_down + (size_t)l * DFF * DM, DFF, DM, c.WDN_T + (size_t)l * DM * DFF, scr, r, lane); continue; } r -= I_DN;
        transpose_item(c.w_glu + (size_t)l * 65536, 256, 256, c.WGLU_T + (size_t)l * 65536, scr, r, lane); }
    for (long i = gtid; i < (long)2 * (PLD - INW) * DM / 8; i += gn) { const int l = (int)(i / ((PLD - INW) * DM / 8)); const long r = i % ((PLD - INW) * DM / 8);
        *(u32x4_t*)(c.WIN_T + ((size_t)l * PLD + INW) * DM + r * 8) = (u32x4_t){0u, 0u, 0u, 0u}; }
    { f32x4_t g[4];
#pragma unroll
      for (int j = 0; j < 4; ++j) g[j] = ((const f32x4_t*)c.ln1)[lane + 64 * j];
      for (int r = gw; r < TT; r += NGW) { const f32x4_t* xr = (const f32x4_t*)(r < TP ? c.x_prompt + (size_t)r * DM : c.x_sample + (size_t)(r - TP) * DM) + lane; f32x4_t v[4]; float s = 0.f;
#pragma unroll
        for (int j = 0; j < 4; ++j) { v[j] = xr[64 * j]; s += (v[j][0] * v[j][0] + v[j][1] * v[j][1]) + (v[j][2] * v[j][2] + v[j][3] * v[j][3]); ((f32x4_t*)(c.X + (size_t)r * DM))[lane + 64 * j] = v[j]; }
        const float rs = 1.0f / sqrtf(wave_sum(s) * (1.0f / DM) + NEPS);
#pragma unroll
        for (int j = 0; j < 4; ++j) { const f32x4_t o = v[j] * rs * g[j]; u32x2_t w = {cvtpk(o[0], o[1]), cvtpk(o[2], o[3])}; ((u32x2_t*)(c.XN + (size_t)r * DM))[lane + 64 * j] = w; } } }
}
template <bool FINAL> DEV void dev_rmsnorm(CREF c, const float* gain, int bx, int tid, int nsplit) {
    const int wave = tid >> 6, lane = tid & 63, gw = bx * 8 + wave, NGW = (int)gridDim.x * 8;
    f32x4_t g[4];
#pragma unroll
    for (int j = 0; j < 4; ++j) g[j] = ((const f32x4_t*)gain)[lane + 64 * j];
    for (int r = gw; r < TT; r += NGW) { f32x4_t* xr = (f32x4_t*)(c.X + (size_t)r * DM) + lane; f32x4_t v[4]; float s = 0.f;
#pragma unroll
        for (int j = 0; j < 4; ++j) v[j] = xr[64 * j];
        if (r >= TP) {
            for (int ks = 0; ks < nsplit; ++ks) { const f32x4_t* pr = (const f32x4_t*)(c.PART + ((size_t)ks * TS + (r - TP)) * DM) + lane;
#pragma unroll
                for (int j = 0; j < 4; ++j) v[j] += pr[64 * j]; }
            if (!FINAL) {
#pragma unroll
                for (int j = 0; j < 4; ++j) xr[64 * j] = v[j]; } }
#pragma unroll
        for (int j = 0; j < 4; ++j) s += (v[j][0] * v[j][0] + v[j][1] * v[j][1]) + (v[j][2] * v[j][2] + v[j][3] * v[j][3]);
        const float rs = 1.0f / sqrtf(wave_sum(s) * (1.0f / DM) + NEPS);
#pragma unroll
        for (int j = 0; j < 4; ++j) { const f32x4_t o = v[j] * rs * g[j];
            if (FINAL) ((f32x4_t*)(c.out + O_YP + (size_t)r * DM))[lane + 64 * j] = o;
            else { u32x2_t w = {cvtpk(o[0], o[1]), cvtpk(o[2], o[3])}; ((u32x2_t*)(c.XN + (size_t)r * DM))[lane + 64 * j] = w; } } }
}
DEV void dev_copy_out(CREF c, int l, long gtid, long gn) {
    for (long i = gtid; i < (long)TT * 128; i += gn) { const int r = (int)(i >> 7), k = (int)(i & 127); const f32x4_t v = *(const f32x4_t*)(c.PROJ + (size_t)r * PLD + C_KV + 4 * k);
        float* dst = r < TP ? c.out + O_KVP + ((size_t)l * TP + r) * 512 : c.out + O_KVS + ((size_t)l * TS + (r - TP)) * 512; *(f32x4_t*)(dst + 4 * k) = v; }
    for (long i = gtid; i < (long)BATCH * 512 * 64; i += gn) { const int b = (int)(i / (512 * 64)), w = (int)((i >> 6) & 511), k = (int)(i & 63);
        ((f32x4_t*)(c.out + O_WINP + (size_t)l * BATCH * 512 * 256))[i] = *(const f32x4_t*)(c.PROJ + (size_t)(b * SEQ + SEQ - 512 + w) * PLD + C_KV + 512 + 4 * k); }
    for (long i = gtid; i < (long)DB * 512 * 64; i += gn) { const int b = (int)(i / (512 * 64)), w = (int)((i >> 6) & 511), k = (int)(i & 63);
        ((f32x4_t*)(c.out + O_WINS + (size_t)l * DB * 512 * 256))[i] = (w < 512 - DSEQ) ? *(const f32x4_t*)(c.cache_win + (((size_t)l * DB + b) * 512 + w + DSEQ) * 256 + 4 * k)
                                                                                       : *(const f32x4_t*)(c.PROJ + (size_t)(TP + b * DSEQ + (w - (512 - DSEQ))) * PLD + C_KV + 512 + 4 * k); }
    for (long i = gtid; i < (long)BATCH * 3 * CONVD / 4; i += gn) { const int b = (int)(i / (3 * CONVD / 4)), w = (int)((i / (CONVD / 4)) % 3), k = (int)(i % (CONVD / 4));
        ((f32x4_t*)(c.out + O_CONVP + (size_t)l * BATCH * 3 * CONVD))[i] = *(const f32x4_t*)(c.PROJ + (size_t)(b * SEQ + SEQ - 3 + w) * PLD + C_DNQKV + 4 * k); }
    for (long i = gtid; i < (long)DB * 3 * CONVD / 4; i += gn) { const int b = (int)(i / (3 * CONVD / 4)), w = (int)((i / (CONVD / 4)) % 3), k = (int)(i % (CONVD / 4));
        ((f32x4_t*)(c.out + O_CONVS + (size_t)l * DB * 3 * CONVD))[i] = *(const f32x4_t*)(c.PROJ + (size_t)(TP + b * DSEQ + DSEQ - 3 + w) * PLD + C_DNQKV + 4 * k); }
}

constexpr int DP_YS = 65;
constexpr int DP_Y = 0, DP_AM = DP_Y + 3 * 64 * DP_YS * 4, DP_R = DP_AM + 64 * 64 * 4, DP_SM = DP_R + 64 * 128 * 4, DP_END = DP_SM + 5 * 64 * 4;
static_assert(DP_END <= 131072, "DeltaNet prep LDS");
DEV void dn_prep_unit(CREF c, int l, LAS unsigned char* L, int u, int tid) {
    asm volatile("" : "+v"(tid));
    const int ch = u % NCH, h = (u / NCH) % DNH, b = u / (NCH * DNH), r0 = b * SEQ + ch * 64, lane = tid & 63, wid = tid >> 6;
    LAS float* Y = (LAS float*)(L + DP_Y); LAS float* AMs = (LAS float*)(L + DP_AM); LAS float* R = (LAS float*)(L + DP_R);
    LAS float* sm = (LAS float*)(L + DP_SM);
    for (int idx = tid; idx < 64 * 192; idx += 512) { const int t = idx / 192, ci = idx % 192, part = ci >> 6, d = ci & 63, cch = part * DNW + h * 64 + d;
        const f32x4_t w = *(const f32x4_t*)(c.conv_w + ((size_t)l * CONVD + cch) * 4); float y = 0.f;
#pragma unroll
        for (int j = 0; j < 4; ++j) { const int tt = ch * 64 + t - 3 + j; if (tt >= 0) y += w[j] * c.PROJ[(size_t)(b * SEQ + tt) * PLD + C_DNQKV + cch]; }
        Y[(part * 64 + t) * DP_YS + d] = y / (1.0f + expf(-y)); }
    if (tid < 64) { const int r = r0 + tid; sm[128 + tid] = sigmoidf_(c.PROJ[(size_t)r * PLD + C_DNB + h]);
        sm[192 + tid] = -expf(c.a_log[l * DNH + h]) * softplusf_(c.PROJ[(size_t)r * PLD + C_DNA + h] + c.dt_bias[l * DNH + h]); }
    __syncthreads();
    for (int rr = wid * 16; rr < wid * 16 + 16; ++rr) { const float y = Y[rr * DP_YS + lane]; const float ss = wave_sum(y * y);
        if (lane == 0) sm[rr] = (rr < 64 ? 0.125f : 1.0f) / sqrtf(ss + 1e-6f); }
    if (tid == 0) { float s = 0.f; for (int t = 0; t < 64; ++t) { s += sm[192 + t]; sm[256 + t] = s; } }
    __syncthreads();
    for (int idx = tid; idx < 128 * 64; idx += 512) { const int rr = idx >> 6, d = idx & 63; Y[rr * DP_YS + d] *= sm[rr]; }
    __syncthreads();
    for (int idx = tid; idx < 64 * 64; idx += 512) { const int t = idx >> 6, d = idx & 63; const float q = Y[t * DP_YS + d], k = Y[(64 + t) * DP_YS + d], vv = Y[(128 + t) * DP_YS + d], be = sm[128 + t];
        c.QN[((size_t)(r0 + t) * DNH + h) * 64 + d] = q; c.KN[((size_t)(r0 + t) * DNH + h) * 64 + d] = k;
        R[t * 128 + d] = vv * be; R[t * 128 + 64 + d] = k * be * expf(sm[256 + t]); }
    if (tid < 64) c.GC[(size_t)u * 64 + tid] = sm[256 + tid];
    {   const int i = tid >> 3, j0 = (tid & 7) * 8; float kk[8], qk[8];
#pragma unroll
        for (int jj = 0; jj < 8; ++jj) { kk[jj] = 0.f; qk[jj] = 0.f; }
        if (j0 <= i) for (int d = 0; d < 64; ++d) { const float ki = Y[(64 + i) * DP_YS + d], qi = Y[i * DP_YS + d];
#pragma unroll
            for (int jj = 0; jj < 8; ++jj) { const float kj = Y[(64 + j0 + jj) * DP_YS + d]; kk[jj] += ki * kj; qk[jj] += qi * kj; } }
        const float gi = sm[256 + i], bi = sm[128 + i];
#pragma unroll
        for (int jj = 0; jj < 8; ++jj) { const int j = j0 + jj; const float dec = j <= i ? expf(gi - sm[256 + j]) : 0.f;
            AMs[i * 64 + j] = j < i ? bi * kk[jj] * dec : 0.f; c.AQK[(size_t)u * 4096 + i * 64 + j] = j <= i ? qk[jj] * dec : 0.f; } }
    __syncthreads();
    if (tid < 128) { float x[64];
#pragma unroll
        for (int i = 0; i < 64; ++i) { float s = R[i * 128 + tid];
#pragma unroll
            for (int j = 0; j < i; ++j) s -= AMs[i * 64 + j] * x[j];
            x[i] = s; c.SOL[(size_t)u * 8192 + i * 128 + tid] = s; } }
    __syncthreads();
}
DEV void dev_dn_out(CREF c, int l, int bx, int tid) {
    const int wave = tid >> 6, lane = tid & 63, gw = bx * 8 + wave, NGW = (int)gridDim.x * 8; const float nw = c.dn_norm_w[l * 64 + lane];
    for (int i = gw; i < TP * DNH; i += NGW) { const int r = i / DNH, h = i % DNH; const float o = c.ODN[(size_t)i * 64 + lane]; const float ss = wave_sum(o * o);
        const float z = c.PROJ[(size_t)r * PLD + C_DNZ + h * 64 + lane];
        c.MIXB[(size_t)r * DM + 512 + h * 64 + lane] = tobf(o / sqrtf(ss * (1.0f / 64.0f) + NEPS) * nw * (z / (1.0f + expf(-z)))); }
}

typedef float f32x16_t __attribute__((ext_vector_type(16)));
#define MFMA32(a, b, c) __builtin_amdgcn_mfma_f32_32x32x16_bf16((a), (b), (c), 0, 0, 0)
constexpr int NA_RS = 144;
constexpr int NA_T = 64 * NA_RS, NA_BUF = 2 * NA_T;
constexpr int NA_IMP = 2 * NA_BUF, NA_SELM = NA_IMP + 64 * 128 * 4, NA_UNI = NA_SELM + 64 * 16, NA_NIT = NA_UNI + 16, NA_ITEMS = NA_NIT + 16, NA_END = NA_ITEMS + 160 * 4;
static_assert(NA_END <= 131072, "NSA LDS");
constexpr float LOG2E = 1.4426950408889634f;
DEV int crow32(int reg, int hh) { return (reg & 3) + 8 * (reg >> 2) + 4 * hh; }
struct NaStage { f32x4_t k0, k1, v0, v1; };
template <bool SMP> DEV void na_load(CREF c, NaStage& st, int l, int mode, int b, int g, int n, int tid) {
    const int key = tid >> 3, d0 = (tid & 7) * 8; const float* kp; bool zero = false;
    if (mode == 0) { kp = c.KC + (((size_t)((SMP ? BATCH : 0) + b) * NBMAX + 64 * n + key) * 2 + g) * 64 + d0;
        const float* vp = c.VC + (kp - c.KC); const bool zp = SMP && key >= NBC_S; const f32x4_t z0 = {0.f, 0.f, 0.f, 0.f};
        st.k0 = zp ? z0 : *(const f32x4_t*)kp; st.k1 = zp ? z0 : *(const f32x4_t*)(kp + 4); st.v0 = zp ? z0 : *(const f32x4_t*)vp; st.v1 = zp ? z0 : *(const f32x4_t*)(vp + 4); return; }
    const int slot = mode == 1 ? 2 : 4;
    if (!SMP) kp = c.PROJ + (size_t)(b * SEQ + 64 * n + key) * PLD + C_KV + slot * 128 + g * 64 + d0;
    else { const int pos = 64 * n + key;
        if (pos >= PAST) { const int j = pos - PAST; zero = j >= DSEQ; kp = c.PROJ + (size_t)(TP + b * DSEQ + (zero ? 0 : j)) * PLD + C_KV + slot * 128 + g * 64 + d0; }
        else if (mode == 1) { const int pg = c.page_table[b * NPAGES + pos / PAGE]; kp = c.cache_nsa + ((((size_t)l * NPHYS + pg) * PAGE + (pos % PAGE)) * 4 + slot) * 128 + g * 64 + d0; }
        else kp = c.cache_win + ((((size_t)l * DB + b) * WIN + (pos - W0S)) * 2 + (slot - 4)) * 128 + g * 64 + d0; }
    const f32x4_t z = {0.f, 0.f, 0.f, 0.f};
    st.k0 = zero ? z : *(const f32x4_t*)kp; st.k1 = zero ? z : *(const f32x4_t*)(kp + 4); st.v0 = zero ? z : *(const f32x4_t*)(kp + 128); st.v1 = zero ? z : *(const f32x4_t*)(kp + 132);
}
DEV void na_store(const NaStage& st, LAS unsigned char* buf, int tid) {
    const int key = tid >> 3, d0 = (tid & 7) * 8;
    *(LAS bf16x8_t*)(buf + key * NA_RS + d0 * 2) = pack8(st.k0, st.k1);
    LAS unsigned short* vt = (LAS unsigned short*)(buf + NA_T);
    const unsigned a = cvtpk(st.v0[0], st.v0[1]), bb = cvtpk(st.v0[2], st.v0[3]), cc = cvtpk(st.v1[0], st.v1[1]), dd = cvtpk(st.v1[2], st.v1[3]);
    vt[(d0 + 0) * (NA_RS / 2) + key] = (unsigned short)a; vt[(d0 + 1) * (NA_RS / 2) + key] = (unsigned short)(a >> 16);
    vt[(d0 + 2) * (NA_RS / 2) + key] = (unsigned short)bb; vt[(d0 + 3) * (NA_RS / 2) + key] = (unsigned short)(bb >> 16);
    vt[(d0 + 4) * (NA_RS / 2) + key] = (unsigned short)cc; vt[(d0 + 5) * (NA_RS / 2) + key] = (unsigned short)(cc >> 16);
    vt[(d0 + 6) * (NA_RS / 2) + key] = (unsigned short)dd; vt[(d0 + 7) * (NA_RS / 2) + key] = (unsigned short)(dd >> 16);
}
DEV void na_scores(const LAS unsigned char* kb, const bf16x8_t (&qf)[4], int lane, f32x16_t& s0, f32x16_t& s1) {
    const int n = lane & 31, hh = lane >> 5;
#pragma unroll
    for (int i = 0; i < 16; ++i) { s0[i] = 0.f; s1[i] = 0.f; }
#pragma unroll
    for (int ks = 0; ks < 4; ++ks) { const bf16x8_t a0 = *(const LAS bf16x8_t*)(kb + n * NA_RS + (16 * ks + 8 * hh) * 2), a1 = *(const LAS bf16x8_t*)(kb + (32 + n) * NA_RS + (16 * ks + 8 * hh) * 2);
        s0 = MFMA32(a0, qf[ks], s0); s1 = MFMA32(a1, qf[ks], s1); }
}
DEV void na_pv(const LAS unsigned char* vb, const f32x16_t& p0, const f32x16_t& p1, int lane, f32x16_t& o0, f32x16_t& o1) {
    const int n = lane & 31, hh = lane >> 5;
#pragma unroll
    for (int s = 0; s < 4; ++s) { const f32x16_t& p = (s < 2) ? p0 : p1; const int e = 8 * (s & 1);
        const bf16x8_t pf = pack8((f32x4_t){p[e], p[e + 1], p[e + 2], p[e + 3]}, (f32x4_t){p[e + 4], p[e + 5], p[e + 6], p[e + 7]});
#pragma unroll
        for (int mt = 0; mt < 2; ++mt) { const LAS unsigned char* vp = vb + (32 * mt + n) * NA_RS + (16 * s + 4 * hh) * 2;
            const u32x2_t lo = *(const LAS u32x2_t*)vp, hi = *(const LAS u32x2_t*)(vp + 16); const u32x4_t w = {lo[0], lo[1], hi[0], hi[1]};
            if (mt == 0) o0 = MFMA32(__builtin_bit_cast(bf16x8_t, w), pf, o0); else o1 = MFMA32(__builtin_bit_cast(bf16x8_t, w), pf, o1); } }
}
template <bool SMP> DEV void nsa_unit(CREF c, int l, LAS unsigned char* L, int b, int qb, int g, int tid) {
    asm volatile("" : "+v"(tid));
    const int lane = tid & 63, wid = tid >> 6, n = lane & 31, hh = lane >> 5, tl = 8 * wid + (n >> 2), r = n & 3, h = 4 * g + r, t = 64 * qb + tl;
    const bool act = !SMP || wid == 0;
    const size_t row = SMP ? (size_t)(TP + b * DSEQ + (tl & 7)) : (size_t)(b * SEQ + t);
    LAS float* IMP = (LAS float*)(L + NA_IMP); LAS unsigned* SELM = (LAS unsigned*)(L + NA_SELM); LAS unsigned* UNI = (LAS unsigned*)(L + NA_UNI);
    LAS int* NIT = (LAS int*)(L + NA_NIT); LAS int* ITEMS = (LAS int*)(L + NA_ITEMS);
    const float slope2 = exp2f(-(float)(h + 1)) * LOG2E;
    bf16x8_t qf[4];
#pragma unroll
    for (int ks = 0; ks < 4; ++ks) { const float* qp = c.PROJ + row * PLD + C_Q + h * 64 + 16 * ks + 8 * hh; const f32x4_t a = *(const f32x4_t*)qp * (0.125f * LOG2E), bq = *(const f32x4_t*)(qp + 4) * (0.125f * LOG2E); qf[ks] = pack8(a, bq); }
    const float* gp = c.PROJ + row * PLD + C_GATE + h * 3; const float g0 = sigmoidf_(gp[0]), g1 = sigmoidf_(gp[1]), g2 = sigmoidf_(gp[2]);
    f32x16_t ot0, ot1, oa0, oa1;
    if (tid < 4) UNI[tid] = 0u;
    const int nbc = (!SMP && qb >= 64) ? 2 : 1;
    { NaStage st; na_load<SMP>(c, st, l, 0, b, g, 0, tid); na_store(st, L, tid); if (nbc == 2) { na_load<SMP>(c, st, l, 0, b, g, 1, tid); na_store(st, L + NA_BUF, tid); } }
    __syncthreads();
    if (act) {
        f32x16_t sa0, sa1, sb0, sb1;
        na_scores(L, qf, lane, sa0, sa1);
        if (nbc == 2) na_scores(L + NA_BUF, qf, lane, sb0, sb1);
        else {
#pragma unroll
            for (int i = 0; i < 16; ++i) { sb0[i] = 0.f; sb1[i] = 0.f; } }
        float m = -1e30f;
#pragma unroll
        for (int i = 0; i < 16; ++i) { const int k0 = crow32(i, hh);
            { const int np = k0;       const bool ok = 64 * np + 63 <= t;              sa0[i] = ok ? sa0[i] - slope2 * ((float)(t - 64 * np) - 31.5f) : -1e30f; m = fmaxf(m, sa0[i]); }
            { const int np = 32 + k0;  const bool ok = 64 * np + 63 <= t;              sa1[i] = ok ? sa1[i] - slope2 * ((float)(t - 64 * np) - 31.5f) : -1e30f; m = fmaxf(m, sa1[i]); }
            { const int np = 64 + k0;  const bool ok = nbc == 2 && 64 * np + 63 <= t;  sb0[i] = ok ? sb0[i] - slope2 * ((float)(t - 64 * np) - 31.5f) : -1e30f; m = fmaxf(m, sb0[i]); }
            { const int np = 96 + k0;  const bool ok = nbc == 2 && 64 * np + 63 <= t;  sb1[i] = ok ? sb1[i] - slope2 * ((float)(t - 64 * np) - 31.5f) : -1e30f; m = fmaxf(m, sb1[i]); } }
        m = fmaxf(m, __shfl_xor(m, 32));
        float ls = 0.f;
#pragma unroll
        for (int i = 0; i < 16; ++i) { sa0[i] = sa0[i] > -1e29f ? exp2f(sa0[i] - m) : 0.f; sa1[i] = sa1[i] > -1e29f ? exp2f(sa1[i] - m) : 0.f;
                                       sb0[i] = sb0[i] > -1e29f ? exp2f(sb0[i] - m) : 0.f; sb1[i] = sb1[i] > -1e29f ? exp2f(sb1[i] - m) : 0.f; ls += (sa0[i] + sa1[i]) + (sb0[i] + sb1[i]); }
        ls += __shfl_xor(ls, 32);
        const float inv = 1.0f / fmaxf(ls, 1e-30f);
#pragma unroll
        for (int i = 0; i < 16; ++i) { sa0[i] *= inv; sa1[i] *= inv; sb0[i] *= inv; sb1[i] *= inv; }
#pragma unroll
        for (int i = 0; i < 16; ++i) { const int k0 = crow32(i, hh);
            float v0 = sa0[i], v1 = sa1[i], v2 = sb0[i], v3 = sb1[i];
            v0 += __shfl_xor(v0, 1); v1 += __shfl_xor(v1, 1); v2 += __shfl_xor(v2, 1); v3 += __shfl_xor(v3, 1);
            v0 += __shfl_xor(v0, 2); v1 += __shfl_xor(v1, 2); v2 += __shfl_xor(v2, 2); v3 += __shfl_xor(v3, 2);
            if (r == 0) { IMP[tl * 128 + k0] = v0; IMP[tl * 128 + 32 + k0] = v1; IMP[tl * 128 + 64 + k0] = v2; IMP[tl * 128 + 96 + k0] = v3; } }
#pragma unroll
        for (int i = 0; i < 16; ++i) { oa0[i] = 0.f; oa1[i] = 0.f; }
        na_pv(L + NA_T, sa0, sa1, lane, oa0, oa1);
        if (nbc == 2) na_pv(L + NA_BUF + NA_T, sb0, sb1, lane, oa0, oa1);
#pragma unroll
        for (int i = 0; i < 16; ++i) { ot0[i] = g0 * oa0[i]; ot1[i] = g0 * oa1[i]; }
    }
    __syncthreads();
    {
        const int tk = tid >> 3, s8 = tid & 7, cur = qb;
        if (!SMP || tk < DSEQ) {
        float v[16];
#pragma unroll
        for (int i = 0; i < 16; ++i) { const int nn = 16 * s8 + i; v[i] = (nn >= 1 && nn <= cur - 2) ? IMP[tk * 128 + nn] : -1.0f; }
        unsigned mk0 = 0u, mk1 = 0u, mk2 = 0u, mk3 = 0u;
        const int nforced = cur >= 2 ? 3 : cur + 1;
        for (int rd = 0; rd < TOPK - nforced; ++rd) {
            float bv = -0.5f; int bn = 1000;
#pragma unroll
            for (int i = 0; i < 16; ++i) if (v[i] > bv) { bv = v[i]; bn = 16 * s8 + i; }
#pragma unroll
            for (int o = 1; o < 8; o <<= 1) { const float ov = __shfl_xor(bv, o); const int on = __shfl_xor(bn, o); if (ov > bv || (ov == bv && on < bn)) { bv = ov; bn = on; } }
            if (bn >= 1000) break;
#pragma unroll
            for (int i = 0; i < 16; ++i) if (16 * s8 + i == bn) v[i] = -1.0f;
            const unsigned bit = 1u << (bn & 31); const int w = bn >> 5;
            mk0 |= w == 0 ? bit : 0u; mk1 |= w == 1 ? bit : 0u; mk2 |= w == 2 ? bit : 0u; mk3 |= w == 3 ? bit : 0u;
        }
#pragma unroll
        for (int f = 0; f < 3; ++f) { const int fn = f == 0 ? 0 : (f == 1 ? cur : cur - 1); if (fn >= 0) { const unsigned bit = 1u << (fn & 31); const int w = fn >> 5;
            mk0 |= w == 0 ? bit : 0u; mk1 |= w == 1 ? bit : 0u; mk2 |= w == 2 ? bit : 0u; mk3 |= w == 3 ? bit : 0u; } }
        if (s8 == 0) { SELM[tk * 4 + 0] = mk0; SELM[tk * 4 + 1] = mk1; SELM[tk * 4 + 2] = mk2; SELM[tk * 4 + 3] = mk3;
            atomicOr((unsigned*)&UNI[0], mk0); atomicOr((unsigned*)&UNI[1], mk1); atomicOr((unsigned*)&UNI[2], mk2); atomicOr((unsigned*)&UNI[3], mk3); }
        }
    }
    __syncthreads();
    if (tid == 0) { int k = 0;
        for (int nn = qb; nn >= 0; --nn) if ((UNI[nn >> 5] >> (nn & 31)) & 1u) ITEMS[k++] = nn;
        for (int nn = qb; nn >= (qb >= 8 ? qb - 8 : 0); --nn) ITEMS[k++] = 256 + nn;
        NIT[0] = k; }
    __syncthreads();
    const int nit = NIT[0];
    const unsigned sm0 = SELM[tl * 4 + 0], sm1 = SELM[tl * 4 + 1], sm2 = SELM[tl * 4 + 2], sm3 = SELM[tl * 4 + 3];
    float m = -1e30f, ls = 0.f; int curmode = 0;
#pragma unroll
    for (int i = 0; i < 16; ++i) { oa0[i] = 0.f; oa1[i] = 0.f; }
    { NaStage st; const int it0 = ITEMS[0]; na_load<SMP>(c, st, l, 1 + (it0 >> 8), b, g, it0 & 255, tid); na_store(st, L, tid); }
    __syncthreads();
    for (int it = 0; it < nit; ++it) {
        const int item = ITEMS[it], mode = item >> 8, nblk = item & 255;
        NaStage st; const bool more = it + 1 < nit;
        if (more) { const int nx = ITEMS[it + 1]; na_load<SMP>(c, st, l, 1 + (nx >> 8), b, g, nx & 255, tid); }
        if (act) {
        if (mode != curmode) {
            const float lf = ls + __shfl_xor(ls, 32); const float sc = g1 / fmaxf(lf, 1e-30f);
#pragma unroll
            for (int i = 0; i < 16; ++i) { ot0[i] += sc * oa0[i]; ot1[i] += sc * oa1[i]; oa0[i] = 0.f; oa1[i] = 0.f; }
            m = -1e30f; ls = 0.f; curmode = mode; }
        const LAS unsigned char* buf = L + (it & 1) * NA_BUF;
        f32x16_t s0, s1; na_scores(buf, qf, lane, s0, s1);
        const int dbase = 64 * (qb - nblk) + tl;
        const unsigned smw = nblk < 32 ? sm0 : (nblk < 64 ? sm1 : (nblk < 96 ? sm2 : sm3));
        const bool blk_ok = mode == 1 ? true : ((smw >> (nblk & 31)) & 1u) != 0u;
        const bool full = (nblk == qb) || (mode == 1 && nblk == qb - 8);
        float mn, al, psum = 0.f;
        if (full) {
            float mloc = -1e30f;
#pragma unroll
            for (int i = 0; i < 16; ++i) { const int k0 = crow32(i, hh);
                { const int dist = dbase - k0;        const bool ok = blk_ok && dist >= 0 && (mode == 0 || dist < WIN); s0[i] = ok ? s0[i] - slope2 * (float)dist : -1e30f; mloc = fmaxf(mloc, s0[i]); }
                { const int dist = dbase - 32 - k0;   const bool ok = blk_ok && dist >= 0 && (mode == 0 || dist < WIN); s1[i] = ok ? s1[i] - slope2 * (float)dist : -1e30f; mloc = fmaxf(mloc, s1[i]); } }
            mloc = fmaxf(mloc, __shfl_xor(mloc, 32));
            mn = fmaxf(m, mloc); al = __builtin_amdgcn_exp2f(m - mn); m = mn;
#pragma unroll
            for (int i = 0; i < 16; ++i) { s0[i] = s0[i] > -1e29f ? __builtin_amdgcn_exp2f(s0[i] - mn) : 0.f; s1[i] = s1[i] > -1e29f ? __builtin_amdgcn_exp2f(s1[i] - mn) : 0.f; psum += s0[i] + s1[i]; }
        } else {
            const float c0 = -slope2 * (float)(dbase - 4 * hh);
            float tm = -1e30f;
#pragma unroll
            for (int i = 0; i < 16; ++i) { const float ci = (float)((i & 3) + 8 * (i >> 2));
                s0[i] = fmaf(slope2, ci, s0[i]); s1[i] = fmaf(slope2, ci + 32.0f, s1[i]); tm = fmaxf(tm, fmaxf(s0[i], s1[i])); }
            float mloc = blk_ok ? tm + c0 : -1e30f;
            mloc = fmaxf(mloc, __shfl_xor(mloc, 32));
            mn = fmaxf(m, mloc); al = __builtin_amdgcn_exp2f(m - mn); m = mn;
            const float mm = blk_ok ? mn - c0 : 1e30f;
#pragma unroll
            for (int i = 0; i < 16; ++i) { s0[i] = __builtin_amdgcn_exp2f(s0[i] - mm); s1[i] = __builtin_amdgcn_exp2f(s1[i] - mm); psum += s0[i] + s1[i]; }
        }
        ls = ls * al + psum;
        if (__builtin_amdgcn_ballot_w64(al != 1.0f) != 0ull) {
#pragma unroll
            for (int i = 0; i < 16; ++i) { oa0[i] *= al; oa1[i] *= al; } }
        na_pv(buf + NA_T, s0, s1, lane, oa0, oa1);
        }
        if (more) na_store(st, L + ((it + 1) & 1) * NA_BUF, tid);
        __syncthreads();
    }
    if (act) {
    {   const float lf = ls + __shfl_xor(ls, 32); const float sc = g2 / fmaxf(lf, 1e-30f);
#pragma unroll
        for (int i = 0; i < 16; ++i) { ot0[i] += sc * oa0[i]; ot1[i] += sc * oa1[i]; } }
    bf16_t* orow = c.MIXB + row * DM + h * 64;
#pragma unroll
    for (int q4 = 0; q4 < 4; ++q4) { const int d = 8 * q4 + 4 * hh;
        u32x2_t w0 = {cvtpk(ot0[4 * q4], ot0[4 * q4 + 1]), cvtpk(ot0[4 * q4 + 2], ot0[4 * q4 + 3])}; *(u32x2_t*)(orow + d) = w0;
        u32x2_t w1 = {cvtpk(ot1[4 * q4], ot1[4 * q4 + 1]), cvtpk(ot1[4 * q4 + 2], ot1[4 * q4 + 3])}; *(u32x2_t*)(orow + 32 + d) = w1; }
    }
    __syncthreads();
}

DEV void pool_unit(CREF c, int l, int seq, int n, int col) {
    const int slot = col >> 7, g = (col >> 6) & 1;
    const float* src; size_t stride;
    if (seq < BATCH) { src = c.PROJ + (size_t)(seq * SEQ + 64 * n) * PLD + C_KV + col; stride = PLD; }
    else { const int b = seq - BATCH, pg = c.page_table[b * NPAGES + (64 * n) / PAGE]; src = c.cache_nsa + (((size_t)l * NPHYS + pg) * PAGE + ((64 * n) % PAGE)) * 512 + col; stride = 512; }
    const float* w = (slot == 0 ? c.wck : c.wcv) + (l * 2 + g) * 64;
    float a0 = 0.f, a1 = 0.f;
#pragma unroll 16
    for (int j = 0; j < 64; j += 2) { a0 += w[j] * src[(size_t)j * stride]; a1 += w[j + 1] * src[(size_t)(j + 1) * stride]; }
    (slot == 0 ? c.KC : c.VC)[(((size_t)seq * NBMAX + n) * 2 + g) * 64 + (col & 63)] = a0 + a1;
}

DEV void dev_s5_y(CREF c, int l, long gtid, long gn) {
    for (long i = gtid; i < (long)TT * 256; i += gn) { const int r = (int)(i >> 8), ch = (int)(i & 255), g = ch / S5C, cc = ch % S5C;
        const float* cr = c.c_re + (((size_t)l * S5G + g) * S5C + cc) * S5P; const float* ci = c.c_im + (((size_t)l * S5G + g) * S5C + cc) * S5P;
        const f32x4_t* hs = (const f32x4_t*)(c.S5HS + ((size_t)r * S5G + g) * S5P * 2); float y = 0.f;
#pragma unroll 8
        for (int p2 = 0; p2 < S5P / 2; ++p2) { const f32x4_t hv = hs[p2]; y += cr[2 * p2] * hv[0] - ci[2 * p2] * hv[1] + cr[2 * p2 + 1] * hv[2] - ci[2 * p2 + 1] * hv[3]; }
        y += c.s5_d[l * 256 + ch] * c.PROJ[(size_t)r * PLD + C_S5U + ch]; c.GLB[i] = tobf(geluf_(y)); }
}

constexpr int S5_U = 0, S5_HT = 65536;
template <bool PASS_B, bool SMP> DEV void s5_unit(CREF c, int l, LAS unsigned char* L, int b, int ch, int tid) {
    asm volatile("" : "+v"(tid));
    constexpr int NT = SMP ? DSEQ : 64;
    const int r0 = SMP ? TP + b * DSEQ : b * SEQ + ch * 64;
    LAS float* U = (LAS float*)(L + S5_U); LAS float* HT = (LAS float*)(L + S5_HT);
    for (int i = tid; i < NT * 64; i += 512) { const int t = i >> 6, q = i & 63; *(LAS f32x4_t*)(U + t * 256 + 4 * q) = *(const f32x4_t*)(c.PROJ + (size_t)(r0 + t) * PLD + C_S5U + 4 * q); }
    float bb[2][32], ar[2], ai[2], hr[2], hi[2];
#pragma unroll
    for (int s = 0; s < 2; ++s) { const int idx = tid + 512 * s; const size_t gi = (size_t)l * S5G * S5P + idx;
        const f32x4_t* bp = (const f32x4_t*)(c.S5BB + gi * 32);
#pragma unroll
        for (int k = 0; k < 8; ++k) { const f32x4_t v = bp[k]; bb[s][4 * k] = v[0]; bb[s][4 * k + 1] = v[1]; bb[s][4 * k + 2] = v[2]; bb[s][4 * k + 3] = v[3]; }
        ar[s] = c.S5K[gi * 4]; ai[s] = c.S5K[gi * 4 + 1];
        if (SMP) { hr[s] = c.st_s5re[((size_t)l * DB + b) * 1024 + idx]; hi[s] = c.st_s5im[((size_t)l * DB + b) * 1024 + idx]; }
        else if (PASS_B) {
            const float a64r = c.S5K[gi * 4 + 2], a64i = c.S5K[gi * 4 + 3]; float cr_ = 0.f, ci_ = 0.f;
            for (int c0 = 0; c0 < ch; c0 += 16) { f32x2_t e[16];
#pragma unroll
                for (int k = 0; k < 16; ++k) e[k] = (c0 + k < ch) ? *(const f32x2_t*)(c.S5E + (((size_t)b * NCH + c0 + k) * 1024 + idx) * 2) : (f32x2_t){0.f, 0.f};
#pragma unroll
                for (int k = 0; k < 16; ++k) if (c0 + k < ch) { const float nr = a64r * cr_ - a64i * ci_ + e[k][0], ni = a64r * ci_ + a64i * cr_ + e[k][1]; cr_ = nr; ci_ = ni; } }
            hr[s] = cr_; hi[s] = ci_; }
        else { hr[s] = 0.f; hi[s] = 0.f; } }
    const int gy = tid >> 5, cy = (tid >> 1) & 15, half = tid & 1;
    float cr[32], ci[32]; float dcoef = 0.f;
    if (PASS_B) { const f32x4_t* crp = (const f32x4_t*)(c.c_re + (((size_t)l * S5G + gy) * S5C + cy) * S5P + 32 * half); const f32x4_t* cip = (const f32x4_t*)(c.c_im + (((size_t)l * S5G + gy) * S5C + cy) * S5P + 32 * half);
#pragma unroll
        for (int k = 0; k < 8; ++k) { const f32x4_t a = crp[k], bq = cip[k]; cr[4 * k] = a[0]; cr[4 * k + 1] = a[1]; cr[4 * k + 2] = a[2]; cr[4 * k + 3] = a[3]; ci[4 * k] = bq[0]; ci[4 * k + 1] = bq[1]; ci[4 * k + 2] = bq[2]; ci[4 * k + 3] = bq[3]; }
        dcoef = c.s5_d[l * 256 + gy * 16 + cy]; }
    __syncthreads();
    for (int sb = 0; sb < NT / 8; ++sb) {
#pragma unroll 2
        for (int tt = 0; tt < 8; ++tt) { const int t = sb * 8 + tt;
#pragma unroll
            for (int s = 0; s < 2; ++s) { const int g = (tid >> 6) + 8 * s; const LAS f32x4_t* up = (const LAS f32x4_t*)(U + t * 256 + g * 16); float br = 0.f, bi = 0.f;
#pragma unroll
                for (int k = 0; k < 4; ++k) { const f32x4_t uv = up[k];
#pragma unroll
                    for (int e = 0; e < 4; ++e) { br += bb[s][2 * (4 * k + e)] * uv[e]; bi += bb[s][2 * (4 * k + e) + 1] * uv[e]; } }
                const float nr = ar[s] * hr[s] - ai[s] * hi[s] + br, ni = ar[s] * hi[s] + ai[s] * hr[s] + bi; hr[s] = nr; hi[s] = ni;
                if (PASS_B) *(LAS f32x2_t*)(HT + (tt * 1024 + tid + 512 * s) * 2) = (f32x2_t){nr, ni}; } }
        if (PASS_B) {
            __syncthreads();
#pragma unroll 2
            for (int tt = 0; tt < 8; ++tt) { const int t = sb * 8 + tt; const LAS f32x4_t* hp = (const LAS f32x4_t*)(HT + (tt * 1024 + gy * 64 + 32 * half) * 2); float y = 0.f;
#pragma unroll
                for (int k = 0; k < 16; ++k) { const f32x4_t hv = hp[k]; y += cr[2 * k] * hv[0] - ci[2 * k] * hv[1] + cr[2 * k + 1] * hv[2] - ci[2 * k + 1] * hv[3]; }
                y += __shfl_xor(y, 1);
                if (half == 0) { y += dcoef * U[t * 256 + gy * 16 + cy]; c.GLB[(size_t)(r0 + t) * 256 + gy * 16 + cy] = tobf(geluf_(y)); } }
            __syncthreads(); } }
#pragma unroll
    for (int s = 0; s < 2; ++s) { const int idx = tid + 512 * s;
        if (SMP) { c.out[O_S5RS + ((size_t)l * DB + b) * 1024 + idx] = hr[s]; c.out[O_S5IS + ((size_t)l * DB + b) * 1024 + idx] = hi[s]; }
        else if (!PASS_B) { const size_t e = (((size_t)b * NCH + ch) * 1024 + idx) * 2; c.S5E[e] = hr[s]; c.S5E[e + 1] = hi[s]; } }
    __syncthreads();
}

DEV void dn_sample_unit(CREF c, int l, LAS unsigned char* L, int b, int tid) {
    asm volatile("" : "+v"(tid));
    LAS float* Y = (LAS float*)L;
    LAS float* sm = Y + 8 * 768;
    const int r0 = TP + b * DSEQ, lane = tid & 63, wid = tid >> 6;
    for (int idx = tid; idx < 8 * 768; idx += 512) { const int t = idx / 768, cch = idx % 768; const f32x4_t w = *(const f32x4_t*)(c.conv_w + ((size_t)l * CONVD + cch) * 4); float y = 0.f;
#pragma unroll
        for (int j = 0; j < 4; ++j) { const int tt = t - 3 + j; y += w[j] * (tt >= 0 ? c.PROJ[(size_t)(r0 + tt) * PLD + C_DNQKV + cch] : c.st_conv[(((size_t)l * DB + b) * 3 + 3 + tt) * CONVD + cch]); }
        Y[idx] = y / (1.0f + expf(-y)); }
    if (tid < 32) { const int t = tid >> 2, h = tid & 3; sm[64 + tid] = sigmoidf_(c.PROJ[(size_t)(r0 + t) * PLD + C_DNB + h]);
        sm[96 + tid] = expf(-expf(c.a_log[l * DNH + h]) * softplusf_(c.PROJ[(size_t)(r0 + t) * PLD + C_DNA + h] + c.dt_bias[l * DNH + h])); }
    __syncthreads();
    for (int rr = wid * 8; rr < wid * 8 + 8; ++rr) { const int t = rr >> 3, part = (rr >> 2) & 1, h = rr & 3; const float y = Y[t * 768 + part * 256 + h * 64 + lane]; const float ss = wave_sum(y * y);
        if (lane == 0) sm[rr] = (part == 0 ? 0.125f : 1.0f) / sqrtf(ss + 1e-6f); }
    __syncthreads();
    if (tid < 256) { const int h = tid >> 6, jc = tid & 63; float S[64]; const float* s0 = c.st_dn + (((size_t)l * DB + b) * DNH + h) * 4096 + jc;
#pragma unroll
        for (int kk = 0; kk < 64; ++kk) S[kk] = s0[kk * 64];
        const float nw = c.dn_norm_w[l * 64 + jc];
        for (int t = 0; t < DSEQ; ++t) { const LAS float* qp = Y + t * 768 + h * 64; const LAS float* kp = qp + 256; const float qs = sm[t * 8 + h], ksc = sm[t * 8 + 4 + h], a = sm[96 + t * 4 + h], be = sm[64 + t * 4 + h];
            float ks = 0.f;
#pragma unroll
            for (int kk = 0; kk < 64; ++kk) { S[kk] *= a; ks += kp[kk] * S[kk]; }
            const float vn = be * (Y[t * 768 + 512 + h * 64 + jc] - ks * ksc), kv = vn * ksc; float os = 0.f;
#pragma unroll
            for (int kk = 0; kk < 64; ++kk) { S[kk] += kp[kk] * kv; os += qp[kk] * S[kk]; }
            os *= qs;
            const float ss = wave_sum(os * os); const float z = c.PROJ[(size_t)(r0 + t) * PLD + C_DNZ + h * 64 + jc];
            c.MIXB[(size_t)(r0 + t) * DM + 512 + h * 64 + jc] = tobf(os / sqrtf(ss * (1.0f / 64.0f) + NEPS) * nw * (z / (1.0f + expf(-z)))); }
#pragma unroll
        for (int kk = 0; kk < 64; ++kk) c.out[O_DNS + (((size_t)l * DB + b) * DNH + h) * 4096 + kk * 64 + jc] = S[kk]; }
    __syncthreads();
}
DEV void s5_carry_unit(CREF c, int l, int b, int tid) {
    for (int s = 0; s < 2; ++s) { const int idx = tid + 512 * s; const float* K = c.S5K + ((size_t)l * 1024 + idx) * 4; const float a64r = K[2], a64i = K[3]; float hr = 0.f, hi = 0.f;
        for (int c0 = 0; c0 < NCH; c0 += 16) { f32x2_t e[16];
#pragma unroll
            for (int k = 0; k < 16; ++k) e[k] = *(const f32x2_t*)(c.S5E + (((size_t)b * NCH + c0 + k) * 1024 + idx) * 2);
#pragma unroll
            for (int k = 0; k < 16; ++k) { *(f32x2_t*)(c.S5HIN + (((size_t)b * NCH + c0 + k) * 1024 + idx) * 2) = (f32x2_t){hr, hi};
                const float nr = a64r * hr - a64i * hi + e[k][0], ni = a64r * hi + a64i * hr + e[k][1]; hr = nr; hi = ni; } }
        c.out[O_S5RP + ((size_t)l * BATCH + b) * 1024 + idx] = hr; c.out[O_S5IP + ((size_t)l * BATCH + b) * 1024 + idx] = hi; }
}
#ifndef N_LAUNCH_MODE
#define N_LAUNCH_MODE 1
#endif
namespace pg8 {
template <bool ADD> struct EpiF32 {
    static constexpr bool PERM = false, AFTER_DRAIN = false;
    float* C; int ldc;
    __device__ __forceinline__ void operator()(const f32x4 (&acc)[2][2][4][2], const Unit& u, int wr, int wc, int fr, int fq) const {
        const int row0 = u.pm * BM + wr * 64 + fr, col0 = u.pn * BM + wc * 32 + 4 * fq;
#pragma unroll
        for (int ai = 0; ai < 2; ++ai)
#pragma unroll
            for (int m = 0; m < 4; ++m) { float* rowp = C + (size_t)(row0 + ai * HALF + m * 16) * ldc + col0;
#pragma unroll
                for (int bj = 0; bj < 2; ++bj)
#pragma unroll
                    for (int n = 0; n < 2; ++n) { f32x4 v = acc[ai][bj][m][n]; if (ADD) v += *(const f32x4*)(rowp + bj * HALF + n * 16); *(f32x4*)(rowp + bj * HALF + n * 16) = v; } }
    }
};
struct EpiSqReluBf16 {
    static constexpr bool PERM = true, AFTER_DRAIN = false;
    bf16_t* O; int ldc;
    __device__ __forceinline__ void operator()(const f32x4 (&acc)[2][2][4][2], const Unit& u, int wr, int wc, int fr, int fq) const {
        const int row0 = u.pm * BM + wr * 64 + fr, col0 = u.pn * BM + wc * 32 + 8 * fq;
#pragma unroll
        for (int ai = 0; ai < 2; ++ai)
#pragma unroll
            for (int m = 0; m < 4; ++m) { bf16_t* rowp = O + (size_t)(row0 + ai * HALF + m * 16) * ldc + col0;
#pragma unroll
                for (int bj = 0; bj < 2; ++bj) { f32x4 v0 = acc[ai][bj][m][0], v1 = acc[ai][bj][m][1];
#pragma unroll
                    for (int j = 0; j < 4; ++j) { const float a = v0[j] > 0.f ? v0[j] : 0.f, b = v1[j] > 0.f ? v1[j] : 0.f; v0[j] = a * a; v1[j] = b * b; }
                    u32x4 w; w.x = cvt_pk_bf16(v0[0], v0[1]); w.y = cvt_pk_bf16(v0[2], v0[3]); w.z = cvt_pk_bf16(v1[0], v1[1]); w.w = cvt_pk_bf16(v1[2], v1[3]);
                    *(u32x4*)(rowp + bj * HALF) = w; } }
    }
};
struct EpiGluBf16 {
    static constexpr bool PERM = true, AFTER_DRAIN = false;
    bf16_t* O; int ldc; const bf16_t* GLv;
    __device__ __forceinline__ void operator()(const f32x4 (&acc)[2][2][4][2], const Unit& u, int wr, int wc, int fr_, int fq_) const {
        int ln; asm volatile("v_mbcnt_lo_u32_b32 %0, -1, 0\n\tv_mbcnt_hi_u32_b32 %0, -1, %0" : "=v"(ln)); const int fr = ln & 15, fq = ln >> 4;
        const int row0 = u.pm * BM + wr * 64 + fr, col0 = u.pn * BM + wc * 32 + 8 * fq;
#pragma unroll
        for (int ai = 0; ai < 2; ++ai)
#pragma unroll
            for (int m = 0; m < 4; ++m) { const size_t r = (size_t)(row0 + ai * HALF + m * 16);
#pragma unroll
                for (int bj = 0; bj < 2; ++bj) { const u32x4 gv = *(const u32x4*)(GLv + r * 256 + col0 + bj * HALF); f32x4 v0 = acc[ai][bj][m][0], v1 = acc[ai][bj][m][1];
#pragma unroll
                    for (int j = 0; j < 4; ++j) { v0[j] = __builtin_amdgcn_rcpf(1.0f + __expf(-v0[j])); v1[j] = __builtin_amdgcn_rcpf(1.0f + __expf(-v1[j])); }
                    v0[0] *= __uint_as_float(gv[0] << 16); v0[1] *= __uint_as_float(gv[0] & 0xffff0000u); v0[2] *= __uint_as_float(gv[1] << 16); v0[3] *= __uint_as_float(gv[1] & 0xffff0000u);
                    v1[0] *= __uint_as_float(gv[2] << 16); v1[1] *= __uint_as_float(gv[2] & 0xffff0000u); v1[2] *= __uint_as_float(gv[3] << 16); v1[3] *= __uint_as_float(gv[3] & 0xffff0000u);
                    u32x4 w; w.x = cvt_pk_bf16(v0[0], v0[1]); w.y = cvt_pk_bf16(v0[2], v0[3]); w.z = cvt_pk_bf16(v1[0], v1[1]); w.w = cvt_pk_bf16(v1[2], v1[3]);
                    *(u32x4*)(O + r * ldc + col0 + bj * HALF) = w; } }
    }
};
}

#define XB_TMO      128
#define XB_XCNT(j)  (256  + 64 * (j))
#define XB_XSUB(j)  (1280 + 64 * (j))
#define XB_XGEN(j)  (2304 + 64 * (j))
#define XB_TOP      3328
#define XB_TOPGEN   3392
#define XCD_BAR_WORDS 3456
#define XB_SPIN_CAP (1u << 24)
__device__ __forceinline__ unsigned xb_ld(unsigned* p)              { return __hip_atomic_load(p, __ATOMIC_RELAXED, __HIP_MEMORY_SCOPE_AGENT); }
__device__ __forceinline__ unsigned xb_add(unsigned* p, unsigned v) { return __hip_atomic_fetch_add(p, v, __ATOMIC_RELAXED, __HIP_MEMORY_SCOPE_AGENT); }
__device__ __forceinline__ unsigned xb_xcc_id() { return (unsigned)__builtin_amdgcn_s_getreg((3 << 11) | 20) & 0xFu; }
#define XB_SPIN(cond, bar) do { unsigned _sp = 0; while (cond) { __builtin_amdgcn_s_sleep(1); \
    if ((++_sp & 255u) == 0u) { if (xb_ld(&(bar)[XB_TMO])) break; if (_sp > XB_SPIN_CAP) { atomicAdd(&(bar)[XB_TMO], 1u); break; } } } } while (0)
struct XcdBarrier { unsigned* bar; unsigned x; volatile LAS unsigned* st; };
__device__ __forceinline__ XcdBarrier xcd_barrier_post(unsigned* bar, volatile LAS unsigned* st) {
    XcdBarrier b; b.bar = bar; b.x = xb_xcc_id(); b.st = st;
    if (threadIdx.x == 0) (void)xb_add(&bar[XB_XCNT(b.x)], 1u);
    return b;
}
__device__ __forceinline__ void xcd_barrier_complete(unsigned* bar, unsigned x, unsigned& nloc, unsigned& nx) {
    const unsigned G = gridDim.x * gridDim.y * gridDim.z;
    unsigned sum, cnt, mine, sp = 0u;
    for (;;) {
        sum = 0u; cnt = 0u; mine = 0u;
#pragma unroll
        for (unsigned j = 0; j < 16; ++j) { const unsigned c = xb_ld(&bar[XB_XCNT(j)]); sum += c; cnt += (c > 0u) ? 1u : 0u; mine = (j == x) ? c : mine; }
        if (sum == G) break;
        __builtin_amdgcn_s_sleep(1);
        if ((++sp & 255u) == 0u) { if (xb_ld(&bar[XB_TMO])) break; if (sp > XB_SPIN_CAP) { atomicAdd(&bar[XB_TMO], 1u); break; } }
    }
    nloc = mine > 0u ? mine : 1u; nx = cnt > 0u ? cnt : 1u;
}
__device__ __forceinline__ void xcd_barrier(const XcdBarrier& b, const bool t0) {
    asm volatile("s_waitcnt vmcnt(0)" ::: "memory");
    __syncthreads();
    if (t0) {
        unsigned* bar = b.bar; unsigned bx = b.x; asm volatile("" : "+s"(bar), "+s"(bx));
        __builtin_amdgcn_s_waitcnt(0);
        unsigned nloc = b.st[0], nx = b.st[1];
        if (nloc == 0u) { xcd_barrier_complete(bar, bx, nloc, nx); b.st[0] = nloc; b.st[1] = nx; }
        const unsigned old = xb_add(&bar[XB_XSUB(bx)], 1u);
        const unsigned gen = old / nloc;
        if (old + 1u == (gen + 1u) * nloc) {
            __builtin_amdgcn_fence(__ATOMIC_RELEASE, "agent");
            asm volatile("s_waitcnt vmcnt(0)" ::: "memory");
            const unsigned og = xb_add(&bar[XB_TOP], 1u);
            const unsigned tg = og / nx;
            if (og + 1u == (tg + 1u) * nx) xb_add(&bar[XB_TOPGEN], 1u);
            else XB_SPIN(xb_ld(&bar[XB_TOPGEN]) == tg, bar);
            __builtin_amdgcn_fence(__ATOMIC_ACQUIRE, "agent");
            xb_add(&bar[XB_XGEN(bx)], 1u);
            asm volatile("s_waitcnt vmcnt(0)" ::: "memory");
        } else {
            XB_SPIN(xb_ld(&bar[XB_XGEN(bx)]) == gen, bar);
            __builtin_amdgcn_fence(__ATOMIC_ACQUIRE, "agent");
            asm volatile("s_waitcnt vmcnt(0)" ::: "memory");
        }
    }
    __syncthreads();
}

constexpr int RING_BYTES = 131072, LDSCTL_OFF = RING_BYTES, LDS_BYTES = 147456;
constexpr int NTHREADS = 512;
constexpr size_t al256(size_t x) { return (x + 255) & ~(size_t)255; }
constexpr size_t WS_CTL = 0, CTL_BYTES = 65536;
constexpr size_t WS_X = al256(WS_CTL + CTL_BYTES), WS_SSQ = al256(WS_X + (size_t)TT * DM * 4), WS_XN = al256(WS_SSQ + (size_t)TT * 64 * 4),
    WS_PROJ = al256(WS_XN + (size_t)TT * DM * 2), WS_MIXB = al256(WS_PROJ + (size_t)TT * PLD * 4), WS_UPB = al256(WS_MIXB + (size_t)TT * DM * 2),
    WS_WIN = al256(WS_UPB + (size_t)TT * DFF * 2), WS_WOUT = al256(WS_WIN + (size_t)2 * PLD * DM * 2), WS_WUP = al256(WS_WOUT + (size_t)2 * DM * DM * 2),
    WS_WDN = al256(WS_WUP + (size_t)2 * DFF * DM * 2), WS_KC = al256(WS_WDN + (size_t)2 * DM * DFF * 2), WS_VC = al256(WS_KC + (size_t)NSEQ * NBMAX * 128 * 4),
    WS_PC = al256(WS_VC + (size_t)NSEQ * NBMAX * 128 * 4), WS_OC = al256(WS_PC + (size_t)TT * NH * NBMAX * 4), WS_IDX = al256(WS_OC + (size_t)TT * NH * 64 * 4),
    WS_QN = al256(WS_IDX + (size_t)TT * NG * TOPK * 4), WS_KN = al256(WS_QN + (size_t)TT * 256 * 4), WS_VV = al256(WS_KN + (size_t)TT * 256 * 4),
    WS_GG = al256(WS_VV + (size_t)TT * 256 * 4), WS_BETA = al256(WS_GG + (size_t)TT * DNH * 4), WS_GC = al256(WS_BETA + (size_t)TT * DNH * 4),
    WS_AM = al256(WS_GC + (size_t)NDU * 64 * 4), WS_AQK = al256(WS_AM + (size_t)NDU * 4096 * 4), WS_SOL = al256(WS_AQK + (size_t)NDU * 4096 * 4),
    WS_VNEW = al256(WS_SOL + (size_t)NDU * 8192 * 4), WS_SDN = al256(WS_VNEW + (size_t)BATCH * DNH * 4096 * 4), WS_ODN = al256(WS_SDN + (size_t)BATCH * DNH * 4096 * 4),
    WS_S5K = al256(WS_ODN + (size_t)TT * 256 * 4), WS_S5BB = al256(WS_S5K + 2 * S5G * S5P * 4 * 4), WS_S5E = al256(WS_S5BB + 2 * S5G * S5P * S5C * 2 * 4),
    WS_S5HIN = al256(WS_S5E + (size_t)BATCH * NCH * 2048 * 4), WS_S5HS = al256(WS_S5HIN + (size_t)BATCH * NCH * 2048 * 4), WS_GL = al256(WS_S5HS + (size_t)TT * 2048 * 4),
    WS_GLB = al256(WS_GL + (size_t)TT * 256 * 4), WS_WGLU = al256(WS_GLB + (size_t)TT * 256 * 2), WS_PART = al256(WS_WGLU + (size_t)2 * 65536 * 2), WS_END = al256(WS_PART + (size_t)8 * TS * DM * 4);

struct Args { Ctx c; unsigned* bar; int lo, hi; };
constexpr int NPH = 1 + 2 * 14 + 2;
typedef const __attribute__((address_space(4))) unsigned char* karg_t;
__device__ __forceinline__ int lane_id() { return (int)__builtin_amdgcn_mbcnt_hi(~0u, __builtin_amdgcn_mbcnt_lo(~0u, 0u)); }
__device__ __forceinline__ int lane_id_v() { int t; asm volatile("v_mbcnt_lo_u32_b32 %0, -1, 0\n\tv_mbcnt_hi_u32_b32 %0, -1, %0" : "=v"(t)); return t; }
#define TIDV (wv * 64 + lane_id_v())
template <int P> __device__ __forceinline__ void run_phase(const int l, LAS unsigned char* L, const int wv) {
    karg_t kp = (karg_t)__builtin_amdgcn_kernarg_segment_ptr(); asm volatile("" : "+s"(kp));
    CREF c = *(const __attribute__((address_space(4))) Ctx*)kp;
    int tx_ = wv * 64 + lane_id_v(), bx_ = blockIdx.x; asm volatile("" : "+v"(tx_), "+s"(bx_));
    const long gtid = (long)bx_ * NTHREADS + tx_, gn = (long)gridDim.x * NTHREADS;
    const int G = (int)gridDim.x;
    if constexpr (P == 0) { dev_prologue(c, L, bx_, tx_, gtid, gn); ph_s5_consts(c, gtid, gn); }
    if constexpr (P == 2) dev_rmsnorm<false>(c, c.ln1 + l * DM, bx_, tx_, l == 0 ? 0 : 8);
    if constexpr (P == 3) { pg8::Gemm g{c.XN, c.WIN_T + (size_t)l * PLD * DM, TT, PLD, DM, DM}; pg8::StaticOrder S; S.init(TT, PLD, G, bx_);
        pg8::EpiF32<false> E{c.PROJ, PLD}; pg8::gemm_phase<pg8::EpiF32<false>, pg8::StaticOrder, true, true>(L, g, S, E, wv * 64 + lane_id_v()); }
    if constexpr (P == 4) { for (int u = bx_; u < NDU; u += G) dn_prep_unit(c, l, L, u, TIDV);
        for (int u = bx_; u < BATCH * NCH; u += G) s5_unit<false, false>(c, l, L, u / NCH, u % NCH, TIDV);
        constexpr int NPU = BATCH * NBP + DB * NBC_S;
        { const int t = TIDV; for (int u = 2 * bx_ + (t >> 8); u < NPU; u += 2 * G) { if (u < BATCH * NBP) pool_unit(c, l, u / NBP, u % NBP, t & 255); else pool_unit(c, l, BATCH + (u - BATCH * NBP) / NBC_S, (u - BATCH * NBP) % NBC_S, t & 255); } } }
    if constexpr (P == 5) {
        if (bx_ < BATCH * DNH) dn_scan_mfma(c, l, L, bx_, TIDV);
        constexpr int NU = BATCH * NG * NBP;
        volatile LAS int* qslot = (volatile LAS int*)(L + LDSCTL_OFF + 64);
#define QLOOP(qi, count, ...) for (;;) { if (wv == 0 && lane_id_v() == 0) qslot[0] = (int)__hip_atomic_fetch_add(c.QCTR + 64 * (8 * l + (qi)), 1u, __ATOMIC_RELAXED, __HIP_MEMORY_SCOPE_AGENT); \
            __syncthreads(); const int it = qslot[0]; __syncthreads(); if (it >= (count)) break; __VA_ARGS__; }
        QLOOP(0, NU, { const int qb = NBP - 1 - it / (BATCH * NG), bg = it % (BATCH * NG); nsa_unit<false>(c, l, L, bg / NG, qb, bg % NG, TIDV); })
        QLOOP(1, DB * NG, nsa_unit<true>(c, l, L, it / NG, PAST / 64, it % NG, TIDV))
        QLOOP(2, DB, dn_sample_unit(c, l, L, it, TIDV))
        QLOOP(3, BATCH, s5_carry_unit(c, l, it, TIDV))
        QLOOP(5, BATCH * NCH + DB, { if (it < BATCH * NCH) s5_unit<true, false>(c, l, L, it / NCH, it % NCH, TIDV); else s5_unit<true, true>(c, l, L, it - BATCH * NCH, 0, TIDV); })
        QLOOP(4, 256, dev_copy_out(c, l, (long)it * NTHREADS + TIDV, (long)256 * NTHREADS))
#undef QLOOP
    }
    if constexpr (P == 9) { { pg8::Gemm g{c.GLB, c.WGLU_T + (size_t)l * 65536, TT, 256, 256, 256}; pg8::StaticOrder S; S.init(TT, 256, G, bx_);
               pg8::EpiGluBf16 E{c.MIXB + 768, DM, c.GLB}; pg8::gemm_phase<pg8::EpiGluBf16, pg8::StaticOrder, true, true>(L, g, S, E, wv * 64 + lane_id_v()); }
        { int t2 = wv * 64 + lane_id_v(); asm volatile("" : "+v"(t2)); dev_dn_out(c, l, bx_, t2); } }
    if constexpr (P == 10) {
        { pg8::Gemm g{c.MIXB, c.WOUT_T + (size_t)l * DM * DM, TP, DM, DM, DM}; pg8::StaticOrder S; S.init(TP, DM, G, bx_);
          pg8::EpiF32<true> E{c.X, DM}; pg8::gemm_phase<pg8::EpiF32<true>, pg8::StaticOrder, true, true>(L, g, S, E, wv * 64 + lane_id_v()); }
        if (bx_ < 64) { const int ks = bx_ >> 4; pg8::Gemm g{c.MIXB + (size_t)TP * DM + ks * 256, c.WOUT_T + (size_t)l * DM * DM + ks * 256, TS, DM, 256, DM}; pg8::StaticOrder S; S.init(TS, DM, 16, bx_ & 15);
          pg8::EpiF32<false> E{c.PART + (size_t)ks * TS * DM, DM}; pg8::gemm_phase<pg8::EpiF32<false>, pg8::StaticOrder, true, true>(L, g, S, E, wv * 64 + lane_id_v()); } }
    if constexpr (P == 11) dev_rmsnorm<false>(c, c.ln2 + l * DM, bx_, tx_, 4);
    if constexpr (P == 12) { pg8::Gemm g{c.XN, c.WUP_T + (size_t)l * DFF * DM, TT, DFF, DM, DM}; pg8::StaticOrder S; S.init(TT, DFF, G, bx_);
        pg8::EpiSqReluBf16 E{c.UPB, DFF}; pg8::gemm_phase<pg8::EpiSqReluBf16, pg8::StaticOrder, true, true>(L, g, S, E, wv * 64 + lane_id_v()); }
    if constexpr (P == 13) {
        { pg8::Gemm g{c.UPB, c.WDN_T + (size_t)l * DM * DFF, TP, DM, DFF, DFF}; pg8::StaticOrder S; S.init(TP, DM, G, bx_);
          pg8::EpiF32<true> E{c.X, DM}; pg8::gemm_phase<pg8::EpiF32<true>, pg8::StaticOrder, true, true>(L, g, S, E, wv * 64 + lane_id_v()); }
        if (bx_ < 128) { const int ks = bx_ >> 4; pg8::Gemm g{c.UPB + (size_t)TP * DFF + ks * 512, c.WDN_T + (size_t)l * DM * DFF + ks * 512, TS, DM, 512, DFF}; pg8::StaticOrder S; S.init(TS, DM, 16, bx_ & 15);
          pg8::EpiF32<false> E{c.PART + (size_t)ks * TS * DM, DM}; pg8::gemm_phase<pg8::EpiF32<false>, pg8::StaticOrder, true, true>(L, g, S, E, wv * 64 + lane_id_v()); } }
    if constexpr (P == 14) dev_rmsnorm<true>(c, c.ln_f, bx_, tx_, 8);
}
#if N_LAUNCH_MODE == 1
__global__ void __launch_bounds__(NTHREADS, 2) fwd_kernel(Args a) {
    extern __shared__ __attribute__((aligned(16))) unsigned char lds[];
    LAS unsigned char* L = (LAS unsigned char*)lds;
    volatile LAS unsigned* MISC = (volatile LAS unsigned*)(L + LDSCTL_OFF);
    for (int u = threadIdx.x; u < (LDS_BYTES - LDSCTL_OFF) / 4; u += NTHREADS) ((LAS unsigned*)(L + LDSCTL_OFF))[u] = 0u;
    __syncthreads();
    XcdBarrier bar = xcd_barrier_post(a.bar, MISC + 8);
    const int wv = __builtin_amdgcn_readfirstlane((int)threadIdx.x >> 6);
#define PHASE(P, l) do { run_phase<P>(l, L, wv); xcd_barrier(bar, wv == 0 && lane_id_v() == 0); } while (0)
    PHASE(0, 0);
#define LAYER(l) PHASE(2, l); PHASE(3, l); PHASE(4, l); PHASE(5, l); PHASE(9, l); PHASE(10, l); PHASE(11, l); PHASE(12, l); PHASE(13, l)
#define LAYER0 PHASE(3, 0); PHASE(4, 0); PHASE(5, 0); PHASE(9, 0); PHASE(10, 0); PHASE(11, 0); PHASE(12, 0); PHASE(13, 0)
    LAYER0; LAYER(1);
#undef LAYER
    run_phase<14>(0, L, wv);
#undef PHASE
}
#else
template <int P> __global__ void __launch_bounds__(NTHREADS, 2) k_phase(Args a) {
    extern __shared__ __attribute__((aligned(16))) unsigned char lds[];
    run_phase<P>(a.lo, (LAS unsigned char*)lds, __builtin_amdgcn_readfirstlane((int)threadIdx.x >> 6));
}
template <int P> static void launch_phase(const Args& a, int grid, hipStream_t stream) {
    static bool attr = false;
    if (!attr) { (void)hipFuncSetAttribute((const void*)k_phase<P>, hipFuncAttributeMaxDynamicSharedMemorySize, LDS_BYTES); attr = true; }
    hipLaunchKernelGGL(k_phase<P>, dim3(grid), dim3(NTHREADS), LDS_BYTES, stream, a);
}
#endif

extern "C" void kernel_launch(void* const* d_in, const int* in_sizes, int n_in, void* d_out, int out_size, void* d_ws, size_t ws_size, hipStream_t stream) {
    static int grid = 0;
    if (grid == 0) {
        if (n_in != 31 || in_sizes[0] != TP * DM || (size_t)out_size != O_END || ws_size < WS_END) { fprintf(stderr, "kernel_launch: shape mismatch (n_in %d in0 %d out %d ws %zu need %zu)\n", n_in, n_in > 0 ? in_sizes[0] : -1, out_size, ws_size, (size_t)WS_END); grid = -1; return; }
        int dev = 0, cus = 0;
        if (hipGetDevice(&dev) != hipSuccess || hipDeviceGetAttribute(&cus, hipDeviceAttributeMultiprocessorCount, dev) != hipSuccess) { grid = -1; return; }
#if N_LAUNCH_MODE == 1
        int per_cu = 0;
        if (hipFuncSetAttribute((const void*)fwd_kernel, hipFuncAttributeMaxDynamicSharedMemorySize, LDS_BYTES) != hipSuccess) { fprintf(stderr, "kernel_launch: hipFuncSetAttribute failed\n"); grid = -1; return; }
        if (hipOccupancyMaxActiveBlocksPerMultiprocessor(&per_cu, (const void*)fwd_kernel, NTHREADS, LDS_BYTES) != hipSuccess || per_cu < 1) fprintf(stderr, "kernel_launch: occupancy query reports %d\n", per_cu);
        (void)hipGetLastError();
#endif
        grid = cus;
    }
    if (grid < 0) return;
    if (hipMemsetAsync((char*)d_ws + WS_CTL, 0, CTL_BYTES, stream) != hipSuccess) return;
    Args a{};
    Ctx& c = a.c;
    const float** fp[] = {&c.x_prompt, &c.x_sample, &c.cache_nsa, &c.cache_win, &c.st_conv, &c.st_dn, &c.st_s5re, &c.st_s5im, nullptr, &c.ln1, &c.ln2, &c.ln_f, &c.w_in, &c.w_out, &c.wck, &c.wcv, &c.conv_w, &c.a_log, &c.dt_bias,
                          &c.dn_norm_w, &c.lam_re, &c.lam_im, &c.log_step, &c.b_re, &c.b_im, &c.c_re, &c.c_im, &c.s5_d, &c.w_glu, &c.mlp_up, &c.mlp_down};
    for (int i = 0; i < 31; ++i) { if (i == 8) c.page_table = (const int*)d_in[i]; else *fp[i] = (const float*)d_in[i]; }
    c.out = (float*)d_out;
    char* w = (char*)d_ws;
    c.X = (float*)(w + WS_X); c.SSQ = (float*)(w + WS_SSQ); c.XN = (bf16_t*)(w + WS_XN); c.PROJ = (float*)(w + WS_PROJ); c.MIXB = (bf16_t*)(w + WS_MIXB); c.UPB = (bf16_t*)(w + WS_UPB);
    c.WIN_T = (bf16_t*)(w + WS_WIN); c.WOUT_T = (bf16_t*)(w + WS_WOUT); c.WUP_T = (bf16_t*)(w + WS_WUP); c.WDN_T = (bf16_t*)(w + WS_WDN);
    c.KC = (float*)(w + WS_KC); c.VC = (float*)(w + WS_VC); c.PC = (float*)(w + WS_PC); c.OC = (float*)(w + WS_OC); c.IDX = (int*)(w + WS_IDX);
    c.QN = (float*)(w + WS_QN); c.KN = (float*)(w + WS_KN); c.VV = (float*)(w + WS_VV); c.GG = (float*)(w + WS_GG); c.BETA = (float*)(w + WS_BETA);
    c.GC = (float*)(w + WS_GC); c.AM = (float*)(w + WS_AM); c.AQK = (float*)(w + WS_AQK); c.SOL = (float*)(w + WS_SOL); c.VNEW = (float*)(w + WS_VNEW); c.SDN = (float*)(w + WS_SDN); c.ODN = (float*)(w + WS_ODN);
    c.S5K = (float*)(w + WS_S5K); c.S5BB = (float*)(w + WS_S5BB); c.S5E = (float*)(w + WS_S5E); c.S5HIN = (float*)(w + WS_S5HIN); c.S5HS = (float*)(w + WS_S5HS); c.GL = (float*)(w + WS_GL); c.GLB = (bf16_t*)(w + WS_GLB); c.WGLU_T = (bf16_t*)(w + WS_WGLU); c.QCTR = (unsigned*)(w + WS_CTL) + 8192; c.PART = (float*)(w + WS_PART);
    a.bar = (unsigned*)(w + WS_CTL) + 1024;
#if N_LAUNCH_MODE == 1
    a.lo = 0; a.hi = NPH;
    hipLaunchKernelGGL(fwd_kernel, dim3(grid), dim3(NTHREADS), LDS_BYTES, stream, a);
#else
    a.hi = 0; a.lo = 0; launch_phase<0>(a, grid, stream);
    for (int l = 0; l < 2; ++l) { a.lo = l;
        launch_phase<1>(a, grid, stream); launch_phase<2>(a, grid, stream); launch_phase<3>(a, grid, stream); launch_phase<4>(a, grid, stream); launch_phase<5>(a, grid, stream);
        launch_phase<6>(a, grid, stream); launch_phase<7>(a, grid, stream); launch_phase<8>(a, grid, stream); launch_phase<9>(a, grid, stream); launch_phase<10>(a, grid, stream);
        launch_phase<1>(a, grid, stream); launch_phase<11>(a, grid, stream); launch_phase<12>(a, grid, stream); launch_phase<13>(a, grid, stream); }
    a.lo = 0; launch_phase<1>(a, grid, stream); launch_phase<14>(a, grid, stream);
#endif
}
```

```cpp
#include <hip/hip_runtime.h>
#include <cstdio>
#include <cstdint>
#define N_LAUNCH_MODE 1
#define HD __device__ __forceinline__
#ifndef CFG_SEQ
#define CFG_SEQ 8192
#endif
#ifndef CFG_BATCH
#define CFG_BATCH 2
#endif
#ifndef CFG_DB
#define CFG_DB 128
#endif
constexpr int DM = 1024, SEQ = CFG_SEQ, BATCH = CFG_BATCH, DB = CFG_DB, DSEQ = 8, PAST = 2048, PAGE = 128, NPAGES = PAST / PAGE;
constexpr int NUSED = DB * NPAGES, NPHYS = NUSED + (NUSED + 3) / 4;
constexpr int HD_ = 64, NH = 8, NG = 2, NR = 4, NBLK = 64, TOPK = 16, WIN = 512, W0S = PAST - WIN;
constexpr int DNH = 4, DNW = 256, CONVD = 768, S5G = 16, S5P = 64, S5C = 16, DFF = 4096, INW = 2592;
constexpr int TP = BATCH * SEQ, TS = DB * DSEQ, TT = TP + TS;
constexpr int PLD = 2816;
constexpr int C_Q = 0, C_KV = 512, C_GATE = 1280, C_DNQKV = 1304, C_DNA = 2072, C_DNB = 2076, C_DNZ = 2080, C_S5U = 2336;
constexpr int NBP = SEQ / NBLK;
constexpr int NBS_S = 33, NBC_S = 32;
constexpr int NBMAX = (NBP > 64 ? NBP : 64);
constexpr int NSEQ = BATCH + DB;
constexpr int NCH = SEQ / 64;
constexpr int NDU = BATCH * DNH * NCH;
constexpr float NEPS = 1e-6f;
static_assert(NBMAX <= 128, "selection bitmask is 128 bits");

constexpr size_t O_YP = 0, O_YS = O_YP + (size_t)TP * DM, O_KVP = O_YS + (size_t)TS * DM, O_KVS = O_KVP + (size_t)2 * TP * 512,
    O_WINP = O_KVS + (size_t)2 * TS * 512, O_WINS = O_WINP + (size_t)2 * BATCH * 512 * 256, O_CONVP = O_WINS + (size_t)2 * DB * 512 * 256,
    O_CONVS = O_CONVP + (size_t)2 * BATCH * 3 * CONVD, O_DNP = O_CONVS + (size_t)2 * DB * 3 * CONVD, O_DNS = O_DNP + (size_t)2 * BATCH * DNH * 4096,
    O_S5RP = O_DNS + (size_t)2 * DB * DNH * 4096, O_S5RS = O_S5RP + (size_t)2 * BATCH * 1024, O_S5IP = O_S5RS + (size_t)2 * DB * 1024,
    O_S5IS = O_S5IP + (size_t)2 * BATCH * 1024, O_END = O_S5IS + (size_t)2 * DB * 1024;

#ifdef HOST_EMU
typedef float bf16_t;
HD bf16_t tobf(float f) { return f; }
HD float frombf(bf16_t b) { return b; }
#else
typedef unsigned short bf16_t;
HD bf16_t tobf(float f) { unsigned u = __float_as_uint(f); u += 0x7fffu + ((u >> 16) & 1u); return (bf16_t)(u >> 16); }
HD float frombf(bf16_t b) { return __uint_as_float(((unsigned)b) << 16); }
#endif

struct Ctx {
    const float *x_prompt, *x_sample, *cache_nsa, *cache_win, *st_conv, *st_dn, *st_s5re, *st_s5im; const int* page_table;
    const float *ln1, *ln2, *ln_f, *w_in, *w_out, *wck, *wcv, *conv_w, *a_log, *dt_bias, *dn_norm_w, *lam_re, *lam_im, *log_step,
        *b_re, *b_im, *c_re, *c_im, *s5_d, *w_glu, *mlp_up, *mlp_down;
    float* out;
    float* X;
    float* SSQ;
    bf16_t* XN;
    float* PROJ;
    bf16_t* MIXB;
    bf16_t* UPB;
    bf16_t *WIN_T, *WOUT_T, *WUP_T, *WDN_T;
    float *KC, *VC;
    float* PC;
    float* OC;
    int* IDX;
    float *QN, *KN, *VV;
    float *GG, *BETA;
    float* GC;
    float* AM;
    float* AQK;
    float* SOL;
    float* VNEW;
    float* SDN;
    float* ODN;
    float* S5K;
    float* S5BB;
    float* S5E;
    float* S5HIN;
    float* S5HS;
    float* GL;
    bf16_t* GLB;
    bf16_t* WGLU_T;
    unsigned* QCTR;
    bf16_t* DNF;
    float* DNU;
    float* DNE;
    bf16_t* S5BF;
    bf16_t* S5CF;
    float* PART;
};

HD float sigmoidf_(float x) { return 1.0f / (1.0f + expf(-x)); }
HD float siluf_(float x) { return x * sigmoidf_(x); }
HD float softplusf_(float x) { return (x > 0.f ? x : 0.f) + log1pf(expf(-fabsf(x))); }
HD float geluf_(float x) { return 0.5f * x * (1.0f + tanhf(0.7978845608028654f * (x + 0.044715f * x * x * x))); }

#ifdef HOST_EMU
typedef const Ctx& CREF;
#else
typedef const __attribute__((address_space(4))) Ctx& CREF;
#endif
struct Tok { int smp, b, j, t, seq; };
HD Tok tok_of(int r) { Tok k; if (r < TP) { k.smp = 0; k.b = r / SEQ; k.j = r % SEQ; k.t = k.j; k.seq = k.b; } else { r -= TP; k.smp = 1; k.b = r / DSEQ; k.j = r % DSEQ; k.t = PAST + k.j; k.seq = BATCH + k.b; } return k; }

HD const float* kv_ptr(CREF c, int l, int smp, int b, int pos, int slot, int g) {
    if (!smp) return c.PROJ + (size_t)(b * SEQ + pos) * PLD + C_KV + slot * 128 + g * 64;
    if (pos >= PAST) return c.PROJ + (size_t)(TP + b * DSEQ + (pos - PAST)) * PLD + C_KV + slot * 128 + g * 64;
    if (slot < 4) { const int pg = c.page_table[b * NPAGES + pos / PAGE]; return c.cache_nsa + ((((size_t)l * NPHYS + pg) * PAGE + (pos % PAGE)) * 4 + slot) * 128 + g * 64; }
    return c.cache_win + ((((size_t)l * DB + b) * WIN + (pos - W0S)) * 2 + (slot - 4)) * 128 + g * 64;
}

HD void ph_prologue(CREF c, long gtid, long gn) {
    for (long i = gtid; i < (long)2 * PLD * DM; i += gn) { const int l = (int)(i / ((long)PLD * DM)); const long r = i % ((long)PLD * DM); const int n = (int)(r / DM), k = (int)(r % DM);
        c.WIN_T[i] = tobf(n < INW ? c.w_in[((size_t)l * DM + k) * INW + n] : 0.f); }
    for (long i = gtid; i < (long)2 * DM * DM; i += gn) { const int l = (int)(i / ((long)DM * DM)); const long r = i % ((long)DM * DM); const int n = (int)(r / DM), k = (int)(r % DM);
        c.WOUT_T[i] = tobf(c.w_out[((size_t)l * DM + k) * DM + n]); }
    for (long i = gtid; i < (long)2 * DFF * DM; i += gn) { const int l = (int)(i / ((long)DFF * DM)); const long r = i % ((long)DFF * DM); const int n = (int)(r / DM), k = (int)(r % DM);
        c.WUP_T[i] = tobf(c.mlp_up[((size_t)l * DM + k) * DFF + n]); }
    for (long i = gtid; i < (long)2 * DM * DFF; i += gn) { const int l = (int)(i / ((long)DM * DFF)); const long r = i % ((long)DM * DFF); const int n = (int)(r / DFF), k = (int)(r % DFF);
        c.WDN_T[i] = tobf(c.mlp_down[((size_t)l * DFF + k) * DM + n]); }
    for (long i = gtid; i < (long)TT * DM; i += gn) c.X[i] = i < (long)TP * DM ? c.x_prompt[i] : c.x_sample[i - (long)TP * DM];
}
HD void ph_s5_consts(CREF c, long gtid, long gn) {
    for (long i = gtid; i < 2 * S5G * S5P; i += gn) { const int l = (int)(i / (S5G * S5P)), g = (int)((i / S5P) % S5G);
        const double lr = c.lam_re[i], li = c.lam_im[i], dt = exp((double)c.log_step[l * S5G + g]);
        const double mag = exp(lr * dt), ar = mag * cos(li * dt), ai = mag * sin(li * dt), den = lr * lr + li * li;
        const double fr = ((ar - 1.0) * lr + ai * li) / den, fi = (ai * lr - (ar - 1.0) * li) / den;
        double pr = 1.0, pi = 0.0; for (int s = 0; s < 64; ++s) { const double nr = pr * ar - pi * ai, ni = pr * ai + pi * ar; pr = nr; pi = ni; }
        c.S5K[i * 4 + 0] = (float)ar; c.S5K[i * 4 + 1] = (float)ai; c.S5K[i * 4 + 2] = (float)pr; c.S5K[i * 4 + 3] = (float)pi;
        for (int ch = 0; ch < S5C; ++ch) { const double br = c.b_re[i * S5C + ch], bi = c.b_im[i * S5C + ch];
            c.S5BB[(i * S5C + ch) * 2 + 0] = (float)(fr * br - fi * bi); c.S5BB[(i * S5C + ch) * 2 + 1] = (float)(fr * bi + fi * br);
#ifndef HOST_EMU
            {
                const int p = (int)(i % S5P); const size_t lg = (size_t)(i / S5P);
#pragma unroll
                for (int comp = 0; comp < 2; ++comp) { const int s = 2 * p + comp, j = s >> 4, n = s & 15;
                    c.S5BF[((lg * 8 + j) * 64 + n + 16 * (ch >> 3)) * 8 + (ch & 7)] = tobf((float)(comp == 0 ? fr * br - fi * bi : fr * bi + fi * br));
                    if (ch < 8) { c.S5BF[((lg * 8 + j) * 64 + n + 32) * 8 + ch] = 0; c.S5BF[((lg * 8 + j) * 64 + n + 48) * 8 + ch] = 0; }
                    const int k = s, ks = k >> 5, kg = (k & 31) >> 3, jj = k & 7; const size_t ci = ((lg * S5C + ch) * S5P + p);
                    c.S5CF[((lg * 4 + ks) * 64 + ch + 16 * kg) * 8 + jj] = tobf(comp == 0 ? c.c_re[ci] : -c.c_im[ci]); } }
#endif
        } }
}

HD void ph_ssq(CREF c, long gtid, long gn) {
    for (long i = gtid; i < (long)TT * 64; i += gn) { const float* p = c.X + i * 16; float s = 0.f; for (int k = 0; k < 16; ++k) s += p[k] * p[k]; c.SSQ[i] = s; }
}
HD float row_rstd(CREF c, int r) { const float* p = c.SSQ + (size_t)r * 64; float s = 0.f; for (int k = 0; k < 64; ++k) s += p[k]; return 1.0f / sqrtf(s * (1.0f / DM) + NEPS); }
HD void ph_norm(CREF c, const float* gain, long gtid, long gn) {
    for (long i = gtid; i < (long)TT * (DM / 4); i += gn) { const int r = (int)(i / (DM / 4)), c4 = (int)(i % (DM / 4)) * 4; const float rs = row_rstd(c, r);
        for (int k = 0; k < 4; ++k) c.XN[(size_t)r * DM + c4 + k] = tobf(c.X[(size_t)r * DM + c4 + k] * rs * gain[c4 + k]); }
}
HD void ph_final(CREF c, long gtid, long gn) {
    for (long i = gtid; i < (long)TT * (DM / 4); i += gn) { const int r = (int)(i / (DM / 4)), c4 = (int)(i % (DM / 4)) * 4; const float rs = row_rstd(c, r);
        for (int k = 0; k < 4; ++k) c.out[O_YP + (size_t)r * DM + c4 + k] = c.X[(size_t)r * DM + c4 + k] * rs * c.ln_f[c4 + k]; }
}

HD void ph_copy_out(CREF c, int l, long gtid, long gn) {
    for (long i = gtid; i < (long)TT * 512; i += gn) { const int r = (int)(i / 512), k = (int)(i % 512); const float v = c.PROJ[(size_t)r * PLD + C_KV + k];
        if (r < TP) c.out[O_KVP + ((size_t)l * TP + r) * 512 + k] = v; else c.out[O_KVS + ((size_t)l * TS + (r - TP)) * 512 + k] = v; }
    for (long i = gtid; i < (long)BATCH * 512 * 256; i += gn) { const int b = (int)(i / (512 * 256)), w = (int)((i / 256) % 512), k = (int)(i % 256);
        c.out[O_WINP + (size_t)l * BATCH * 512 * 256 + i] = c.PROJ[(size_t)(b * SEQ + SEQ - 512 + w) * PLD + C_KV + 512 + k]; }
    for (long i = gtid; i < (long)DB * 512 * 256; i += gn) { const int b = (int)(i / (512 * 256)), w = (int)((i / 256) % 512), k = (int)(i % 256);
        c.out[O_WINS + (size_t)l * DB * 512 * 256 + i] = (w < 512 - DSEQ) ? c.cache_win[(((size_t)l * DB + b) * 512 + w + DSEQ) * 256 + k]
                                                                          : c.PROJ[(size_t)(TP + b * DSEQ + (w - (512 - DSEQ))) * PLD + C_KV + 512 + k]; }
    for (long i = gtid; i < (long)BATCH * 3 * CONVD; i += gn) { const int b = (int)(i / (3 * CONVD)), w = (int)((i / CONVD) % 3), k = (int)(i % CONVD);
        c.out[O_CONVP + (size_t)l * BATCH * 3 * CONVD + i] = c.PROJ[(size_t)(b * SEQ + SEQ - 3 + w) * PLD + C_DNQKV + k]; }
    for (long i = gtid; i < (long)DB * 3 * CONVD; i += gn) { const int b = (int)(i / (3 * CONVD)), w = (int)((i / CONVD) % 3), k = (int)(i % CONVD);
        c.out[O_CONVS + (size_t)l * DB * 3 * CONVD + i] = c.PROJ[(size_t)(TP + b * DSEQ + DSEQ - 3 + w) * PLD + C_DNQKV + k]; }
}
HD float dn_x(CREF c, int l, const Tok& k, int r, int back, int ch) {
    const int jj = k.j - back;
    if (jj >= 0) return c.PROJ[(size_t)(r - back) * PLD + C_DNQKV + ch];
    if (!k.smp) return 0.f;
    return c.st_conv[(((size_t)l * DB + k.b) * 3 + (3 + jj)) * CONVD + ch];
}
HD float dn_conv1(CREF c, int l, const Tok& k, int r, int ch) {
    const float* w = c.conv_w + ((size_t)l * CONVD + ch) * 4; float y = 0.f;
    for (int j = 0; j < 4; ++j) y += w[j] * dn_x(c, l, k, r, 3 - j, ch);
    return siluf_(y);
}
HD void ph_dn_conv(CREF c, int l, long gtid, long gn, int rbeg = 0) {
    for (long i = gtid + (long)rbeg * 3 * DNH; i < (long)TT * 3 * DNH; i += gn) { const int r = (int)(i / (3 * DNH)), part = (int)((i / DNH) % 3), h = (int)(i % DNH); const Tok k = tok_of(r);
        const int ch0 = part * DNW + h * 64; float ss = 0.f;
        if (part < 2) for (int d = 0; d < 64; ++d) { const float y = dn_conv1(c, l, k, r, ch0 + d); ss += y * y; }
        const float sc = part == 0 ? 0.125f / sqrtf(ss + 1e-6f) : (part == 1 ? 1.0f / sqrtf(ss + 1e-6f) : 1.0f);
        float* dst = (part == 0 ? c.QN : (part == 1 ? c.KN : c.VV)) + ((size_t)r * DNH + h) * 64;
        for (int d = 0; d < 64; ++d) dst[d] = dn_conv1(c, l, k, r, ch0 + d) * sc; }
    for (long i = gtid + (long)rbeg * DNH; i < (long)TT * DNH; i += gn) { const int r = (int)(i / DNH), h = (int)(i % DNH);
        c.BETA[i] = sigmoidf_(c.PROJ[(size_t)r * PLD + C_DNB + h]);
        c.GG[i] = -expf(c.a_log[l * DNH + h]) * softplusf_(c.PROJ[(size_t)r * PLD + C_DNA + h] + c.dt_bias[l * DNH + h]); }
}
HD void ph_pool(CREF c, int l, long gtid, long gn) {
    for (long i = gtid; i < (long)NSEQ * NBMAX * 128; i += gn) { const int seq = (int)(i / (NBMAX * 128)), n = (int)((i / 128) % NBMAX), g = (int)((i / 64) % 2), d = (int)(i % 64);
        const int smp = seq >= BATCH, b = smp ? seq - BATCH : seq; if (n >= (smp ? NBC_S : NBP)) continue;
        float sk = 0.f, sv = 0.f;
        for (int j = 0; j < 64; ++j) { sk += c.wck[(l * 2 + g) * 64 + j] * kv_ptr(c, l, smp, b, n * 64 + j, 0, g)[d]; sv += c.wcv[(l * 2 + g) * 64 + j] * kv_ptr(c, l, smp, b, n * 64 + j, 1, g)[d]; }
        c.KC[i] = sk; c.VC[i] = sv; }
}
HD void s5_scan(CREF c, int l, int g, int p, int r0, int len, float& hr, float& hi, bool store) {
    const float* K = c.S5K + ((size_t)(l * S5G + g) * S5P + p) * 4; const float ar = K[0], ai = K[1];
    const float* bb = c.S5BB + ((size_t)(l * S5G + g) * S5P + p) * S5C * 2;
    for (int t = 0; t < len; ++t) { const float* u = c.PROJ + (size_t)(r0 + t) * PLD + C_S5U + g * S5C; float br = 0.f, bi = 0.f;
        for (int ch = 0; ch < S5C; ++ch) { br += bb[ch * 2] * u[ch]; bi += bb[ch * 2 + 1] * u[ch]; }
        const float nr = ar * hr - ai * hi + br, ni = ar * hi + ai * hr + bi; hr = nr; hi = ni;
        if (store) { float* hs = c.S5HS + (((size_t)(r0 + t) * S5G + g) * S5P + p) * 2; hs[0] = hr; hs[1] = hi; } }
}
HD void ph_s5_passA(CREF c, int l, long gtid, long gn) {
    for (long i = gtid; i < (long)BATCH * NCH * S5G * S5P; i += gn) { const int p = (int)(i % S5P), g = (int)((i / S5P) % S5G), ch = (int)((i / (S5P * S5G)) % NCH), b = (int)(i / ((long)S5P * S5G * NCH));
        float hr = 0.f, hi = 0.f; s5_scan(c, l, g, p, b * SEQ + ch * 64, 64, hr, hi, false); c.S5E[i * 2] = hr; c.S5E[i * 2 + 1] = hi; }
}
HD void ph_dn_gc(CREF c, long gtid, long gn) {
    for (long i = gtid; i < NDU; i += gn) { const int ch = (int)(i % NCH), h = (int)((i / NCH) % DNH), b = (int)(i / (NCH * DNH)); float s = 0.f;
        for (int t = 0; t < 64; ++t) { s += c.GG[(size_t)(b * SEQ + ch * 64 + t) * DNH + h]; c.GC[i * 64 + t] = s; } }
}
HD void ph_cmp(CREF c, int l, long gtid, long gn, int rbeg = 0) {
    for (long i = gtid + (long)rbeg * NH; i < (long)TT * NH; i += gn) { const int r = (int)(i / NH), h = (int)(i % NH), g = h / NR; const Tok k = tok_of(r);
        const float slope = exp2f(-(float)(h + 1)); const int nbv = (k.t + 1) / 64;
        const float* q = c.PROJ + (size_t)r * PLD + C_Q + h * 64; float* pc = c.PC + (size_t)i * NBMAX; float* oc = c.OC + (size_t)i * 64;
        float m = -1e30f;
        for (int n = 0; n < nbv; ++n) { const float* kc = c.KC + (((size_t)k.seq * NBMAX + n) * 2 + g) * 64; float s = 0.f; for (int d = 0; d < 64; ++d) s += q[d] * kc[d];
            s = s * 0.125f - slope * ((float)k.t - ((float)(n * 64) + 31.5f)); pc[n] = s; m = s > m ? s : m; }
        float sum = 0.f; for (int n = 0; n < nbv; ++n) { const float e = expf(pc[n] - m); pc[n] = e; sum += e; }
        const float inv = 1.0f / (sum > 1e-30f ? sum : 1e-30f);
        for (int d = 0; d < 64; ++d) oc[d] = 0.f;
        for (int n = 0; n < nbv; ++n) { const float p = pc[n] * inv; pc[n] = p; const float* vc = c.VC + (((size_t)k.seq * NBMAX + n) * 2 + g) * 64; for (int d = 0; d < 64; ++d) oc[d] += p * vc[d]; }
        for (int n = nbv; n < NBMAX; ++n) pc[n] = 0.f; }
}
HD void ph_s5_carry(CREF c, int l, long gtid, long gn) {
    for (long i = gtid; i < (long)BATCH * S5G * S5P; i += gn) { const int p = (int)(i % S5P), g = (int)((i / S5P) % S5G), b = (int)(i / (S5P * S5G));
        const float* K = c.S5K + ((size_t)(l * S5G + g) * S5P + p) * 4; const float a64r = K[2], a64i = K[3]; float hr = 0.f, hi = 0.f;
        for (int ch = 0; ch < NCH; ++ch) { const size_t e = ((((size_t)b * NCH + ch) * S5G + g) * S5P + p) * 2; c.S5HIN[e] = hr; c.S5HIN[e + 1] = hi;
            const float nr = a64r * hr - a64i * hi + c.S5E[e], ni = a64r * hi + a64i * hr + c.S5E[e + 1]; hr = nr; hi = ni; }
        c.out[O_S5RP + ((size_t)l * BATCH + b) * 1024 + g * S5P + p] = hr; c.out[O_S5IP + ((size_t)l * BATCH + b) * 1024 + g * S5P + p] = hi; }
}
HD void ph_dn_mats(CREF c, long gtid, long gn) {
    for (long i = gtid; i < (long)NDU * 4096; i += gn) { const int u = (int)(i / 4096), ii = (int)((i / 64) % 64), jj = (int)(i % 64);
        const int ch = u % NCH, h = (u / NCH) % DNH, b = u / (NCH * DNH); const int r0 = b * SEQ + ch * 64;
        float am = 0.f, aq = 0.f;
        if (jj <= ii) { const float* ki = c.KN + ((size_t)(r0 + ii) * DNH + h) * 64; const float* kj = c.KN + ((size_t)(r0 + jj) * DNH + h) * 64; const float* qi = c.QN + ((size_t)(r0 + ii) * DNH + h) * 64;
            float kk = 0.f, qk = 0.f; for (int d = 0; d < 64; ++d) { kk += ki[d] * kj[d]; qk += qi[d] * kj[d]; }
            const float dec = expf(c.GC[(size_t)u * 64 + ii] - c.GC[(size_t)u * 64 + jj]);
            aq = qk * dec; if (jj < ii) am = c.BETA[(size_t)(r0 + ii) * DNH + h] * kk * dec; }
        c.AM[i] = am; c.AQK[i] = aq; }
    for (long i = gtid; i < (long)NDU * 64 * 128; i += gn) { const int u = (int)(i / 8192), ii = (int)((i / 128) % 64), col = (int)(i % 128);
        const int ch = u % NCH, h = (u / NCH) % DNH, b = u / (NCH * DNH); const int r = b * SEQ + ch * 64 + ii; const float be = c.BETA[(size_t)r * DNH + h];
        c.SOL[i] = col < 64 ? c.VV[((size_t)r * DNH + h) * 64 + col] * be : c.KN[((size_t)r * DNH + h) * 64 + (col - 64)] * be * expf(c.GC[(size_t)u * 64 + ii]); }
}
HD void ph_topk(CREF c, long gtid, long gn, int rbeg = 0) {
    for (long i = gtid + (long)rbeg * NG; i < (long)TT * NG; i += gn) { const int r = (int)(i / NG), g = (int)(i % NG); const Tok k = tok_of(r);
        const int cur = k.t / 64, nbs = k.smp ? NBS_S : NBP; const float* pc = c.PC + ((size_t)r * NH + g * NR) * NBMAX;
        unsigned long long tk0 = 0ull, tk1 = 0ull; int* idx = c.IDX + (size_t)i * TOPK;
        const int nsel = nbs < TOPK ? nbs : TOPK;
        for (int s = 0; s < TOPK; ++s) { int best = -1; float bv = 0.f;
            if (s < nsel) for (int n = 0; n < nbs; ++n) { const bool taken = n < 64 ? ((tk0 >> n) & 1ull) : ((tk1 >> (n - 64)) & 1ull); if (taken) continue;
                float sc; if (n > cur) sc = -1e9f; else if (n == 0 || n == cur || n == cur - 1) sc = 1e9f; else sc = (pc[n] + pc[NBMAX + n]) + (pc[2 * NBMAX + n] + pc[3 * NBMAX + n]);
                if (best < 0 || sc > bv) { best = n; bv = sc; } }
            if (best >= 0) { if (best < 64) tk0 |= 1ull << best; else tk1 |= 1ull << (best - 64); }
            idx[s] = (best >= 0 && best <= cur) ? best : -1; } }
}
HD void ph_s5_passB(CREF c, int l, long gtid, long gn) {
    for (long i = gtid; i < (long)BATCH * NCH * S5G * S5P; i += gn) { const int p = (int)(i % S5P), g = (int)((i / S5P) % S5G), ch = (int)((i / (S5P * S5G)) % NCH), b = (int)(i / ((long)S5P * S5G * NCH));
        float hr = c.S5HIN[i * 2], hi = c.S5HIN[i * 2 + 1]; s5_scan(c, l, g, p, b * SEQ + ch * 64, 64, hr, hi, true); }
    for (long i = gtid; i < (long)DB * S5G * S5P; i += gn) { const int p = (int)(i % S5P), g = (int)((i / S5P) % S5G), b = (int)(i / (S5P * S5G));
        float hr = c.st_s5re[(size_t)l * DB * 1024 + i], hi = c.st_s5im[(size_t)l * DB * 1024 + i]; s5_scan(c, l, g, p, TP + b * DSEQ, DSEQ, hr, hi, true);
        c.out[O_S5RS + (size_t)l * DB * 1024 + i] = hr; c.out[O_S5IS + (size_t)l * DB * 1024 + i] = hi; }
}
HD void ph_dn_solve(CREF c, long gtid, long gn) {
    for (long i = gtid; i < (long)NDU * 128; i += gn) { const int u = (int)(i / 128), col = (int)(i % 128); float* x = c.SOL + (size_t)u * 8192 + col; const float* A = c.AM + (size_t)u * 4096;
        for (int ii = 1; ii < 64; ++ii) { float s = x[ii * 128]; for (int jj = 0; jj < ii; ++jj) s -= A[ii * 64 + jj] * x[jj * 128]; x[ii * 128] = s; } }
}
HD void ph_attn(CREF c, int l, long gtid, long gn, int rbeg = 0) {
    for (long i = gtid + (long)rbeg * NH; i < (long)TT * NH; i += gn) { const int r = (int)(i / NH), h = (int)(i % NH), g = h / NR; const Tok k = tok_of(r);
        const float slope = exp2f(-(float)(h + 1));
        float q[64];
#pragma unroll
        for (int d = 0; d < 64; ++d) q[d] = c.PROJ[(size_t)r * PLD + C_Q + h * 64 + d] * 0.125f;
        const float* gp = c.PROJ + (size_t)r * PLD + C_GATE + h * 3; const float g0 = sigmoidf_(gp[0]), g1 = sigmoidf_(gp[1]), g2 = sigmoidf_(gp[2]);
        float* oc = c.OC + (size_t)i * 64;
        float o[64]; float m = -1e30f, lsum = 0.f;
#pragma unroll
        for (int d = 0; d < 64; ++d) o[d] = 0.f;
        const int* idx = c.IDX + ((size_t)r * NG + g) * TOPK;
        for (int s = 0; s < TOPK; ++s) { const int n = idx[s]; if (n < 0) continue;
            for (int j = 0; j < 64; ++j) { const int pos = n * 64 + j; if (pos > k.t) break;
                const float* kp = kv_ptr(c, l, k.smp, k.b, pos, 2, g); const float* vp = kv_ptr(c, l, k.smp, k.b, pos, 3, g);
                float sc = 0.f;
#pragma unroll
                for (int d = 0; d < 64; ++d) sc += q[d] * kp[d];
                sc -= slope * (float)(k.t - pos);
                const float mn = sc > m ? sc : m, al = expf(m - mn), p = expf(sc - mn); m = mn; lsum = lsum * al + p;
#pragma unroll
                for (int d = 0; d < 64; ++d) o[d] = o[d] * al + p * vp[d]; } }
        { const float inv = g1 / (lsum > 1e-30f ? lsum : 1e-30f);
#pragma unroll
          for (int d = 0; d < 64; ++d) oc[d] = g0 * oc[d] + inv * o[d]; }
        m = -1e30f; lsum = 0.f;
#pragma unroll
        for (int d = 0; d < 64; ++d) o[d] = 0.f;
        const int w0 = k.smp ? W0S : 0; int p0 = k.t - (WIN - 1); if (p0 < w0) p0 = w0;
        for (int pos = p0; pos <= k.t; ++pos) { const float* kp = kv_ptr(c, l, k.smp, k.b, pos, 4, g); const float* vp = kv_ptr(c, l, k.smp, k.b, pos, 5, g);
            float sc = 0.f;
#pragma unroll
            for (int d = 0; d < 64; ++d) sc += q[d] * kp[d];
            sc -= slope * (float)(k.t - pos);
            const float mn = sc > m ? sc : m, al = expf(m - mn), p = expf(sc - mn); m = mn; lsum = lsum * al + p;
#pragma unroll
            for (int d = 0; d < 64; ++d) o[d] = o[d] * al + p * vp[d]; }
        { const float inv = g2 / (lsum > 1e-30f ? lsum : 1e-30f);
#pragma unroll
          for (int d = 0; d < 64; ++d) c.MIXB[(size_t)r * DM + h * 64 + d] = tobf(oc[d] + inv * o[d]); } }
}
HD void ph_s5_y(CREF c, int l, long gtid, long gn) {
    for (long i = gtid; i < (long)TT * 256; i += gn) { const int r = (int)(i / 256), ch = (int)(i % 256), g = ch / S5C, cc = ch % S5C;
        const float* cr = c.c_re + (((size_t)l * S5G + g) * S5C + cc) * S5P; const float* ci = c.c_im + (((size_t)l * S5G + g) * S5C + cc) * S5P;
        const float* hs = c.S5HS + ((size_t)r * S5G + g) * S5P * 2; float y = 0.f;
        for (int p = 0; p < S5P; ++p) y += cr[p] * hs[2 * p] - ci[p] * hs[2 * p + 1];
        y += c.s5_d[l * 256 + ch] * c.PROJ[(size_t)r * PLD + C_S5U + ch]; c.GL[i] = geluf_(y); }
}
HD void ph_dn_scan_prompt(CREF c, int l, long gtid, long gn) {
    for (long i = gtid; i < (long)BATCH * DNH * 64; i += gn) { const int jc = (int)(i % 64), h = (int)((i / 64) % DNH), b = (int)(i / (64 * DNH));
        float S[64];
#pragma unroll
        for (int kk = 0; kk < 64; ++kk) S[kk] = 0.f;
        float* vn = c.VNEW + (size_t)(b * DNH + h) * 4096 + jc;
        for (int ch = 0; ch < NCH; ++ch) { const int u = (b * DNH + h) * NCH + ch; const int r0 = b * SEQ + ch * 64;
            const float* sol = c.SOL + (size_t)u * 8192; const float* gc = c.GC + (size_t)u * 64; const float* aqk = c.AQK + (size_t)u * 4096;
            for (int t = 0; t < 64; ++t) { const float* w = sol + t * 128 + 64; float s = sol[t * 128 + jc];
#pragma unroll
                for (int kk = 0; kk < 64; ++kk) s -= w[kk] * S[kk];
                vn[t * 64] = s; }
            for (int t = 0; t < 64; ++t) { const float* qq = c.QN + ((size_t)(r0 + t) * DNH + h) * 64; float s = 0.f;
#pragma unroll
                for (int kk = 0; kk < 64; ++kk) s += qq[kk] * S[kk];
                s *= expf(gc[t]);
                for (int t2 = 0; t2 <= t; ++t2) s += aqk[t * 64 + t2] * vn[t2 * 64];
                c.ODN[((size_t)(r0 + t) * DNH + h) * 64 + jc] = s; }
            const float gl = gc[63], eg = expf(gl);
#pragma unroll
            for (int kk = 0; kk < 64; ++kk) S[kk] *= eg;
            for (int t = 0; t < 64; ++t) { const float* kk_ = c.KN + ((size_t)(r0 + t) * DNH + h) * 64; const float f = expf(gl - gc[t]) * vn[t * 64];
#pragma unroll
                for (int kk = 0; kk < 64; ++kk) S[kk] += kk_[kk] * f; } }
#pragma unroll
        for (int kk = 0; kk < 64; ++kk) c.out[O_DNP + (((size_t)l * BATCH + b) * DNH + h) * 4096 + kk * 64 + jc] = S[kk]; }
}
HD void ph_dn_scan_sample(CREF c, int l, long gtid, long gn) {
    for (long i = gtid; i < (long)DB * DNH * 64; i += gn) { const int jc = (int)(i % 64), h = (int)((i / 64) % DNH), b = (int)(i / (64 * DNH));
        float S[64]; const float* s0 = c.st_dn + (((size_t)l * DB + b) * DNH + h) * 4096 + jc;
#pragma unroll
        for (int kk = 0; kk < 64; ++kk) S[kk] = s0[kk * 64];
        for (int t = 0; t < DSEQ; ++t) { const int r = TP + b * DSEQ + t; const float* kv = c.KN + ((size_t)r * DNH + h) * 64; const float* qq = c.QN + ((size_t)r * DNH + h) * 64;
            const float a = expf(c.GG[(size_t)r * DNH + h]), be = c.BETA[(size_t)r * DNH + h]; float ks = 0.f;
#pragma unroll
            for (int kk = 0; kk < 64; ++kk) { S[kk] *= a; ks += kv[kk] * S[kk]; }
            const float vnw = be * (c.VV[((size_t)r * DNH + h) * 64 + jc] - ks); float os = 0.f;
#pragma unroll
            for (int kk = 0; kk < 64; ++kk) { S[kk] += kv[kk] * vnw; os += qq[kk] * S[kk]; }
            c.ODN[((size_t)r * DNH + h) * 64 + jc] = os; }
#pragma unroll
        for (int kk = 0; kk < 64; ++kk) c.out[O_DNS + (((size_t)l * DB + b) * DNH + h) * 4096 + kk * 64 + jc] = S[kk]; }
}
HD void ph_s5_glu(CREF c, int l, long gtid, long gn) {
    for (long i = gtid; i < (long)TT * 256; i += gn) { const int r = (int)(i / 256), ch = (int)(i % 256); const float* gl = c.GL + (size_t)r * 256; const float* w = c.w_glu + (size_t)l * 65536 + ch; float z = 0.f;
        for (int kk = 0; kk < 256; ++kk) z += gl[kk] * w[kk * 256];
        c.MIXB[(size_t)r * DM + 768 + ch] = tobf(gl[ch] * sigmoidf_(z)); }
}
HD void ph_dn_out(CREF c, int l, long gtid, long gn) {
    for (long i = gtid; i < (long)TT * DNH; i += gn) { const int r = (int)(i / DNH), h = (int)(i % DNH); const float* o = c.ODN + (size_t)i * 64; float ss = 0.f;
        for (int d = 0; d < 64; ++d) ss += o[d] * o[d];
        const float rs = 1.0f / sqrtf(ss * (1.0f / 64.0f) + NEPS);
        for (int d = 0; d < 64; ++d) c.MIXB[(size_t)r * DM + 512 + h * 64 + d] = tobf(o[d] * rs * c.dn_norm_w[l * 64 + d] * siluf_(c.PROJ[(size_t)r * PLD + C_DNZ + h * 64 + d])); }
}
namespace pg8 {
#define PG8_LAS __attribute__((address_space(3)))
typedef unsigned short bf16_t;
typedef short bf16x8 __attribute__((ext_vector_type(8)));
typedef float f32x4 __attribute__((ext_vector_type(4)));
typedef unsigned u32x4 __attribute__((ext_vector_type(4)));
constexpr int BM = 256, BK = 64, HALF = 128, HTB = HALF * BK * 2  , STAGE_BYTES = 8 * HTB, NXCD = 8, WGM = 8;

__host__ __device__ __forceinline__ int lds_byte(int r, int c) { const int st = (r >> 4) * 2 + (c >> 5), rr = r & 15, cc = c & 31, ob = rr * 64 + cc * 2; return st * 1024 + (ob ^ (((ob >> 9) & 1) << 5)); }
__host__ __device__ __forceinline__ void stage_rc(int b, int& R, int& C) { const int st = b / 1024, sb = b % 1024, swz = sb ^ (((sb >> 9) & 1) << 5); R = (st >> 1) * 16 + swz / 64; C = (st & 1) * 32 + (swz % 64) / 2; }
__host__ __device__ __forceinline__ int perm32(int rho) { const int n = rho >> 4, i = rho & 15; return 8 * (i >> 2) + 4 * n + (i & 3); }

struct Unit { int pm, pn; };
struct Gemm { const bf16_t* A; const bf16_t* Bt; int M, N, K, ld; };

struct StaticOrder {
    int nM, nN, nwg, G, c;
    __host__ __device__ void init(int M, int N, int G_, int c_) { nM = M / BM; nN = N / BM; nwg = nM * nN; G = G_; c = c_; }
    __host__ __device__ bool next(int i, Unit& u) const {
        const long L = (long)i * G + c; if (L >= nwg) return false;
        int wgid = (int)L; { const int q = nwg / NXCD, r = nwg % NXCD, xcd = wgid % NXCD, off = wgid / NXCD; wgid = (xcd < r ? xcd * (q + 1) : r * (q + 1) + (xcd - r) * q) + off; }
        const int nig = WGM * nN, gid = wgid / nig, fm = gid * WGM, gsz = (nM - fm) < WGM ? (nM - fm) : WGM;
        u.pm = fm + ((wgid % nig) % gsz); u.pn = (wgid % nig) / gsz; return true;
    }
    __device__ __forceinline__ void a_ready(const Unit&) const {}
    __device__ __forceinline__ void done(const Unit&) const {}
};

__device__ __forceinline__ unsigned cvt_pk_bf16(float lo, float hi) { unsigned r; asm volatile("v_cvt_pk_bf16_f32 %0, %1, %2" : "=v"(r) : "v"(lo), "v"(hi)); return r; }
typedef float f32x2 __attribute__((ext_vector_type(2)));
template <class Epi, class Sched, bool ALIGN_EPI = false, bool SP2 = false>
__device__ __forceinline__ void gemm_phase(PG8_LAS unsigned char* lds, const Gemm g, const Sched& S, const Epi& E, int tid_) {
    asm volatile("" : "+v"(tid_));
    const int tid = tid_, wid = __builtin_amdgcn_readfirstlane(tid >> 6), lane = tid & 63, wr = wid >> 2, wc = wid & 3, fr = lane & 15, fq = lane >> 4;
    const int K = g.K, nt = K / BK;
    unsigned voffA[2], voffB[2];
#pragma unroll
    for (int i = 0; i < 2; ++i) { int R, C; stage_rc(tid * 16 + i * 8192, R, C); const int Rb = Epi::PERM ? ((R & ~31) + perm32(R & 31)) : R;
        voffA[i] = (unsigned)(R * g.ld + C) * 2u; voffB[i] = (unsigned)(Rb * g.ld + C) * 2u; }
    const size_t kstep = (size_t)(BK * 2);
    const size_t hstep = (size_t)HALF * g.ld * 2;
    const size_t tstep = 2 * hstep;
    const unsigned ldsw = (unsigned)wid * 1024u;
    const int aoff = lds_byte(wr * 64 + fr, fq * 8), boff = lds_byte(wc * 32 + fr, fq * 8);
#define PG8_SA(b, h) (((b) * 2 + (h)) * HTB)
#define PG8_SB(b, h) ((4 + (b) * 2 + (h)) * HTB)
#define PG8_STAGE(bufoff, gbase, voff) do { _Pragma("unroll") for (int _i = 0; _i < 2; ++_i) \
        __builtin_amdgcn_global_load_lds((const unsigned*)((const char*)(gbase) + (voff)[_i]), (PG8_LAS unsigned*)(lds + (bufoff) + ldsw + _i * 8192), 16, 0, 0); } while (0)
#define PG8_LDA(dst, b, h) do { _Pragma("unroll") for (int m = 0; m < 4; ++m) _Pragma("unroll") for (int k = 0; k < 2; ++k) dst[m][k] = *(const PG8_LAS bf16x8*)(lds + PG8_SA(b, h) + aoff + m * 2048 + k * 1024); } while (0)
#define PG8_LDB(dst, b, h) do { _Pragma("unroll") for (int n = 0; n < 2; ++n) _Pragma("unroll") for (int k = 0; k < 2; ++k) dst[n][k] = *(const PG8_LAS bf16x8*)(lds + PG8_SB(b, h) + boff + n * 2048 + k * 1024); } while (0)
#define PG8_MMA(ai, bj, At, Bt) do { __builtin_amdgcn_s_setprio(1); _Pragma("unroll") for (int m = 0; m < 4; ++m) _Pragma("unroll") for (int n = 0; n < 2; ++n) _Pragma("unroll") for (int k = 0; k < 2; ++k) \
        acc[ai][bj][m][n] = __builtin_amdgcn_mfma_f32_16x16x32_bf16(Bt[n][k], At[m][k], acc[ai][bj][m][n], 0, 0, 0); __builtin_amdgcn_s_setprio(0); } while (0)
#define PG8_WAIT_V(n) asm volatile("s_waitcnt vmcnt(" #n ")" ::: "memory")
#define PG8_WAIT_L(n) asm volatile("s_waitcnt lgkmcnt(" #n ")" ::: "memory")
#define PG8_BAR __builtin_amdgcn_s_barrier()
#define PG8_SCHED __builtin_amdgcn_sched_barrier(0)
    Unit cur, nxt; int ui = 0;
    if (!S.next(0, cur)) return;
    f32x4 acc[2][2][4][2];
#pragma unroll
    for (int a = 0; a < 2; ++a)
#pragma unroll
        for (int b = 0; b < 2; ++b)
#pragma unroll
            for (int m = 0; m < 4; ++m)
#pragma unroll
                for (int n = 0; n < 2; ++n) acc[a][b][m][n] = (f32x4){0.f, 0.f, 0.f, 0.f};
    bf16x8 At[4][2], B0[2][2], B1[2][2];
    const char* cA = (const char*)g.A + (size_t)cur.pm * tstep; const char* cB = (const char*)g.Bt + (size_t)cur.pn * tstep;
    S.a_ready(cur);
    if constexpr (SP2) {
        PG8_STAGE(PG8_SB(0, 0), cB, voffB); PG8_STAGE(PG8_SB(0, 1), cB + hstep, voffB); PG8_STAGE(PG8_SA(0, 0), cA, voffA); PG8_STAGE(PG8_SA(0, 1), cA + hstep, voffA);
        if (wr == 1) PG8_BAR;
        PG8_WAIT_V(2); PG8_BAR;
        PG8_STAGE(PG8_SB(1, 0), cB + kstep, voffB); PG8_STAGE(PG8_SA(1, 0), cA + kstep, voffA); PG8_STAGE(PG8_SB(1, 1), cB + hstep + kstep, voffB);
        PG8_WAIT_V(6); PG8_BAR;
    } else {
        PG8_STAGE(PG8_SB(0, 0), cB, voffB); PG8_STAGE(PG8_SA(0, 0), cA, voffA); PG8_STAGE(PG8_SB(0, 1), cB + hstep, voffB); PG8_STAGE(PG8_SA(0, 1), cA + hstep, voffA);
        if (wr == 1) PG8_BAR;
        PG8_WAIT_V(4); PG8_BAR;
        PG8_STAGE(PG8_SB(1, 0), cB + kstep, voffB); PG8_STAGE(PG8_SA(1, 0), cA + kstep, voffA); PG8_STAGE(PG8_SB(1, 1), cB + hstep + kstep, voffB);
        PG8_WAIT_V(6); PG8_BAR;
    }
    for (;;) {
        const bool has_next = S.next(ui + 1, nxt);
        const char* nA = has_next ? (const char*)g.A + (size_t)nxt.pm * tstep : cA; const char* nB = has_next ? (const char*)g.Bt + (size_t)nxt.pn * tstep : cB;
        for (int t = 0; t < nt; t += 2) {
            const bool last = (t == nt - 2);
            const char* a1 = cA + (size_t)(t + 1) * kstep;
            const char* a2 = last ? nA : cA + (size_t)(t + 2) * kstep; const char* b2 = last ? nB : cB + (size_t)(t + 2) * kstep;
            const char* a3 = a2 + kstep; const char* b3 = b2 + kstep;
            if (last && has_next) S.a_ready(nxt);
            if constexpr (SP2) {
            PG8_LDB(B0, 0, 0); PG8_LDB(B1, 0, 1); PG8_SCHED; PG8_LDA(At, 0, 0); PG8_STAGE(PG8_SA(1, 1), a1 + hstep, voffA);
            PG8_WAIT_V(8); PG8_WAIT_L(0); PG8_BAR; PG8_MMA(0, 0, At, B0); PG8_MMA(0, 1, At, B1); PG8_BAR; PG8_SCHED;
            PG8_LDA(At, 0, 1); PG8_STAGE(PG8_SB(0, 0), b2, voffB); PG8_STAGE(PG8_SB(0, 1), b2 + hstep, voffB); PG8_STAGE(PG8_SA(0, 0), a2, voffA);
            PG8_WAIT_V(8); PG8_WAIT_L(0); PG8_BAR; PG8_MMA(1, 0, At, B0); PG8_MMA(1, 1, At, B1); PG8_BAR; PG8_SCHED;
            PG8_LDB(B0, 1, 0); PG8_LDB(B1, 1, 1); PG8_SCHED; PG8_LDA(At, 1, 0); PG8_STAGE(PG8_SA(0, 1), a2 + hstep, voffA);
            PG8_WAIT_V(8); PG8_WAIT_L(0); PG8_BAR; PG8_MMA(0, 0, At, B0); PG8_MMA(0, 1, At, B1); PG8_BAR; PG8_SCHED;
            PG8_LDA(At, 1, 1); PG8_STAGE(PG8_SB(1, 0), b3, voffB); PG8_STAGE(PG8_SB(1, 1), b3 + hstep, voffB); PG8_STAGE(PG8_SA(1, 0), a3, voffA);
            PG8_WAIT_V(8); PG8_WAIT_L(0); PG8_BAR; PG8_MMA(1, 0, At, B0); PG8_MMA(1, 1, At, B1); PG8_BAR; PG8_SCHED;
            } else {
            PG8_LDB(B0, 0, 0); PG8_SCHED; PG8_LDA(At, 0, 0); PG8_STAGE(PG8_SA(1, 1), a1 + hstep, voffA);
            PG8_WAIT_L(8); PG8_BAR; PG8_WAIT_L(0); PG8_MMA(0, 0, At, B0); PG8_BAR; PG8_SCHED;
            PG8_LDB(B1, 0, 1); PG8_STAGE(PG8_SB(0, 0), b2, voffB);
            PG8_BAR; PG8_WAIT_L(0); PG8_MMA(0, 1, At, B1); PG8_BAR;
            PG8_LDA(At, 0, 1); PG8_STAGE(PG8_SA(0, 0), a2, voffA);
            PG8_BAR; PG8_WAIT_L(0); PG8_MMA(1, 0, At, B0); PG8_BAR; PG8_SCHED;
            PG8_STAGE(PG8_SB(0, 1), b2 + hstep, voffB);
            PG8_WAIT_V(6); PG8_BAR; PG8_MMA(1, 1, At, B1); PG8_BAR;
            PG8_LDB(B0, 1, 0); PG8_SCHED; PG8_LDA(At, 1, 0); PG8_STAGE(PG8_SA(0, 1), a2 + hstep, voffA);
            PG8_WAIT_L(8); PG8_BAR; PG8_WAIT_L(0); PG8_MMA(0, 0, At, B0); PG8_BAR; PG8_SCHED;
            PG8_LDB(B1, 1, 1); PG8_STAGE(PG8_SB(1, 0), b3, voffB);
            PG8_BAR; PG8_WAIT_L(0); PG8_MMA(0, 1, At, B1); PG8_BAR;
            PG8_LDA(At, 1, 1); PG8_STAGE(PG8_SA(1, 0), a3, voffA);
            PG8_BAR; PG8_WAIT_L(0); PG8_MMA(1, 0, At, B0); PG8_BAR; PG8_SCHED;
            PG8_STAGE(PG8_SB(1, 1), b3 + hstep, voffB);
            PG8_WAIT_V(6); PG8_BAR; PG8_MMA(1, 1, At, B1); PG8_BAR;
            }
        }
        if constexpr (ALIGN_EPI) { if (wr == 0) PG8_BAR; }
        if constexpr (!Epi::AFTER_DRAIN) { E(acc, cur, wr, wc, fr, fq); S.done(cur); }
        if (!has_next) break;
#pragma unroll
        for (int a = 0; a < 2; ++a)
#pragma unroll
            for (int b = 0; b < 2; ++b)
#pragma unroll
                for (int m = 0; m < 4; ++m)
#pragma unroll
                    for (int n = 0; n < 2; ++n) acc[a][b][m][n] = (f32x4){0.f, 0.f, 0.f, 0.f};
        cur = nxt; cA = nA; cB = nB; ++ui;
        if constexpr (ALIGN_EPI) { if (wr == 1) PG8_BAR; }
    }
    PG8_WAIT_V(0);
    if constexpr (!ALIGN_EPI) { if (wr == 0) PG8_BAR; }
    PG8_BAR;
    if constexpr (Epi::AFTER_DRAIN) { E.fused(acc, cur, wr, wc, fr, fq, lds, wid, lane); S.done(cur); }
#undef PG8_SA
#undef PG8_SB
#undef PG8_STAGE
#undef PG8_LDA
#undef PG8_LDB
#undef PG8_MMA
#undef PG8_WAIT_V
#undef PG8_WAIT_L
#undef PG8_BAR
#undef PG8_SCHED
}
}
#define LAS __attribute__((address_space(3)))
typedef short bf16x8_t __attribute__((ext_vector_type(8)));
typedef float f32x4_t __attribute__((ext_vector_type(4)));
typedef float f32x2_t __attribute__((ext_vector_type(2)));
typedef __bf16 bf16x2_t __attribute__((ext_vector_type(2)));
typedef unsigned u32x4_t __attribute__((ext_vector_type(4)));
typedef unsigned u32x2_t __attribute__((ext_vector_type(2)));
#define DEV __device__ __forceinline__
DEV unsigned cvtpk(float lo, float hi) { f32x2_t v = {lo, hi}; bf16x2_t b = __builtin_convertvector(v, bf16x2_t); return __builtin_bit_cast(unsigned, b); }
DEV bf16x8_t pack8(const f32x4_t a, const f32x4_t b) { u32x4_t p = {cvtpk(a[0], a[1]), cvtpk(a[2], a[3]), cvtpk(b[0], b[1]), cvtpk(b[2], b[3])}; return __builtin_bit_cast(bf16x8_t, p); }
#define MFMA16(a, b, c) __builtin_amdgcn_mfma_f32_16x16x32_bf16((a), (b), (c), 0, 0, 0)

constexpr int DNS_FB = 8192, DNS_US = 68, DNS_EG = 4 * DNS_FB + 64 * DNS_US * 4, DNS_BUF = DNS_EG + 16;
struct DnStage { u32x4_t fr[8]; f32x4_t ut[4]; float eg; };
DEV void dn_scan_load(CREF c, DnStage& st, int u, int pt) {
    const u32x4_t* f = (const u32x4_t*)(c.DNF + (size_t)u * 16384) + pt; const f32x4_t* uq = (const f32x4_t*)(c.DNU + (size_t)u * 4096) + pt;
#pragma unroll
    for (int k = 0; k < 8; ++k) st.fr[k] = f[256 * k];
#pragma unroll
    for (int k = 0; k < 4; ++k) st.ut[k] = uq[256 * k];
    st.eg = c.DNE[u];
}
DEV void dn_scan_store(const DnStage& st, LAS unsigned char* dst, int pt) {
#pragma unroll
    for (int k = 0; k < 8; ++k) *(LAS u32x4_t*)(dst + (pt + 256 * k) * 16) = st.fr[k];
#pragma unroll
    for (int k = 0; k < 4; ++k) { const int idx = pt + 256 * k, v = idx & 63, tq = idx >> 6; *(LAS f32x4_t*)(dst + 4 * DNS_FB + (v * DNS_US + 4 * tq) * 4) = st.ut[k]; }
    if (pt == 0) *(LAS float*)(dst + DNS_EG) = st.eg;
}
DEV void dn_scan_consume(CREF c, const LAS unsigned char* buf, f32x4_t (&S)[4], int r0, int h, int v, int lane, int kb) {
    const LAS unsigned char* fb = buf + lane * 16;
    const LAS float* ut = (const LAS float*)(buf + 4 * DNS_FB) + v * DNS_US + 4 * kb;
#define DNS_FR(mat, mt, ks) (*(const LAS bf16x8_t*)(fb + (mat) * DNS_FB + ((mt) * 2 + (ks)) * 1024))
    const float eg = *(const LAS float*)(buf + DNS_EG);
    const bf16x8_t Sb0 = pack8(S[0], S[1]), Sb1 = pack8(S[2], S[3]);
    f32x4_t ws[4], qs[4], ds[4], vn[4];
    const f32x4_t z4 = {0.f, 0.f, 0.f, 0.f};
#pragma unroll
    for (int mt = 0; mt < 4; ++mt) { ws[mt] = MFMA16(DNS_FR(0, mt, 0), Sb0, z4); ws[mt] = MFMA16(DNS_FR(0, mt, 1), Sb1, ws[mt]);
                                     qs[mt] = MFMA16(DNS_FR(1, mt, 0), Sb0, z4); qs[mt] = MFMA16(DNS_FR(1, mt, 1), Sb1, qs[mt]); }
#pragma unroll
    for (int mt = 0; mt < 4; ++mt) vn[mt] = *(const LAS f32x4_t*)(ut + 16 * mt) - ws[mt];
    const bf16x8_t Vb0 = pack8(vn[0], vn[1]), Vb1 = pack8(vn[2], vn[3]);
#pragma unroll
    for (int mt = 0; mt < 4; ++mt) { qs[mt] = MFMA16(DNS_FR(2, mt, 0), Vb0, qs[mt]); qs[mt] = MFMA16(DNS_FR(2, mt, 1), Vb1, qs[mt]);
                                     ds[mt] = MFMA16(DNS_FR(3, mt, 0), Vb0, z4); ds[mt] = MFMA16(DNS_FR(3, mt, 1), Vb1, ds[mt]); }
#pragma unroll
    for (int mt = 0; mt < 4; ++mt) { S[mt] = S[mt] * eg + ds[mt];
#pragma unroll
        for (int i = 0; i < 4; ++i) c.ODN[((size_t)(r0 + 16 * mt + 4 * kb + i) * DNH + h) * 64 + v] = qs[mt][i]; }
#undef DNS_FR
}
DEV void dn_scan_mfma(CREF c, int l, LAS unsigned char* L, int bh, int tid) {
    asm volatile("" : "+v"(tid));
    const int b = bh / DNH, h = bh % DNH, wid = tid >> 6, lane = tid & 63, n = lane & 15, kb = lane >> 4;
    const bool producer = wid >= 4;
    const int v = 16 * (wid & 3) + n;
    f32x4_t S[4];
#pragma unroll
    for (int mt = 0; mt < 4; ++mt) S[mt] = (f32x4_t){0.f, 0.f, 0.f, 0.f};
    const int u0 = (b * DNH + h) * NCH, rb = b * SEQ, pt = tid - 256;
    if (producer) {
        DnStage s0, s1, s2, s3;
        dn_scan_load(c, s0, u0, pt); dn_scan_store(s0, L, pt);
        dn_scan_load(c, s0, u0 + 1, pt); dn_scan_load(c, s1, u0 + 2, pt); dn_scan_load(c, s2, u0 + 3, pt); dn_scan_load(c, s3, u0 + 4, pt);
#define DNS_STEP(st, ch_) { __syncthreads(); if ((ch_) + 1 < NCH) { dn_scan_store(st, L + (((ch_) + 1) & 1) * DNS_BUF, pt); if ((ch_) + 5 < NCH) dn_scan_load(c, st, u0 + (ch_) + 5, pt); } }
        for (int ch = 0; ch < NCH; ch += 4) { DNS_STEP(s0, ch) DNS_STEP(s1, ch + 1) DNS_STEP(s2, ch + 2) DNS_STEP(s3, ch + 3) }
#undef DNS_STEP
    } else {
        for (int ch = 0; ch < NCH; ch += 2) {
            __syncthreads();
            dn_scan_consume(c, L, S, rb + ch * 64, h, v, lane, kb);
            __syncthreads();
            dn_scan_consume(c, L + DNS_BUF, S, rb + (ch + 1) * 64, h, v, lane, kb);
        }
    }
    if (!producer) {
#pragma unroll
        for (int mt = 0; mt < 4; ++mt)
#pragma unroll
            for (int i = 0; i < 4; ++i) c.out[O_DNP + (((size_t)l * BATCH + b) * DNH + h) * 4096 + (16 * mt + 4 * kb + i) * 64 + v] = S[mt][i];
    }
    __syncthreads();
}

DEV float wave_sum(float v) {
#pragma unroll
    for (int o = 1; o < 64; o <<= 1) v += __shfl_xor(v, o);
    return v;
}
DEV void transpose_item(const float* W, int K, int N, bf16_t* WT, LAS float* scr, int item, int lane) {
    const int nblk = N / 32, kb = item / nblk, nb = item % nblk, k0 = 64 * kb, n0 = 32 * nb;
#pragma unroll 8
    for (int i = 0; i < 32; ++i) { const int kk = 2 * i + (lane >> 5); scr[kk * 33 + (lane & 31)] = W[(size_t)(k0 + kk) * N + n0 + (lane & 31)]; }
    asm volatile("s_waitcnt lgkmcnt(0)" ::: "memory");
    const int cch = lane & 7;
#pragma unroll
    for (int j = 0; j < 4; ++j) { const int n = (lane >> 3) + 8 * j; const LAS float* s = scr + (8 * cch) * 33 + n;
        u32x4_t o; o.x = cvtpk(s[0 * 33], s[1 * 33]); o.y = cvtpk(s[2 * 33], s[3 * 33]); o.z = cvtpk(s[4 * 33], s[5 * 33]); o.w = cvtpk(s[6 * 33], s[7 * 33]);
        *(u32x4_t*)(WT + (size_t)(n0 + n) * K + k0 + 8 * cch) = o; }
    asm volatile("s_waitcnt lgkmcnt(0)" ::: "memory");
}
DEV void dev_prologue(CREF c, LAS unsigned char* L, int bx, int tid, long gtid, long gn) {
    const int wave = tid >> 6, lane = tid & 63, gw = bx * 8 + wave, NGW = (int)gridDim.x * 8;
    LAS float* scr = (LAS float*)(L + wave * 16384);
    constexpr int I_IN = (DM / 64) * (INW / 32), I_OUT = (DM / 64) * (DM / 32), I_UP = (DM / 64) * (DFF / 32), I_DN = (DFF / 64) * (DM / 32), I_GL = (256 / 64) * (256 / 32), I_L = I_IN + I_OUT + I_UP + I_DN + I_GL;
    for (int it = gw; it < 2 * I_L; it += NGW) { const int l = it / I_L; int r = it % I_L;
        if (r < I_IN) { transpose_item(c.w_in + (size_t)l * DM * INW, DM, INW, c.WIN_T + (size_t)l * PLD * DM, scr, r, lane); continue; } r -= I_IN;
        if (r < I_OUT) { transpose_item(c.w_out + (size_t)l * DM * DM, DM, DM, c.WOUT_T + (size_t)l * DM * DM, scr, r, lane); continue; } r -= I_OUT;
        if (r < I_UP) { transpose_item(c.mlp_up + (size_t)l * DM * DFF, DM, DFF, c.WUP_T + (size_t)l * DFF * DM, scr, r, lane); continue; } r -= I_UP;
        if (r < I_DN) { transpose_item(c.mlp_down + (size_t)l * DFF * DM, DFF, DM, c.WDN_T + (size_t)l * DM * DFF, scr, r, lane); continue; } r -= I_DN;
        transpose_item(c.w_glu + (size_t)l * 65536, 256, 256, c.WGLU_T + (size_t)l * 65536, scr, r, lane); }
    for (long i = gtid; i < (long)2 * (PLD - INW) * DM / 8; i += gn) { const int l = (int)(i / ((PLD - INW) * DM / 8)); const long r = i % ((PLD - INW) * DM / 8);
        *(u32x4_t*)(c.WIN_T + ((size_t)l * PLD + INW) * DM + r * 8) = (u32x4_t){0u, 0u, 0u, 0u}; }
    { f32x4_t g[4];
#pragma unroll
      for (int j = 0; j < 4; ++j) g[j] = ((const f32x4_t*)c.ln1)[lane + 64 * j];
      for (int r = gw; r < TT; r += NGW) { const f32x4_t* xr = (const f32x4_t*)(r < TP ? c.x_prompt + (size_t)r * DM : c.x_sample + (size_t)(r - TP) * DM) + lane; f32x4_t v[4]; float s = 0.f;
#pragma unroll
        for (int j = 0; j < 4; ++j) { v[j] = xr[64 * j]; s += (v[j][0] * v[j][0] + v[j][1] * v[j][1]) + (v[j][2] * v[j][2] + v[j][3] * v[j][3]); ((f32x4_t*)(c.X + (size_t)r * DM))[lane + 64 * j] = v[j]; }
        const float rs = 1.0f / sqrtf(wave_sum(s) * (1.0f / DM) + NEPS);
#pragma unroll
        for (int j = 0; j < 4; ++j) { const f32x4_t o = v[j] * rs * g[j]; u32x2_t w = {cvtpk(o[0], o[1]), cvtpk(o[2], o[3])}; ((u32x2_t*)(c.XN + (size_t)r * DM))[lane + 64 * j] = w; } } }
}
template <bool FINAL> DEV void dev_rmsnorm(CREF c, const float* gain, int bx, int tid, int nsplit) {
    const int wave = tid >> 6, lane = tid & 63, gw = bx * 8 + wave, NGW = (int)gridDim.x * 8;
    f32x4_t g[4];
#pragma unroll
    for (int j = 0; j < 4; ++j) g[j] = ((const f32x4_t*)gain)[lane + 64 * j];
    for (int r = gw; r < TT; r += NGW) { f32x4_t* xr = (f32x4_t*)(c.X + (size_t)r * DM) + lane; f32x4_t v[4]; float s = 0.f;
#pragma unroll
        for (int j = 0; j < 4; ++j) v[j] = xr[64 * j];
        if (r >= TP) {
            for (int ks = 0; ks < nsplit; ++ks) { const f32x4_t* pr = (const f32x4_t*)(c.PART + ((size_t)ks * TS + (r - TP)) * DM) + lane;
#pragma unroll
                for (int j = 0; j < 4; ++j) v[j] += pr[64 * j]; }
            if (!FINAL) {
#pragma unroll
                for (int j = 0; j < 4; ++j) xr[64 * j] = v[j]; } }
#pragma unroll
        for (int j = 0; j < 4; ++j) s += (v[j][0] * v[j][0] + v[j][1] * v[j][1]) + (v[j][2] * v[j][2] + v[j][3] * v[j][3]);
        const float rs = 1.0f / sqrtf(wave_sum(s) * (1.0f / DM) + NEPS);
#pragma unroll
        for (int j = 0; j < 4; ++j) { const f32x4_t o = v[j] * rs * g[j];
            if (FINAL) ((f32x4_t*)(c.out + O_YP + (size_t)r * DM))[lane + 64 * j] = o;
            else { u32x2_t w = {cvtpk(o[0], o[1]), cvtpk(o[2], o[3])}; ((u32x2_t*)(c.XN + (size_t)r * DM))[lane + 64 * j] = w; } } }
}
DEV void dev_copy_out(CREF c, int l, long gtid, long gn) {
    for (long i = gtid; i < (long)TT * 128; i += gn) { const int r = (int)(i >> 7), k = (int)(i & 127); const f32x4_t v = *(const f32x4_t*)(c.PROJ + (size_t)r * PLD + C_KV + 4 * k);
        float* dst = r < TP ? c.out + O_KVP + ((size_t)l * TP + r) * 512 : c.out + O_KVS + ((size_t)l * TS + (r - TP)) * 512; *(f32x4_t*)(dst + 4 * k) = v; }
    for (long i = gtid; i < (long)BATCH * 512 * 64; i += gn) { const int b = (int)(i / (512 * 64)), w = (int)((i >> 6) & 511), k = (int)(i & 63);
        ((f32x4_t*)(c.out + O_WINP + (size_t)l * BATCH * 512 * 256))[i] = *(const f32x4_t*)(c.PROJ + (size_t)(b * SEQ + SEQ - 512 + w) * PLD + C_KV + 512 + 4 * k); }
    for (long i = gtid; i < (long)DB * 512 * 64; i += gn) { const int b = (int)(i / (512 * 64)), w = (int)((i >> 6) & 511), k = (int)(i & 63);
        ((f32x4_t*)(c.out + O_WINS + (size_t)l * DB * 512 * 256))[i] = (w < 512 - DSEQ) ? *(const f32x4_t*)(c.cache_win + (((size_t)l * DB + b) * 512 + w + DSEQ) * 256 + 4 * k)
                                                                                       : *(const f32x4_t*)(c.PROJ + (size_t)(TP + b * DSEQ + (w - (512 - DSEQ))) * PLD + C_KV + 512 + 4 * k); }
    for (long i = gtid; i < (long)BATCH * 3 * CONVD / 4; i += gn) { const int b = (int)(i / (3 * CONVD / 4)), w = (int)((i / (CONVD / 4)) % 3), k = (int)(i % (CONVD / 4));
        ((f32x4_t*)(c.out + O_CONVP + (size_t)l * BATCH * 3 * CONVD))[i] = *(const f32x4_t*)(c.PROJ + (size_t)(b * SEQ + SEQ - 3 + w) * PLD + C_DNQKV + 4 * k); }
    for (long i = gtid; i < (long)DB * 3 * CONVD / 4; i += gn) { const int b = (int)(i / (3 * CONVD / 4)), w = (int)((i / (CONVD / 4)) % 3), k = (int)(i % (CONVD / 4));
        ((f32x4_t*)(c.out + O_CONVS + (size_t)l * DB * 3 * CONVD))[i] = *(const f32x4_t*)(c.PROJ + (size_t)(TP + b * DSEQ + DSEQ - 3 + w) * PLD + C_DNQKV + 4 * k); }
}

constexpr int DP_YS = 65;
constexpr int DP_Y = 0, DP_AM = DP_Y + 3 * 64 * DP_YS * 4, DP_R = DP_AM + 64 * 64 * 4, DP_AQ = DP_R + 64 * 128 * 4, DP_SM = DP_AQ + 64 * 64 * 4, DP_END = DP_SM + 6 * 64 * 4;
static_assert(DP_END <= 131072, "DeltaNet prep LDS");
DEV void dn_prep_unit(CREF c, int l, LAS unsigned char* L, int u, int tid) {
    asm volatile("" : "+v"(tid));
    const int ch = u % NCH, h = (u / NCH) % DNH, b = u / (NCH * DNH), r0 = b * SEQ + ch * 64, lane = tid & 63, wid = tid >> 6;
    LAS float* Y = (LAS float*)(L + DP_Y); LAS float* AMs = (LAS float*)(L + DP_AM); LAS float* R = (LAS float*)(L + DP_R);
    LAS float* sm = (LAS float*)(L + DP_SM);
    LAS float* AQs = (LAS float*)(L + DP_AQ);
    if (tid < 384) { const int ci = tid % 192, tg = tid / 192, part = ci >> 6, d = ci & 63, cch = part * DNW + h * 64 + d;
        const f32x4_t w = *(const f32x4_t*)(c.conv_w + ((size_t)l * CONVD + cch) * 4); float x[35];
        const int tt0 = ch * 64 + 32 * tg - 3; const float* px = c.PROJ + (size_t)(b * SEQ) * PLD + C_DNQKV + cch;
#pragma unroll
        for (int k = 0; k < 35; ++k) { const int tt = tt0 + k; const float v = px[(size_t)(tt < 0 ? 0 : tt) * PLD]; x[k] = tt < 0 ? 0.f : v; }
#pragma unroll
        for (int t = 0; t < 32; ++t) { const float y = (w[0] * x[t] + w[1] * x[t + 1]) + (w[2] * x[t + 2] + w[3] * x[t + 3]); Y[(part * 64 + 32 * tg + t) * DP_YS + d] = y * __builtin_amdgcn_rcpf(1.0f + __expf(-y)); } }
    else if (tid >= 448) { const int t = tid - 448, r = r0 + t; sm[128 + t] = sigmoidf_(c.PROJ[(size_t)r * PLD + C_DNB + h]);
        sm[192 + t] = -expf(c.a_log[l * DNH + h]) * softplusf_(c.PROJ[(size_t)r * PLD + C_DNA + h] + c.dt_bias[l * DNH + h]); }
    __syncthreads();
    {   const int rr = tid >> 2, q4 = tid & 3; const LAS float* yr = Y + rr * DP_YS + 16 * q4; float ss = 0.f;
#pragma unroll
        for (int k = 0; k < 16; ++k) ss += yr[k] * yr[k];
        ss += __shfl_xor(ss, 1); ss += __shfl_xor(ss, 2);
        if (q4 == 0) sm[rr] = (rr < 64 ? 0.125f : 1.0f) / sqrtf(ss + 1e-6f); }
    if (wid == 7) { float s = sm[192 + lane];
#pragma unroll
        for (int o = 1; o < 64; o <<= 1) { const float t = __shfl_up(s, o); if (lane >= o) s += t; }
        sm[256 + lane] = s; }
    __syncthreads();
    for (int idx = tid; idx < 128 * 64; idx += 512) { const int rr = idx >> 6, d = idx & 63; Y[rr * DP_YS + d] *= sm[rr]; }
    __syncthreads();
    for (int idx = tid; idx < 64 * 64; idx += 512) { const int t = idx >> 6, d = idx & 63; const float q = Y[t * DP_YS + d], k = Y[(64 + t) * DP_YS + d], vv = Y[(128 + t) * DP_YS + d], be = sm[128 + t];
        (void)q; R[t * 128 + d] = vv * be; R[t * 128 + 64 + d] = k * be * expf(sm[256 + t]); }
    if (tid < 64) sm[320 + tid] = expf(sm[256 + 63] - sm[256 + tid]);
    {   const int i = tid >> 3, j0 = (tid & 7) * 8; float kk[8], qk[8];
#pragma unroll
        for (int jj = 0; jj < 8; ++jj) { kk[jj] = 0.f; qk[jj] = 0.f; }
        if (j0 <= i) for (int d = 0; d < 64; ++d) { const float ki = Y[(64 + i) * DP_YS + d], qi = Y[i * DP_YS + d];
#pragma unroll
            for (int jj = 0; jj < 8; ++jj) { const float kj = Y[(64 + j0 + jj) * DP_YS + d]; kk[jj] += ki * kj; qk[jj] += qi * kj; } }
        const float gi = sm[256 + i], bi = sm[128 + i];
#pragma unroll
        for (int jj = 0; jj < 8; ++jj) { const int j = j0 + jj; const float dec = j <= i ? expf(gi - sm[256 + j]) : 0.f;
            AMs[i * 64 + j] = j < i ? bi * kk[jj] * dec : 0.f; AQs[i * 64 + j] = j <= i ? qk[jj] * dec : 0.f; } }
    __syncthreads();
    {   const int col = tid >> 2, q = tid & 3; float xq[16];
#pragma unroll
        for (int jj = 0; jj < 16; ++jj) xq[jj] = 0.f;
#pragma unroll
        for (int i = 0; i < 64; ++i) { float s = 0.f;
#pragma unroll
            for (int jj = 0; jj < (i + 3) / 4; ++jj) s -= AMs[i * 64 + 4 * jj + q] * xq[jj];
            s += __shfl_xor(s, 1); s += __shfl_xor(s, 2); s += R[i * 128 + col];
            xq[i >> 2] = ((i & 3) == q) ? s : xq[i >> 2];
            if (q == 0) R[i * 128 + col] = s; } }
    __syncthreads();
    {   const int mt = tid >> 7, ks = (tid >> 6) & 1, m16 = tid & 15, kb = (tid >> 4) & 3, row = 16 * mt + m16, k0 = 32 * ks + 4 * kb, k1 = k0 + 16;
        bf16_t* fo = c.DNF + (size_t)u * 16384 + tid * 8;
        { const f32x4_t a = *(const LAS f32x4_t*)(R + row * 128 + 64 + k0), bq = *(const LAS f32x4_t*)(R + row * 128 + 64 + k1); *(bf16x8_t*)(fo) = pack8(a, bq); }
        { const float e = expf(sm[256 + row]); const LAS float* q = Y + row * DP_YS; const f32x4_t a = {q[k0] * e, q[k0 + 1] * e, q[k0 + 2] * e, q[k0 + 3] * e}, bq = {q[k1] * e, q[k1 + 1] * e, q[k1 + 2] * e, q[k1 + 3] * e};
          *(bf16x8_t*)(fo + 4096) = pack8(a, bq); }
        { const f32x4_t a = *(const LAS f32x4_t*)(AQs + row * 64 + k0), bq = *(const LAS f32x4_t*)(AQs + row * 64 + k1); *(bf16x8_t*)(fo + 8192) = pack8(a, bq); }
        { const LAS float* kT = Y + 64 * DP_YS + row; f32x4_t a, bq;
#pragma unroll
          for (int i = 0; i < 4; ++i) { a[i] = kT[(k0 + i) * DP_YS] * sm[320 + k0 + i]; bq[i] = kT[(k1 + i) * DP_YS] * sm[320 + k1 + i]; }
          *(bf16x8_t*)(fo + 12288) = pack8(a, bq); }
#pragma unroll
        for (int s = 0; s < 2; ++s) { const int idx = tid + 512 * s, v = idx & 63, tq = idx >> 6; const f32x4_t uv = {R[(4 * tq) * 128 + v], R[(4 * tq + 1) * 128 + v], R[(4 * tq + 2) * 128 + v], R[(4 * tq + 3) * 128 + v]};
            *(f32x4_t*)(c.DNU + (size_t)u * 4096 + idx * 4) = uv; }
        if (tid == 0) c.DNE[u] = expf(sm[256 + 63]); }
    __syncthreads();
}
DEV void dev_dn_out(CREF c, int l, int bx, int tid) {
    const int wave = tid >> 6, lane = tid & 63, gw = bx * 8 + wave, NGW = (int)gridDim.x * 8; const float nw = c.dn_norm_w[l * 64 + lane];
    for (int i = gw; i < TP * DNH; i += NGW) { const int r = i / DNH, h = i % DNH; const float o = c.ODN[(size_t)i * 64 + lane]; const float ss = wave_sum(o * o);
        const float z = c.PROJ[(size_t)r * PLD + C_DNZ + h * 64 + lane];
        c.MIXB[(size_t)r * DM + 512 + h * 64 + lane] = tobf(o / sqrtf(ss * (1.0f / 64.0f) + NEPS) * nw * (z / (1.0f + expf(-z)))); }
}

typedef float f32x16_t __attribute__((ext_vector_type(16)));
#define MFMA32(a, b, c) __builtin_amdgcn_mfma_f32_32x32x16_bf16((a), (b), (c), 0, 0, 0)
constexpr int NA_RS = 144;
constexpr int NA_T = 64 * NA_RS, NA_BUF = 2 * NA_T;
constexpr int NA_IMP = 2 * NA_BUF, NA_SELM = NA_IMP + 64 * 128 * 4, NA_UNI = NA_SELM + 64 * 16, NA_NIT = NA_UNI + 16, NA_ITEMS = NA_NIT + 16, NA_END = NA_ITEMS + 160 * 4;
static_assert(NA_END <= 131072, "NSA LDS");
constexpr float LOG2E = 1.4426950408889634f;
DEV int crow32(int reg, int hh) { return (reg & 3) + 8 * (reg >> 2) + 4 * hh; }
struct NaStage { f32x4_t k0, k1, v0, v1; };
template <bool SMP> DEV void na_load(CREF c, NaStage& st, int l, int mode, int b, int g, int n, int tid) {
    const int key = tid >> 3, d0 = (tid & 7) * 8; const float* kp; bool zero = false;
    if (mode == 0) { kp = c.KC + (((size_t)((SMP ? BATCH : 0) + b) * NBMAX + 64 * n + key) * 2 + g) * 64 + d0;
        const float* vp = c.VC + (kp - c.KC); const bool zp = SMP && key >= NBC_S; const f32x4_t z0 = {0.f, 0.f, 0.f, 0.f};
        st.k0 = zp ? z0 : *(const f32x4_t*)kp; st.k1 = zp ? z0 : *(const f32x4_t*)(kp + 4); st.v0 = zp ? z0 : *(const f32x4_t*)vp; st.v1 = zp ? z0 : *(const f32x4_t*)(vp + 4); return; }
    const int slot = mode == 1 ? 2 : 4;
    if (!SMP) kp = c.PROJ + (size_t)(b * SEQ + 64 * n + key) * PLD + C_KV + slot * 128 + g * 64 + d0;
    else { const int pos = 64 * n + key;
        if (pos >= PAST) { const int j = pos - PAST; zero = j >= DSEQ; kp = c.PROJ + (size_t)(TP + b * DSEQ + (zero ? 0 : j)) * PLD + C_KV + slot * 128 + g * 64 + d0; }
        else if (mode == 1) { const int pg = c.page_table[b * NPAGES + pos / PAGE]; kp = c.cache_nsa + ((((size_t)l * NPHYS + pg) * PAGE + (pos % PAGE)) * 4 + slot) * 128 + g * 64 + d0; }
        else kp = c.cache_win + ((((size_t)l * DB + b) * WIN + (pos - W0S)) * 2 + (slot - 4)) * 128 + g * 64 + d0; }
    const f32x4_t z = {0.f, 0.f, 0.f, 0.f};
    st.k0 = zero ? z : *(const f32x4_t*)kp; st.k1 = zero ? z : *(const f32x4_t*)(kp + 4); st.v0 = zero ? z : *(const f32x4_t*)(kp + 128); st.v1 = zero ? z : *(const f32x4_t*)(kp + 132);
}
DEV void na_store(const NaStage& st, LAS unsigned char* buf, int tid) {
    const int key = tid >> 3, d0 = (tid & 7) * 8;
    *(LAS bf16x8_t*)(buf + key * NA_RS + d0 * 2) = pack8(st.k0, st.k1);
    LAS unsigned short* vt = (LAS unsigned short*)(buf + NA_T);
    const unsigned a = cvtpk(st.v0[0], st.v0[1]), bb = cvtpk(st.v0[2], st.v0[3]), cc = cvtpk(st.v1[0], st.v1[1]), dd = cvtpk(st.v1[2], st.v1[3]);
    vt[(d0 + 0) * (NA_RS / 2) + key] = (unsigned short)a; vt[(d0 + 1) * (NA_RS / 2) + key] = (unsigned short)(a >> 16);
    vt[(d0 + 2) * (NA_RS / 2) + key] = (unsigned short)bb; vt[(d0 + 3) * (NA_RS / 2) + key] = (unsigned short)(bb >> 16);
    vt[(d0 + 4) * (NA_RS / 2) + key] = (unsigned short)cc; vt[(d0 + 5) * (NA_RS / 2) + key] = (unsigned short)(cc >> 16);
    vt[(d0 + 6) * (NA_RS / 2) + key] = (unsigned short)dd; vt[(d0 + 7) * (NA_RS / 2) + key] = (unsigned short)(dd >> 16);
}
DEV void na_scores(const LAS unsigned char* kb, const bf16x8_t (&qf)[4], int lane, f32x16_t& s0, f32x16_t& s1) {
    const int n = lane & 31, hh = lane >> 5;
#pragma unroll
    for (int i = 0; i < 16; ++i) { s0[i] = 0.f; s1[i] = 0.f; }
#pragma unroll
    for (int ks = 0; ks < 4; ++ks) { const bf16x8_t a0 = *(const LAS bf16x8_t*)(kb + n * NA_RS + (16 * ks + 8 * hh) * 2), a1 = *(const LAS bf16x8_t*)(kb + (32 + n) * NA_RS + (16 * ks + 8 * hh) * 2);
        s0 = MFMA32(a0, qf[ks], s0); s1 = MFMA32(a1, qf[ks], s1); }
}
DEV void na_pv(const LAS unsigned char* vb, const f32x16_t& p0, const f32x16_t& p1, int lane, f32x16_t& o0, f32x16_t& o1) {
    const int n = lane & 31, hh = lane >> 5;
#pragma unroll
    for (int s = 0; s < 4; ++s) { const f32x16_t& p = (s < 2) ? p0 : p1; const int e = 8 * (s & 1);
        const bf16x8_t pf = pack8((f32x4_t){p[e], p[e + 1], p[e + 2], p[e + 3]}, (f32x4_t){p[e + 4], p[e + 5], p[e + 6], p[e + 7]});
#pragma unroll
        for (int mt = 0; mt < 2; ++mt) { const LAS unsigned char* vp = vb + (32 * mt + n) * NA_RS + (16 * s + 4 * hh) * 2;
            const u32x2_t lo = *(const LAS u32x2_t*)vp, hi = *(const LAS u32x2_t*)(vp + 16); const u32x4_t w = {lo[0], lo[1], hi[0], hi[1]};
            if (mt == 0) o0 = MFMA32(__builtin_bit_cast(bf16x8_t, w), pf, o0); else o1 = MFMA32(__builtin_bit_cast(bf16x8_t, w), pf, o1); } }
}
template <bool SMP> DEV void nsa_unit(CREF c, int l, LAS unsigned char* L, int b, int qb, int g, int tid) {
    asm volatile("" : "+v"(tid));
    const int lane = tid & 63, wid = tid >> 6, n = lane & 31, hh = lane >> 5, tl = 8 * wid + (n >> 2), r = n & 3, h = 4 * g + r, t = 64 * qb + tl;
    const bool act = !SMP || wid == 0;
    const size_t row = SMP ? (size_t)(TP + b * DSEQ + (tl & 7)) : (size_t)(b * SEQ + t);
    LAS float* IMP = (LAS float*)(L + NA_IMP); LAS unsigned* SELM = (LAS unsigned*)(L + NA_SELM); LAS unsigned* UNI = (LAS unsigned*)(L + NA_UNI);
    LAS int* NIT = (LAS int*)(L + NA_NIT); LAS int* ITEMS = (LAS int*)(L + NA_ITEMS);
    const float slope2 = exp2f(-(float)(h + 1)) * LOG2E;
    bf16x8_t qf[4];
#pragma unroll
    for (int ks = 0; ks < 4; ++ks) { const float* qp = c.PROJ + row * PLD + C_Q + h * 64 + 16 * ks + 8 * hh; const f32x4_t a = *(const f32x4_t*)qp * (0.125f * LOG2E), bq = *(const f32x4_t*)(qp + 4) * (0.125f * LOG2E); qf[ks] = pack8(a, bq); }
    const float* gp = c.PROJ + row * PLD + C_GATE + h * 3; const float g0 = sigmoidf_(gp[0]), g1 = sigmoidf_(gp[1]), g2 = sigmoidf_(gp[2]);
    f32x16_t ot0, ot1, oa0, oa1;
    if (tid < 4) UNI[tid] = 0u;
    const int nbc = (!SMP && qb >= 64) ? 2 : 1;
    { NaStage st; na_load<SMP>(c, st, l, 0, b, g, 0, tid); na_store(st, L, tid); if (nbc == 2) { na_load<SMP>(c, st, l, 0, b, g, 1, tid); na_store(st, L + NA_BUF, tid); } }
    __syncthreads();
    if (act) {
        f32x16_t sa0, sa1, sb0, sb1;
        na_scores(L, qf, lane, sa0, sa1);
        if (nbc == 2) na_scores(L + NA_BUF, qf, lane, sb0, sb1);
        else {
#pragma unroll
            for (int i = 0; i < 16; ++i) { sb0[i] = 0.f; sb1[i] = 0.f; } }
        float m = -1e30f;
#pragma unroll
        for (int i = 0; i < 16; ++i) { const int k0 = crow32(i, hh);
            { const int np = k0;       const bool ok = 64 * np + 63 <= t;              sa0[i] = ok ? sa0[i] - slope2 * ((float)(t - 64 * np) - 31.5f) : -1e30f; m = fmaxf(m, sa0[i]); }
            { const int np = 32 + k0;  const bool ok = 64 * np + 63 <= t;              sa1[i] = ok ? sa1[i] - slope2 * ((float)(t - 64 * np) - 31.5f) : -1e30f; m = fmaxf(m, sa1[i]); }
            { const int np = 64 + k0;  const bool ok = nbc == 2 && 64 * np + 63 <= t;  sb0[i] = ok ? sb0[i] - slope2 * ((float)(t - 64 * np) - 31.5f) : -1e30f; m = fmaxf(m, sb0[i]); }
            { const int np = 96 + k0;  const bool ok = nbc == 2 && 64 * np + 63 <= t;  sb1[i] = ok ? sb1[i] - slope2 * ((float)(t - 64 * np) - 31.5f) : -1e30f; m = fmaxf(m, sb1[i]); } }
        m = fmaxf(m, __shfl_xor(m, 32));
        float ls = 0.f;
#pragma unroll
        for (int i = 0; i < 16; ++i) { sa0[i] = sa0[i] > -1e29f ? exp2f(sa0[i] - m) : 0.f; sa1[i] = sa1[i] > -1e29f ? exp2f(sa1[i] - m) : 0.f;
                                       sb0[i] = sb0[i] > -1e29f ? exp2f(sb0[i] - m) : 0.f; sb1[i] = sb1[i] > -1e29f ? exp2f(sb1[i] - m) : 0.f; ls += (sa0[i] + sa1[i]) + (sb0[i] + sb1[i]); }
        ls += __shfl_xor(ls, 32);
        const float inv = 1.0f / fmaxf(ls, 1e-30f);
#pragma unroll
        for (int i = 0; i < 16; ++i) { sa0[i] *= inv; sa1[i] *= inv; sb0[i] *= inv; sb1[i] *= inv; }
#pragma unroll
        for (int i = 0; i < 16; ++i) { const int k0 = crow32(i, hh);
            float v0 = sa0[i], v1 = sa1[i], v2 = sb0[i], v3 = sb1[i];
            v0 += __shfl_xor(v0, 1); v1 += __shfl_xor(v1, 1); v2 += __shfl_xor(v2, 1); v3 += __shfl_xor(v3, 1);
            v0 += __shfl_xor(v0, 2); v1 += __shfl_xor(v1, 2); v2 += __shfl_xor(v2, 2); v3 += __shfl_xor(v3, 2);
            if (r == 0) { IMP[tl * 128 + k0] = v0; IMP[tl * 128 + 32 + k0] = v1; IMP[tl * 128 + 64 + k0] = v2; IMP[tl * 128 + 96 + k0] = v3; } }
#pragma unroll
        for (int i = 0; i < 16; ++i) { oa0[i] = 0.f; oa1[i] = 0.f; }
        na_pv(L + NA_T, sa0, sa1, lane, oa0, oa1);
        if (nbc == 2) na_pv(L + NA_BUF + NA_T, sb0, sb1, lane, oa0, oa1);
#pragma unroll
        for (int i = 0; i < 16; ++i) { ot0[i] = g0 * oa0[i]; ot1[i] = g0 * oa1[i]; }
    }
    __syncthreads();
    {
        const int tk = tid >> 3, s8 = tid & 7, cur = qb;
        if (!SMP || tk < DSEQ) {
        float v[16];
#pragma unroll
        for (int i = 0; i < 16; ++i) { const int nn = 16 * s8 + i; v[i] = (nn >= 1 && nn <= cur - 2) ? IMP[tk * 128 + nn] : -1.0f; }
        unsigned mk0 = 0u, mk1 = 0u, mk2 = 0u, mk3 = 0u;
        const int nforced = cur >= 2 ? 3 : cur + 1;
        for (int rd = 0; rd < TOPK - nforced; ++rd) {
            float bv = -0.5f; int bn = 1000;
#pragma unroll
            for (int i = 0; i < 16; ++i) if (v[i] > bv) { bv = v[i]; bn = 16 * s8 + i; }
#pragma unroll
            for (int o = 1; o < 8; o <<= 1) { const float ov = __shfl_xor(bv, o); const int on = __shfl_xor(bn, o); if (ov > bv || (ov == bv && on < bn)) { bv = ov; bn = on; } }
            if (bn >= 1000) break;
#pragma unroll
            for (int i = 0; i < 16; ++i) if (16 * s8 + i == bn) v[i] = -1.0f;
            const unsigned bit = 1u << (bn & 31); const int w = bn >> 5;
            mk0 |= w == 0 ? bit : 0u; mk1 |= w == 1 ? bit : 0u; mk2 |= w == 2 ? bit : 0u; mk3 |= w == 3 ? bit : 0u;
        }
#pragma unroll
        for (int f = 0; f < 3; ++f) { const int fn = f == 0 ? 0 : (f == 1 ? cur : cur - 1); if (fn >= 0) { const unsigned bit = 1u << (fn & 31); const int w = fn >> 5;
            mk0 |= w == 0 ? bit : 0u; mk1 |= w == 1 ? bit : 0u; mk2 |= w == 2 ? bit : 0u; mk3 |= w == 3 ? bit : 0u; } }
        if (s8 == 0) { SELM[tk * 4 + 0] = mk0; SELM[tk * 4 + 1] = mk1; SELM[tk * 4 + 2] = mk2; SELM[tk * 4 + 3] = mk3;
            atomicOr((unsigned*)&UNI[0], mk0); atomicOr((unsigned*)&UNI[1], mk1); atomicOr((unsigned*)&UNI[2], mk2); atomicOr((unsigned*)&UNI[3], mk3); }
        }
    }
    __syncthreads();
    if (tid == 0) { int k = 0;
        for (int nn = qb; nn >= 0; --nn) if ((UNI[nn >> 5] >> (nn & 31)) & 1u) ITEMS[k++] = nn;
        for (int nn = qb; nn >= (qb >= 8 ? qb - 8 : 0); --nn) ITEMS[k++] = 256 + nn;
        NIT[0] = k; }
    __syncthreads();
    const int nit = NIT[0];
    const unsigned sm0 = SELM[tl * 4 + 0], sm1 = SELM[tl * 4 + 1], sm2 = SELM[tl * 4 + 2], sm3 = SELM[tl * 4 + 3];
    float m = -1e30f, ls = 0.f; int curmode = 0;
#pragma unroll
    for (int i = 0; i < 16; ++i) { oa0[i] = 0.f; oa1[i] = 0.f; }
    { NaStage st; const int it0 = ITEMS[0]; na_load<SMP>(c, st, l, 1 + (it0 >> 8), b, g, it0 & 255, tid); na_store(st, L, tid); }
    __syncthreads();
    for (int it = 0; it < nit; ++it) {
        const int item = ITEMS[it], mode = item >> 8, nblk = item & 255;
        NaStage st; const bool more = it + 1 < nit;
        if (more) { const int nx = ITEMS[it + 1]; na_load<SMP>(c, st, l, 1 + (nx >> 8), b, g, nx & 255, tid); }
        if (act) {
        if (mode != curmode) {
            const float lf = ls + __shfl_xor(ls, 32); const float sc = g1 / fmaxf(lf, 1e-30f);
#pragma unroll
            for (int i = 0; i < 16; ++i) { ot0[i] += sc * oa0[i]; ot1[i] += sc * oa1[i]; oa0[i] = 0.f; oa1[i] = 0.f; }
            m = -1e30f; ls = 0.f; curmode = mode; }
        const LAS unsigned char* buf = L + (it & 1) * NA_BUF;
        f32x16_t s0, s1; na_scores(buf, qf, lane, s0, s1);
        const int dbase = 64 * (qb - nblk) + tl;
        const unsigned smw = nblk < 32 ? sm0 : (nblk < 64 ? sm1 : (nblk < 96 ? sm2 : sm3));
        const bool blk_ok = mode == 1 ? true : ((smw >> (nblk & 31)) & 1u) != 0u;
        const bool full = (nblk == qb) || (mode == 1 && nblk == qb - 8);
        float mn, al, psum = 0.f;
        if (full) {
            float mloc = -1e30f;
#pragma unroll
            for (int i = 0; i < 16; ++i) { const int k0 = crow32(i, hh);
                { const int dist = dbase - k0;        const bool ok = blk_ok && dist >= 0 && (mode == 0 || dist < WIN); s0[i] = ok ? s0[i] - slope2 * (float)dist : -1e30f; mloc = fmaxf(mloc, s0[i]); }
                { const int dist = dbase - 32 - k0;   const bool ok = blk_ok && dist >= 0 && (mode == 0 || dist < WIN); s1[i] = ok ? s1[i] - slope2 * (float)dist : -1e30f; mloc = fmaxf(mloc, s1[i]); } }
            mloc = fmaxf(mloc, __shfl_xor(mloc, 32));
            mn = fmaxf(m, mloc); al = __builtin_amdgcn_exp2f(m - mn); m = mn;
#pragma unroll
            for (int i = 0; i < 16; ++i) { s0[i] = s0[i] > -1e29f ? __builtin_amdgcn_exp2f(s0[i] - mn) : 0.f; s1[i] = s1[i] > -1e29f ? __builtin_amdgcn_exp2f(s1[i] - mn) : 0.f; psum += s0[i] + s1[i]; }
        } else {
            const float c0 = -slope2 * (float)(dbase - 4 * hh);
            float tm = -1e30f;
#pragma unroll
            for (int i = 0; i < 16; ++i) { const float ci = (float)((i & 3) + 8 * (i >> 2));
                s0[i] = fmaf(slope2, ci, s0[i]); s1[i] = fmaf(slope2, ci + 32.0f, s1[i]); tm = fmaxf(tm, fmaxf(s0[i], s1[i])); }
            float mloc = blk_ok ? tm + c0 : -1e30f;
            mloc = fmaxf(mloc, __shfl_xor(mloc, 32));
            mn = fmaxf(m, mloc); al = __builtin_amdgcn_exp2f(m - mn); m = mn;
            const float mm = blk_ok ? mn - c0 : 1e30f;
#pragma unroll
            for (int i = 0; i < 16; ++i) { s0[i] = __builtin_amdgcn_exp2f(s0[i] - mm); s1[i] = __builtin_amdgcn_exp2f(s1[i] - mm); psum += s0[i] + s1[i]; }
        }
        ls = ls * al + psum;
        if (__builtin_amdgcn_ballot_w64(al != 1.0f) != 0ull) {
#pragma unroll
            for (int i = 0; i < 16; ++i) { oa0[i] *= al; oa1[i] *= al; } }
        na_pv(buf + NA_T, s0, s1, lane, oa0, oa1);
        }
        if (more) na_store(st, L + ((it + 1) & 1) * NA_BUF, tid);
        __syncthreads();
    }
    if (act) {
    {   const float lf = ls + __shfl_xor(ls, 32); const float sc = g2 / fmaxf(lf, 1e-30f);
#pragma unroll
        for (int i = 0; i < 16; ++i) { ot0[i] += sc * oa0[i]; ot1[i] += sc * oa1[i]; } }
    bf16_t* orow = c.MIXB + row * DM + h * 64;
#pragma unroll
    for (int q4 = 0; q4 < 4; ++q4) { const int d = 8 * q4 + 4 * hh;
        u32x2_t w0 = {cvtpk(ot0[4 * q4], ot0[4 * q4 + 1]), cvtpk(ot0[4 * q4 + 2], ot0[4 * q4 + 3])}; *(u32x2_t*)(orow + d) = w0;
        u32x2_t w1 = {cvtpk(ot1[4 * q4], ot1[4 * q4 + 1]), cvtpk(ot1[4 * q4 + 2], ot1[4 * q4 + 3])}; *(u32x2_t*)(orow + 32 + d) = w1; }
    }
    __syncthreads();
}

DEV void pool_unit(CREF c, int l, int seq, int n, int col) {
    const int slot = col >> 7, g = (col >> 6) & 1;
    const float* src; size_t stride;
    if (seq < BATCH) { src = c.PROJ + (size_t)(seq * SEQ + 64 * n) * PLD + C_KV + col; stride = PLD; }
    else { const int b = seq - BATCH, pg = c.page_table[b * NPAGES + (64 * n) / PAGE]; src = c.cache_nsa + (((size_t)l * NPHYS + pg) * PAGE + ((64 * n) % PAGE)) * 512 + col; stride = 512; }
    const float* w = (slot == 0 ? c.wck : c.wcv) + (l * 2 + g) * 64;
    float a0 = 0.f, a1 = 0.f;
#pragma unroll 16
    for (int j = 0; j < 64; j += 2) { a0 += w[j] * src[(size_t)j * stride]; a1 += w[j + 1] * src[(size_t)(j + 1) * stride]; }
    (slot == 0 ? c.KC : c.VC)[(((size_t)seq * NBMAX + n) * 2 + g) * 64 + (col & 63)] = a0 + a1;
}

DEV void dev_s5_y(CREF c, int l, long gtid, long gn) {
    for (long i = gtid; i < (long)TT * 256; i += gn) { const int r = (int)(i >> 8), ch = (int)(i & 255), g = ch / S5C, cc = ch % S5C;
        const float* cr = c.c_re + (((size_t)l * S5G + g) * S5C + cc) * S5P; const float* ci = c.c_im + (((size_t)l * S5G + g) * S5C + cc) * S5P;
        const f32x4_t* hs = (const f32x4_t*)(c.S5HS + ((size_t)r * S5G + g) * S5P * 2); float y = 0.f;
#pragma unroll 8
        for (int p2 = 0; p2 < S5P / 2; ++p2) { const f32x4_t hv = hs[p2]; y += cr[2 * p2] * hv[0] - ci[2 * p2] * hv[1] + cr[2 * p2 + 1] * hv[2] - ci[2 * p2 + 1] * hv[3]; }
        y += c.s5_d[l * 256 + ch] * c.PROJ[(size_t)r * PLD + C_S5U + ch]; c.GLB[i] = tobf(geluf_(y)); }
}

constexpr int S5_URS = 528, S5_HRS = 4112;
constexpr int S5_U = 0, S5_HT = 64 * S5_URS;
static_assert(S5_HT + 16 * S5_HRS <= 131072, "S5 LDS");
template <bool PASS_B, bool SMP> DEV void s5_unit(CREF c, int l, LAS unsigned char* L, int b, int ch, int tid) {
    asm volatile("" : "+v"(tid));
    constexpr int NT = SMP ? DSEQ : 64, NSB = SMP ? 1 : 4, TSB = SMP ? DSEQ : 16;
    const int r0 = SMP ? TP + b * DSEQ : b * SEQ + ch * 64, lane = tid & 63, wid = tid >> 6, n16 = lane & 15, kg = lane >> 4;
    LAS unsigned char* UB = L + S5_U; LAS unsigned char* BH = L + S5_HT;
    for (int i = tid; i < 16 * (SMP ? 1 : 4) * 64; i += 512) { const int t = i >> 6, q = i & 63; f32x4_t v = {0.f, 0.f, 0.f, 0.f}; if (t < NT) v = *(const f32x4_t*)(c.PROJ + (size_t)(r0 + t) * PLD + C_S5U + 4 * q);
        u32x2_t w = {cvtpk(v[0], v[1]), cvtpk(v[2], v[3])}; *(LAS u32x2_t*)(UB + t * S5_URS + q * 8) = w; }
    float ar[2], ai[2], hr[2], hi[2];
#pragma unroll
    for (int s = 0; s < 2; ++s) { const int idx = tid + 512 * s; const size_t gi = (size_t)l * S5G * S5P + idx;
        ar[s] = c.S5K[gi * 4]; ai[s] = c.S5K[gi * 4 + 1];
        if (SMP) { hr[s] = c.st_s5re[((size_t)l * DB + b) * 1024 + idx]; hi[s] = c.st_s5im[((size_t)l * DB + b) * 1024 + idx]; }
        else if (PASS_B) {
            const float a64r = c.S5K[gi * 4 + 2], a64i = c.S5K[gi * 4 + 3]; float cr_ = 0.f, ci_ = 0.f;
            for (int c0 = 0; c0 < ch; c0 += 16) { f32x2_t e[16];
#pragma unroll
                for (int k = 0; k < 16; ++k) e[k] = (c0 + k < ch) ? *(const f32x2_t*)(c.S5E + (((size_t)b * NCH + c0 + k) * 1024 + idx) * 2) : (f32x2_t){0.f, 0.f};
#pragma unroll
                for (int k = 0; k < 16; ++k) if (c0 + k < ch) { const float nr = a64r * cr_ - a64i * ci_ + e[k][0], ni = a64r * ci_ + a64i * cr_ + e[k][1]; cr_ = nr; ci_ = ni; } }
            hr[s] = cr_; hi[s] = ci_; }
        else { hr[s] = 0.f; hi[s] = 0.f; } }
    bf16x8_t bbf[2][8], ccf[2][4]; float dco[2];
#pragma unroll
    for (int gi2 = 0; gi2 < 2; ++gi2) { const size_t lg = (size_t)l * S5G + 2 * wid + gi2;
#pragma unroll
        for (int j = 0; j < 8; ++j) bbf[gi2][j] = *(const bf16x8_t*)(c.S5BF + ((lg * 8 + j) * 64 + lane) * 8);
        if (PASS_B) {
#pragma unroll
            for (int ks = 0; ks < 4; ++ks) ccf[gi2][ks] = *(const bf16x8_t*)(c.S5CF + ((lg * 4 + ks) * 64 + lane) * 8);
            dco[gi2] = c.s5_d[l * 256 + (2 * wid + gi2) * 16 + n16]; } }
    __syncthreads();
    const f32x4_t z4 = {0.f, 0.f, 0.f, 0.f}; const bf16x8_t zf = {0, 0, 0, 0, 0, 0, 0, 0};
    for (int sb = 0; sb < NSB; ++sb) {
#pragma unroll
        for (int gi2 = 0; gi2 < 2; ++gi2) { const int g = 2 * wid + gi2;
            const bf16x8_t af = kg < 2 ? *(const LAS bf16x8_t*)(UB + (16 * sb + n16) * S5_URS + (16 * g + 8 * kg) * 2) : zf;
#pragma unroll
            for (int j = 0; j < 8; ++j) { const f32x4_t acc = MFMA16(af, bbf[gi2][j], z4);
                LAS unsigned short* o = (LAS unsigned short*)(BH + (4 * kg) * S5_HRS + (g * 128 + 16 * j + n16) * 2);
                const unsigned p01 = cvtpk(acc[0], acc[1]), p23 = cvtpk(acc[2], acc[3]);
                o[0] = (unsigned short)p01; o[S5_HRS / 2] = (unsigned short)(p01 >> 16); o[S5_HRS] = (unsigned short)p23; o[3 * (S5_HRS / 2)] = (unsigned short)(p23 >> 16); } }
        __syncthreads();
#pragma unroll 4
        for (int tt = 0; tt < TSB; ++tt) {
#pragma unroll
            for (int s = 0; s < 2; ++s) { LAS unsigned* bp = (LAS unsigned*)(BH + tt * S5_HRS + (tid + 512 * s) * 4); const unsigned w = *bp;
                const float br = __uint_as_float(w << 16), bi = __uint_as_float(w & 0xffff0000u);
                const float nr = ar[s] * hr[s] - ai[s] * hi[s] + br, ni = ar[s] * hi[s] + ai[s] * hr[s] + bi; hr[s] = nr; hi[s] = ni;
                if (PASS_B) *bp = cvtpk(nr, ni); } }
        if (PASS_B) {
            __syncthreads();
#pragma unroll
            for (int gi2 = 0; gi2 < 2; ++gi2) { const int g = 2 * wid + gi2; f32x4_t y = z4;
#pragma unroll
                for (int ks = 0; ks < 4; ++ks) { const bf16x8_t hf = *(const LAS bf16x8_t*)(BH + n16 * S5_HRS + (g * 128 + 32 * ks + 8 * kg) * 2); y = MFMA16(hf, ccf[gi2][ks], y); }
#pragma unroll
                for (int i = 0; i < 4; ++i) { const int t = 16 * sb + 4 * kg + i;
                    if (t < NT) { const float uu = __uint_as_float(((unsigned)*(const LAS unsigned short*)(UB + t * S5_URS + (16 * g + n16) * 2)) << 16);
                        c.GLB[(size_t)(r0 + t) * 256 + 16 * g + n16] = tobf(geluf_(y[i] + dco[gi2] * uu)); } } }
        }
        __syncthreads();
    }
#pragma unroll
    for (int s = 0; s < 2; ++s) { const int idx = tid + 512 * s;
        if (SMP) { c.out[O_S5RS + ((size_t)l * DB + b) * 1024 + idx] = hr[s]; c.out[O_S5IS + ((size_t)l * DB + b) * 1024 + idx] = hi[s]; }
        else if (!PASS_B) { const size_t e = (((size_t)b * NCH + ch) * 1024 + idx) * 2; c.S5E[e] = hr[s]; c.S5E[e + 1] = hi[s]; } }
    __syncthreads();
}

DEV void dn_sample_unit(CREF c, int l, LAS unsigned char* L, int b, int tid) {
    asm volatile("" : "+v"(tid));
    LAS float* Y = (LAS float*)L;
    LAS float* sm = Y + 8 * 768;
    const int r0 = TP + b * DSEQ, lane = tid & 63, wid = tid >> 6;
    for (int idx = tid; idx < 8 * 768; idx += 512) { const int t = idx / 768, cch = idx % 768; const f32x4_t w = *(const f32x4_t*)(c.conv_w + ((size_t)l * CONVD + cch) * 4); float y = 0.f;
#pragma unroll
        for (int j = 0; j < 4; ++j) { const int tt = t - 3 + j; y += w[j] * (tt >= 0 ? c.PROJ[(size_t)(r0 + tt) * PLD + C_DNQKV + cch] : c.st_conv[(((size_t)l * DB + b) * 3 + 3 + tt) * CONVD + cch]); }
        Y[idx] = y / (1.0f + expf(-y)); }
    if (tid < 32) { const int t = tid >> 2, h = tid & 3; sm[64 + tid] = sigmoidf_(c.PROJ[(size_t)(r0 + t) * PLD + C_DNB + h]);
        sm[96 + tid] = expf(-expf(c.a_log[l * DNH + h]) * softplusf_(c.PROJ[(size_t)(r0 + t) * PLD + C_DNA + h] + c.dt_bias[l * DNH + h])); }
    __syncthreads();
    for (int rr = wid * 8; rr < wid * 8 + 8; ++rr) { const int t = rr >> 3, part = (rr >> 2) & 1, h = rr & 3; const float y = Y[t * 768 + part * 256 + h * 64 + lane]; const float ss = wave_sum(y * y);
        if (lane == 0) sm[rr] = (part == 0 ? 0.125f : 1.0f) / sqrtf(ss + 1e-6f); }
    __syncthreads();
    if (tid < 256) { const int h = tid >> 6, jc = tid & 63; float S[64]; const float* s0 = c.st_dn + (((size_t)l * DB + b) * DNH + h) * 4096 + jc;
#pragma unroll
        for (int kk = 0; kk < 64; ++kk) S[kk] = s0[kk * 64];
        const float nw = c.dn_norm_w[l * 64 + jc];
        for (int t = 0; t < DSEQ; ++t) { const LAS float* qp = Y + t * 768 + h * 64; const LAS float* kp = qp + 256; const float qs = sm[t * 8 + h], ksc = sm[t * 8 + 4 + h], a = sm[96 + t * 4 + h], be = sm[64 + t * 4 + h];
            float ks = 0.f;
#pragma unroll
            for (int kk = 0; kk < 64; ++kk) { S[kk] *= a; ks += kp[kk] * S[kk]; }
            const float vn = be * (Y[t * 768 + 512 + h * 64 + jc] - ks * ksc), kv = vn * ksc; float os = 0.f;
#pragma unroll
            for (int kk = 0; kk < 64; ++kk) { S[kk] += kp[kk] * kv; os += qp[kk] * S[kk]; }
            os *= qs;
            const float ss = wave_sum(os * os); const float z = c.PROJ[(size_t)(r0 + t) * PLD + C_DNZ + h * 64 + jc];
            c.MIXB[(size_t)(r0 + t) * DM + 512 + h * 64 + jc] = tobf(os / sqrtf(ss * (1.0f / 64.0f) + NEPS) * nw * (z / (1.0f + expf(-z)))); }
#pragma unroll
        for (int kk = 0; kk < 64; ++kk) c.out[O_DNS + (((size_t)l * DB + b) * DNH + h) * 4096 + kk * 64 + jc] = S[kk]; }
    __syncthreads();
}
DEV void s5_carry_unit(CREF c, int l, int b, int tid) {
    for (int s = 0; s < 2; ++s) { const int idx = tid + 512 * s; const float* K = c.S5K + ((size_t)l * 1024 + idx) * 4; const float a64r = K[2], a64i = K[3]; float hr = 0.f, hi = 0.f;
        for (int c0 = 0; c0 < NCH; c0 += 16) { f32x2_t e[16];
#pragma unroll
            for (int k = 0; k < 16; ++k) e[k] = *(const f32x2_t*)(c.S5E + (((size_t)b * NCH + c0 + k) * 1024 + idx) * 2);
#pragma unroll
            for (int k = 0; k < 16; ++k) { *(f32x2_t*)(c.S5HIN + (((size_t)b * NCH + c0 + k) * 1024 + idx) * 2) = (f32x2_t){hr, hi};
                const float nr = a64r * hr - a64i * hi + e[k][0], ni = a64r * hi + a64i * hr + e[k][1]; hr = nr; hi = ni; } }
        c.out[O_S5RP + ((size_t)l * BATCH + b) * 1024 + idx] = hr; c.out[O_S5IP + ((size_t)l * BATCH + b) * 1024 + idx] = hi; }
}
#ifndef N_LAUNCH_MODE
#define N_LAUNCH_MODE 1
#endif
namespace pg8 {
template <bool ADD> struct EpiF32 {
    static constexpr bool PERM = false, AFTER_DRAIN = false;
    float* C; int ldc;
    __device__ __forceinline__ void operator()(const f32x4 (&acc)[2][2][4][2], const Unit& u, int wr, int wc, int fr, int fq) const {
        const int row0 = u.pm * BM + wr * 64 + fr, col0 = u.pn * BM + wc * 32 + 4 * fq;
#pragma unroll
        for (int ai = 0; ai < 2; ++ai)
#pragma unroll
            for (int m = 0; m < 4; ++m) { float* rowp = C + (size_t)(row0 + ai * HALF + m * 16) * ldc + col0;
#pragma unroll
                for (int bj = 0; bj < 2; ++bj)
#pragma unroll
                    for (int n = 0; n < 2; ++n) { f32x4 v = acc[ai][bj][m][n]; if (ADD) v += *(const f32x4*)(rowp + bj * HALF + n * 16); *(f32x4*)(rowp + bj * HALF + n * 16) = v; } }
    }
};
struct EpiSqReluBf16 {
    static constexpr bool PERM = true, AFTER_DRAIN = false;
    bf16_t* O; int ldc;
    __device__ __forceinline__ void operator()(const f32x4 (&acc)[2][2][4][2], const Unit& u, int wr, int wc, int fr, int fq) const {
        const int row0 = u.pm * BM + wr * 64 + fr, col0 = u.pn * BM + wc * 32 + 8 * fq;
#pragma unroll
        for (int ai = 0; ai < 2; ++ai)
#pragma unroll
            for (int m = 0; m < 4; ++m) { bf16_t* rowp = O + (size_t)(row0 + ai * HALF + m * 16) * ldc + col0;
#pragma unroll
                for (int bj = 0; bj < 2; ++bj) { f32x4 v0 = acc[ai][bj][m][0], v1 = acc[ai][bj][m][1];
#pragma unroll
                    for (int j = 0; j < 4; ++j) { const float a = v0[j] > 0.f ? v0[j] : 0.f, b = v1[j] > 0.f ? v1[j] : 0.f; v0[j] = a * a; v1[j] = b * b; }
                    u32x4 w; w.x = cvt_pk_bf16(v0[0], v0[1]); w.y = cvt_pk_bf16(v0[2], v0[3]); w.z = cvt_pk_bf16(v1[0], v1[1]); w.w = cvt_pk_bf16(v1[2], v1[3]);
                    *(u32x4*)(rowp + bj * HALF) = w; } }
    }
};
struct EpiGluBf16 {
    static constexpr bool PERM = true, AFTER_DRAIN = false;
    bf16_t* O; int ldc; const bf16_t* GLv;
    __device__ __forceinline__ void operator()(const f32x4 (&acc)[2][2][4][2], const Unit& u, int wr, int wc, int fr_, int fq_) const {
        int ln; asm volatile("v_mbcnt_lo_u32_b32 %0, -1, 0\n\tv_mbcnt_hi_u32_b32 %0, -1, %0" : "=v"(ln)); const int fr = ln & 15, fq = ln >> 4;
        const int row0 = u.pm * BM + wr * 64 + fr, col0 = u.pn * BM + wc * 32 + 8 * fq;
#pragma unroll
        for (int ai = 0; ai < 2; ++ai)
#pragma unroll
            for (int m = 0; m < 4; ++m) { const size_t r = (size_t)(row0 + ai * HALF + m * 16);
#pragma unroll
                for (int bj = 0; bj < 2; ++bj) { const u32x4 gv = *(const u32x4*)(GLv + r * 256 + col0 + bj * HALF); f32x4 v0 = acc[ai][bj][m][0], v1 = acc[ai][bj][m][1];
#pragma unroll
                    for (int j = 0; j < 4; ++j) { v0[j] = __builtin_amdgcn_rcpf(1.0f + __expf(-v0[j])); v1[j] = __builtin_amdgcn_rcpf(1.0f + __expf(-v1[j])); }
                    v0[0] *= __uint_as_float(gv[0] << 16); v0[1] *= __uint_as_float(gv[0] & 0xffff0000u); v0[2] *= __uint_as_float(gv[1] << 16); v0[3] *= __uint_as_float(gv[1] & 0xffff0000u);
                    v1[0] *= __uint_as_float(gv[2] << 16); v1[1] *= __uint_as_float(gv[2] & 0xffff0000u); v1[2] *= __uint_as_float(gv[3] << 16); v1[3] *= __uint_as_float(gv[3] & 0xffff0000u);
                    u32x4 w; w.x = cvt_pk_bf16(v0[0], v0[1]); w.y = cvt_pk_bf16(v0[2], v0[3]); w.z = cvt_pk_bf16(v1[0], v1[1]); w.w = cvt_pk_bf16(v1[2], v1[3]);
                    *(u32x4*)(O + r * ldc + col0 + bj * HALF) = w; } }
    }
};
}

#define XB_TMO      128
#define XB_XCNT(j)  (256  + 64 * (j))
#define XB_XSUB(j)  (1280 + 64 * (j))
#define XB_XGEN(j)  (2304 + 64 * (j))
#define XB_TOP      3328
#define XB_TOPGEN   3392
#define XCD_BAR_WORDS 3456
#define XB_SPIN_CAP (1u << 24)
__device__ __forceinline__ unsigned xb_ld(unsigned* p)              { return __hip_atomic_load(p, __ATOMIC_RELAXED, __HIP_MEMORY_SCOPE_AGENT); }
__device__ __forceinline__ unsigned xb_add(unsigned* p, unsigned v) { return __hip_atomic_fetch_add(p, v, __ATOMIC_RELAXED, __HIP_MEMORY_SCOPE_AGENT); }
__device__ __forceinline__ unsigned xb_xcc_id() { return (unsigned)__builtin_amdgcn_s_getreg((3 << 11) | 20) & 0xFu; }
#define XB_SPIN(cond, bar) do { unsigned _sp = 0; while (cond) { __builtin_amdgcn_s_sleep(1); \
    if ((++_sp & 255u) == 0u) { if (xb_ld(&(bar)[XB_TMO])) break; if (_sp > XB_SPIN_CAP) { atomicAdd(&(bar)[XB_TMO], 1u); break; } } } } while (0)
struct XcdBarrier { unsigned* bar; unsigned x; volatile LAS unsigned* st; };
__device__ __forceinline__ XcdBarrier xcd_barrier_post(unsigned* bar, volatile LAS unsigned* st) {
    XcdBarrier b; b.bar = bar; b.x = xb_xcc_id(); b.st = st;
    if (threadIdx.x == 0) (void)xb_add(&bar[XB_XCNT(b.x)], 1u);
    return b;
}
__device__ __forceinline__ void xcd_barrier_complete(unsigned* bar, unsigned x, unsigned& nloc, unsigned& nx) {
    const unsigned G = gridDim.x * gridDim.y * gridDim.z;
    unsigned sum, cnt, mine, sp = 0u;
    for (;;) {
        sum = 0u; cnt = 0u; mine = 0u;
#pragma unroll
        for (unsigned j = 0; j < 16; ++j) { const unsigned c = xb_ld(&bar[XB_XCNT(j)]); sum += c; cnt += (c > 0u) ? 1u : 0u; mine = (j == x) ? c : mine; }
        if (sum == G) break;
        __builtin_amdgcn_s_sleep(1);
        if ((++sp & 255u) == 0u) { if (xb_ld(&bar[XB_TMO])) break; if (sp > XB_SPIN_CAP) { atomicAdd(&bar[XB_TMO], 1u); break; } }
    }
    nloc = mine > 0u ? mine : 1u; nx = cnt > 0u ? cnt : 1u;
}
__device__ __forceinline__ void xcd_barrier(const XcdBarrier& b, const bool t0) {
    asm volatile("s_waitcnt vmcnt(0)" ::: "memory");
    __syncthreads();
    if (t0) {
        unsigned* bar = b.bar; unsigned bx = b.x; asm volatile("" : "+s"(bar), "+s"(bx));
        __builtin_amdgcn_s_waitcnt(0);
        unsigned nloc = b.st[0], nx = b.st[1];
        if (nloc == 0u) { xcd_barrier_complete(bar, bx, nloc, nx); b.st[0] = nloc; b.st[1] = nx; }
        const unsigned old = xb_add(&bar[XB_XSUB(bx)], 1u);
        const unsigned gen = old / nloc;
        if (old + 1u == (gen + 1u) * nloc) {
            __builtin_amdgcn_fence(__ATOMIC_RELEASE, "agent");
            asm volatile("s_waitcnt vmcnt(0)" ::: "memory");
            const unsigned og = xb_add(&bar[XB_TOP], 1u);
            const unsigned tg = og / nx;
            if (og + 1u == (tg + 1u) * nx) xb_add(&bar[XB_TOPGEN], 1u);
            else XB_SPIN(xb_ld(&bar[XB_TOPGEN]) == tg, bar);
            __builtin_amdgcn_fence(__ATOMIC_ACQUIRE, "agent");
            xb_add(&bar[XB_XGEN(bx)], 1u);
            asm volatile("s_waitcnt vmcnt(0)" ::: "memory");
        } else {
            XB_SPIN(xb_ld(&bar[XB_XGEN(bx)]) == gen, bar);
            __builtin_amdgcn_fence(__ATOMIC_ACQUIRE, "agent");
            asm volatile("s_waitcnt vmcnt(0)" ::: "memory");
        }
    }
    __syncthreads();
}

constexpr int RING_BYTES = 131072, LDSCTL_OFF = RING_BYTES, LDS_BYTES = 147456;
constexpr int NTHREADS = 512;
constexpr size_t al256(size_t x) { return (x + 255) & ~(size_t)255; }
constexpr size_t WS_CTL = 0, CTL_BYTES = 65536;
constexpr size_t WS_X = al256(WS_CTL + CTL_BYTES), WS_SSQ = al256(WS_X + (size_t)TT * DM * 4), WS_XN = al256(WS_SSQ + (size_t)TT * 64 * 4),
    WS_PROJ = al256(WS_XN + (size_t)TT * DM * 2), WS_MIXB = al256(WS_PROJ + (size_t)TT * PLD * 4), WS_UPB = al256(WS_MIXB + (size_t)TT * DM * 2),
    WS_WIN = al256(WS_UPB + (size_t)TT * DFF * 2), WS_WOUT = al256(WS_WIN + (size_t)2 * PLD * DM * 2), WS_WUP = al256(WS_WOUT + (size_t)2 * DM * DM * 2),
    WS_WDN = al256(WS_WUP + (size_t)2 * DFF * DM * 2), WS_KC = al256(WS_WDN + (size_t)2 * DM * DFF * 2), WS_VC = al256(WS_KC + (size_t)NSEQ * NBMAX * 128 * 4),
    WS_PC = al256(WS_VC + (size_t)NSEQ * NBMAX * 128 * 4), WS_OC = al256(WS_PC + (size_t)TT * NH * NBMAX * 4), WS_IDX = al256(WS_OC + (size_t)TT * NH * 64 * 4),
    WS_QN = al256(WS_IDX + (size_t)TT * NG * TOPK * 4), WS_KN = al256(WS_QN + (size_t)TT * 256 * 4), WS_VV = al256(WS_KN + (size_t)TT * 256 * 4),
    WS_GG = al256(WS_VV + (size_t)TT * 256 * 4), WS_BETA = al256(WS_GG + (size_t)TT * DNH * 4), WS_GC = al256(WS_BETA + (size_t)TT * DNH * 4),
    WS_AM = al256(WS_GC + (size_t)NDU * 64 * 4), WS_AQK = al256(WS_AM + (size_t)NDU * 4096 * 4), WS_SOL = al256(WS_AQK + (size_t)NDU * 4096 * 4),
    WS_VNEW = al256(WS_SOL + (size_t)NDU * 8192 * 4), WS_SDN = al256(WS_VNEW + (size_t)BATCH * DNH * 4096 * 4), WS_ODN = al256(WS_SDN + (size_t)BATCH * DNH * 4096 * 4),
    WS_S5K = al256(WS_ODN + (size_t)TT * 256 * 4), WS_S5BB = al256(WS_S5K + 2 * S5G * S5P * 4 * 4), WS_S5E = al256(WS_S5BB + 2 * S5G * S5P * S5C * 2 * 4),
    WS_S5HIN = al256(WS_S5E + (size_t)BATCH * NCH * 2048 * 4), WS_S5HS = al256(WS_S5HIN + (size_t)BATCH * NCH * 2048 * 4), WS_GL = al256(WS_S5HS + (size_t)TT * 2048 * 4),
    WS_GLB = al256(WS_GL + (size_t)TT * 256 * 4), WS_WGLU = al256(WS_GLB + (size_t)TT * 256 * 2), WS_PART = al256(WS_WGLU + (size_t)2 * 65536 * 2), WS_DNF = al256(WS_PART + (size_t)8 * TS * DM * 4), WS_DNU = al256(WS_DNF + (size_t)NDU * 16384 * 2), WS_DNE = al256(WS_DNU + (size_t)NDU * 4096 * 4), WS_S5BF = al256(WS_DNE + (size_t)NDU * 4), WS_S5CF = al256(WS_S5BF + (size_t)2 * 16 * 8 * 64 * 8 * 2), WS_END = al256(WS_S5CF + (size_t)2 * 16 * 4 * 64 * 8 * 2);

struct Args { Ctx c; unsigned* bar; int lo, hi; };
constexpr int NPH = 1 + 2 * 14 + 2;
typedef const __attribute__((address_space(4))) unsigned char* karg_t;
__device__ __forceinline__ int lane_id() { return (int)__builtin_amdgcn_mbcnt_hi(~0u, __builtin_amdgcn_mbcnt_lo(~0u, 0u)); }
__device__ __forceinline__ int lane_id_v() { int t; asm volatile("v_mbcnt_lo_u32_b32 %0, -1, 0\n\tv_mbcnt_hi_u32_b32 %0, -1, %0" : "=v"(t)); return t; }
#define TIDV (wv * 64 + lane_id_v())
template <int P> __device__ __forceinline__ void run_phase(const int l, LAS unsigned char* L, const int wv) {
    karg_t kp = (karg_t)__builtin_amdgcn_kernarg_segment_ptr(); asm volatile("" : "+s"(kp));
    CREF c = *(const __attribute__((address_space(4))) Ctx*)kp;
    int tx_ = wv * 64 + lane_id_v(), bx_ = blockIdx.x; asm volatile("" : "+v"(tx_), "+s"(bx_));
    const long gtid = (long)bx_ * NTHREADS + tx_, gn = (long)gridDim.x * NTHREADS;
    const int G = (int)gridDim.x;
    if constexpr (P == 0) { dev_prologue(c, L, bx_, tx_, gtid, gn); ph_s5_consts(c, gtid, gn); }
    if constexpr (P == 2) dev_rmsnorm<false>(c, c.ln1 + l * DM, bx_, tx_, l == 0 ? 0 : 8);
    if constexpr (P == 3) { pg8::Gemm g{c.XN, c.WIN_T + (size_t)l * PLD * DM, TT, PLD, DM, DM}; pg8::StaticOrder S; S.init(TT, PLD, G, bx_);
        pg8::EpiF32<false> E{c.PROJ, PLD}; pg8::gemm_phase<pg8::EpiF32<false>, pg8::StaticOrder, true, true>(L, g, S, E, wv * 64 + lane_id_v()); }
    if constexpr (P == 4) { for (int u = bx_; u < NDU; u += G) dn_prep_unit(c, l, L, u, TIDV);
        for (int u = bx_; u < BATCH * NCH; u += G) s5_unit<false, false>(c, l, L, u / NCH, u % NCH, TIDV);
        constexpr int NPU = BATCH * NBP + DB * NBC_S;
        { const int t = TIDV; for (int u = 2 * bx_ + (t >> 8); u < NPU; u += 2 * G) { if (u < BATCH * NBP) pool_unit(c, l, u / NBP, u % NBP, t & 255); else pool_unit(c, l, BATCH + (u - BATCH * NBP) / NBC_S, (u - BATCH * NBP) % NBC_S, t & 255); } } }
    if constexpr (P == 5) {
        if (bx_ < BATCH * DNH) dn_scan_mfma(c, l, L, bx_, TIDV);
        constexpr int NU = BATCH * NG * NBP;
        volatile LAS int* qslot = (volatile LAS int*)(L + LDSCTL_OFF + 64);
#define QLOOP(qi, count, ...) for (;;) { if (wv == 0 && lane_id_v() == 0) qslot[0] = (int)__hip_atomic_fetch_add(c.QCTR + 64 * (8 * l + (qi)), 1u, __ATOMIC_RELAXED, __HIP_MEMORY_SCOPE_AGENT); \
            __syncthreads(); const int it = qslot[0]; __syncthreads(); if (it >= (count)) break; __VA_ARGS__; }
        QLOOP(0, NU, { const int qb = NBP - 1 - it / (BATCH * NG), bg = it % (BATCH * NG); nsa_unit<false>(c, l, L, bg / NG, qb, bg % NG, TIDV); })
        QLOOP(1, DB * NG, nsa_unit<true>(c, l, L, it / NG, PAST / 64, it % NG, TIDV))
        QLOOP(2, DB, dn_sample_unit(c, l, L, it, TIDV))
        QLOOP(3, BATCH, s5_carry_unit(c, l, it, TIDV))
        QLOOP(5, BATCH * NCH + DB, { if (it < BATCH * NCH) s5_unit<true, false>(c, l, L, it / NCH, it % NCH, TIDV); else s5_unit<true, true>(c, l, L, it - BATCH * NCH, 0, TIDV); })
        QLOOP(4, 256, dev_copy_out(c, l, (long)it * NTHREADS + TIDV, (long)256 * NTHREADS))
#undef QLOOP
    }
    if constexpr (P == 9) { { pg8::Gemm g{c.GLB, c.WGLU_T + (size_t)l * 65536, TT, 256, 256, 256}; pg8::StaticOrder S; S.init(TT, 256, G, bx_);
               pg8::EpiGluBf16 E{c.MIXB + 768, DM, c.GLB}; pg8::gemm_phase<pg8::EpiGluBf16, pg8::StaticOrder, true, true>(L, g, S, E, wv * 64 + lane_id_v()); }
        { int t2 = wv * 64 + lane_id_v(); asm volatile("" : "+v"(t2)); dev_dn_out(c, l, bx_, t2); } }
    if constexpr (P == 10) {
        { pg8::Gemm g{c.MIXB, c.WOUT_T + (size_t)l * DM * DM, TP, DM, DM, DM}; pg8::StaticOrder S; S.init(TP, DM, G, bx_);
          pg8::EpiF32<true> E{c.X, DM}; pg8::gemm_phase<pg8::EpiF32<true>, pg8::StaticOrder, true, true>(L, g, S, E, wv * 64 + lane_id_v()); }
        if (bx_ < 64) { const int ks = bx_ >> 4; pg8::Gemm g{c.MIXB + (size_t)TP * DM + ks * 256, c.WOUT_T + (size_t)l * DM * DM + ks * 256, TS, DM, 256, DM}; pg8::StaticOrder S; S.init(TS, DM, 16, bx_ & 15);
          pg8::EpiF32<false> E{c.PART + (size_t)ks * TS * DM, DM}; pg8::gemm_phase<pg8::EpiF32<false>, pg8::StaticOrder, true, true>(L, g, S, E, wv * 64 + lane_id_v()); } }
    if constexpr (P == 11) dev_rmsnorm<false>(c, c.ln2 + l * DM, bx_, tx_, 4);
    if constexpr (P == 12) { pg8::Gemm g{c.XN, c.WUP_T + (size_t)l * DFF * DM, TT, DFF, DM, DM}; pg8::StaticOrder S; S.init(TT, DFF, G, bx_);
        pg8::EpiSqReluBf16 E{c.UPB, DFF}; pg8::gemm_phase<pg8::EpiSqReluBf16, pg8::StaticOrder, true, true>(L, g, S, E, wv * 64 + lane_id_v()); }
    if constexpr (P == 13) {
        { pg8::Gemm g{c.UPB, c.WDN_T + (size_t)l * DM * DFF, TP, DM, DFF, DFF}; pg8::StaticOrder S; S.init(TP, DM, G, bx_);
          pg8::EpiF32<true> E{c.X, DM}; pg8::gemm_phase<pg8::EpiF32<true>, pg8::StaticOrder, true, true>(L, g, S, E, wv * 64 + lane_id_v()); }
        if (bx_ < 128) { const int ks = bx_ >> 4; pg8::Gemm g{c.UPB + (size_t)TP * DFF + ks * 512, c.WDN_T + (size_t)l * DM * DFF + ks * 512, TS, DM, 512, DFF}; pg8::StaticOrder S; S.init(TS, DM, 16, bx_ & 15);
          pg8::EpiF32<false> E{c.PART + (size_t)ks * TS * DM, DM}; pg8::gemm_phase<pg8::EpiF32<false>, pg8::StaticOrder, true, true>(L, g, S, E, wv * 64 + lane_id_v()); } }
    if constexpr (P == 14) dev_rmsnorm<true>(c, c.ln_f, bx_, tx_, 8);
}
#if N_LAUNCH_MODE == 1
__global__ void __launch_bounds__(NTHREADS, 2) fwd_kernel(Args a) {
    extern __shared__ __attribute__((aligned(16))) unsigned char lds[];
    LAS unsigned char* L = (LAS unsigned char*)lds;
    volatile LAS unsigned* MISC = (volatile LAS unsigned*)(L + LDSCTL_OFF);
    for (int u = threadIdx.x; u < (LDS_BYTES - LDSCTL_OFF) / 4; u += NTHREADS) ((LAS unsigned*)(L + LDSCTL_OFF))[u] = 0u;
    __syncthreads();
    XcdBarrier bar = xcd_barrier_post(a.bar, MISC + 8);
    const int wv = __builtin_amdgcn_readfirstlane((int)threadIdx.x >> 6);
#define PHASE(P, l) do { run_phase<P>(l, L, wv); xcd_barrier(bar, wv == 0 && lane_id_v() == 0); } while (0)
    PHASE(0, 0);
#define LAYER(l) PHASE(2, l); PHASE(3, l); PHASE(4, l); PHASE(5, l); PHASE(9, l); PHASE(10, l); PHASE(11, l); PHASE(12, l); PHASE(13, l)
#define LAYER0 PHASE(3, 0); PHASE(4, 0); PHASE(5, 0); PHASE(9, 0); PHASE(10, 0); PHASE(11, 0); PHASE(12, 0); PHASE(13, 0)
    LAYER0; LAYER(1);
#undef LAYER
    run_phase<14>(0, L, wv);
#undef PHASE
}
#else
template <int P> __global__ void __launch_bounds__(NTHREADS, 2) k_phase(Args a) {
    extern __shared__ __attribute__((aligned(16))) unsigned char lds[];
    run_phase<P>(a.lo, (LAS unsigned char*)lds, __builtin_amdgcn_readfirstlane((int)threadIdx.x >> 6));
}
template <int P> static void launch_phase(const Args& a, int grid, hipStream_t stream) {
    static bool attr = false;
    if (!attr) { (void)hipFuncSetAttribute((const void*)k_phase<P>, hipFuncAttributeMaxDynamicSharedMemorySize, LDS_BYTES); attr = true; }
    hipLaunchKernelGGL(k_phase<P>, dim3(grid), dim3(NTHREADS), LDS_BYTES, stream, a);
}
#endif

extern "C" void kernel_launch(void* const* d_in, const int* in_sizes, int n_in, void* d_out, int out_size, void* d_ws, size_t ws_size, hipStream_t stream) {
    static int grid = 0;
    if (grid == 0) {
        if (n_in != 31 || in_sizes[0] != TP * DM || (size_t)out_size != O_END || ws_size < WS_END) { fprintf(stderr, "kernel_launch: shape mismatch (n_in %d in0 %d out %d ws %zu need %zu)\n", n_in, n_in > 0 ? in_sizes[0] : -1, out_size, ws_size, (size_t)WS_END); grid = -1; return; }
        int dev = 0, cus = 0;
        if (hipGetDevice(&dev) != hipSuccess || hipDeviceGetAttribute(&cus, hipDeviceAttributeMultiprocessorCount, dev) != hipSuccess) { grid = -1; return; }
#if N_LAUNCH_MODE == 1
        int per_cu = 0;
        if (hipFuncSetAttribute((const void*)fwd_kernel, hipFuncAttributeMaxDynamicSharedMemorySize, LDS_BYTES) != hipSuccess) { fprintf(stderr, "kernel_launch: hipFuncSetAttribute failed\n"); grid = -1; return; }
        if (hipOccupancyMaxActiveBlocksPerMultiprocessor(&per_cu, (const void*)fwd_kernel, NTHREADS, LDS_BYTES) != hipSuccess || per_cu < 1) fprintf(stderr, "kernel_launch: occupancy query reports %d\n", per_cu);
        (void)hipGetLastError();
#endif
        grid = cus;
    }
    if (grid < 0) return;
    if (hipMemsetAsync((char*)d_ws + WS_CTL, 0, CTL_BYTES, stream) != hipSuccess) return;
    Args a{};
    Ctx& c = a.c;
    const float** fp[] = {&c.x_prompt, &c.x_sample, &c.cache_nsa, &c.cache_win, &c.st_conv, &c.st_dn, &c.st_s5re, &c.st_s5im, nullptr, &c.ln1, &c.ln2, &c.ln_f, &c.w_in, &c.w_out, &c.wck, &c.wcv, &c.conv_w, &c.a_log, &c.dt_bias,
                          &c.dn_norm_w, &c.lam_re, &c.lam_im, &c.log_step, &c.b_re, &c.b_im, &c.c_re, &c.c_im, &c.s5_d, &c.w_glu, &c.mlp_up, &c.mlp_down};
    for (int i = 0; i < 31; ++i) { if (i == 8) c.page_table = (const int*)d_in[i]; else *fp[i] = (const float*)d_in[i]; }
    c.out = (float*)d_out;
    char* w = (char*)d_ws;
    c.X = (float*)(w + WS_X); c.SSQ = (float*)(w + WS_SSQ); c.XN = (bf16_t*)(w + WS_XN); c.PROJ = (float*)(w + WS_PROJ); c.MIXB = (bf16_t*)(w + WS_MIXB); c.UPB = (bf16_t*)(w + WS_UPB);
    c.WIN_T = (bf16_t*)(w + WS_WIN); c.WOUT_T = (bf16_t*)(w + WS_WOUT); c.WUP_T = (bf16_t*)(w + WS_WUP); c.WDN_T = (bf16_t*)(w + WS_WDN);
    c.KC = (float*)(w + WS_KC); c.VC = (float*)(w + WS_VC); c.PC = (float*)(w + WS_PC); c.OC = (float*)(w + WS_OC); c.IDX = (int*)(w + WS_IDX);
    c.QN = (float*)(w + WS_QN); c.KN = (float*)(w + WS_KN); c.VV = (float*)(w + WS_VV); c.GG = (float*)(w + WS_GG); c.BETA = (float*)(w + WS_BETA);
    c.GC = (float*)(w + WS_GC); c.AM = (float*)(w + WS_AM); c.AQK = (float*)(w + WS_AQK); c.SOL = (float*)(w + WS_SOL); c.VNEW = (float*)(w + WS_VNEW); c.SDN = (float*)(w + WS_SDN); c.ODN = (float*)(w + WS_ODN);
    c.S5K = (float*)(w + WS_S5K); c.S5BB = (float*)(w + WS_S5BB); c.S5E = (float*)(w + WS_S5E); c.S5HIN = (float*)(w + WS_S5HIN); c.S5HS = (float*)(w + WS_S5HS); c.GL = (float*)(w + WS_GL); c.GLB = (bf16_t*)(w + WS_GLB); c.WGLU_T = (bf16_t*)(w + WS_WGLU); c.QCTR = (unsigned*)(w + WS_CTL) + 8192; c.PART = (float*)(w + WS_PART); c.DNF = (bf16_t*)(w + WS_DNF); c.DNU = (float*)(w + WS_DNU); c.DNE = (float*)(w + WS_DNE); c.S5BF = (bf16_t*)(w + WS_S5BF); c.S5CF = (bf16_t*)(w + WS_S5CF);
    a.bar = (unsigned*)(w + WS_CTL) + 1024;
#if N_LAUNCH_MODE == 1
    a.lo = 0; a.hi = NPH;
    hipLaunchKernelGGL(fwd_kernel, dim3(grid), dim3(NTHREADS), LDS_BYTES, stream, a);
#else
    a.hi = 0; a.lo = 0; launch_phase<0>(a, grid, stream);
    for (int l = 0; l < 2; ++l) { a.lo = l;
        launch_phase<1>(a, grid, stream); launch_phase<2>(a, grid, stream); launch_phase<3>(a, grid, stream); launch_phase<4>(a, grid, stream); launch_phase<5>(a, grid, stream);
        launch_phase<6>(a, grid, stream); launch_phase<7>(a, grid, stream); launch_phase<8>(a, grid, stream); launch_phase<9>(a, grid, stream); launch_phase<10>(a, grid, stream);
        launch_phase<1>(a, grid, stream); launch_phase<11>(a, grid, stream); launch_phase<12>(a, grid, stream); launch_phase<13>(a, grid, stream); }
    a.lo = 0; launch_phase<1>(a, grid, stream); launch_phase<14>(a, grid, stream);
#endif
}
```

```cpp
#include <hip/hip_runtime.h>
#include <cstdio>
#include <cstdint>
#define N_LAUNCH_MODE 1
#define HD __device__ __forceinline__
#ifndef CFG_SEQ
#define CFG_SEQ 8192
#endif
#ifndef CFG_BATCH
#define CFG_BATCH 2
#endif
#ifndef CFG_DB
#define CFG_DB 128
#endif
constexpr int DM = 1024, SEQ = CFG_SEQ, BATCH = CFG_BATCH, DB = CFG_DB, DSEQ = 8, PAST = 2048, PAGE = 128, NPAGES = PAST / PAGE;
constexpr int NUSED = DB * NPAGES, NPHYS = NUSED + (NUSED + 3) / 4;
constexpr int HD_ = 64, NH = 8, NG = 2, NR = 4, NBLK = 64, TOPK = 16, WIN = 512, W0S = PAST - WIN;
constexpr int DNH = 4, DNW = 256, CONVD = 768, S5G = 16, S5P = 64, S5C = 16, DFF = 4096, INW = 2592;
constexpr int TP = BATCH * SEQ, TS = DB * DSEQ, TT = TP + TS;
constexpr int PLD = 2816;
constexpr int C_Q = 0, C_KV = 512, C_GATE = 1280, C_DNQKV = 1304, C_DNA = 2072, C_DNB = 2076, C_DNZ = 2080, C_S5U = 2336;
constexpr int NBP = SEQ / NBLK;
constexpr int NBS_S = 33, NBC_S = 32;
constexpr int NBMAX = (NBP > 64 ? NBP : 64);
constexpr int NSEQ = BATCH + DB;
constexpr int NCH = SEQ / 64;
constexpr int NDU = BATCH * DNH * NCH;
constexpr float NEPS = 1e-6f;
static_assert(NBMAX <= 128, "selection bitmask is 128 bits");

constexpr size_t O_YP = 0, O_YS = O_YP + (size_t)TP * DM, O_KVP = O_YS + (size_t)TS * DM, O_KVS = O_KVP + (size_t)2 * TP * 512,
    O_WINP = O_KVS + (size_t)2 * TS * 512, O_WINS = O_WINP + (size_t)2 * BATCH * 512 * 256, O_CONVP = O_WINS + (size_t)2 * DB * 512 * 256,
    O_CONVS = O_CONVP + (size_t)2 * BATCH * 3 * CONVD, O_DNP = O_CONVS + (size_t)2 * DB * 3 * CONVD, O_DNS = O_DNP + (size_t)2 * BATCH * DNH * 4096,
    O_S5RP = O_DNS + (size_t)2 * DB * DNH * 4096, O_S5RS = O_S5RP + (size_t)2 * BATCH * 1024, O_S5IP = O_S5RS + (size_t)2 * DB * 1024,
    O_S5IS = O_S5IP + (size_t)2 * BATCH * 1024, O_END = O_S5IS + (size_t)2 * DB * 1024;

#ifdef HOST_EMU
typedef float bf16_t;
HD bf16_t tobf(float f) { return f; }
HD float frombf(bf16_t b) { return b; }
#else
typedef unsigned short bf16_t;
HD bf16_t tobf(float f) { unsigned u = __float_as_uint(f); u += 0x7fffu + ((u >> 16) & 1u); return (bf16_t)(u >> 16); }
HD float frombf(bf16_t b) { return __uint_as_float(((unsigned)b) << 16); }
#endif

struct Ctx {
    const float *x_prompt, *x_sample, *cache_nsa, *cache_win, *st_conv, *st_dn, *st_s5re, *st_s5im; const int* page_table;
    const float *ln1, *ln2, *ln_f, *w_in, *w_out, *wck, *wcv, *conv_w, *a_log, *dt_bias, *dn_norm_w, *lam_re, *lam_im, *log_step,
        *b_re, *b_im, *c_re, *c_im, *s5_d, *w_glu, *mlp_up, *mlp_down;
    float* out;
    float* X;
    float* SSQ;
    bf16_t* XN;
    float* PROJ;
    bf16_t* MIXB;
    bf16_t* UPB;
    bf16_t *WIN_T, *WOUT_T, *WUP_T, *WDN_T;
    float *KC, *VC;
    float* PC;
    float* OC;
    int* IDX;
    float *QN, *KN, *VV;
    float *GG, *BETA;
    float* GC;
    float* AM;
    float* AQK;
    float* SOL;
    float* VNEW;
    float* SDN;
    float* ODN;
    float* S5K;
    float* S5BB;
    float* S5E;
    float* S5HIN;
    float* S5HS;
    float* GL;
    bf16_t* GLB;
    bf16_t* WGLU_T;
    unsigned* QCTR;
    bf16_t* DNF;
    float* DNU;
    float* DNE;
    bf16_t* S5BF;
    bf16_t* S5CF;
    float* PART;
};

HD float sigmoidf_(float x) { return 1.0f / (1.0f + expf(-x)); }
HD float siluf_(float x) { return x * sigmoidf_(x); }
HD float softplusf_(float x) { return (x > 0.f ? x : 0.f) + log1pf(expf(-fabsf(x))); }
HD float geluf_(float x) { return 0.5f * x * (1.0f + tanhf(0.7978845608028654f * (x + 0.044715f * x * x * x))); }

#ifdef HOST_EMU
typedef const Ctx& CREF;
#else
typedef const __attribute__((address_space(4))) Ctx& CREF;
#endif
struct Tok { int smp, b, j, t, seq; };
HD Tok tok_of(int r) { Tok k; if (r < TP) { k.smp = 0; k.b = r / SEQ; k.j = r % SEQ; k.t = k.j; k.seq = k.b; } else { r -= TP; k.smp = 1; k.b = r / DSEQ; k.j = r % DSEQ; k.t = PAST + k.j; k.seq = BATCH + k.b; } return k; }

HD const float* kv_ptr(CREF c, int l, int smp, int b, int pos, int slot, int g) {
    if (!smp) return c.PROJ + (size_t)(b * SEQ + pos) * PLD + C_KV + slot * 128 + g * 64;
    if (pos >= PAST) return c.PROJ + (size_t)(TP + b * DSEQ + (pos - PAST)) * PLD + C_KV + slot * 128 + g * 64;
    if (slot < 4) { const int pg = c.page_table[b * NPAGES + pos / PAGE]; return c.cache_nsa + ((((size_t)l * NPHYS + pg) * PAGE + (pos % PAGE)) * 4 + slot) * 128 + g * 64; }
    return c.cache_win + ((((size_t)l * DB + b) * WIN + (pos - W0S)) * 2 + (slot - 4)) * 128 + g * 64;
}

HD void ph_prologue(CREF c, long gtid, long gn) {
    for (long i = gtid; i < (long)2 * PLD * DM; i += gn) { const int l = (int)(i / ((long)PLD * DM)); const long r = i % ((long)PLD * DM); const int n = (int)(r / DM), k = (int)(r % DM);
        c.WIN_T[i] = tobf(n < INW ? c.w_in[((size_t)l * DM + k) * INW + n] : 0.f); }
    for (long i = gtid; i < (long)2 * DM * DM; i += gn) { const int l = (int)(i / ((long)DM * DM)); const long r = i % ((long)DM * DM); const int n = (int)(r / DM), k = (int)(r % DM);
        c.WOUT_T[i] = tobf(c.w_out[((size_t)l * DM + k) * DM + n]); }
    for (long i = gtid; i < (long)2 * DFF * DM; i += gn) { const int l = (int)(i / ((long)DFF * DM)); const long r = i % ((long)DFF * DM); const int n = (int)(r / DM), k = (int)(r % DM);
        c.WUP_T[i] = tobf(c.mlp_up[((size_t)l * DM + k) * DFF + n]); }
    for (long i = gtid; i < (long)2 * DM * DFF; i += gn) { const int l = (int)(i / ((long)DM * DFF)); const long r = i % ((long)DM * DFF); const int n = (int)(r / DFF), k = (int)(r % DFF);
        c.WDN_T[i] = tobf(c.mlp_down[((size_t)l * DFF + k) * DM + n]); }
    for (long i = gtid; i < (long)TT * DM; i += gn) c.X[i] = i < (long)TP * DM ? c.x_prompt[i] : c.x_sample[i - (long)TP * DM];
}
HD void ph_s5_consts(CREF c, long gtid, long gn) {
    for (long i = gtid; i < 2 * S5G * S5P; i += gn) { const int l = (int)(i / (S5G * S5P)), g = (int)((i / S5P) % S5G);
        const double lr = c.lam_re[i], li = c.lam_im[i], dt = exp((double)c.log_step[l * S5G + g]);
        const double mag = exp(lr * dt), ar = mag * cos(li * dt), ai = mag * sin(li * dt), den = lr * lr + li * li;
        const double fr = ((ar - 1.0) * lr + ai * li) / den, fi = (ai * lr - (ar - 1.0) * li) / den;
        double pr = 1.0, pi = 0.0; for (int s = 0; s < 64; ++s) { const double nr = pr * ar - pi * ai, ni = pr * ai + pi * ar; pr = nr; pi = ni; }
        c.S5K[i * 4 + 0] = (float)ar; c.S5K[i * 4 + 1] = (float)ai; c.S5K[i * 4 + 2] = (float)pr; c.S5K[i * 4 + 3] = (float)pi;
        for (int ch = 0; ch < S5C; ++ch) { const double br = c.b_re[i * S5C + ch], bi = c.b_im[i * S5C + ch];
            c.S5BB[(i * S5C + ch) * 2 + 0] = (float)(fr * br - fi * bi); c.S5BB[(i * S5C + ch) * 2 + 1] = (float)(fr * bi + fi * br);
#ifndef HOST_EMU
            {
                const int p = (int)(i % S5P); const size_t lg = (size_t)(i / S5P);
#pragma unroll
                for (int comp = 0; comp < 2; ++comp) { const int s = 2 * p + comp, j = s >> 4, n = s & 15;
                    c.S5BF[((lg * 8 + j) * 64 + n + 16 * (ch >> 3)) * 8 + (ch & 7)] = tobf((float)(comp == 0 ? fr * br - fi * bi : fr * bi + fi * br));
                    if (ch < 8) { c.S5BF[((lg * 8 + j) * 64 + n + 32) * 8 + ch] = 0; c.S5BF[((lg * 8 + j) * 64 + n + 48) * 8 + ch] = 0; }
                    const int k = s, ks = k >> 5, kg = (k & 31) >> 3, jj = k & 7; const size_t ci = ((lg * S5C + ch) * S5P + p);
                    c.S5CF[((lg * 4 + ks) * 64 + ch + 16 * kg) * 8 + jj] = tobf(comp == 0 ? c.c_re[ci] : -c.c_im[ci]); } }
#endif
        } }
}

HD void ph_ssq(CREF c, long gtid, long gn) {
    for (long i = gtid; i < (long)TT * 64; i += gn) { const float* p = c.X + i * 16; float s = 0.f; for (int k = 0; k < 16; ++k) s += p[k] * p[k]; c.SSQ[i] = s; }
}
HD float row_rstd(CREF c, int r) { const float* p = c.SSQ + (size_t)r * 64; float s = 0.f; for (int k = 0; k < 64; ++k) s += p[k]; return 1.0f / sqrtf(s * (1.0f / DM) + NEPS); }
HD void ph_norm(CREF c, const float* gain, long gtid, long gn) {
    for (long i = gtid; i < (long)TT * (DM / 4); i += gn) { const int r = (int)(i / (DM / 4)), c4 = (int)(i % (DM / 4)) * 4; const float rs = row_rstd(c, r);
        for (int k = 0; k < 4; ++k) c.XN[(size_t)r * DM + c4 + k] = tobf(c.X[(size_t)r * DM + c4 + k] * rs * gain[c4 + k]); }
}
HD void ph_final(CREF c, long gtid, long gn) {
    for (long i = gtid; i < (long)TT * (DM / 4); i += gn) { const int r = (int)(i / (DM / 4)), c4 = (int)(i % (DM / 4)) * 4; const float rs = row_rstd(c, r);
        for (int k = 0; k < 4; ++k) c.out[O_YP + (size_t)r * DM + c4 + k] = c.X[(size_t)r * DM + c4 + k] * rs * c.ln_f[c4 + k]; }
}

HD void ph_copy_out(CREF c, int l, long gtid, long gn) {
    for (long i = gtid; i < (long)TT * 512; i += gn) { const int r = (int)(i / 512), k = (int)(i % 512); const float v = c.PROJ[(size_t)r * PLD + C_KV + k];
        if (r < TP) c.out[O_KVP + ((size_t)l * TP + r) * 512 + k] = v; else c.out[O_KVS + ((size_t)l * TS + (r - TP)) * 512 + k] = v; }
    for (long i = gtid; i < (long)BATCH * 512 * 256; i += gn) { const int b = (int)(i / (512 * 256)), w = (int)((i / 256) % 512), k = (int)(i % 256);
        c.out[O_WINP + (size_t)l * BATCH * 512 * 256 + i] = c.PROJ[(size_t)(b * SEQ + SEQ - 512 + w) * PLD + C_KV + 512 + k]; }
    for (long i = gtid; i < (long)DB * 512 * 256; i += gn) { const int b = (int)(i / (512 * 256)), w = (int)((i / 256) % 512), k = (int)(i % 256);
        c.out[O_WINS + (size_t)l * DB * 512 * 256 + i] = (w < 512 - DSEQ) ? c.cache_win[(((size_t)l * DB + b) * 512 + w + DSEQ) * 256 + k]
                                                                          : c.PROJ[(size_t)(TP + b * DSEQ + (w - (512 - DSEQ))) * PLD + C_KV + 512 + k]; }
    for (long i = gtid; i < (long)BATCH * 3 * CONVD; i += gn) { const int b = (int)(i / (3 * CONVD)), w = (int)((i / CONVD) % 3), k = (int)(i % CONVD);
        c.out[O_CONVP + (size_t)l * BATCH * 3 * CONVD + i] = c.PROJ[(size_t)(b * SEQ + SEQ - 3 + w) * PLD + C_DNQKV + k]; }
    for (long i = gtid; i < (long)DB * 3 * CONVD; i += gn) { const int b = (int)(i / (3 * CONVD)), w = (int)((i / CONVD) % 3), k = (int)(i % CONVD);
        c.out[O_CONVS + (size_t)l * DB * 3 * CONVD + i] = c.PROJ[(size_t)(TP + b * DSEQ + DSEQ - 3 + w) * PLD + C_DNQKV + k]; }
}
HD float dn_x(CREF c, int l, const Tok& k, int r, int back, int ch) {
    const int jj = k.j - back;
    if (jj >= 0) return c.PROJ[(size_t)(r - back) * PLD + C_DNQKV + ch];
    if (!k.smp) return 0.f;
    return c.st_conv[(((size_t)l * DB + k.b) * 3 + (3 + jj)) * CONVD + ch];
}
HD float dn_conv1(CREF c, int l, const Tok& k, int r, int ch) {
    const float* w = c.conv_w + ((size_t)l * CONVD + ch) * 4; float y = 0.f;
    for (int j = 0; j < 4; ++j) y += w[j] * dn_x(c, l, k, r, 3 - j, ch);
    return siluf_(y);
}
HD void ph_dn_conv(CREF c, int l, long gtid, long gn, int rbeg = 0) {
    for (long i = gtid + (long)rbeg * 3 * DNH; i < (long)TT * 3 * DNH; i += gn) { const int r = (int)(i / (3 * DNH)), part = (int)((i / DNH) % 3), h = (int)(i % DNH); const Tok k = tok_of(r);
        const int ch0 = part * DNW + h * 64; float ss = 0.f;
        if (part < 2) for (int d = 0; d < 64; ++d) { const float y = dn_conv1(c, l, k, r, ch0 + d); ss += y * y; }
        const float sc = part == 0 ? 0.125f / sqrtf(ss + 1e-6f) : (part == 1 ? 1.0f / sqrtf(ss + 1e-6f) : 1.0f);
        float* dst = (part == 0 ? c.QN : (part == 1 ? c.KN : c.VV)) + ((size_t)r * DNH + h) * 64;
        for (int d = 0; d < 64; ++d) dst[d] = dn_conv1(c, l, k, r, ch0 + d) * sc; }
    for (long i = gtid + (long)rbeg * DNH; i < (long)TT * DNH; i += gn) { const int r = (int)(i / DNH), h = (int)(i % DNH);
        c.BETA[i] = sigmoidf_(c.PROJ[(size_t)r * PLD + C_DNB + h]);
        c.GG[i] = -expf(c.a_log[l * DNH + h]) * softplusf_(c.PROJ[(size_t)r * PLD + C_DNA + h] + c.dt_bias[l * DNH + h]); }
}
HD void ph_pool(CREF c, int l, long gtid, long gn) {
    for (long i = gtid; i < (long)NSEQ * NBMAX * 128; i += gn) { const int seq = (int)(i / (NBMAX * 128)), n = (int)((i / 128) % NBMAX), g = (int)((i / 64) % 2), d = (int)(i % 64);
        const int smp = seq >= BATCH, b = smp ? seq - BATCH : seq; if (n >= (smp ? NBC_S : NBP)) continue;
        float sk = 0.f, sv = 0.f;
        for (int j = 0; j < 64; ++j) { sk += c.wck[(l * 2 + g) * 64 + j] * kv_ptr(c, l, smp, b, n * 64 + j, 0, g)[d]; sv += c.wcv[(l * 2 + g) * 64 + j] * kv_ptr(c, l, smp, b, n * 64 + j, 1, g)[d]; }
        c.KC[i] = sk; c.VC[i] = sv; }
}
HD void s5_scan(CREF c, int l, int g, int p, int r0, int len, float& hr, float& hi, bool store) {
    const float* K = c.S5K + ((size_t)(l * S5G + g) * S5P + p) * 4; const float ar = K[0], ai = K[1];
    const float* bb = c.S5BB + ((size_t)(l * S5G + g) * S5P + p) * S5C * 2;
    for (int t = 0; t < len; ++t) { const float* u = c.PROJ + (size_t)(r0 + t) * PLD + C_S5U + g * S5C; float br = 0.f, bi = 0.f;
        for (int ch = 0; ch < S5C; ++ch) { br += bb[ch * 2] * u[ch]; bi += bb[ch * 2 + 1] * u[ch]; }
        const float nr = ar * hr - ai * hi + br, ni = ar * hi + ai * hr + bi; hr = nr; hi = ni;
        if (store) { float* hs = c.S5HS + (((size_t)(r0 + t) * S5G + g) * S5P + p) * 2; hs[0] = hr; hs[1] = hi; } }
}
HD void ph_s5_passA(CREF c, int l, long gtid, long gn) {
    for (long i = gtid; i < (long)BATCH * NCH * S5G * S5P; i += gn) { const int p = (int)(i % S5P), g = (int)((i / S5P) % S5G), ch = (int)((i / (S5P * S5G)) % NCH), b = (int)(i / ((long)S5P * S5G * NCH));
        float hr = 0.f, hi = 0.f; s5_scan(c, l, g, p, b * SEQ + ch * 64, 64, hr, hi, false); c.S5E[i * 2] = hr; c.S5E[i * 2 + 1] = hi; }
}
HD void ph_dn_gc(CREF c, long gtid, long gn) {
    for (long i = gtid; i < NDU; i += gn) { const int ch = (int)(i % NCH), h = (int)((i / NCH) % DNH), b = (int)(i / (NCH * DNH)); float s = 0.f;
        for (int t = 0; t < 64; ++t) { s += c.GG[(size_t)(b * SEQ + ch * 64 + t) * DNH + h]; c.GC[i * 64 + t] = s; } }
}
HD void ph_cmp(CREF c, int l, long gtid, long gn, int rbeg = 0) {
    for (long i = gtid + (long)rbeg * NH; i < (long)TT * NH; i += gn) { const int r = (int)(i / NH), h = (int)(i % NH), g = h / NR; const Tok k = tok_of(r);
        const float slope = exp2f(-(float)(h + 1)); const int nbv = (k.t + 1) / 64;
        const float* q = c.PROJ + (size_t)r * PLD + C_Q + h * 64; float* pc = c.PC + (size_t)i * NBMAX; float* oc = c.OC + (size_t)i * 64;
        float m = -1e30f;
        for (int n = 0; n < nbv; ++n) { const float* kc = c.KC + (((size_t)k.seq * NBMAX + n) * 2 + g) * 64; float s = 0.f; for (int d = 0; d < 64; ++d) s += q[d] * kc[d];
            s = s * 0.125f - slope * ((float)k.t - ((float)(n * 64) + 31.5f)); pc[n] = s; m = s > m ? s : m; }
        float sum = 0.f; for (int n = 0; n < nbv; ++n) { const float e = expf(pc[n] - m); pc[n] = e; sum += e; }
        const float inv = 1.0f / (sum > 1e-30f ? sum : 1e-30f);
        for (int d = 0; d < 64; ++d) oc[d] = 0.f;
        for (int n = 0; n < nbv; ++n) { const float p = pc[n] * inv; pc[n] = p; const float* vc = c.VC + (((size_t)k.seq * NBMAX + n) * 2 + g) * 64; for (int d = 0; d < 64; ++d) oc[d] += p * vc[d]; }
        for (int n = nbv; n < NBMAX; ++n) pc[n] = 0.f; }
}
HD void ph_s5_carry(CREF c, int l, long gtid, long gn) {
    for (long i = gtid; i < (long)BATCH * S5G * S5P; i += gn) { const int p = (int)(i % S5P), g = (int)((i / S5P) % S5G), b = (int)(i / (S5P * S5G));
        const float* K = c.S5K + ((size_t)(l * S5G + g) * S5P + p) * 4; const float a64r = K[2], a64i = K[3]; float hr = 0.f, hi = 0.f;
        for (int ch = 0; ch < NCH; ++ch) { const size_t e = ((((size_t)b * NCH + ch) * S5G + g) * S5P + p) * 2; c.S5HIN[e] = hr; c.S5HIN[e + 1] = hi;
            const float nr = a64r * hr - a64i * hi + c.S5E[e], ni = a64r * hi + a64i * hr + c.S5E[e + 1]; hr = nr; hi = ni; }
        c.out[O_S5RP + ((size_t)l * BATCH + b) * 1024 + g * S5P + p] = hr; c.out[O_S5IP + ((size_t)l * BATCH + b) * 1024 + g * S5P + p] = hi; }
}
HD void ph_dn_mats(CREF c, long gtid, long gn) {
    for (long i = gtid; i < (long)NDU * 4096; i += gn) { const int u = (int)(i / 4096), ii = (int)((i / 64) % 64), jj = (int)(i % 64);
        const int ch = u % NCH, h = (u / NCH) % DNH, b = u / (NCH * DNH); const int r0 = b * SEQ + ch * 64;
        float am = 0.f, aq = 0.f;
        if (jj <= ii) { const float* ki = c.KN + ((size_t)(r0 + ii) * DNH + h) * 64; const float* kj = c.KN + ((size_t)(r0 + jj) * DNH + h) * 64; const float* qi = c.QN + ((size_t)(r0 + ii) * DNH + h) * 64;
            float kk = 0.f, qk = 0.f; for (int d = 0; d < 64; ++d) { kk += ki[d] * kj[d]; qk += qi[d] * kj[d]; }
            const float dec = expf(c.GC[(size_t)u * 64 + ii] - c.GC[(size_t)u * 64 + jj]);
            aq = qk * dec; if (jj < ii) am = c.BETA[(size_t)(r0 + ii) * DNH + h] * kk * dec; }
        c.AM[i] = am; c.AQK[i] = aq; }
    for (long i = gtid; i < (long)NDU * 64 * 128; i += gn) { const int u = (int)(i / 8192), ii = (int)((i / 128) % 64), col = (int)(i % 128);
        const int ch = u % NCH, h = (u / NCH) % DNH, b = u / (NCH * DNH); const int r = b * SEQ + ch * 64 + ii; const float be = c.BETA[(size_t)r * DNH + h];
        c.SOL[i] = col < 64 ? c.VV[((size_t)r * DNH + h) * 64 + col] * be : c.KN[((size_t)r * DNH + h) * 64 + (col - 64)] * be * expf(c.GC[(size_t)u * 64 + ii]); }
}
HD void ph_topk(CREF c, long gtid, long gn, int rbeg = 0) {
    for (long i = gtid + (long)rbeg * NG; i < (long)TT * NG; i += gn) { const int r = (int)(i / NG), g = (int)(i % NG); const Tok k = tok_of(r);
        const int cur = k.t / 64, nbs = k.smp ? NBS_S : NBP; const float* pc = c.PC + ((size_t)r * NH + g * NR) * NBMAX;
        unsigned long long tk0 = 0ull, tk1 = 0ull; int* idx = c.IDX + (size_t)i * TOPK;
        const int nsel = nbs < TOPK ? nbs : TOPK;
        for (int s = 0; s < TOPK; ++s) { int best = -1; float bv = 0.f;
            if (s < nsel) for (int n = 0; n < nbs; ++n) { const bool taken = n < 64 ? ((tk0 >> n) & 1ull) : ((tk1 >> (n - 64)) & 1ull); if (taken) continue;
                float sc; if (n > cur) sc = -1e9f; else if (n == 0 || n == cur || n == cur - 1) sc = 1e9f; else sc = (pc[n] + pc[NBMAX + n]) + (pc[2 * NBMAX + n] + pc[3 * NBMAX + n]);
                if (best < 0 || sc > bv) { best = n; bv = sc; } }
            if (best >= 0) { if (best < 64) tk0 |= 1ull << best; else tk1 |= 1ull << (best - 64); }
            idx[s] = (best >= 0 && best <= cur) ? best : -1; } }
}
HD void ph_s5_passB(CREF c, int l, long gtid, long gn) {
    for (long i = gtid; i < (long)BATCH * NCH * S5G * S5P; i += gn) { const int p = (int)(i % S5P), g = (int)((i / S5P) % S5G), ch = (int)((i / (S5P * S5G)) % NCH), b = (int)(i / ((long)S5P * S5G * NCH));
        float hr = c.S5HIN[i * 2], hi = c.S5HIN[i * 2 + 1]; s5_scan(c, l, g, p, b * SEQ + ch * 64, 64, hr, hi, true); }
    for (long i = gtid; i < (long)DB * S5G * S5P; i += gn) { const int p = (int)(i % S5P), g = (int)((i / S5P) % S5G), b = (int)(i / (S5P * S5G));
        float hr = c.st_s5re[(size_t)l * DB * 1024 + i], hi = c.st_s5im[(size_t)l * DB * 1024 + i]; s5_scan(c, l, g, p, TP + b * DSEQ, DSEQ, hr, hi, true);
        c.out[O_S5RS + (size_t)l * DB * 1024 + i] = hr; c.out[O_S5IS + (size_t)l * DB * 1024 + i] = hi; }
}
HD void ph_dn_solve(CREF c, long gtid, long gn) {
    for (long i = gtid; i < (long)NDU * 128; i += gn) { const int u = (int)(i / 128), col = (int)(i % 128); float* x = c.SOL + (size_t)u * 8192 + col; const float* A = c.AM + (size_t)u * 4096;
        for (int ii = 1; ii < 64; ++ii) { float s = x[ii * 128]; for (int jj = 0; jj < ii; ++jj) s -= A[ii * 64 + jj] * x[jj * 128]; x[ii * 128] = s; } }
}
HD void ph_attn(CREF c, int l, long gtid, long gn, int rbeg = 0) {
    for (long i = gtid + (long)rbeg * NH; i < (long)TT * NH; i += gn) { const int r = (int)(i / NH), h = (int)(i % NH), g = h / NR; const Tok k = tok_of(r);
        const float slope = exp2f(-(float)(h + 1));
        float q[64];
#pragma unroll
        for (int d = 0; d < 64; ++d) q[d] = c.PROJ[(size_t)r * PLD + C_Q + h * 64 + d] * 0.125f;
        const float* gp = c.PROJ + (size_t)r * PLD + C_GATE + h * 3; const float g0 = sigmoidf_(gp[0]), g1 = sigmoidf_(gp[1]), g2 = sigmoidf_(gp[2]);
        float* oc = c.OC + (size_t)i * 64;
        float o[64]; float m = -1e30f, lsum = 0.f;
#pragma unroll
        for (int d = 0; d < 64; ++d) o[d] = 0.f;
        const int* idx = c.IDX + ((size_t)r * NG + g) * TOPK;
        for (int s = 0; s < TOPK; ++s) { const int n = idx[s]; if (n < 0) continue;
            for (int j = 0; j < 64; ++j) { const int pos = n * 64 + j; if (pos > k.t) break;
                const float* kp = kv_ptr(c, l, k.smp, k.b, pos, 2, g); const float* vp = kv_ptr(c, l, k.smp, k.b, pos, 3, g);
                float sc = 0.f;
#pragma unroll
                for (int d = 0; d < 64; ++d) sc += q[d] * kp[d];
                sc -= slope * (float)(k.t - pos);
                const float mn = sc > m ? sc : m, al = expf(m - mn), p = expf(sc - mn); m = mn; lsum = lsum * al + p;
#pragma unroll
                for (int d = 0; d < 64; ++d) o[d] = o[d] * al + p * vp[d]; } }
        { const float inv = g1 / (lsum > 1e-30f ? lsum : 1e-30f);
#pragma unroll
          for (int d = 0; d < 64; ++d) oc[d] = g0 * oc[d] + inv * o[d]; }
        m = -1e30f; lsum = 0.f;
#pragma unroll
        for (int d = 0; d < 64; ++d) o[d] = 0.f;
        const int w0 = k.smp ? W0S : 0; int p0 = k.t - (WIN - 1); if (p0 < w0) p0 = w0;
        for (int pos = p0; pos <= k.t; ++pos) { const float* kp = kv_ptr(c, l, k.smp, k.b, pos, 4, g); const float* vp = kv_ptr(c, l, k.smp, k.b, pos, 5, g);
            float sc = 0.f;
#pragma unroll
            for (int d = 0; d < 64; ++d) sc += q[d] * kp[d];
            sc -= slope * (float)(k.t - pos);
            const float mn = sc > m ? sc : m, al = expf(m - mn), p = expf(sc - mn); m = mn; lsum = lsum * al + p;
#pragma unroll
            for (int d = 0; d < 64; ++d) o[d] = o[d] * al + p * vp[d]; }
        { const float inv = g2 / (lsum > 1e-30f ? lsum : 1e-30f);
#pragma unroll
          for (int d = 0; d < 64; ++d) c.MIXB[(size_t)r * DM + h * 64 + d] = tobf(oc[d] + inv * o[d]); } }
}
HD void ph_s5_y(CREF c, int l, long gtid, long gn) {
    for (long i = gtid; i < (long)TT * 256; i += gn) { const int r = (int)(i / 256), ch = (int)(i % 256), g = ch / S5C, cc = ch % S5C;
        const float* cr = c.c_re + (((size_t)l * S5G + g) * S5C + cc) * S5P; const float* ci = c.c_im + (((size_t)l * S5G + g) * S5C + cc) * S5P;
        const float* hs = c.S5HS + ((size_t)r * S5G + g) * S5P * 2; float y = 0.f;
        for (int p = 0; p < S5P; ++p) y += cr[p] * hs[2 * p] - ci[p] * hs[2 * p + 1];
        y += c.s5_d[l * 256 + ch] * c.PROJ[(size_t)r * PLD + C_S5U + ch]; c.GL[i] = geluf_(y); }
}
HD void ph_dn_scan_prompt(CREF c, int l, long gtid, long gn) {
    for (long i = gtid; i < (long)BATCH * DNH * 64; i += gn) { const int jc = (int)(i % 64), h = (int)((i / 64) % DNH), b = (int)(i / (64 * DNH));
        float S[64];
#pragma unroll
        for (int kk = 0; kk < 64; ++kk) S[kk] = 0.f;
        float* vn = c.VNEW + (size_t)(b * DNH + h) * 4096 + jc;
        for (int ch = 0; ch < NCH; ++ch) { const int u = (b * DNH + h) * NCH + ch; const int r0 = b * SEQ + ch * 64;
            const float* sol = c.SOL + (size_t)u * 8192; const float* gc = c.GC + (size_t)u * 64; const float* aqk = c.AQK + (size_t)u * 4096;
            for (int t = 0; t < 64; ++t) { const float* w = sol + t * 128 + 64; float s = sol[t * 128 + jc];
#pragma unroll
                for (int kk = 0; kk < 64; ++kk) s -= w[kk] * S[kk];
                vn[t * 64] = s; }
            for (int t = 0; t < 64; ++t) { const float* qq = c.QN + ((size_t)(r0 + t) * DNH + h) * 64; float s = 0.f;
#pragma unroll
                for (int kk = 0; kk < 64; ++kk) s += qq[kk] * S[kk];
                s *= expf(gc[t]);
                for (int t2 = 0; t2 <= t; ++t2) s += aqk[t * 64 + t2] * vn[t2 * 64];
                c.ODN[((size_t)(r0 + t) * DNH + h) * 64 + jc] = s; }
            const float gl = gc[63], eg = expf(gl);
#pragma unroll
            for (int kk = 0; kk < 64; ++kk) S[kk] *= eg;
            for (int t = 0; t < 64; ++t) { const float* kk_ = c.KN + ((size_t)(r0 + t) * DNH + h) * 64; const float f = expf(gl - gc[t]) * vn[t * 64];
#pragma unroll
                for (int kk = 0; kk < 64; ++kk) S[kk] += kk_[kk] * f; } }
#pragma unroll
        for (int kk = 0; kk < 64; ++kk) c.out[O_DNP + (((size_t)l * BATCH + b) * DNH + h) * 4096 + kk * 64 + jc] = S[kk]; }
}
HD void ph_dn_scan_sample(CREF c, int l, long gtid, long gn) {
    for (long i = gtid; i < (long)DB * DNH * 64; i += gn) { const int jc = (int)(i % 64), h = (int)((i / 64) % DNH), b = (int)(i / (64 * DNH));
        float S[64]; const float* s0 = c.st_dn + (((size_t)l * DB + b) * DNH + h) * 4096 + jc;
#pragma unroll
        for (int kk = 0; kk < 64; ++kk) S[kk] = s0[kk * 64];
        for (int t = 0; t < DSEQ; ++t) { const int r = TP + b * DSEQ + t; const float* kv = c.KN + ((size_t)r * DNH + h) * 64; const float* qq = c.QN + ((size_t)r * DNH + h) * 64;
            const float a = expf(c.GG[(size_t)r * DNH + h]), be = c.BETA[(size_t)r * DNH + h]; float ks = 0.f;
#pragma unroll
            for (int kk = 0; kk < 64; ++kk) { S[kk] *= a; ks += kv[kk] * S[kk]; }
            const float vnw = be * (c.VV[((size_t)r * DNH + h) * 64 + jc] - ks); float os = 0.f;
#pragma unroll
            for (int kk = 0; kk < 64; ++kk) { S[kk] += kv[kk] * vnw; os += qq[kk] * S[kk]; }
            c.ODN[((size_t)r * DNH + h) * 64 + jc] = os; }
#pragma unroll
        for (int kk = 0; kk < 64; ++kk) c.out[O_DNS + (((size_t)l * DB + b) * DNH + h) * 4096 + kk * 64 + jc] = S[kk]; }
}
HD void ph_s5_glu(CREF c, int l, long gtid, long gn) {
    for (long i = gtid; i < (long)TT * 256; i += gn) { const int r = (int)(i / 256), ch = (int)(i % 256); const float* gl = c.GL + (size_t)r * 256; const float* w = c.w_glu + (size_t)l * 65536 + ch; float z = 0.f;
        for (int kk = 0; kk < 256; ++kk) z += gl[kk] * w[kk * 256];
        c.MIXB[(size_t)r * DM + 768 + ch] = tobf(gl[ch] * sigmoidf_(z)); }
}
HD void ph_dn_out(CREF c, int l, long gtid, long gn) {
    for (long i = gtid; i < (long)TT * DNH; i += gn) { const int r = (int)(i / DNH), h = (int)(i % DNH); const float* o = c.ODN + (size_t)i * 64; float ss = 0.f;
        for (int d = 0; d < 64; ++d) ss += o[d] * o[d];
        const float rs = 1.0f / sqrtf(ss * (1.0f / 64.0f) + NEPS);
        for (int d = 0; d < 64; ++d) c.MIXB[(size_t)r * DM + 512 + h * 64 + d] = tobf(o[d] * rs * c.dn_norm_w[l * 64 + d] * siluf_(c.PROJ[(size_t)r * PLD + C_DNZ + h * 64 + d])); }
}
namespace pg8 {
#define PG8_LAS __attribute__((address_space(3)))
typedef unsigned short bf16_t;
typedef short bf16x8 __attribute__((ext_vector_type(8)));
typedef float f32x4 __attribute__((ext_vector_type(4)));
typedef unsigned u32x4 __attribute__((ext_vector_type(4)));
constexpr int BM = 256, BK = 64, HALF = 128, HTB = HALF * BK * 2  , STAGE_BYTES = 8 * HTB, NXCD = 8, WGM = 8;

__host__ __device__ __forceinline__ int lds_byte(int r, int c) { const int st = (r >> 4) * 2 + (c >> 5), rr = r & 15, cc = c & 31, ob = rr * 64 + cc * 2; return st * 1024 + (ob ^ (((ob >> 9) & 1) << 5)); }
__host__ __device__ __forceinline__ void stage_rc(int b, int& R, int& C) { const int st = b / 1024, sb = b % 1024, swz = sb ^ (((sb >> 9) & 1) << 5); R = (st >> 1) * 16 + swz / 64; C = (st & 1) * 32 + (swz % 64) / 2; }
__host__ __device__ __forceinline__ int perm32(int rho) { const int n = rho >> 4, i = rho & 15; return 8 * (i >> 2) + 4 * n + (i & 3); }

struct Unit { int pm, pn; };
struct Gemm { const bf16_t* A; const bf16_t* Bt; int M, N, K, ld; };

struct StaticOrder {
    int nM, nN, nwg, G, c;
    __host__ __device__ void init(int M, int N, int G_, int c_) { nM = M / BM; nN = N / BM; nwg = nM * nN; G = G_; c = c_; }
    __host__ __device__ bool next(int i, Unit& u) const {
        const long L = (long)i * G + c; if (L >= nwg) return false;
        int wgid = (int)L; { const int q = nwg / NXCD, r = nwg % NXCD, xcd = wgid % NXCD, off = wgid / NXCD; wgid = (xcd < r ? xcd * (q + 1) : r * (q + 1) + (xcd - r) * q) + off; }
        const int nig = WGM * nN, gid = wgid / nig, fm = gid * WGM, gsz = (nM - fm) < WGM ? (nM - fm) : WGM;
        u.pm = fm + ((wgid % nig) % gsz); u.pn = (wgid % nig) / gsz; return true;
    }
    __device__ __forceinline__ void a_ready(const Unit&) const {}
    __device__ __forceinline__ void done(const Unit&) const {}
};

__device__ __forceinline__ unsigned cvt_pk_bf16(float lo, float hi) { unsigned r; asm volatile("v_cvt_pk_bf16_f32 %0, %1, %2" : "=v"(r) : "v"(lo), "v"(hi)); return r; }
typedef float f32x2 __attribute__((ext_vector_type(2)));
template <class Epi, class Sched, bool ALIGN_EPI = false, bool SP2 = false>
__device__ __forceinline__ void gemm_phase(PG8_LAS unsigned char* lds, const Gemm g, const Sched& S, const Epi& E, int tid_) {
    asm volatile("" : "+v"(tid_));
    const int tid = tid_, wid = __builtin_amdgcn_readfirstlane(tid >> 6), lane = tid & 63, wr = wid >> 2, wc = wid & 3, fr = lane & 15, fq = lane >> 4;
    const int K = g.K, nt = K / BK;
    unsigned voffA[2], voffB[2];
#pragma unroll
    for (int i = 0; i < 2; ++i) { int R, C; stage_rc(tid * 16 + i * 8192, R, C); const int Rb = Epi::PERM ? ((R & ~31) + perm32(R & 31)) : R;
        voffA[i] = (unsigned)(R * g.ld + C) * 2u; voffB[i] = (unsigned)(Rb * g.ld + C) * 2u; }
    const size_t kstep = (size_t)(BK * 2);
    const size_t hstep = (size_t)HALF * g.ld * 2;
    const size_t tstep = 2 * hstep;
    const unsigned ldsw = (unsigned)wid * 1024u;
    const int aoff = lds_byte(wr * 64 + fr, fq * 8), boff = lds_byte(wc * 32 + fr, fq * 8);
#define PG8_SA(b, h) (((b) * 2 + (h)) * HTB)
#define PG8_SB(b, h) ((4 + (b) * 2 + (h)) * HTB)
#define PG8_STAGE(bufoff, gbase, voff) do { _Pragma("unroll") for (int _i = 0; _i < 2; ++_i) \
        __builtin_amdgcn_global_load_lds((const unsigned*)((const char*)(gbase) + (voff)[_i]), (PG8_LAS unsigned*)(lds + (bufoff) + ldsw + _i * 8192), 16, 0, 0); } while (0)
#define PG8_LDA(dst, b, h) do { _Pragma("unroll") for (int m = 0; m < 4; ++m) _Pragma("unroll") for (int k = 0; k < 2; ++k) dst[m][k] = *(const PG8_LAS bf16x8*)(lds + PG8_SA(b, h) + aoff + m * 2048 + k * 1024); } while (0)
#define PG8_LDB(dst, b, h) do { _Pragma("unroll") for (int n = 0; n < 2; ++n) _Pragma("unroll") for (int k = 0; k < 2; ++k) dst[n][k] = *(const PG8_LAS bf16x8*)(lds + PG8_SB(b, h) + boff + n * 2048 + k * 1024); } while (0)
#define PG8_MMA(ai, bj, At, Bt) do { __builtin_amdgcn_s_setprio(1); _Pragma("unroll") for (int m = 0; m < 4; ++m) _Pragma("unroll") for (int n = 0; n < 2; ++n) _Pragma("unroll") for (int k = 0; k < 2; ++k) \
        acc[ai][bj][m][n] = __builtin_amdgcn_mfma_f32_16x16x32_bf16(Bt[n][k], At[m][k], acc[ai][bj][m][n], 0, 0, 0); __builtin_amdgcn_s_setprio(0); } while (0)
#define PG8_WAIT_V(n) asm volatile("s_waitcnt vmcnt(" #n ")" ::: "memory")
#define PG8_WAIT_L(n) asm volatile("s_waitcnt lgkmcnt(" #n ")" ::: "memory")
#define PG8_BAR __builtin_amdgcn_s_barrier()
#define PG8_SCHED __builtin_amdgcn_sched_barrier(0)
    Unit cur, nxt; int ui = 0;
    if (!S.next(0, cur)) return;
    f32x4 acc[2][2][4][2];
#pragma unroll
    for (int a = 0; a < 2; ++a)
#pragma unroll
        for (int b = 0; b < 2; ++b)
#pragma unroll
            for (int m = 0; m < 4; ++m)
#pragma unroll
                for (int n = 0; n < 2; ++n) acc[a][b][m][n] = (f32x4){0.f, 0.f, 0.f, 0.f};
    bf16x8 At[4][2], B0[2][2], B1[2][2];
    const char* cA = (const char*)g.A + (size_t)cur.pm * tstep; const char* cB = (const char*)g.Bt + (size_t)cur.pn * tstep;
    S.a_ready(cur);
    if constexpr (SP2) {
        PG8_STAGE(PG8_SB(0, 0), cB, voffB); PG8_STAGE(PG8_SB(0, 1), cB + hstep, voffB); PG8_STAGE(PG8_SA(0, 0), cA, voffA); PG8_STAGE(PG8_SA(0, 1), cA + hstep, voffA);
        if (wr == 1) PG8_BAR;
        PG8_WAIT_V(2); PG8_BAR;
        PG8_STAGE(PG8_SB(1, 0), cB + kstep, voffB); PG8_STAGE(PG8_SA(1, 0), cA + kstep, voffA); PG8_STAGE(PG8_SB(1, 1), cB + hstep + kstep, voffB);
        PG8_WAIT_V(6); PG8_BAR;
    } else {
        PG8_STAGE(PG8_SB(0, 0), cB, voffB); PG8_STAGE(PG8_SA(0, 0), cA, voffA); PG8_STAGE(PG8_SB(0, 1), cB + hstep, voffB); PG8_STAGE(PG8_SA(0, 1), cA + hstep, voffA);
        if (wr == 1) PG8_BAR;
        PG8_WAIT_V(4); PG8_BAR;
        PG8_STAGE(PG8_SB(1, 0), cB + kstep, voffB); PG8_STAGE(PG8_SA(1, 0), cA + kstep, voffA); PG8_STAGE(PG8_SB(1, 1), cB + hstep + kstep, voffB);
        PG8_WAIT_V(6); PG8_BAR;
    }
    for (;;) {
        const bool has_next = S.next(ui + 1, nxt);
        const char* nA = has_next ? (const char*)g.A + (size_t)nxt.pm * tstep : cA; const char* nB = has_next ? (const char*)g.Bt + (size_t)nxt.pn * tstep : cB;
        for (int t = 0; t < nt; t += 2) {
            const bool last = (t == nt - 2);
            const char* a1 = cA + (size_t)(t + 1) * kstep;
            const char* a2 = last ? nA : cA + (size_t)(t + 2) * kstep; const char* b2 = last ? nB : cB + (size_t)(t + 2) * kstep;
            const char* a3 = a2 + kstep; const char* b3 = b2 + kstep;
            if (last && has_next) S.a_ready(nxt);
            if constexpr (SP2) {
            PG8_LDB(B0, 0, 0); PG8_LDB(B1, 0, 1); PG8_SCHED; PG8_LDA(At, 0, 0); PG8_STAGE(PG8_SA(1, 1), a1 + hstep, voffA);
            PG8_WAIT_V(8); PG8_WAIT_L(0); PG8_BAR; PG8_MMA(0, 0, At, B0); PG8_MMA(0, 1, At, B1); PG8_BAR; PG8_SCHED;
            PG8_LDA(At, 0, 1); PG8_STAGE(PG8_SB(0, 0), b2, voffB); PG8_STAGE(PG8_SB(0, 1), b2 + hstep, voffB); PG8_STAGE(PG8_SA(0, 0), a2, voffA);
            PG8_WAIT_V(8); PG8_WAIT_L(0); PG8_BAR; PG8_MMA(1, 0, At, B0); PG8_MMA(1, 1, At, B1); PG8_BAR; PG8_SCHED;
            PG8_LDB(B0, 1, 0); PG8_LDB(B1, 1, 1); PG8_SCHED; PG8_LDA(At, 1, 0); PG8_STAGE(PG8_SA(0, 1), a2 + hstep, voffA);
            PG8_WAIT_V(8); PG8_WAIT_L(0); PG8_BAR; PG8_MMA(0, 0, At, B0); PG8_MMA(0, 1, At, B1); PG8_BAR; PG8_SCHED;
            PG8_LDA(At, 1, 1); PG8_STAGE(PG8_SB(1, 0), b3, voffB); PG8_STAGE(PG8_SB(1, 1), b3 + hstep, voffB); PG8_STAGE(PG8_SA(1, 0), a3, voffA);
            PG8_WAIT_V(8); PG8_WAIT_L(0); PG8_BAR; PG8_MMA(1, 0, At, B0); PG8_MMA(1, 1, At, B1); PG8_BAR; PG8_SCHED;
            } else {
            PG8_LDB(B0, 0, 0); PG8_SCHED; PG8_LDA(At, 0, 0); PG8_STAGE(PG8_SA(1, 1), a1 + hstep, voffA);
            PG8_WAIT_L(8); PG8_BAR; PG8_WAIT_L(0); PG8_MMA(0, 0, At, B0); PG8_BAR; PG8_SCHED;
            PG8_LDB(B1, 0, 1); PG8_STAGE(PG8_SB(0, 0), b2, voffB);
            PG8_BAR; PG8_WAIT_L(0); PG8_MMA(0, 1, At, B1); PG8_BAR;
            PG8_LDA(At, 0, 1); PG8_STAGE(PG8_SA(0, 0), a2, voffA);
            PG8_BAR; PG8_WAIT_L(0); PG8_MMA(1, 0, At, B0); PG8_BAR; PG8_SCHED;
            PG8_STAGE(PG8_SB(0, 1), b2 + hstep, voffB);
            PG8_WAIT_V(6); PG8_BAR; PG8_MMA(1, 1, At, B1); PG8_BAR;
            PG8_LDB(B0, 1, 0); PG8_SCHED; PG8_LDA(At, 1, 0); PG8_STAGE(PG8_SA(0, 1), a2 + hstep, voffA);
            PG8_WAIT_L(8); PG8_BAR; PG8_WAIT_L(0); PG8_MMA(0, 0, At, B0); PG8_BAR; PG8_SCHED;
            PG8_LDB(B1, 1, 1); PG8_STAGE(PG8_SB(1, 0), b3, voffB);
            PG8_BAR; PG8_WAIT_L(0); PG8_MMA(0, 1, At, B1); PG8_BAR;
            PG8_LDA(At, 1, 1); PG8_STAGE(PG8_SA(1, 0), a3, voffA);
            PG8_BAR; PG8_WAIT_L(0); PG8_MMA(1, 0, At, B0); PG8_BAR; PG8_SCHED;
            PG8_STAGE(PG8_SB(1, 1), b3 + hstep, voffB);
            PG8_WAIT_V(6); PG8_BAR; PG8_MMA(1, 1, At, B1); PG8_BAR;
            }
        }
        if constexpr (ALIGN_EPI) { if (wr == 0) PG8_BAR; }
        if constexpr (!Epi::AFTER_DRAIN) { E(acc, cur, wr, wc, fr, fq); S.done(cur); }
        if (!has_next) break;
#pragma unroll
        for (int a = 0; a < 2; ++a)
#pragma unroll
            for (int b = 0; b < 2; ++b)
#pragma unroll
                for (int m = 0; m < 4; ++m)
#pragma unroll
                    for (int n = 0; n < 2; ++n) acc[a][b][m][n] = (f32x4){0.f, 0.f, 0.f, 0.f};
        cur = nxt; cA = nA; cB = nB; ++ui;
        if constexpr (ALIGN_EPI) { if (wr == 1) PG8_BAR; }
    }
    PG8_WAIT_V(0);
    if constexpr (!ALIGN_EPI) { if (wr == 0) PG8_BAR; }
    PG8_BAR;
    if constexpr (Epi::AFTER_DRAIN) { E.fused(acc, cur, wr, wc, fr, fq, lds, wid, lane); S.done(cur); }
#undef PG8_SA
#undef PG8_SB
#undef PG8_STAGE
#undef PG8_LDA
#undef PG8_LDB
#undef PG8_MMA
#undef PG8_WAIT_V
#undef PG8_WAIT_L
#undef PG8_BAR
#undef PG8_SCHED
}
}
#define LAS __attribute__((address_space(3)))
typedef short bf16x8_t __attribute__((ext_vector_type(8)));
typedef float f32x4_t __attribute__((ext_vector_type(4)));
typedef float f32x2_t __attribute__((ext_vector_type(2)));
typedef __bf16 bf16x2_t __attribute__((ext_vector_type(2)));
typedef unsigned u32x4_t __attribute__((ext_vector_type(4)));
typedef unsigned u32x2_t __attribute__((ext_vector_type(2)));
#define DEV __device__ __forceinline__
DEV unsigned cvtpk(float lo, float hi) { f32x2_t v = {lo, hi}; bf16x2_t b = __builtin_convertvector(v, bf16x2_t); return __builtin_bit_cast(unsigned, b); }
DEV bf16x8_t pack8(const f32x4_t a, const f32x4_t b) { u32x4_t p = {cvtpk(a[0], a[1]), cvtpk(a[2], a[3]), cvtpk(b[0], b[1]), cvtpk(b[2], b[3])}; return __builtin_bit_cast(bf16x8_t, p); }
#define MFMA16(a, b, c) __builtin_amdgcn_mfma_f32_16x16x32_bf16((a), (b), (c), 0, 0, 0)
template <int CTRL> DEV float dppf(float x) { return __builtin_bit_cast(float, __builtin_amdgcn_mov_dpp(__builtin_bit_cast(int, x), CTRL, 0xF, 0xF, true)); }
template <int CTRL> DEV int dppi(int x) { return __builtin_amdgcn_mov_dpp(x, CTRL, 0xF, 0xF, true); }
constexpr int DPP_X1 = 0xB1, DPP_X2 = 0x4E, DPP_HM = 0x141, DPP_RM = 0x140;

constexpr int DNS_FB = 8192, DNS_US = 68, DNS_EG = 4 * DNS_FB + 64 * DNS_US * 4, DNS_BUF = DNS_EG + 16;
struct DnStage { u32x4_t fr[8]; f32x4_t ut[4]; float eg; };
DEV void dn_scan_load(CREF c, DnStage& st, int u, int pt) {
    const u32x4_t* f = (const u32x4_t*)(c.DNF + (size_t)u * 16384) + pt; const f32x4_t* uq = (const f32x4_t*)(c.DNU + (size_t)u * 4096) + pt;
#pragma unroll
    for (int k = 0; k < 8; ++k) st.fr[k] = f[256 * k];
#pragma unroll
    for (int k = 0; k < 4; ++k) st.ut[k] = uq[256 * k];
    st.eg = c.DNE[u];
}
DEV void dn_scan_store(const DnStage& st, LAS unsigned char* dst, int pt) {
#pragma unroll
    for (int k = 0; k < 8; ++k) *(LAS u32x4_t*)(dst + (pt + 256 * k) * 16) = st.fr[k];
#pragma unroll
    for (int k = 0; k < 4; ++k) { const int idx = pt + 256 * k, v = idx & 63, tq = idx >> 6; *(LAS f32x4_t*)(dst + 4 * DNS_FB + (v * DNS_US + 4 * tq) * 4) = st.ut[k]; }
    if (pt == 0) *(LAS float*)(dst + DNS_EG) = st.eg;
}
DEV void dn_scan_consume(CREF c, const LAS unsigned char* buf, f32x4_t (&S)[4], int r0, int h, int v, int lane, int kb) {
    const LAS unsigned char* fb = buf + lane * 16;
    const LAS float* ut = (const LAS float*)(buf + 4 * DNS_FB) + v * DNS_US + 4 * kb;
#define DNS_FR(mat, mt, ks) (*(const LAS bf16x8_t*)(fb + (mat) * DNS_FB + ((mt) * 2 + (ks)) * 1024))
    const float eg = *(const LAS float*)(buf + DNS_EG);
    const bf16x8_t Sb0 = pack8(S[0], S[1]), Sb1 = pack8(S[2], S[3]);
    f32x4_t ws[4], qs[4], ds[4], vn[4];
    const f32x4_t z4 = {0.f, 0.f, 0.f, 0.f};
#pragma unroll
    for (int mt = 0; mt < 4; ++mt) { ws[mt] = MFMA16(DNS_FR(0, mt, 0), Sb0, z4); ws[mt] = MFMA16(DNS_FR(0, mt, 1), Sb1, ws[mt]);
                                     qs[mt] = MFMA16(DNS_FR(1, mt, 0), Sb0, z4); qs[mt] = MFMA16(DNS_FR(1, mt, 1), Sb1, qs[mt]); }
#pragma unroll
    for (int mt = 0; mt < 4; ++mt) vn[mt] = *(const LAS f32x4_t*)(ut + 16 * mt) - ws[mt];
    const bf16x8_t Vb0 = pack8(vn[0], vn[1]), Vb1 = pack8(vn[2], vn[3]);
#pragma unroll
    for (int mt = 0; mt < 4; ++mt) { qs[mt] = MFMA16(DNS_FR(2, mt, 0), Vb0, qs[mt]); qs[mt] = MFMA16(DNS_FR(2, mt, 1), Vb1, qs[mt]);
                                     ds[mt] = MFMA16(DNS_FR(3, mt, 0), Vb0, z4); ds[mt] = MFMA16(DNS_FR(3, mt, 1), Vb1, ds[mt]); }
#pragma unroll
    for (int mt = 0; mt < 4; ++mt) { S[mt] = S[mt] * eg + ds[mt];
#pragma unroll
        for (int i = 0; i < 4; ++i) c.ODN[((size_t)(r0 + 16 * mt + 4 * kb + i) * DNH + h) * 64 + v] = qs[mt][i]; }
#undef DNS_FR
}
DEV void dn_scan_mfma(CREF c, int l, LAS unsigned char* L, int bh, int tid) {
    asm volatile("" : "+v"(tid));
    const int b = bh / DNH, h = bh % DNH, wid = tid >> 6, lane = tid & 63, n = lane & 15, kb = lane >> 4;
    const bool producer = wid >= 4;
    const int v = 16 * (wid & 3) + n;
    f32x4_t S[4];
#pragma unroll
    for (int mt = 0; mt < 4; ++mt) S[mt] = (f32x4_t){0.f, 0.f, 0.f, 0.f};
    const int u0 = (b * DNH + h) * NCH, rb = b * SEQ, pt = tid - 256;
    if (producer) {
        DnStage s0, s1, s2, s3;
        dn_scan_load(c, s0, u0, pt); dn_scan_store(s0, L, pt);
        dn_scan_load(c, s0, u0 + 1, pt); dn_scan_load(c, s1, u0 + 2, pt); dn_scan_load(c, s2, u0 + 3, pt); dn_scan_load(c, s3, u0 + 4, pt);
#define DNS_STEP(st, ch_) { __syncthreads(); if ((ch_) + 1 < NCH) { dn_scan_store(st, L + (((ch_) + 1) & 1) * DNS_BUF, pt); if ((ch_) + 5 < NCH) dn_scan_load(c, st, u0 + (ch_) + 5, pt); } }
        for (int ch = 0; ch < NCH; ch += 4) { DNS_STEP(s0, ch) DNS_STEP(s1, ch + 1) DNS_STEP(s2, ch + 2) DNS_STEP(s3, ch + 3) }
#undef DNS_STEP
    } else {
        for (int ch = 0; ch < NCH; ch += 2) {
            __syncthreads();
            dn_scan_consume(c, L, S, rb + ch * 64, h, v, lane, kb);
            __syncthreads();
            dn_scan_consume(c, L + DNS_BUF, S, rb + (ch + 1) * 64, h, v, lane, kb);
        }
    }
    if (!producer) {
#pragma unroll
        for (int mt = 0; mt < 4; ++mt)
#pragma unroll
            for (int i = 0; i < 4; ++i) c.out[O_DNP + (((size_t)l * BATCH + b) * DNH + h) * 4096 + (16 * mt + 4 * kb + i) * 64 + v] = S[mt][i];
    }
    __syncthreads();
}

DEV float wave_sum(float v) {
    v += dppf<DPP_X1>(v); v += dppf<DPP_X2>(v); v += dppf<DPP_HM>(v); v += dppf<DPP_RM>(v); v += __shfl_xor(v, 16); v += __shfl_xor(v, 32);
    return v;
}
DEV void transpose_item(const float* W, int K, int N, bf16_t* WT, LAS float* scr, int item, int lane) {
    const int nblk = N / 32, kb = item / nblk, nb = item % nblk, k0 = 64 * kb, n0 = 32 * nb;
#pragma unroll
    for (int i = 0; i < 32; ++i) { const int kk = 2 * i + (lane >> 5); scr[kk * 33 + (lane & 31)] = W[(size_t)(k0 + kk) * N + n0 + (lane & 31)]; }
    asm volatile("s_waitcnt lgkmcnt(0)" ::: "memory");
    const int cch = lane & 7;
#pragma unroll
    for (int j = 0; j < 4; ++j) { const int n = (lane >> 3) + 8 * j; const LAS float* s = scr + (8 * cch) * 33 + n;
        u32x4_t o; o.x = cvtpk(s[0 * 33], s[1 * 33]); o.y = cvtpk(s[2 * 33], s[3 * 33]); o.z = cvtpk(s[4 * 33], s[5 * 33]); o.w = cvtpk(s[6 * 33], s[7 * 33]);
        *(u32x4_t*)(WT + (size_t)(n0 + n) * K + k0 + 8 * cch) = o; }
    asm volatile("s_waitcnt lgkmcnt(0)" ::: "memory");
}
DEV void dev_s5_consts(CREF c, long gtid, long gn) {
    for (long t = gtid; t < (long)2 * S5G * S5P * S5C; t += gn) { const long i = t >> 4; const int ch = (int)(t & 15); const int l = (int)(i / (S5G * S5P)), g = (int)((i / S5P) % S5G), p = (int)(i % S5P); const size_t lg = (size_t)(i / S5P);
        const float lr = c.lam_re[i], li = c.lam_im[i], dt = expf(c.log_step[l * S5G + g]);
        const float zr = lr * dt, zi = li * dt, mag = expf(zr), cz = cosf(zi), sz = sinf(zi), sh = sinf(0.5f * zi);
        const float ar = mag * cz, ai = mag * sz, am1 = expm1f(zr) * cz - 2.0f * sh * sh, den = lr * lr + li * li;
        const float fr = (am1 * lr + ai * li) / den, fi = (ai * lr - am1 * li) / den;
        if (ch == 0) { float pr = ar, pi = ai;
#pragma unroll
            for (int s = 0; s < 6; ++s) { const float nr = pr * pr - pi * pi, ni = 2.0f * pr * pi; pr = nr; pi = ni; }
            c.S5K[i * 4 + 0] = ar; c.S5K[i * 4 + 1] = ai; c.S5K[i * 4 + 2] = pr; c.S5K[i * 4 + 3] = pi; }
        const float br = c.b_re[i * S5C + ch], bi = c.b_im[i * S5C + ch]; const float bbr = fr * br - fi * bi, bbi = fr * bi + fi * br;
        c.S5BB[(i * S5C + ch) * 2 + 0] = bbr; c.S5BB[(i * S5C + ch) * 2 + 1] = bbi;
#pragma unroll
        for (int comp = 0; comp < 2; ++comp) { const int s = 2 * p + comp, j = s >> 4, n = s & 15;
            c.S5BF[((lg * 8 + j) * 64 + n + 16 * (ch >> 3)) * 8 + (ch & 7)] = tobf(comp == 0 ? bbr : bbi);
            if (ch < 8) { c.S5BF[((lg * 8 + j) * 64 + n + 32) * 8 + ch] = 0; c.S5BF[((lg * 8 + j) * 64 + n + 48) * 8 + ch] = 0; }
            const int k = s, ks = k >> 5, kg = (k & 31) >> 3, jj = k & 7; const size_t ci = ((lg * S5C + ch) * S5P + p);
            c.S5CF[((lg * 4 + ks) * 64 + ch + 16 * kg) * 8 + jj] = tobf(comp == 0 ? c.c_re[ci] : -c.c_im[ci]); } }
}
DEV void dev_prologue(CREF c, LAS unsigned char* L, int bx, int tid, long gtid, long gn) {
    const int wave = tid >> 6, lane = tid & 63, gw = bx * 8 + wave, NGW = (int)gridDim.x * 8;
    LAS float* scr = (LAS float*)(L + wave * 16384);
    constexpr int I_IN = (DM / 64) * (INW / 32), I_OUT = (DM / 64) * (DM / 32), I_UP = (DM / 64) * (DFF / 32), I_DN = (DFF / 64) * (DM / 32), I_GL = (256 / 64) * (256 / 32), I_L = I_IN + I_OUT + I_UP + I_DN + I_GL;
    for (int it = gw; it < 2 * I_L; it += NGW) { const int l = it / I_L; int r = it % I_L;
        if (r < I_IN) { transpose_item(c.w_in + (size_t)l * DM * INW, DM, INW, c.WIN_T + (size_t)l * PLD * DM, scr, r, lane); continue; } r -= I_IN;
        if (r < I_OUT) { transpose_item(c.w_out + (size_t)l * DM * DM, DM, DM, c.WOUT_T + (size_t)l * DM * DM, scr, r, lane); continue; } r -= I_OUT;
        if (r < I_UP) { transpose_item(c.mlp_up + (size_t)l * DM * DFF, DM, DFF, c.WUP_T + (size_t)l * DFF * DM, scr, r, lane); continue; } r -= I_UP;
        if (r < I_DN) { transpose_item(c.mlp_down + (size_t)l * DFF * DM, DFF, DM, c.WDN_T + (size_t)l * DM * DFF, scr, r, lane); continue; } r -= I_DN;
        transpose_item(c.w_glu + (size_t)l * 65536, 256, 256, c.WGLU_T + (size_t)l * 65536, scr, r, lane); }
    for (long i = gtid; i < (long)2 * (PLD - INW) * DM / 8; i += gn) { const int l = (int)(i / ((PLD - INW) * DM / 8)); const long r = i % ((PLD - INW) * DM / 8);
        *(u32x4_t*)(c.WIN_T + ((size_t)l * PLD + INW) * DM + r * 8) = (u32x4_t){0u, 0u, 0u, 0u}; }
    { f32x4_t g[4];
#pragma unroll
      for (int j = 0; j < 4; ++j) g[j] = ((const f32x4_t*)c.ln1)[lane + 64 * j];
      for (int r = gw; r < TT; r += NGW) { const f32x4_t* xr = (const f32x4_t*)(r < TP ? c.x_prompt + (size_t)r * DM : c.x_sample + (size_t)(r - TP) * DM) + lane; f32x4_t v[4]; float s = 0.f;
#pragma unroll
        for (int j = 0; j < 4; ++j) { v[j] = xr[64 * j]; s += (v[j][0] * v[j][0] + v[j][1] * v[j][1]) + (v[j][2] * v[j][2] + v[j][3] * v[j][3]); ((f32x4_t*)(c.X + (size_t)r * DM))[lane + 64 * j] = v[j]; }
        const float rs = 1.0f / sqrtf(wave_sum(s) * (1.0f / DM) + NEPS);
#pragma unroll
        for (int j = 0; j < 4; ++j) { const f32x4_t o = v[j] * rs * g[j]; u32x2_t w = {cvtpk(o[0], o[1]), cvtpk(o[2], o[3])}; ((u32x2_t*)(c.XN + (size_t)r * DM))[lane + 64 * j] = w; } } }
}
template <bool FINAL> DEV void dev_rmsnorm(CREF c, const float* gain, int bx, int tid, int nsplit) {
    const int wave = tid >> 6, lane = tid & 63, gw = bx * 8 + wave, NGW = (int)gridDim.x * 8;
    f32x4_t g[4];
#pragma unroll
    for (int j = 0; j < 4; ++j) g[j] = ((const f32x4_t*)gain)[lane + 64 * j];
    for (int r = gw; r < TT; r += NGW) { f32x4_t* xr = (f32x4_t*)(c.X + (size_t)r * DM) + lane; f32x4_t v[4]; float s = 0.f;
#pragma unroll
        for (int j = 0; j < 4; ++j) v[j] = xr[64 * j];
        if (r >= TP) {
            for (int ks = 0; ks < nsplit; ++ks) { const f32x4_t* pr = (const f32x4_t*)(c.PART + ((size_t)ks * TS + (r - TP)) * DM) + lane;
#pragma unroll
                for (int j = 0; j < 4; ++j) v[j] += pr[64 * j]; }
            if (!FINAL) {
#pragma unroll
                for (int j = 0; j < 4; ++j) xr[64 * j] = v[j]; } }
#pragma unroll
        for (int j = 0; j < 4; ++j) s += (v[j][0] * v[j][0] + v[j][1] * v[j][1]) + (v[j][2] * v[j][2] + v[j][3] * v[j][3]);
        const float rs = 1.0f / sqrtf(wave_sum(s) * (1.0f / DM) + NEPS);
#pragma unroll
        for (int j = 0; j < 4; ++j) { const f32x4_t o = v[j] * rs * g[j];
            if (FINAL) ((f32x4_t*)(c.out + O_YP + (size_t)r * DM))[lane + 64 * j] = o;
            else { u32x2_t w = {cvtpk(o[0], o[1]), cvtpk(o[2], o[3])}; ((u32x2_t*)(c.XN + (size_t)r * DM))[lane + 64 * j] = w; } } }
}
DEV void dev_copy_out(CREF c, int l, long gtid, long gn) {
    for (long i = gtid; i < (long)TT * 128; i += gn) { const int r = (int)(i >> 7), k = (int)(i & 127); const f32x4_t v = *(const f32x4_t*)(c.PROJ + (size_t)r * PLD + C_KV + 4 * k);
        float* dst = r < TP ? c.out + O_KVP + ((size_t)l * TP + r) * 512 : c.out + O_KVS + ((size_t)l * TS + (r - TP)) * 512; *(f32x4_t*)(dst + 4 * k) = v; }
    for (long i = gtid; i < (long)BATCH * 512 * 64; i += gn) { const int b = (int)(i / (512 * 64)), w = (int)((i >> 6) & 511), k = (int)(i & 63);
        ((f32x4_t*)(c.out + O_WINP + (size_t)l * BATCH * 512 * 256))[i] = *(const f32x4_t*)(c.PROJ + (size_t)(b * SEQ + SEQ - 512 + w) * PLD + C_KV + 512 + 4 * k); }
    for (long i = gtid; i < (long)DB * 512 * 64; i += gn) { const int b = (int)(i / (512 * 64)), w = (int)((i >> 6) & 511), k = (int)(i & 63);
        ((f32x4_t*)(c.out + O_WINS + (size_t)l * DB * 512 * 256))[i] = (w < 512 - DSEQ) ? *(const f32x4_t*)(c.cache_win + (((size_t)l * DB + b) * 512 + w + DSEQ) * 256 + 4 * k)
                                                                                       : *(const f32x4_t*)(c.PROJ + (size_t)(TP + b * DSEQ + (w - (512 - DSEQ))) * PLD + C_KV + 512 + 4 * k); }
    for (long i = gtid; i < (long)BATCH * 3 * CONVD / 4; i += gn) { const int b = (int)(i / (3 * CONVD / 4)), w = (int)((i / (CONVD / 4)) % 3), k = (int)(i % (CONVD / 4));
        ((f32x4_t*)(c.out + O_CONVP + (size_t)l * BATCH * 3 * CONVD))[i] = *(const f32x4_t*)(c.PROJ + (size_t)(b * SEQ + SEQ - 3 + w) * PLD + C_DNQKV + 4 * k); }
    for (long i = gtid; i < (long)DB * 3 * CONVD / 4; i += gn) { const int b = (int)(i / (3 * CONVD / 4)), w = (int)((i / (CONVD / 4)) % 3), k = (int)(i % (CONVD / 4));
        ((f32x4_t*)(c.out + O_CONVS + (size_t)l * DB * 3 * CONVD))[i] = *(const f32x4_t*)(c.PROJ + (size_t)(TP + b * DSEQ + DSEQ - 3 + w) * PLD + C_DNQKV + 4 * k); }
}

constexpr int DP_YS = 65;
constexpr int DP_Y = 0, DP_AM = DP_Y + 3 * 64 * DP_YS * 4, DP_R = DP_AM + 64 * 64 * 4, DP_AQ = DP_R + 64 * 128 * 4, DP_SM = DP_AQ + 64 * 64 * 4, DP_END = DP_SM + 6 * 64 * 4;
static_assert(DP_END <= 131072, "DeltaNet prep LDS");
DEV void dn_prep_unit(CREF c, int l, LAS unsigned char* L, int u, int tid) {
    asm volatile("" : "+v"(tid));
    const int ch = u % NCH, h = (u / NCH) % DNH, b = u / (NCH * DNH), r0 = b * SEQ + ch * 64, lane = tid & 63, wid = tid >> 6;
    LAS float* Y = (LAS float*)(L + DP_Y); LAS float* AMs = (LAS float*)(L + DP_AM); LAS float* R = (LAS float*)(L + DP_R);
    LAS float* sm = (LAS float*)(L + DP_SM);
    LAS float* AQs = (LAS float*)(L + DP_AQ);
    if (tid < 384) { const int ci = tid % 192, tg = tid / 192, part = ci >> 6, d = ci & 63, cch = part * DNW + h * 64 + d;
        const f32x4_t w = *(const f32x4_t*)(c.conv_w + ((size_t)l * CONVD + cch) * 4); float x[35];
        const int tt0 = ch * 64 + 32 * tg - 3; const float* px = c.PROJ + (size_t)(b * SEQ) * PLD + C_DNQKV + cch;
#pragma unroll
        for (int k = 0; k < 35; ++k) { const int tt = tt0 + k; const float v = px[(size_t)(tt < 0 ? 0 : tt) * PLD]; x[k] = tt < 0 ? 0.f : v; }
#pragma unroll
        for (int t = 0; t < 32; ++t) { const float y = (w[0] * x[t] + w[1] * x[t + 1]) + (w[2] * x[t + 2] + w[3] * x[t + 3]); Y[(part * 64 + 32 * tg + t) * DP_YS + d] = y * __builtin_amdgcn_rcpf(1.0f + __expf(-y)); } }
    else if (tid >= 448) { const int t = tid - 448, r = r0 + t; sm[128 + t] = sigmoidf_(c.PROJ[(size_t)r * PLD + C_DNB + h]);
        sm[192 + t] = -expf(c.a_log[l * DNH + h]) * softplusf_(c.PROJ[(size_t)r * PLD + C_DNA + h] + c.dt_bias[l * DNH + h]); }
    __syncthreads();
    {   const int rr = tid >> 2, q4 = tid & 3; const LAS float* yr = Y + rr * DP_YS + 16 * q4; float ss = 0.f;
#pragma unroll
        for (int k = 0; k < 16; ++k) ss += yr[k] * yr[k];
        ss += dppf<DPP_X1>(ss); ss += dppf<DPP_X2>(ss);
        if (q4 == 0) sm[rr] = (rr < 64 ? 0.125f : 1.0f) / sqrtf(ss + 1e-6f); }
    if (wid == 7) { float s = sm[192 + lane];
#pragma unroll
        for (int o = 1; o < 64; o <<= 1) { const float t = __shfl_up(s, o); if (lane >= o) s += t; }
        sm[256 + lane] = s; const float gl = __shfl(s, 63); sm[320 + lane] = expf(gl - s); }
    __syncthreads();
    for (int idx = tid; idx < 128 * 64; idx += 512) { const int rr = idx >> 6, d = idx & 63; Y[rr * DP_YS + d] *= sm[rr]; }
    __syncthreads();
    {   const int mt = tid >> 7, ks = (tid >> 6) & 1, m16 = tid & 15, kb = (tid >> 4) & 3, row = 16 * mt + m16, k0 = 32 * ks + 4 * kb, k1 = k0 + 16;
        bf16_t* fo = c.DNF + (size_t)u * 16384 + tid * 8;
        { const float e = expf(sm[256 + row]); const LAS float* q = Y + row * DP_YS; const f32x4_t a = {q[k0] * e, q[k0 + 1] * e, q[k0 + 2] * e, q[k0 + 3] * e}, bq = {q[k1] * e, q[k1 + 1] * e, q[k1 + 2] * e, q[k1 + 3] * e};
          *(bf16x8_t*)(fo + 4096) = pack8(a, bq); }
        { const LAS float* kT = Y + 64 * DP_YS + row; f32x4_t a, bq;
#pragma unroll
          for (int i = 0; i < 4; ++i) { a[i] = kT[(k0 + i) * DP_YS] * sm[320 + k0 + i]; bq[i] = kT[(k1 + i) * DP_YS] * sm[320 + k1 + i]; }
          *(bf16x8_t*)(fo + 12288) = pack8(a, bq); }
    }
    for (int idx = tid; idx < 64 * 64; idx += 512) { const int t = idx >> 6, d = idx & 63; const float q = Y[t * DP_YS + d], k = Y[(64 + t) * DP_YS + d], vv = Y[(128 + t) * DP_YS + d], be = sm[128 + t];
        (void)q; R[t * 128 + d] = vv * be; R[t * 128 + 64 + d] = k * be * expf(sm[256 + t]); }

    {   const int i = tid >> 3, j0 = (tid & 7) * 8; float kk[8], qk[8];
#pragma unroll
        for (int jj = 0; jj < 8; ++jj) { kk[jj] = 0.f; qk[jj] = 0.f; }
        if (j0 <= i) for (int d = 0; d < 64; ++d) { const float ki = Y[(64 + i) * DP_YS + d], qi = Y[i * DP_YS + d];
#pragma unroll
            for (int jj = 0; jj < 8; ++jj) { const float kj = Y[(64 + j0 + jj) * DP_YS + d]; kk[jj] += ki * kj; qk[jj] += qi * kj; } }
        const float gi = sm[256 + i], bi = sm[128 + i];
#pragma unroll
        for (int jj = 0; jj < 8; ++jj) { const int j = j0 + jj; const float dec = j <= i ? expf(gi - sm[256 + j]) : 0.f;
            AMs[i * 64 + j] = j < i ? bi * kk[jj] * dec : 0.f; AQs[i * 64 + j] = j <= i ? qk[jj] * dec : 0.f; } }
    __syncthreads();
    {   const int col = tid >> 2, q = tid & 3; float xq[16];
#pragma unroll
        for (int jj = 0; jj < 16; ++jj) xq[jj] = 0.f;
#pragma unroll
        for (int i = 0; i < 64; ++i) { float s = 0.f;
#pragma unroll
            for (int jj = 0; jj < (i + 3) / 4; ++jj) s -= AMs[i * 64 + 4 * jj + q] * xq[jj];
            s += dppf<DPP_X1>(s); s += dppf<DPP_X2>(s); s += R[i * 128 + col];
            xq[i >> 2] = ((i & 3) == q) ? s : xq[i >> 2];
            if (q == 0) R[i * 128 + col] = s; } }
    __syncthreads();
    if (wid == 6) {
#pragma unroll
        for (int s8 = 0; s8 < 8; ++s8) { const int slot = lane + 64 * s8, mt = slot >> 7, ks = (slot >> 6) & 1, m16 = slot & 15, kb = (slot >> 4) & 3, row = 16 * mt + m16, k0 = 32 * ks + 4 * kb, k1 = k0 + 16;
            const f32x4_t a = *(const LAS f32x4_t*)(R + row * 128 + 64 + k0), bq = *(const LAS f32x4_t*)(R + row * 128 + 64 + k1); *(bf16x8_t*)(c.DNF + (size_t)u * 16384 + slot * 8) = pack8(a, bq);
            const f32x4_t a2 = *(const LAS f32x4_t*)(AQs + row * 64 + k0), b2 = *(const LAS f32x4_t*)(AQs + row * 64 + k1); *(bf16x8_t*)(c.DNF + (size_t)u * 16384 + 8192 + slot * 8) = pack8(a2, b2); }
#pragma unroll
        for (int s = 0; s < 16; ++s) { const int idx = lane + 64 * s, v = idx & 63, tq = idx >> 6; const f32x4_t uv = {R[(4 * tq) * 128 + v], R[(4 * tq + 1) * 128 + v], R[(4 * tq + 2) * 128 + v], R[(4 * tq + 3) * 128 + v]};
            *(f32x4_t*)(c.DNU + (size_t)u * 4096 + idx * 4) = uv; }
        if (lane == 0) c.DNE[u] = expf(sm[256 + 63]); }
}
DEV void dev_dn_out(CREF c, int l, int bx, int tid) {
    const int wave = tid >> 6, lane = tid & 63, gw = bx * 8 + wave, NGW = (int)gridDim.x * 8; const float nw = c.dn_norm_w[l * 64 + lane];
    for (int i0 = gw * 8; i0 < TP * DNH; i0 += NGW * 8) { float o[8], z[8];
#pragma unroll
        for (int k = 0; k < 8; ++k) { const int i = i0 + k, r = i / DNH, h = i % DNH; o[k] = c.ODN[(size_t)i * 64 + lane]; z[k] = c.PROJ[(size_t)r * PLD + C_DNZ + h * 64 + lane]; }
#pragma unroll
        for (int k = 0; k < 8; ++k) { const int i = i0 + k, r = i / DNH, h = i % DNH; const float ss = wave_sum(o[k] * o[k]);
            c.MIXB[(size_t)r * DM + 512 + h * 64 + lane] = tobf(o[k] * __builtin_amdgcn_rsqf(ss * (1.0f / 64.0f) + NEPS) * nw * (z[k] * __builtin_amdgcn_rcpf(1.0f + __expf(-z[k])))); } }
}

typedef float f32x16_t __attribute__((ext_vector_type(16)));
#define MFMA32(a, b, c) __builtin_amdgcn_mfma_f32_32x32x16_bf16((a), (b), (c), 0, 0, 0)
constexpr int NA_RS = 144;
constexpr int NA_T = 64 * NA_RS, NA_BUF = 2 * NA_T;
constexpr int NA_IMP = 2 * NA_BUF, NA_SELM = NA_IMP + 64 * 128 * 4, NA_UNI = NA_SELM + 64 * 16, NA_NIT = NA_UNI + 16, NA_ITEMS = NA_NIT + 16, NA_PT = NA_ITEMS + 160 * 4, NA_END = NA_PT + 64;
static_assert(NA_END <= 131072, "NSA LDS");
constexpr float LOG2E = 1.4426950408889634f;
DEV int crow32(int reg, int hh) { return (reg & 3) + 8 * (reg >> 2) + 4 * hh; }
struct NaStage { f32x4_t k0, k1, v0, v1; };
template <bool SMP> DEV void na_load(CREF c, NaStage& st, int l, int mode, int b, int g, int n, int tid, const LAS int* pt = nullptr) {
    const int key = tid >> 3, d0 = (tid & 7) * 8; const float* kp; bool zero = false;
    if (mode == 0) { kp = c.KC + (((size_t)((SMP ? BATCH : 0) + b) * NBMAX + 64 * n + key) * 2 + g) * 64 + d0;
        const float* vp = c.VC + (kp - c.KC); const bool zp = SMP && key >= NBC_S; const f32x4_t z0 = {0.f, 0.f, 0.f, 0.f};
        st.k0 = zp ? z0 : *(const f32x4_t*)kp; st.k1 = zp ? z0 : *(const f32x4_t*)(kp + 4); st.v0 = zp ? z0 : *(const f32x4_t*)vp; st.v1 = zp ? z0 : *(const f32x4_t*)(vp + 4); return; }
    const int slot = mode == 1 ? 2 : 4;
    if (!SMP) kp = c.PROJ + (size_t)(b * SEQ + 64 * n + key) * PLD + C_KV + slot * 128 + g * 64 + d0;
    else { const int pos = 64 * n + key;
        if (pos >= PAST) { const int j = pos - PAST; zero = j >= DSEQ; kp = c.PROJ + (size_t)(TP + b * DSEQ + (zero ? 0 : j)) * PLD + C_KV + slot * 128 + g * 64 + d0; }
        else if (mode == 1) { const int pg = pt[pos / PAGE]; kp = c.cache_nsa + ((((size_t)l * NPHYS + pg) * PAGE + (pos % PAGE)) * 4 + slot) * 128 + g * 64 + d0; }
        else kp = c.cache_win + ((((size_t)l * DB + b) * WIN + (pos - W0S)) * 2 + (slot - 4)) * 128 + g * 64 + d0; }
    const f32x4_t z = {0.f, 0.f, 0.f, 0.f};
    st.k0 = zero ? z : *(const f32x4_t*)kp; st.k1 = zero ? z : *(const f32x4_t*)(kp + 4); st.v0 = zero ? z : *(const f32x4_t*)(kp + 128); st.v1 = zero ? z : *(const f32x4_t*)(kp + 132);
}
DEV void na_store(const NaStage& st, LAS unsigned char* buf, int tid) {
    const int key = tid >> 3, d0 = (tid & 7) * 8;
    *(LAS bf16x8_t*)(buf + key * NA_RS + d0 * 2) = pack8(st.k0, st.k1);
    LAS unsigned short* vt = (LAS unsigned short*)(buf + NA_T);
    const unsigned a = cvtpk(st.v0[0], st.v0[1]), bb = cvtpk(st.v0[2], st.v0[3]), cc = cvtpk(st.v1[0], st.v1[1]), dd = cvtpk(st.v1[2], st.v1[3]);
    vt[(d0 + 0) * (NA_RS / 2) + key] = (unsigned short)a; vt[(d0 + 1) * (NA_RS / 2) + key] = (unsigned short)(a >> 16);
    vt[(d0 + 2) * (NA_RS / 2) + key] = (unsigned short)bb; vt[(d0 + 3) * (NA_RS / 2) + key] = (unsigned short)(bb >> 16);
    vt[(d0 + 4) * (NA_RS / 2) + key] = (unsigned short)cc; vt[(d0 + 5) * (NA_RS / 2) + key] = (unsigned short)(cc >> 16);
    vt[(d0 + 6) * (NA_RS / 2) + key] = (unsigned short)dd; vt[(d0 + 7) * (NA_RS / 2) + key] = (unsigned short)(dd >> 16);
}
DEV void na_scores(const LAS unsigned char* kb, const bf16x8_t (&qf)[4], int lane, f32x16_t& s0, f32x16_t& s1) {
    const int n = lane & 31, hh = lane >> 5;
#pragma unroll
    for (int i = 0; i < 16; ++i) { s0[i] = 0.f; s1[i] = 0.f; }
#pragma unroll
    for (int ks = 0; ks < 4; ++ks) { const bf16x8_t a0 = *(const LAS bf16x8_t*)(kb + n * NA_RS + (16 * ks + 8 * hh) * 2), a1 = *(const LAS bf16x8_t*)(kb + (32 + n) * NA_RS + (16 * ks + 8 * hh) * 2);
        s0 = MFMA32(a0, qf[ks], s0); s1 = MFMA32(a1, qf[ks], s1); }
}
DEV void na_pv(const LAS unsigned char* vb, const f32x16_t& p0, const f32x16_t& p1, int lane, f32x16_t& o0, f32x16_t& o1) {
    const int n = lane & 31, hh = lane >> 5;
#pragma unroll
    for (int s = 0; s < 4; ++s) { const f32x16_t& p = (s < 2) ? p0 : p1; const int e = 8 * (s & 1);
        const bf16x8_t pf = pack8((f32x4_t){p[e], p[e + 1], p[e + 2], p[e + 3]}, (f32x4_t){p[e + 4], p[e + 5], p[e + 6], p[e + 7]});
#pragma unroll
        for (int mt = 0; mt < 2; ++mt) { const LAS unsigned char* vp = vb + (32 * mt + n) * NA_RS + (16 * s + 4 * hh) * 2;
            const u32x2_t lo = *(const LAS u32x2_t*)vp, hi = *(const LAS u32x2_t*)(vp + 16); const u32x4_t w = {lo[0], lo[1], hi[0], hi[1]};
            if (mt == 0) o0 = MFMA32(__builtin_bit_cast(bf16x8_t, w), pf, o0); else o1 = MFMA32(__builtin_bit_cast(bf16x8_t, w), pf, o1); } }
}
template <bool SMP> DEV void nsa_unit(CREF c, int l, LAS unsigned char* L, int b, int qb, int g, int tid) {
    asm volatile("" : "+v"(tid));
    const int lane = tid & 63, wid = tid >> 6, n = lane & 31, hh = lane >> 5, tl = 8 * wid + (n >> 2), r = n & 3, h = 4 * g + r, t = 64 * qb + tl;
    const bool act = !SMP || wid == 0;
    const size_t row = SMP ? (size_t)(TP + b * DSEQ + (tl & 7)) : (size_t)(b * SEQ + t);
    LAS float* IMP = (LAS float*)(L + NA_IMP); LAS unsigned* SELM = (LAS unsigned*)(L + NA_SELM); LAS unsigned* UNI = (LAS unsigned*)(L + NA_UNI);
    LAS int* NIT = (LAS int*)(L + NA_NIT); LAS int* ITEMS = (LAS int*)(L + NA_ITEMS);
    const float slope2 = exp2f(-(float)(h + 1)) * LOG2E;
    bf16x8_t qf[4];
#pragma unroll
    for (int ks = 0; ks < 4; ++ks) { const float* qp = c.PROJ + row * PLD + C_Q + h * 64 + 16 * ks + 8 * hh; const f32x4_t a = *(const f32x4_t*)qp * (0.125f * LOG2E), bq = *(const f32x4_t*)(qp + 4) * (0.125f * LOG2E); qf[ks] = pack8(a, bq); }
    const float* gp = c.PROJ + row * PLD + C_GATE + h * 3; const float g0 = sigmoidf_(gp[0]), g1 = sigmoidf_(gp[1]), g2 = sigmoidf_(gp[2]);
    f32x16_t ot0, ot1, oa0, oa1;
    if (tid < 4) UNI[tid] = 0u;
    LAS int* PT = (LAS int*)(L + NA_PT);
    if (SMP && tid >= 64 && tid < 64 + NPAGES) PT[tid - 64] = c.page_table[b * NPAGES + (tid - 64)];
    const int nbc = (!SMP && qb >= 64) ? 2 : 1;
    { NaStage st; na_load<SMP>(c, st, l, 0, b, g, 0, tid); na_store(st, L, tid); if (nbc == 2) { na_load<SMP>(c, st, l, 0, b, g, 1, tid); na_store(st, L + NA_BUF, tid); } }
    __syncthreads();
    if (act) {
        f32x16_t sa0, sa1, sb0, sb1;
        na_scores(L, qf, lane, sa0, sa1);
        if (nbc == 2) na_scores(L + NA_BUF, qf, lane, sb0, sb1);
        else {
#pragma unroll
            for (int i = 0; i < 16; ++i) { sb0[i] = 0.f; sb1[i] = 0.f; } }
        float m = -1e30f;
#pragma unroll
        for (int i = 0; i < 16; ++i) { const int k0 = crow32(i, hh);
            { const int np = k0;       const bool ok = 64 * np + 63 <= t;              sa0[i] = ok ? sa0[i] - slope2 * ((float)(t - 64 * np) - 31.5f) : -1e30f; m = fmaxf(m, sa0[i]); }
            { const int np = 32 + k0;  const bool ok = 64 * np + 63 <= t;              sa1[i] = ok ? sa1[i] - slope2 * ((float)(t - 64 * np) - 31.5f) : -1e30f; m = fmaxf(m, sa1[i]); }
            { const int np = 64 + k0;  const bool ok = nbc == 2 && 64 * np + 63 <= t;  sb0[i] = ok ? sb0[i] - slope2 * ((float)(t - 64 * np) - 31.5f) : -1e30f; m = fmaxf(m, sb0[i]); }
            { const int np = 96 + k0;  const bool ok = nbc == 2 && 64 * np + 63 <= t;  sb1[i] = ok ? sb1[i] - slope2 * ((float)(t - 64 * np) - 31.5f) : -1e30f; m = fmaxf(m, sb1[i]); } }
        m = fmaxf(m, __shfl_xor(m, 32));
        float ls = 0.f;
#pragma unroll
        for (int i = 0; i < 16; ++i) { sa0[i] = sa0[i] > -1e29f ? exp2f(sa0[i] - m) : 0.f; sa1[i] = sa1[i] > -1e29f ? exp2f(sa1[i] - m) : 0.f;
                                       sb0[i] = sb0[i] > -1e29f ? exp2f(sb0[i] - m) : 0.f; sb1[i] = sb1[i] > -1e29f ? exp2f(sb1[i] - m) : 0.f; ls += (sa0[i] + sa1[i]) + (sb0[i] + sb1[i]); }
        ls += __shfl_xor(ls, 32);
        const float inv = 1.0f / fmaxf(ls, 1e-30f);
#pragma unroll
        for (int i = 0; i < 16; ++i) { sa0[i] *= inv; sa1[i] *= inv; sb0[i] *= inv; sb1[i] *= inv; }
#pragma unroll
        for (int i = 0; i < 16; ++i) { const int k0 = crow32(i, hh);
            float v0 = sa0[i], v1 = sa1[i], v2 = sb0[i], v3 = sb1[i];
            v0 += dppf<DPP_X1>(v0); v1 += dppf<DPP_X1>(v1); v2 += dppf<DPP_X1>(v2); v3 += dppf<DPP_X1>(v3);
            v0 += dppf<DPP_X2>(v0); v1 += dppf<DPP_X2>(v1); v2 += dppf<DPP_X2>(v2); v3 += dppf<DPP_X2>(v3);
            if (r == 0) { IMP[tl * 128 + k0] = v0; IMP[tl * 128 + 32 + k0] = v1; IMP[tl * 128 + 64 + k0] = v2; IMP[tl * 128 + 96 + k0] = v3; } }
#pragma unroll
        for (int i = 0; i < 16; ++i) { oa0[i] = 0.f; oa1[i] = 0.f; }
        na_pv(L + NA_T, sa0, sa1, lane, oa0, oa1);
        if (nbc == 2) na_pv(L + NA_BUF + NA_T, sb0, sb1, lane, oa0, oa1);
#pragma unroll
        for (int i = 0; i < 16; ++i) { ot0[i] = g0 * oa0[i]; ot1[i] = g0 * oa1[i]; }
    }
    __syncthreads();
    {
        const int tk = tid >> 3, s8 = tid & 7, cur = qb;
        if (!SMP || tk < DSEQ) {
        float v[16];
#pragma unroll
        for (int i = 0; i < 16; ++i) { const int nn = 16 * s8 + i; v[i] = (nn >= 1 && nn <= cur - 2) ? IMP[tk * 128 + nn] : -1.0f; }
        unsigned mk0 = 0u, mk1 = 0u, mk2 = 0u, mk3 = 0u;
        const int nforced = cur >= 2 ? 3 : cur + 1;
        for (int rd = 0; rd < TOPK - nforced; ++rd) {
            float bv = -0.5f; int bn = 1000;
#pragma unroll
            for (int i = 0; i < 16; ++i) if (v[i] > bv) { bv = v[i]; bn = 16 * s8 + i; }
            { const float ov = dppf<DPP_X1>(bv); const int on = dppi<DPP_X1>(bn); if (ov > bv || (ov == bv && on < bn)) { bv = ov; bn = on; } }
            { const float ov = dppf<DPP_X2>(bv); const int on = dppi<DPP_X2>(bn); if (ov > bv || (ov == bv && on < bn)) { bv = ov; bn = on; } }
            { const float ov = dppf<DPP_HM>(bv); const int on = dppi<DPP_HM>(bn); if (ov > bv || (ov == bv && on < bn)) { bv = ov; bn = on; } }
            if (bn >= 1000) break;
#pragma unroll
            for (int i = 0; i < 16; ++i) if (16 * s8 + i == bn) v[i] = -1.0f;
            const unsigned bit = 1u << (bn & 31); const int w = bn >> 5;
            mk0 |= w == 0 ? bit : 0u; mk1 |= w == 1 ? bit : 0u; mk2 |= w == 2 ? bit : 0u; mk3 |= w == 3 ? bit : 0u;
        }
#pragma unroll
        for (int f = 0; f < 3; ++f) { const int fn = f == 0 ? 0 : (f == 1 ? cur : cur - 1); if (fn >= 0) { const unsigned bit = 1u << (fn & 31); const int w = fn >> 5;
            mk0 |= w == 0 ? bit : 0u; mk1 |= w == 1 ? bit : 0u; mk2 |= w == 2 ? bit : 0u; mk3 |= w == 3 ? bit : 0u; } }
        if (s8 == 0) { SELM[tk * 4 + 0] = mk0; SELM[tk * 4 + 1] = mk1; SELM[tk * 4 + 2] = mk2; SELM[tk * 4 + 3] = mk3;
            atomicOr((unsigned*)&UNI[0], mk0); atomicOr((unsigned*)&UNI[1], mk1); atomicOr((unsigned*)&UNI[2], mk2); atomicOr((unsigned*)&UNI[3], mk3); }
        }
    }
    __syncthreads();
    int nit;
    {   const unsigned u0 = UNI[0], u1 = UNI[1], u2 = UNI[2], u3 = UNI[3];
        const int nn = qb - tid;
        const int sh = nn + 1;
        auto above = [&](unsigned w, int base) -> int { const int s = sh - base; return s <= 0 ? __popc(w) : (s >= 32 ? 0 : __popc(w >> s)); };
        const int nsel = __popc(u0) + __popc(u1) + __popc(u2) + __popc(u3), nwin = qb >= 8 ? 9 : qb + 1;
        if (nn >= 0) { const unsigned w = nn < 32 ? u0 : (nn < 64 ? u1 : (nn < 96 ? u2 : u3));
            if ((w >> (nn & 31)) & 1u) ITEMS[above(u0, 0) + above(u1, 32) + above(u2, 64) + above(u3, 96)] = nn; }
        if (tid < nwin) ITEMS[nsel + tid] = 256 + qb - tid;
        nit = nsel + nwin; }
    __syncthreads();
    const unsigned sm0 = SELM[tl * 4 + 0], sm1 = SELM[tl * 4 + 1], sm2 = SELM[tl * 4 + 2], sm3 = SELM[tl * 4 + 3];
    float m = -1e30f, ls = 0.f; int curmode = 0;
#pragma unroll
    for (int i = 0; i < 16; ++i) { oa0[i] = 0.f; oa1[i] = 0.f; }
    { NaStage st; const int it0 = ITEMS[0]; na_load<SMP>(c, st, l, 1 + (it0 >> 8), b, g, it0 & 255, tid, PT); na_store(st, L, tid); }
    __syncthreads();
    for (int it = 0; it < nit; ++it) {
        const int item = ITEMS[it], mode = item >> 8, nblk = item & 255;
        NaStage st; const bool more = it + 1 < nit;
        if (more) { const int nx = ITEMS[it + 1]; na_load<SMP>(c, st, l, 1 + (nx >> 8), b, g, nx & 255, tid, PT); }
        if (act) {
        if (mode != curmode) {
            const float lf = ls + __shfl_xor(ls, 32); const float sc = g1 / fmaxf(lf, 1e-30f);
#pragma unroll
            for (int i = 0; i < 16; ++i) { ot0[i] += sc * oa0[i]; ot1[i] += sc * oa1[i]; oa0[i] = 0.f; oa1[i] = 0.f; }
            m = -1e30f; ls = 0.f; curmode = mode; }
        const LAS unsigned char* buf = L + (it & 1) * NA_BUF;
        f32x16_t s0, s1; na_scores(buf, qf, lane, s0, s1);
        const int dbase = 64 * (qb - nblk) + tl;
        const unsigned smw = nblk < 32 ? sm0 : (nblk < 64 ? sm1 : (nblk < 96 ? sm2 : sm3));
        const bool blk_ok = mode == 1 ? true : ((smw >> (nblk & 31)) & 1u) != 0u;
        const bool full = (nblk == qb) || (mode == 1 && nblk == qb - 8);
        float mn, al, psum = 0.f;
        if (full) {
            float mloc = -1e30f;
#pragma unroll
            for (int i = 0; i < 16; ++i) { const int k0 = crow32(i, hh);
                { const int dist = dbase - k0;        const bool ok = blk_ok && dist >= 0 && (mode == 0 || dist < WIN); s0[i] = ok ? s0[i] - slope2 * (float)dist : -1e30f; mloc = fmaxf(mloc, s0[i]); }
                { const int dist = dbase - 32 - k0;   const bool ok = blk_ok && dist >= 0 && (mode == 0 || dist < WIN); s1[i] = ok ? s1[i] - slope2 * (float)dist : -1e30f; mloc = fmaxf(mloc, s1[i]); } }
            mloc = fmaxf(mloc, __shfl_xor(mloc, 32));
            mn = fmaxf(m, mloc); al = __builtin_amdgcn_exp2f(m - mn); m = mn;
#pragma unroll
            for (int i = 0; i < 16; ++i) { s0[i] = s0[i] > -1e29f ? __builtin_amdgcn_exp2f(s0[i] - mn) : 0.f; s1[i] = s1[i] > -1e29f ? __builtin_amdgcn_exp2f(s1[i] - mn) : 0.f; psum += s0[i] + s1[i]; }
        } else {
            const float c0 = -slope2 * (float)(dbase - 4 * hh);
            float tm = -1e30f;
#pragma unroll
            for (int i = 0; i < 16; ++i) { const float ci = (float)((i & 3) + 8 * (i >> 2));
                s0[i] = fmaf(slope2, ci, s0[i]); s1[i] = fmaf(slope2, ci + 32.0f, s1[i]); tm = fmaxf(tm, fmaxf(s0[i], s1[i])); }
            float mloc = blk_ok ? tm + c0 : -1e30f;
            mloc = fmaxf(mloc, __shfl_xor(mloc, 32));
            mn = fmaxf(m, mloc); al = __builtin_amdgcn_exp2f(m - mn); m = mn;
            const float mm = blk_ok ? mn - c0 : 1e30f;
#pragma unroll
            for (int i = 0; i < 16; ++i) { s0[i] = __builtin_amdgcn_exp2f(s0[i] - mm); s1[i] = __builtin_amdgcn_exp2f(s1[i] - mm); psum += s0[i] + s1[i]; }
        }
        ls = ls * al + psum;
        if (__builtin_amdgcn_ballot_w64(al != 1.0f) != 0ull) {
#pragma unroll
            for (int i = 0; i < 16; ++i) { oa0[i] *= al; oa1[i] *= al; } }
        na_pv(buf + NA_T, s0, s1, lane, oa0, oa1);
        }
        if (more) na_store(st, L + ((it + 1) & 1) * NA_BUF, tid);
        __syncthreads();
    }
    if (act) {
    {   const float lf = ls + __shfl_xor(ls, 32); const float sc = g2 / fmaxf(lf, 1e-30f);
#pragma unroll
        for (int i = 0; i < 16; ++i) { ot0[i] += sc * oa0[i]; ot1[i] += sc * oa1[i]; } }
    bf16_t* orow = c.MIXB + row * DM + h * 64;
#pragma unroll
    for (int q4 = 0; q4 < 4; ++q4) { const int d = 8 * q4 + 4 * hh;
        u32x2_t w0 = {cvtpk(ot0[4 * q4], ot0[4 * q4 + 1]), cvtpk(ot0[4 * q4 + 2], ot0[4 * q4 + 3])}; *(u32x2_t*)(orow + d) = w0;
        u32x2_t w1 = {cvtpk(ot1[4 * q4], ot1[4 * q4 + 1]), cvtpk(ot1[4 * q4 + 2], ot1[4 * q4 + 3])}; *(u32x2_t*)(orow + 32 + d) = w1; }
    }
    __syncthreads();
}

DEV void pool_unit(CREF c, int l, int seq, int n, int col) {
    const int slot = col >> 7, g = (col >> 6) & 1;
    const float* src; size_t stride;
    if (seq < BATCH) { src = c.PROJ + (size_t)(seq * SEQ + 64 * n) * PLD + C_KV + col; stride = PLD; }
    else { const int b = seq - BATCH, pg = c.page_table[b * NPAGES + (64 * n) / PAGE]; src = c.cache_nsa + (((size_t)l * NPHYS + pg) * PAGE + ((64 * n) % PAGE)) * 512 + col; stride = 512; }
    const float* w = (slot == 0 ? c.wck : c.wcv) + (l * 2 + g) * 64;
    float a0 = 0.f, a1 = 0.f;
#pragma unroll 16
    for (int j = 0; j < 64; j += 2) { a0 += w[j] * src[(size_t)j * stride]; a1 += w[j + 1] * src[(size_t)(j + 1) * stride]; }
    (slot == 0 ? c.KC : c.VC)[(((size_t)seq * NBMAX + n) * 2 + g) * 64 + (col & 63)] = a0 + a1;
}

DEV void dev_s5_y(CREF c, int l, long gtid, long gn) {
    for (long i = gtid; i < (long)TT * 256; i += gn) { const int r = (int)(i >> 8), ch = (int)(i & 255), g = ch / S5C, cc = ch % S5C;
        const float* cr = c.c_re + (((size_t)l * S5G + g) * S5C + cc) * S5P; const float* ci = c.c_im + (((size_t)l * S5G + g) * S5C + cc) * S5P;
        const f32x4_t* hs = (const f32x4_t*)(c.S5HS + ((size_t)r * S5G + g) * S5P * 2); float y = 0.f;
#pragma unroll 8
        for (int p2 = 0; p2 < S5P / 2; ++p2) { const f32x4_t hv = hs[p2]; y += cr[2 * p2] * hv[0] - ci[2 * p2] * hv[1] + cr[2 * p2 + 1] * hv[2] - ci[2 * p2 + 1] * hv[3]; }
        y += c.s5_d[l * 256 + ch] * c.PROJ[(size_t)r * PLD + C_S5U + ch]; c.GLB[i] = tobf(geluf_(y)); }
}

constexpr int S5_URS = 528, S5_HRS = 4112;
constexpr int S5_U = 0, S5_HT = 64 * S5_URS;
static_assert(S5_HT + 16 * S5_HRS <= 131072, "S5 LDS");
template <bool PASS_B, bool SMP> DEV void s5_unit(CREF c, int l, LAS unsigned char* L, int b, int ch, int tid) {
    asm volatile("" : "+v"(tid));
    constexpr int NT = SMP ? DSEQ : 64, NSB = SMP ? 1 : 4, TSB = SMP ? DSEQ : 16;
    const int r0 = SMP ? TP + b * DSEQ : b * SEQ + ch * 64, lane = tid & 63, wid = tid >> 6, n16 = lane & 15, kg = lane >> 4;
    LAS unsigned char* UB = L + S5_U; LAS unsigned char* BH = L + S5_HT;
    for (int i = tid; i < 16 * (SMP ? 1 : 4) * 64; i += 512) { const int t = i >> 6, q = i & 63; f32x4_t v = {0.f, 0.f, 0.f, 0.f}; if (t < NT) v = *(const f32x4_t*)(c.PROJ + (size_t)(r0 + t) * PLD + C_S5U + 4 * q);
        u32x2_t w = {cvtpk(v[0], v[1]), cvtpk(v[2], v[3])}; *(LAS u32x2_t*)(UB + t * S5_URS + q * 8) = w; }
    float ar[2], ai[2], hr[2], hi[2];
#pragma unroll
    for (int s = 0; s < 2; ++s) { const int idx = tid + 512 * s; const size_t gi = (size_t)l * S5G * S5P + idx;
        ar[s] = c.S5K[gi * 4]; ai[s] = c.S5K[gi * 4 + 1];
        if (SMP) { hr[s] = c.st_s5re[((size_t)l * DB + b) * 1024 + idx]; hi[s] = c.st_s5im[((size_t)l * DB + b) * 1024 + idx]; }
        else if (PASS_B) {
            const float a64r = c.S5K[gi * 4 + 2], a64i = c.S5K[gi * 4 + 3]; float cr_ = 0.f, ci_ = 0.f;
            for (int c0 = 0; c0 < ch; c0 += 16) { f32x2_t e[16];
#pragma unroll
                for (int k = 0; k < 16; ++k) e[k] = (c0 + k < ch) ? *(const f32x2_t*)(c.S5E + (((size_t)b * NCH + c0 + k) * 1024 + idx) * 2) : (f32x2_t){0.f, 0.f};
#pragma unroll
                for (int k = 0; k < 16; ++k) if (c0 + k < ch) { const float nr = a64r * cr_ - a64i * ci_ + e[k][0], ni = a64r * ci_ + a64i * cr_ + e[k][1]; cr_ = nr; ci_ = ni; } }
            hr[s] = cr_; hi[s] = ci_; }
        else { hr[s] = 0.f; hi[s] = 0.f; } }
    bf16x8_t bbf[2][8], ccf[2][4]; float dco[2];
#pragma unroll
    for (int gi2 = 0; gi2 < 2; ++gi2) { const size_t lg = (size_t)l * S5G + 2 * wid + gi2;
#pragma unroll
        for (int j = 0; j < 8; ++j) bbf[gi2][j] = *(const bf16x8_t*)(c.S5BF + ((lg * 8 + j) * 64 + lane) * 8);
        if (PASS_B) {
#pragma unroll
            for (int ks = 0; ks < 4; ++ks) ccf[gi2][ks] = *(const bf16x8_t*)(c.S5CF + ((lg * 4 + ks) * 64 + lane) * 8);
            dco[gi2] = c.s5_d[l * 256 + (2 * wid + gi2) * 16 + n16]; } }
    __syncthreads();
    const f32x4_t z4 = {0.f, 0.f, 0.f, 0.f}; const bf16x8_t zf = {0, 0, 0, 0, 0, 0, 0, 0};
    for (int sb = 0; sb < NSB; ++sb) {
#pragma unroll
        for (int gi2 = 0; gi2 < 2; ++gi2) { const int g = 2 * wid + gi2;
            const bf16x8_t af = kg < 2 ? *(const LAS bf16x8_t*)(UB + (16 * sb + n16) * S5_URS + (16 * g + 8 * kg) * 2) : zf;
#pragma unroll
            for (int j = 0; j < 8; ++j) { const f32x4_t acc = MFMA16(af, bbf[gi2][j], z4);
                LAS unsigned short* o = (LAS unsigned short*)(BH + (4 * kg) * S5_HRS + (g * 128 + 16 * j + n16) * 2);
                const unsigned p01 = cvtpk(acc[0], acc[1]), p23 = cvtpk(acc[2], acc[3]);
                o[0] = (unsigned short)p01; o[S5_HRS / 2] = (unsigned short)(p01 >> 16); o[S5_HRS] = (unsigned short)p23; o[3 * (S5_HRS / 2)] = (unsigned short)(p23 >> 16); } }
        __syncthreads();
#pragma unroll 4
        for (int tt = 0; tt < TSB; ++tt) {
#pragma unroll
            for (int s = 0; s < 2; ++s) { LAS unsigned* bp = (LAS unsigned*)(BH + tt * S5_HRS + (tid + 512 * s) * 4); const unsigned w = *bp;
                const float br = __uint_as_float(w << 16), bi = __uint_as_float(w & 0xffff0000u);
                const float nr = ar[s] * hr[s] - ai[s] * hi[s] + br, ni = ar[s] * hi[s] + ai[s] * hr[s] + bi; hr[s] = nr; hi[s] = ni;
                if (PASS_B) *bp = cvtpk(nr, ni); } }
        if (PASS_B) {
            __syncthreads();
#pragma unroll
            for (int gi2 = 0; gi2 < 2; ++gi2) { const int g = 2 * wid + gi2; f32x4_t y = z4;
#pragma unroll
                for (int ks = 0; ks < 4; ++ks) { const bf16x8_t hf = *(const LAS bf16x8_t*)(BH + n16 * S5_HRS + (g * 128 + 32 * ks + 8 * kg) * 2); y = MFMA16(hf, ccf[gi2][ks], y); }
#pragma unroll
                for (int i = 0; i < 4; ++i) { const int t = 16 * sb + 4 * kg + i;
                    if (t < NT) { const float uu = __uint_as_float(((unsigned)*(const LAS unsigned short*)(UB + t * S5_URS + (16 * g + n16) * 2)) << 16);
                        *(LAS unsigned short*)(UB + t * S5_URS + (16 * g + n16) * 2) = tobf(geluf_(y[i] + dco[gi2] * uu)); } } }
        }
        __syncthreads();
    }
    if (PASS_B) {
        bf16x8_t wf[2][8];
#pragma unroll
        for (int nt = 0; nt < 2; ++nt)
#pragma unroll
            for (int ks = 0; ks < 8; ++ks) wf[nt][ks] = *(const bf16x8_t*)(c.WGLU_T + (size_t)l * 65536 + (size_t)(32 * wid + 16 * nt + n16) * 256 + 32 * ks + 8 * kg);
#pragma unroll 1
        for (int mt = 0; mt < (SMP ? 1 : 4); ++mt) { f32x4_t a0 = z4, a1 = z4;
#pragma unroll
            for (int ks = 0; ks < 8; ++ks) { const bf16x8_t af = *(const LAS bf16x8_t*)(UB + (16 * mt + n16) * S5_URS + (32 * ks + 8 * kg) * 2); a0 = MFMA16(af, wf[0][ks], a0); a1 = MFMA16(af, wf[1][ks], a1); }
#pragma unroll
            for (int i = 0; i < 4; ++i) { const int t = 16 * mt + 4 * kg + i;
                if (t < NT) {
#pragma unroll
                    for (int nt = 0; nt < 2; ++nt) { const int col = 32 * wid + 16 * nt + n16; const float z = nt == 0 ? a0[i] : a1[i];
                        const float gl = __uint_as_float(((unsigned)*(const LAS unsigned short*)(UB + t * S5_URS + col * 2)) << 16);
                        c.MIXB[(size_t)(r0 + t) * DM + 768 + col] = tobf(gl * __builtin_amdgcn_rcpf(1.0f + __expf(-z))); } } } } }
#pragma unroll
    for (int s = 0; s < 2; ++s) { const int idx = tid + 512 * s;
        if (SMP) { c.out[O_S5RS + ((size_t)l * DB + b) * 1024 + idx] = hr[s]; c.out[O_S5IS + ((size_t)l * DB + b) * 1024 + idx] = hi[s]; }
        else if (!PASS_B) { const size_t e = (((size_t)b * NCH + ch) * 1024 + idx) * 2; c.S5E[e] = hr[s]; c.S5E[e + 1] = hi[s]; } }
    __syncthreads();
}

DEV void dn_sample_unit(CREF c, int l, LAS unsigned char* L, int b, int tid) {
    asm volatile("" : "+v"(tid));
    LAS float* Y = (LAS float*)L;
    LAS float* sm = Y + 8 * 768;
    const int r0 = TP + b * DSEQ, lane = tid & 63, wid = tid >> 6;
    for (int idx = tid; idx < 8 * 768; idx += 512) { const int t = idx / 768, cch = idx % 768; const f32x4_t w = *(const f32x4_t*)(c.conv_w + ((size_t)l * CONVD + cch) * 4); float y = 0.f;
#pragma unroll
        for (int j = 0; j < 4; ++j) { const int tt = t - 3 + j; y += w[j] * (tt >= 0 ? c.PROJ[(size_t)(r0 + tt) * PLD + C_DNQKV + cch] : c.st_conv[(((size_t)l * DB + b) * 3 + 3 + tt) * CONVD + cch]); }
        Y[idx] = y / (1.0f + expf(-y)); }
    if (tid < 32) { const int t = tid >> 2, h = tid & 3; sm[64 + tid] = sigmoidf_(c.PROJ[(size_t)(r0 + t) * PLD + C_DNB + h]);
        sm[96 + tid] = expf(-expf(c.a_log[l * DNH + h]) * softplusf_(c.PROJ[(size_t)(r0 + t) * PLD + C_DNA + h] + c.dt_bias[l * DNH + h])); }
    __syncthreads();
    for (int rr = wid * 8; rr < wid * 8 + 8; ++rr) { const int t = rr >> 3, part = (rr >> 2) & 1, h = rr & 3; const float y = Y[t * 768 + part * 256 + h * 64 + lane]; const float ss = wave_sum(y * y);
        if (lane == 0) sm[rr] = (part == 0 ? 0.125f : 1.0f) / sqrtf(ss + 1e-6f); }
    __syncthreads();
    if (tid < 256) { const int h = tid >> 6, jc = tid & 63; float S[64]; const float* s0 = c.st_dn + (((size_t)l * DB + b) * DNH + h) * 4096 + jc;
#pragma unroll
        for (int kk = 0; kk < 64; ++kk) S[kk] = s0[kk * 64];
        const float nw = c.dn_norm_w[l * 64 + jc];
        for (int t = 0; t < DSEQ; ++t) { const LAS float* qp = Y + t * 768 + h * 64; const LAS float* kp = qp + 256; const float qs = sm[t * 8 + h], ksc = sm[t * 8 + 4 + h], a = sm[96 + t * 4 + h], be = sm[64 + t * 4 + h];
            float ks = 0.f;
#pragma unroll
            for (int kk = 0; kk < 64; ++kk) { S[kk] *= a; ks += kp[kk] * S[kk]; }
            const float vn = be * (Y[t * 768 + 512 + h * 64 + jc] - ks * ksc), kv = vn * ksc; float os = 0.f;
#pragma unroll
            for (int kk = 0; kk < 64; ++kk) { S[kk] += kp[kk] * kv; os += qp[kk] * S[kk]; }
            os *= qs;
            const float ss = wave_sum(os * os); const float z = c.PROJ[(size_t)(r0 + t) * PLD + C_DNZ + h * 64 + jc];
            c.MIXB[(size_t)(r0 + t) * DM + 512 + h * 64 + jc] = tobf(os / sqrtf(ss * (1.0f / 64.0f) + NEPS) * nw * (z / (1.0f + expf(-z)))); }
#pragma unroll
        for (int kk = 0; kk < 64; ++kk) c.out[O_DNS + (((size_t)l * DB + b) * DNH + h) * 4096 + kk * 64 + jc] = S[kk]; }
    __syncthreads();
}
DEV void s5_carry_unit(CREF c, int l, int b, int tid) {
    for (int s = 0; s < 2; ++s) { const int idx = tid + 512 * s; const float* K = c.S5K + ((size_t)l * 1024 + idx) * 4; const float a64r = K[2], a64i = K[3]; float hr = 0.f, hi = 0.f;
        for (int c0 = 0; c0 < NCH; c0 += 16) { f32x2_t e[16];
#pragma unroll
            for (int k = 0; k < 16; ++k) e[k] = *(const f32x2_t*)(c.S5E + (((size_t)b * NCH + c0 + k) * 1024 + idx) * 2);
#pragma unroll
            for (int k = 0; k < 16; ++k) { *(f32x2_t*)(c.S5HIN + (((size_t)b * NCH + c0 + k) * 1024 + idx) * 2) = (f32x2_t){hr, hi};
                const float nr = a64r * hr - a64i * hi + e[k][0], ni = a64r * hi + a64i * hr + e[k][1]; hr = nr; hi = ni; } }
        c.out[O_S5RP + ((size_t)l * BATCH + b) * 1024 + idx] = hr; c.out[O_S5IP + ((size_t)l * BATCH + b) * 1024 + idx] = hi; }
}
#ifndef N_LAUNCH_MODE
#define N_LAUNCH_MODE 1
#endif
namespace pg8 {
template <bool ADD> struct EpiF32 {
    static constexpr bool PERM = false, AFTER_DRAIN = false;
    float* C; int ldc;
    __device__ __forceinline__ void operator()(const f32x4 (&acc)[2][2][4][2], const Unit& u, int wr, int wc, int fr, int fq) const {
        const int row0 = u.pm * BM + wr * 64 + fr, col0 = u.pn * BM + wc * 32 + 4 * fq;
#pragma unroll
        for (int ai = 0; ai < 2; ++ai)
#pragma unroll
            for (int m = 0; m < 4; ++m) { float* rowp = C + (size_t)(row0 + ai * HALF + m * 16) * ldc + col0;
#pragma unroll
                for (int bj = 0; bj < 2; ++bj)
#pragma unroll
                    for (int n = 0; n < 2; ++n) { f32x4 v = acc[ai][bj][m][n]; if (ADD) v += *(const f32x4*)(rowp + bj * HALF + n * 16); *(f32x4*)(rowp + bj * HALF + n * 16) = v; } }
    }
};
struct EpiSqReluBf16 {
    static constexpr bool PERM = true, AFTER_DRAIN = false;
    bf16_t* O; int ldc;
    __device__ __forceinline__ void operator()(const f32x4 (&acc)[2][2][4][2], const Unit& u, int wr, int wc, int fr, int fq) const {
        const int row0 = u.pm * BM + wr * 64 + fr, col0 = u.pn * BM + wc * 32 + 8 * fq;
#pragma unroll
        for (int ai = 0; ai < 2; ++ai)
#pragma unroll
            for (int m = 0; m < 4; ++m) { bf16_t* rowp = O + (size_t)(row0 + ai * HALF + m * 16) * ldc + col0;
#pragma unroll
                for (int bj = 0; bj < 2; ++bj) { f32x4 v0 = acc[ai][bj][m][0], v1 = acc[ai][bj][m][1];
#pragma unroll
                    for (int j = 0; j < 4; ++j) { const float a = v0[j] > 0.f ? v0[j] : 0.f, b = v1[j] > 0.f ? v1[j] : 0.f; v0[j] = a * a; v1[j] = b * b; }
                    u32x4 w; w.x = cvt_pk_bf16(v0[0], v0[1]); w.y = cvt_pk_bf16(v0[2], v0[3]); w.z = cvt_pk_bf16(v1[0], v1[1]); w.w = cvt_pk_bf16(v1[2], v1[3]);
                    *(u32x4*)(rowp + bj * HALF) = w; } }
    }
};
struct EpiGluBf16 {
    static constexpr bool PERM = true, AFTER_DRAIN = false;
    bf16_t* O; int ldc; const bf16_t* GLv;
    __device__ __forceinline__ void operator()(const f32x4 (&acc)[2][2][4][2], const Unit& u, int wr, int wc, int fr_, int fq_) const {
        int ln; asm volatile("v_mbcnt_lo_u32_b32 %0, -1, 0\n\tv_mbcnt_hi_u32_b32 %0, -1, %0" : "=v"(ln)); const int fr = ln & 15, fq = ln >> 4;
        const int row0 = u.pm * BM + wr * 64 + fr, col0 = u.pn * BM + wc * 32 + 8 * fq;
#pragma unroll
        for (int ai = 0; ai < 2; ++ai)
#pragma unroll
            for (int m = 0; m < 4; ++m) { const size_t r = (size_t)(row0 + ai * HALF + m * 16);
#pragma unroll
                for (int bj = 0; bj < 2; ++bj) { const u32x4 gv = *(const u32x4*)(GLv + r * 256 + col0 + bj * HALF); f32x4 v0 = acc[ai][bj][m][0], v1 = acc[ai][bj][m][1];
#pragma unroll
                    for (int j = 0; j < 4; ++j) { v0[j] = __builtin_amdgcn_rcpf(1.0f + __expf(-v0[j])); v1[j] = __builtin_amdgcn_rcpf(1.0f + __expf(-v1[j])); }
                    v0[0] *= __uint_as_float(gv[0] << 16); v0[1] *= __uint_as_float(gv[0] & 0xffff0000u); v0[2] *= __uint_as_float(gv[1] << 16); v0[3] *= __uint_as_float(gv[1] & 0xffff0000u);
                    v1[0] *= __uint_as_float(gv[2] << 16); v1[1] *= __uint_as_float(gv[2] & 0xffff0000u); v1[2] *= __uint_as_float(gv[3] << 16); v1[3] *= __uint_as_float(gv[3] & 0xffff0000u);
                    u32x4 w; w.x = cvt_pk_bf16(v0[0], v0[1]); w.y = cvt_pk_bf16(v0[2], v0[3]); w.z = cvt_pk_bf16(v1[0], v1[1]); w.w = cvt_pk_bf16(v1[2], v1[3]);
                    *(u32x4*)(O + r * ldc + col0 + bj * HALF) = w; } }
    }
};
}

#define XB_TMO      128
#define XB_XCNT(j)  (256  + 64 * (j))
#define XB_XSUB(j)  (1280 + 64 * (j))
#define XB_XGEN(j)  (2304 + 64 * (j))
#define XB_TOP      3328
#define XB_TOPGEN   3392
#define XCD_BAR_WORDS 3456
#define XB_SPIN_CAP (1u << 24)
__device__ __forceinline__ unsigned xb_ld(unsigned* p)              { return __hip_atomic_load(p, __ATOMIC_RELAXED, __HIP_MEMORY_SCOPE_AGENT); }
__device__ __forceinline__ unsigned xb_add(unsigned* p, unsigned v) { return __hip_atomic_fetch_add(p, v, __ATOMIC_RELAXED, __HIP_MEMORY_SCOPE_AGENT); }
__device__ __forceinline__ unsigned xb_xcc_id() { return (unsigned)__builtin_amdgcn_s_getreg((3 << 11) | 20) & 0xFu; }
#define XB_SPIN(cond, bar) do { unsigned _sp = 0; while (cond) { __builtin_amdgcn_s_sleep(1); \
    if ((++_sp & 255u) == 0u) { if (xb_ld(&(bar)[XB_TMO])) break; if (_sp > XB_SPIN_CAP) { atomicAdd(&(bar)[XB_TMO], 1u); break; } } } } while (0)
struct XcdBarrier { unsigned* bar; unsigned x; volatile LAS unsigned* st; };
__device__ __forceinline__ XcdBarrier xcd_barrier_post(unsigned* bar, volatile LAS unsigned* st) {
    XcdBarrier b; b.bar = bar; b.x = xb_xcc_id(); b.st = st;
    if (threadIdx.x == 0) (void)xb_add(&bar[XB_XCNT(b.x)], 1u);
    return b;
}
__device__ __forceinline__ void xcd_barrier_complete(unsigned* bar, unsigned x, unsigned& nloc, unsigned& nx) {
    const unsigned G = gridDim.x * gridDim.y * gridDim.z;
    unsigned sum, cnt, mine, sp = 0u;
    for (;;) {
        sum = 0u; cnt = 0u; mine = 0u;
#pragma unroll
        for (unsigned j = 0; j < 16; ++j) { const unsigned c = xb_ld(&bar[XB_XCNT(j)]); sum += c; cnt += (c > 0u) ? 1u : 0u; mine = (j == x) ? c : mine; }
        if (sum == G) break;
        __builtin_amdgcn_s_sleep(1);
        if ((++sp & 255u) == 0u) { if (xb_ld(&bar[XB_TMO])) break; if (sp > XB_SPIN_CAP) { atomicAdd(&bar[XB_TMO], 1u); break; } }
    }
    nloc = mine > 0u ? mine : 1u; nx = cnt > 0u ? cnt : 1u;
}
__device__ __forceinline__ void xcd_barrier(const XcdBarrier& b, const bool t0) {
    asm volatile("s_waitcnt vmcnt(0)" ::: "memory");
    __syncthreads();
    if (t0) {
        unsigned* bar = b.bar; unsigned bx = b.x; asm volatile("" : "+s"(bar), "+s"(bx));
        __builtin_amdgcn_s_waitcnt(0);
        unsigned nloc = b.st[0], nx = b.st[1];
        if (nloc == 0u) { xcd_barrier_complete(bar, bx, nloc, nx); b.st[0] = nloc; b.st[1] = nx; }
        const unsigned old = xb_add(&bar[XB_XSUB(bx)], 1u);
        const unsigned gen = old / nloc;
        if (old + 1u == (gen + 1u) * nloc) {
            __builtin_amdgcn_fence(__ATOMIC_RELEASE, "agent");
            asm volatile("s_waitcnt vmcnt(0)" ::: "memory");
            const unsigned og = xb_add(&bar[XB_TOP], 1u);
            const unsigned tg = og / nx;
            if (og + 1u == (tg + 1u) * nx) xb_add(&bar[XB_TOPGEN], 1u);
            else XB_SPIN(xb_ld(&bar[XB_TOPGEN]) == tg, bar);
            __builtin_amdgcn_fence(__ATOMIC_ACQUIRE, "agent");
            xb_add(&bar[XB_XGEN(bx)], 1u);
            asm volatile("s_waitcnt vmcnt(0)" ::: "memory");
        } else {
            XB_SPIN(xb_ld(&bar[XB_XGEN(bx)]) == gen, bar);
            __builtin_amdgcn_fence(__ATOMIC_ACQUIRE, "agent");
            asm volatile("s_waitcnt vmcnt(0)" ::: "memory");
        }
    }
    __syncthreads();
}

constexpr int RING_BYTES = 131072, LDSCTL_OFF = RING_BYTES, LDS_BYTES = 147456;
constexpr int NTHREADS = 512;
constexpr size_t al256(size_t x) { return (x + 255) & ~(size_t)255; }
constexpr size_t WS_CTL = 0, CTL_BYTES = 65536;
constexpr size_t WS_X = al256(WS_CTL + CTL_BYTES), WS_SSQ = al256(WS_X + (size_t)TT * DM * 4), WS_XN = al256(WS_SSQ + (size_t)TT * 64 * 4),
    WS_PROJ = al256(WS_XN + (size_t)TT * DM * 2), WS_MIXB = al256(WS_PROJ + (size_t)TT * PLD * 4), WS_UPB = al256(WS_MIXB + (size_t)TT * DM * 2),
    WS_WIN = al256(WS_UPB + (size_t)TT * DFF * 2), WS_WOUT = al256(WS_WIN + (size_t)2 * PLD * DM * 2), WS_WUP = al256(WS_WOUT + (size_t)2 * DM * DM * 2),
    WS_WDN = al256(WS_WUP + (size_t)2 * DFF * DM * 2), WS_KC = al256(WS_WDN + (size_t)2 * DM * DFF * 2), WS_VC = al256(WS_KC + (size_t)NSEQ * NBMAX * 128 * 4),
    WS_PC = al256(WS_VC + (size_t)NSEQ * NBMAX * 128 * 4), WS_OC = al256(WS_PC + (size_t)TT * NH * NBMAX * 4), WS_IDX = al256(WS_OC + (size_t)TT * NH * 64 * 4),
    WS_QN = al256(WS_IDX + (size_t)TT * NG * TOPK * 4), WS_KN = al256(WS_QN + (size_t)TT * 256 * 4), WS_VV = al256(WS_KN + (size_t)TT * 256 * 4),
    WS_GG = al256(WS_VV + (size_t)TT * 256 * 4), WS_BETA = al256(WS_GG + (size_t)TT * DNH * 4), WS_GC = al256(WS_BETA + (size_t)TT * DNH * 4),
    WS_AM = al256(WS_GC + (size_t)NDU * 64 * 4), WS_AQK = al256(WS_AM + (size_t)NDU * 4096 * 4), WS_SOL = al256(WS_AQK + (size_t)NDU * 4096 * 4),
    WS_VNEW = al256(WS_SOL + (size_t)NDU * 8192 * 4), WS_SDN = al256(WS_VNEW + (size_t)BATCH * DNH * 4096 * 4), WS_ODN = al256(WS_SDN + (size_t)BATCH * DNH * 4096 * 4),
    WS_S5K = al256(WS_ODN + (size_t)TT * 256 * 4), WS_S5BB = al256(WS_S5K + 2 * S5G * S5P * 4 * 4), WS_S5E = al256(WS_S5BB + 2 * S5G * S5P * S5C * 2 * 4),
    WS_S5HIN = al256(WS_S5E + (size_t)BATCH * NCH * 2048 * 4), WS_S5HS = al256(WS_S5HIN + (size_t)BATCH * NCH * 2048 * 4), WS_GL = al256(WS_S5HS + (size_t)TT * 2048 * 4),
    WS_GLB = al256(WS_GL + (size_t)TT * 256 * 4), WS_WGLU = al256(WS_GLB + (size_t)TT * 256 * 2), WS_PART = al256(WS_WGLU + (size_t)2 * 65536 * 2), WS_DNF = al256(WS_PART + (size_t)8 * TS * DM * 4), WS_DNU = al256(WS_DNF + (size_t)NDU * 16384 * 2), WS_DNE = al256(WS_DNU + (size_t)NDU * 4096 * 4), WS_S5BF = al256(WS_DNE + (size_t)NDU * 4), WS_S5CF = al256(WS_S5BF + (size_t)2 * 16 * 8 * 64 * 8 * 2), WS_END = al256(WS_S5CF + (size_t)2 * 16 * 4 * 64 * 8 * 2);

struct Args { Ctx c; unsigned* bar; int lo, hi; };
constexpr int NPH = 1 + 2 * 14 + 2;
typedef const __attribute__((address_space(4))) unsigned char* karg_t;
__device__ __forceinline__ int lane_id() { return (int)__builtin_amdgcn_mbcnt_hi(~0u, __builtin_amdgcn_mbcnt_lo(~0u, 0u)); }
__device__ __forceinline__ int lane_id_v() { int t; asm volatile("v_mbcnt_lo_u32_b32 %0, -1, 0\n\tv_mbcnt_hi_u32_b32 %0, -1, %0" : "=v"(t)); return t; }
#define TIDV (wv * 64 + lane_id_v())
template <int P> __device__ __forceinline__ void run_phase(const int l, LAS unsigned char* L, const int wv) {
    karg_t kp = (karg_t)__builtin_amdgcn_kernarg_segment_ptr(); asm volatile("" : "+s"(kp));
    CREF c = *(const __attribute__((address_space(4))) Ctx*)kp;
    int tx_ = wv * 64 + lane_id_v(), bx_ = blockIdx.x; asm volatile("" : "+v"(tx_), "+s"(bx_));
    const long gtid = (long)bx_ * NTHREADS + tx_, gn = (long)gridDim.x * NTHREADS;
    const int G = (int)gridDim.x;
    if constexpr (P == 0) { dev_prologue(c, L, bx_, tx_, gtid, gn); dev_s5_consts(c, (long)(G - 1 - bx_) * NTHREADS + tx_, gn);   }
    if constexpr (P == 2) dev_rmsnorm<false>(c, c.ln1 + l * DM, bx_, tx_, l == 0 ? 0 : 8);
    if constexpr (P == 3) { pg8::Gemm g{c.XN, c.WIN_T + (size_t)l * PLD * DM, TT, PLD, DM, DM}; pg8::StaticOrder S; S.init(TT, PLD, G, bx_);
        pg8::EpiF32<false> E{c.PROJ, PLD}; pg8::gemm_phase<pg8::EpiF32<false>, pg8::StaticOrder, true, true>(L, g, S, E, wv * 64 + lane_id_v()); }
    if constexpr (P == 4) { for (int u = bx_; u < NDU; u += G) dn_prep_unit(c, l, L, u, TIDV);
        for (int u = bx_; u < BATCH * NCH; u += G) s5_unit<false, false>(c, l, L, u / NCH, u % NCH, TIDV);
        constexpr int NPU = BATCH * NBP + DB * NBC_S;
        { const int t = TIDV; for (int u = 2 * bx_ + (t >> 8); u < NPU; u += 2 * G) { if (u < BATCH * NBP) pool_unit(c, l, u / NBP, u % NBP, t & 255); else pool_unit(c, l, BATCH + (u - BATCH * NBP) / NBC_S, (u - BATCH * NBP) % NBC_S, t & 255); } } }
    if constexpr (P == 5) {
        if (bx_ < BATCH * DNH) dn_scan_mfma(c, l, L, bx_, TIDV);
        constexpr int NU = BATCH * NG * NBP;
        volatile LAS int* qslot = (volatile LAS int*)(L + LDSCTL_OFF + 64);
#define QLOOP(qi, count, ...) for (;;) { if (wv == 0 && lane_id_v() == 0) qslot[0] = (int)__hip_atomic_fetch_add(c.QCTR + 64 * (8 * l + (qi)), 1u, __ATOMIC_RELAXED, __HIP_MEMORY_SCOPE_AGENT); \
            __syncthreads(); const int it = qslot[0]; __syncthreads(); if (it >= (count)) break; __VA_ARGS__; }
        QLOOP(0, NU, { const int qb = NBP - 1 - it / (BATCH * NG), bg = it % (BATCH * NG); nsa_unit<false>(c, l, L, bg / NG, qb, bg % NG, TIDV); })
        QLOOP(1, DB * NG, nsa_unit<true>(c, l, L, it / NG, PAST / 64, it % NG, TIDV))
        QLOOP(2, DB, dn_sample_unit(c, l, L, it, TIDV))
        QLOOP(3, BATCH, s5_carry_unit(c, l, it, TIDV))
        QLOOP(5, BATCH * NCH + DB, { if (it < BATCH * NCH) s5_unit<true, false>(c, l, L, it / NCH, it % NCH, TIDV); else s5_unit<true, true>(c, l, L, it - BATCH * NCH, 0, TIDV); })
        QLOOP(4, 256, dev_copy_out(c, l, (long)it * NTHREADS + TIDV, (long)256 * NTHREADS))
#undef QLOOP
    }
    if constexpr (P == 9) dev_dn_out(c, l, bx_, tx_);
    if constexpr (P == 10) {
        { pg8::Gemm g{c.MIXB, c.WOUT_T + (size_t)l * DM * DM, TP, DM, DM, DM}; pg8::StaticOrder S; S.init(TP, DM, G, bx_);
          pg8::EpiF32<true> E{c.X, DM}; pg8::gemm_phase<pg8::EpiF32<true>, pg8::StaticOrder, true, true>(L, g, S, E, wv * 64 + lane_id_v()); }
        if (bx_ < 64) { const int ks = bx_ >> 4; pg8::Gemm g{c.MIXB + (size_t)TP * DM + ks * 256, c.WOUT_T + (size_t)l * DM * DM + ks * 256, TS, DM, 256, DM}; pg8::StaticOrder S; S.init(TS, DM, 16, bx_ & 15);
          pg8::EpiF32<false> E{c.PART + (size_t)ks * TS * DM, DM}; pg8::gemm_phase<pg8::EpiF32<false>, pg8::StaticOrder, true, true>(L, g, S, E, wv * 64 + lane_id_v()); } }
    if constexpr (P == 11) dev_rmsnorm<false>(c, c.ln2 + l * DM, bx_, tx_, 4);
    if constexpr (P == 12) { pg8::Gemm g{c.XN, c.WUP_T + (size_t)l * DFF * DM, TT, DFF, DM, DM}; pg8::StaticOrder S; S.init(TT, DFF, G, bx_);
        pg8::EpiSqReluBf16 E{c.UPB, DFF}; pg8::gemm_phase<pg8::EpiSqReluBf16, pg8::StaticOrder, true, true>(L, g, S, E, wv * 64 + lane_id_v()); }
    if constexpr (P == 13) {
        { pg8::Gemm g{c.UPB, c.WDN_T + (size_t)l * DM * DFF, TP, DM, DFF, DFF}; pg8::StaticOrder S; S.init(TP, DM, G, bx_);
          pg8::EpiF32<true> E{c.X, DM}; pg8::gemm_phase<pg8::EpiF32<true>, pg8::StaticOrder, true, true>(L, g, S, E, wv * 64 + lane_id_v()); }
        if (bx_ < 128) { const int ks = bx_ >> 4; pg8::Gemm g{c.UPB + (size_t)TP * DFF + ks * 512, c.WDN_T + (size_t)l * DM * DFF + ks * 512, TS, DM, 512, DFF}; pg8::StaticOrder S; S.init(TS, DM, 16, bx_ & 15);
          pg8::EpiF32<false> E{c.PART + (size_t)ks * TS * DM, DM}; pg8::gemm_phase<pg8::EpiF32<false>, pg8::StaticOrder, true, true>(L, g, S, E, wv * 64 + lane_id_v()); } }
    if constexpr (P == 14) dev_rmsnorm<true>(c, c.ln_f, bx_, tx_, 8);
}
#if N_LAUNCH_MODE == 1
__global__ void __launch_bounds__(NTHREADS, 2) fwd_kernel(Args a) {
    extern __shared__ __attribute__((aligned(16))) unsigned char lds[];
    LAS unsigned char* L = (LAS unsigned char*)lds;
    volatile LAS unsigned* MISC = (volatile LAS unsigned*)(L + LDSCTL_OFF);
    for (int u = threadIdx.x; u < (LDS_BYTES - LDSCTL_OFF) / 4; u += NTHREADS) ((LAS unsigned*)(L + LDSCTL_OFF))[u] = 0u;
    __syncthreads();
    XcdBarrier bar = xcd_barrier_post(a.bar, MISC + 8);
    const int wv = __builtin_amdgcn_readfirstlane((int)threadIdx.x >> 6);
#define PHASE(P, l) do { run_phase<P>(l, L, wv); xcd_barrier(bar, wv == 0 && lane_id_v() == 0); } while (0)
    PHASE(0, 0);
#define LAYER(l) PHASE(2, l); PHASE(3, l); PHASE(4, l); PHASE(5, l); PHASE(9, l); PHASE(10, l); PHASE(11, l); PHASE(12, l); PHASE(13, l)
#define LAYER0 PHASE(3, 0); PHASE(4, 0); PHASE(5, 0); PHASE(9, 0); PHASE(10, 0); PHASE(11, 0); PHASE(12, 0); PHASE(13, 0)
    LAYER0; LAYER(1);
#undef LAYER
    run_phase<14>(0, L, wv);
#undef PHASE
}
#else
template <int P> __global__ void __launch_bounds__(NTHREADS, 2) k_phase(Args a) {
    extern __shared__ __attribute__((aligned(16))) unsigned char lds[];
    run_phase<P>(a.lo, (LAS unsigned char*)lds, __builtin_amdgcn_readfirstlane((int)threadIdx.x >> 6));
}
template <int P> static void launch_phase(const Args& a, int grid, hipStream_t stream) {
    static bool attr = false;
    if (!attr) { (void)hipFuncSetAttribute((const void*)k_phase<P>, hipFuncAttributeMaxDynamicSharedMemorySize, LDS_BYTES); attr = true; }
    hipLaunchKernelGGL(k_phase<P>, dim3(grid), dim3(NTHREADS), LDS_BYTES, stream, a);
}
#endif

extern "C" void kernel_launch(void* const* d_in, const int* in_sizes, int n_in, void* d_out, int out_size, void* d_ws, size_t ws_size, hipStream_t stream) {
    static int grid = 0;
    if (grid == 0) {
        if (n_in != 31 || in_sizes[0] != TP * DM || (size_t)out_size != O_END || ws_size < WS_END) { fprintf(stderr, "kernel_launch: shape mismatch (n_in %d in0 %d out %d ws %zu need %zu)\n", n_in, n_in > 0 ? in_sizes[0] : -1, out_size, ws_size, (size_t)WS_END); grid = -1; return; }
        int dev = 0, cus = 0;
        if (hipGetDevice(&dev) != hipSuccess || hipDeviceGetAttribute(&cus, hipDeviceAttributeMultiprocessorCount, dev) != hipSuccess) { grid = -1; return; }
#if N_LAUNCH_MODE == 1
        int per_cu = 0;
        if (hipFuncSetAttribute((const void*)fwd_kernel, hipFuncAttributeMaxDynamicSharedMemorySize, LDS_BYTES) != hipSuccess) { fprintf(stderr, "kernel_launch: hipFuncSetAttribute failed\n"); grid = -1; return; }
        if (hipOccupancyMaxActiveBlocksPerMultiprocessor(&per_cu, (const void*)fwd_kernel, NTHREADS, LDS_BYTES) != hipSuccess || per_cu < 1) fprintf(stderr, "kernel_launch: occupancy query reports %d\n", per_cu);
        (void)hipGetLastError();
#endif
        grid = cus;
    }
    if (grid < 0) return;
    if (hipMemsetAsync((char*)d_ws + WS_CTL, 0, CTL_BYTES, stream) != hipSuccess) return;
    Args a{};
    Ctx& c = a.c;
    const float** fp[] = {&c.x_prompt, &c.x_sample, &c.cache_nsa, &c.cache_win, &c.st_conv, &c.st_dn, &c.st_s5re, &c.st_s5im, nullptr, &c.ln1, &c.ln2, &c.ln_f, &c.w_in, &c.w_out, &c.wck, &c.wcv, &c.conv_w, &c.a_log, &c.dt_bias,
                          &c.dn_norm_w, &c.lam_re, &c.lam_im, &c.log_step, &c.b_re, &c.b_im, &c.c_re, &c.c_im, &c.s5_d, &c.w_glu, &c.mlp_up, &c.mlp_down};
    for (int i = 0; i < 31; ++i) { if (i == 8) c.page_table = (const int*)d_in[i]; else *fp[i] = (const float*)d_in[i]; }
    c.out = (float*)d_out;
    char* w = (char*)d_ws;
    c.X = (float*)(w + WS_X); c.SSQ = (float*)(w + WS_SSQ); c.XN = (bf16_t*)(w + WS_XN); c.PROJ = (float*)(w + WS_PROJ); c.MIXB = (bf16_t*)(w + WS_MIXB); c.UPB = (bf16_t*)(w + WS_UPB);
    c.WIN_T = (bf16_t*)(w + WS_WIN); c.WOUT_T = (bf16_t*)(w + WS_WOUT); c.WUP_T = (bf16_t*)(w + WS_WUP); c.WDN_T = (bf16_t*)(w + WS_WDN);
    c.KC = (float*)(w + WS_KC); c.VC = (float*)(w + WS_VC); c.PC = (float*)(w + WS_PC); c.OC = (float*)(w + WS_OC); c.IDX = (int*)(w + WS_IDX);
    c.QN = (float*)(w + WS_QN); c.KN = (float*)(w + WS_KN); c.VV = (float*)(w + WS_VV); c.GG = (float*)(w + WS_GG); c.BETA = (float*)(w + WS_BETA);
    c.GC = (float*)(w + WS_GC); c.AM = (float*)(w + WS_AM); c.AQK = (float*)(w + WS_AQK); c.SOL = (float*)(w + WS_SOL); c.VNEW = (float*)(w + WS_VNEW); c.SDN = (float*)(w + WS_SDN); c.ODN = (float*)(w + WS_ODN);
    c.S5K = (float*)(w + WS_S5K); c.S5BB = (float*)(w + WS_S5BB); c.S5E = (float*)(w + WS_S5E); c.S5HIN = (float*)(w + WS_S5HIN); c.S5HS = (float*)(w + WS_S5HS); c.GL = (float*)(w + WS_GL); c.GLB = (bf16_t*)(w + WS_GLB); c.WGLU_T = (bf16_t*)(w + WS_WGLU); c.QCTR = (unsigned*)(w + WS_CTL) + 8192; c.PART = (float*)(w + WS_PART); c.DNF = (bf16_t*)(w + WS_DNF); c.DNU = (float*)(w + WS_DNU); c.DNE = (float*)(w + WS_DNE); c.S5BF = (bf16_t*)(w + WS_S5BF); c.S5CF = (bf16_t*)(w + WS_S5CF);
    a.bar = (unsigned*)(w + WS_CTL) + 1024;
#if N_LAUNCH_MODE == 1
    a.lo = 0; a.hi = NPH;
    hipLaunchKernelGGL(fwd_kernel, dim3(grid), dim3(NTHREADS), LDS_BYTES, stream, a);
#else
    a.hi = 0; a.lo = 0; launch_phase<0>(a, grid, stream);
    for (int l = 0; l < 2; ++l) { a.lo = l;
        launch_phase<1>(a, grid, stream); launch_phase<2>(a, grid, stream); launch_phase<3>(a, grid, stream); launch_phase<4>(a, grid, stream); launch_phase<5>(a, grid, stream);
        launch_phase<6>(a, grid, stream); launch_phase<7>(a, grid, stream); launch_phase<8>(a, grid, stream); launch_phase<9>(a, grid, stream); launch_phase<10>(a, grid, stream);
        launch_phase<1>(a, grid, stream); launch_phase<11>(a, grid, stream); launch_phase<12>(a, grid, stream); launch_phase<13>(a, grid, stream); }
    a.lo = 0; launch_phase<1>(a, grid, stream); launch_phase<14>(a, grid, stream);
#endif
}
```

```cpp
#include <hip/hip_runtime.h>
#include <cstdio>
#include <cstdint>
#define N_LAUNCH_MODE 1
#define HD __device__ __forceinline__
#ifndef CFG_SEQ
#define CFG_SEQ 8192
#endif
#ifndef CFG_BATCH
#define CFG_BATCH 2
#endif
#ifndef CFG_DB
#define CFG_DB 128
#endif
constexpr int DM = 1024, SEQ = CFG_SEQ, BATCH = CFG_BATCH, DB = CFG_DB, DSEQ = 8, PAST = 2048, PAGE = 128, NPAGES = PAST / PAGE;
constexpr int NUSED = DB * NPAGES, NPHYS = NUSED + (NUSED + 3) / 4;
constexpr int HD_ = 64, NH = 8, NG = 2, NR = 4, NBLK = 64, TOPK = 16, WIN = 512, W0S = PAST - WIN;
constexpr int DNH = 4, DNW = 256, CONVD = 768, S5G = 16, S5P = 64, S5C = 16, DFF = 4096, INW = 2592;
constexpr int TP = BATCH * SEQ, TS = DB * DSEQ, TT = TP + TS;
constexpr int PLD = 2816;
constexpr int C_Q = 0, C_KV = 512, C_GATE = 1280, C_DNQKV = 1304, C_DNA = 2072, C_DNB = 2076, C_DNZ = 2080, C_S5U = 2336;
constexpr int NBP = SEQ / NBLK;
constexpr int NBS_S = 33, NBC_S = 32;
constexpr int NBMAX = (NBP > 64 ? NBP : 64);
constexpr int NSEQ = BATCH + DB;
constexpr int NCH = SEQ / 64;
constexpr int NDU = BATCH * DNH * NCH;
constexpr float NEPS = 1e-6f;
static_assert(NBMAX <= 128, "selection bitmask is 128 bits");

constexpr size_t O_YP = 0, O_YS = O_YP + (size_t)TP * DM, O_KVP = O_YS + (size_t)TS * DM, O_KVS = O_KVP + (size_t)2 * TP * 512,
    O_WINP = O_KVS + (size_t)2 * TS * 512, O_WINS = O_WINP + (size_t)2 * BATCH * 512 * 256, O_CONVP = O_WINS + (size_t)2 * DB * 512 * 256,
    O_CONVS = O_CONVP + (size_t)2 * BATCH * 3 * CONVD, O_DNP = O_CONVS + (size_t)2 * DB * 3 * CONVD, O_DNS = O_DNP + (size_t)2 * BATCH * DNH * 4096,
    O_S5RP = O_DNS + (size_t)2 * DB * DNH * 4096, O_S5RS = O_S5RP + (size_t)2 * BATCH * 1024, O_S5IP = O_S5RS + (size_t)2 * DB * 1024,
    O_S5IS = O_S5IP + (size_t)2 * BATCH * 1024, O_END = O_S5IS + (size_t)2 * DB * 1024;

#ifdef HOST_EMU
typedef float bf16_t;
HD bf16_t tobf(float f) { return f; }
HD float frombf(bf16_t b) { return b; }
#else
typedef unsigned short bf16_t;
HD bf16_t tobf(float f) { unsigned u = __float_as_uint(f); u += 0x7fffu + ((u >> 16) & 1u); return (bf16_t)(u >> 16); }
HD float frombf(bf16_t b) { return __uint_as_float(((unsigned)b) << 16); }
#endif

struct Ctx {
    const float *x_prompt, *x_sample, *cache_nsa, *cache_win, *st_conv, *st_dn, *st_s5re, *st_s5im; const int* page_table;
    const float *ln1, *ln2, *ln_f, *w_in, *w_out, *wck, *wcv, *conv_w, *a_log, *dt_bias, *dn_norm_w, *lam_re, *lam_im, *log_step,
        *b_re, *b_im, *c_re, *c_im, *s5_d, *w_glu, *mlp_up, *mlp_down;
    float* out;
    float* X;
    float* SSQ;
    bf16_t* XN;
    float* PROJ;
    bf16_t* MIXB;
    bf16_t* UPB;
    bf16_t *WIN_T, *WOUT_T, *WUP_T, *WDN_T;
    float *KC, *VC;
    float* PC;
    float* OC;
    int* IDX;
    float *QN, *KN, *VV;
    float *GG, *BETA;
    float* GC;
    float* AM;
    float* AQK;
    float* SOL;
    float* VNEW;
    float* SDN;
    float* ODN;
    float* S5K;
    float* S5BB;
    float* S5E;
    float* S5HIN;
    float* S5HS;
    float* GL;
    bf16_t* GLB;
    bf16_t* WGLU_T;
    unsigned* QCTR;
    bf16_t* DNF;
    float* DNU;
    float* DNE;
    bf16_t* DNG;
    bf16_t* S5BF;
    bf16_t* S5CF;
    float* PART;
};

HD float sigmoidf_(float x) { return 1.0f / (1.0f + expf(-x)); }
HD float siluf_(float x) { return x * sigmoidf_(x); }
HD float softplusf_(float x) { return (x > 0.f ? x : 0.f) + log1pf(expf(-fabsf(x))); }
HD float geluf_(float x) { return 0.5f * x * (1.0f + tanhf(0.7978845608028654f * (x + 0.044715f * x * x * x))); }

#ifdef HOST_EMU
typedef const Ctx& CREF;
#else
typedef const __attribute__((address_space(4))) Ctx& CREF;
#endif
struct Tok { int smp, b, j, t, seq; };
HD Tok tok_of(int r) { Tok k; if (r < TP) { k.smp = 0; k.b = r / SEQ; k.j = r % SEQ; k.t = k.j; k.seq = k.b; } else { r -= TP; k.smp = 1; k.b = r / DSEQ; k.j = r % DSEQ; k.t = PAST + k.j; k.seq = BATCH + k.b; } return k; }

HD const float* kv_ptr(CREF c, int l, int smp, int b, int pos, int slot, int g) {
    if (!smp) return c.PROJ + (size_t)(b * SEQ + pos) * PLD + C_KV + slot * 128 + g * 64;
    if (pos >= PAST) return c.PROJ + (size_t)(TP + b * DSEQ + (pos - PAST)) * PLD + C_KV + slot * 128 + g * 64;
    if (slot < 4) { const int pg = c.page_table[b * NPAGES + pos / PAGE]; return c.cache_nsa + ((((size_t)l * NPHYS + pg) * PAGE + (pos % PAGE)) * 4 + slot) * 128 + g * 64; }
    return c.cache_win + ((((size_t)l * DB + b) * WIN + (pos - W0S)) * 2 + (slot - 4)) * 128 + g * 64;
}

HD void ph_prologue(CREF c, long gtid, long gn) {
    for (long i = gtid; i < (long)2 * PLD * DM; i += gn) { const int l = (int)(i / ((long)PLD * DM)); const long r = i % ((long)PLD * DM); const int n = (int)(r / DM), k = (int)(r % DM);
        c.WIN_T[i] = tobf(n < INW ? c.w_in[((size_t)l * DM + k) * INW + n] : 0.f); }
    for (long i = gtid; i < (long)2 * DM * DM; i += gn) { const int l = (int)(i / ((long)DM * DM)); const long r = i % ((long)DM * DM); const int n = (int)(r / DM), k = (int)(r % DM);
        c.WOUT_T[i] = tobf(c.w_out[((size_t)l * DM + k) * DM + n]); }
    for (long i = gtid; i < (long)2 * DFF * DM; i += gn) { const int l = (int)(i / ((long)DFF * DM)); const long r = i % ((long)DFF * DM); const int n = (int)(r / DM), k = (int)(r % DM);
        c.WUP_T[i] = tobf(c.mlp_up[((size_t)l * DM + k) * DFF + n]); }
    for (long i = gtid; i < (long)2 * DM * DFF; i += gn) { const int l = (int)(i / ((long)DM * DFF)); const long r = i % ((long)DM * DFF); const int n = (int)(r / DFF), k = (int)(r % DFF);
        c.WDN_T[i] = tobf(c.mlp_down[((size_t)l * DFF + k) * DM + n]); }
    for (long i = gtid; i < (long)TT * DM; i += gn) c.X[i] = i < (long)TP * DM ? c.x_prompt[i] : c.x_sample[i - (long)TP * DM];
}
HD void ph_s5_consts(CREF c, long gtid, long gn) {
    for (long i = gtid; i < 2 * S5G * S5P; i += gn) { const int l = (int)(i / (S5G * S5P)), g = (int)((i / S5P) % S5G);
        const double lr = c.lam_re[i], li = c.lam_im[i], dt = exp((double)c.log_step[l * S5G + g]);
        const double mag = exp(lr * dt), ar = mag * cos(li * dt), ai = mag * sin(li * dt), den = lr * lr + li * li;
        const double fr = ((ar - 1.0) * lr + ai * li) / den, fi = (ai * lr - (ar - 1.0) * li) / den;
        double pr = 1.0, pi = 0.0; for (int s = 0; s < 64; ++s) { const double nr = pr * ar - pi * ai, ni = pr * ai + pi * ar; pr = nr; pi = ni; }
        c.S5K[i * 4 + 0] = (float)ar; c.S5K[i * 4 + 1] = (float)ai; c.S5K[i * 4 + 2] = (float)pr; c.S5K[i * 4 + 3] = (float)pi;
        for (int ch = 0; ch < S5C; ++ch) { const double br = c.b_re[i * S5C + ch], bi = c.b_im[i * S5C + ch];
            c.S5BB[(i * S5C + ch) * 2 + 0] = (float)(fr * br - fi * bi); c.S5BB[(i * S5C + ch) * 2 + 1] = (float)(fr * bi + fi * br);
#ifndef HOST_EMU
            {
                const int p = (int)(i % S5P); const size_t lg = (size_t)(i / S5P);
#pragma unroll
                for (int comp = 0; comp < 2; ++comp) { const int s = 2 * p + comp, j = s >> 4, n = s & 15;
                    c.S5BF[((lg * 8 + j) * 64 + n + 16 * (ch >> 3)) * 8 + (ch & 7)] = tobf((float)(comp == 0 ? fr * br - fi * bi : fr * bi + fi * br));
                    if (ch < 8) { c.S5BF[((lg * 8 + j) * 64 + n + 32) * 8 + ch] = 0; c.S5BF[((lg * 8 + j) * 64 + n + 48) * 8 + ch] = 0; }
                    const int k = s, ks = k >> 5, kg = (k & 31) >> 3, jj = k & 7; const size_t ci = ((lg * S5C + ch) * S5P + p);
                    c.S5CF[((lg * 4 + ks) * 64 + ch + 16 * kg) * 8 + jj] = tobf(comp == 0 ? c.c_re[ci] : -c.c_im[ci]); } }
#endif
        } }
}

HD void ph_ssq(CREF c, long gtid, long gn) {
    for (long i = gtid; i < (long)TT * 64; i += gn) { const float* p = c.X + i * 16; float s = 0.f; for (int k = 0; k < 16; ++k) s += p[k] * p[k]; c.SSQ[i] = s; }
}
HD float row_rstd(CREF c, int r) { const float* p = c.SSQ + (size_t)r * 64; float s = 0.f; for (int k = 0; k < 64; ++k) s += p[k]; return 1.0f / sqrtf(s * (1.0f / DM) + NEPS); }
HD void ph_norm(CREF c, const float* gain, long gtid, long gn) {
    for (long i = gtid; i < (long)TT * (DM / 4); i += gn) { const int r = (int)(i / (DM / 4)), c4 = (int)(i % (DM / 4)) * 4; const float rs = row_rstd(c, r);
        for (int k = 0; k < 4; ++k) c.XN[(size_t)r * DM + c4 + k] = tobf(c.X[(size_t)r * DM + c4 + k] * rs * gain[c4 + k]); }
}
HD void ph_final(CREF c, long gtid, long gn) {
    for (long i = gtid; i < (long)TT * (DM / 4); i += gn) { const int r = (int)(i / (DM / 4)), c4 = (int)(i % (DM / 4)) * 4; const float rs = row_rstd(c, r);
        for (int k = 0; k < 4; ++k) c.out[O_YP + (size_t)r * DM + c4 + k] = c.X[(size_t)r * DM + c4 + k] * rs * c.ln_f[c4 + k]; }
}

HD void ph_copy_out(CREF c, int l, long gtid, long gn) {
    for (long i = gtid; i < (long)TT * 512; i += gn) { const int r = (int)(i / 512), k = (int)(i % 512); const float v = c.PROJ[(size_t)r * PLD + C_KV + k];
        if (r < TP) c.out[O_KVP + ((size_t)l * TP + r) * 512 + k] = v; else c.out[O_KVS + ((size_t)l * TS + (r - TP)) * 512 + k] = v; }
    for (long i = gtid; i < (long)BATCH * 512 * 256; i += gn) { const int b = (int)(i / (512 * 256)), w = (int)((i / 256) % 512), k = (int)(i % 256);
        c.out[O_WINP + (size_t)l * BATCH * 512 * 256 + i] = c.PROJ[(size_t)(b * SEQ + SEQ - 512 + w) * PLD + C_KV + 512 + k]; }
    for (long i = gtid; i < (long)DB * 512 * 256; i += gn) { const int b = (int)(i / (512 * 256)), w = (int)((i / 256) % 512), k = (int)(i % 256);
        c.out[O_WINS + (size_t)l * DB * 512 * 256 + i] = (w < 512 - DSEQ) ? c.cache_win[(((size_t)l * DB + b) * 512 + w + DSEQ) * 256 + k]
                                                                          : c.PROJ[(size_t)(TP + b * DSEQ + (w - (512 - DSEQ))) * PLD + C_KV + 512 + k]; }
    for (long i = gtid; i < (long)BATCH * 3 * CONVD; i += gn) { const int b = (int)(i / (3 * CONVD)), w = (int)((i / CONVD) % 3), k = (int)(i % CONVD);
        c.out[O_CONVP + (size_t)l * BATCH * 3 * CONVD + i] = c.PROJ[(size_t)(b * SEQ + SEQ - 3 + w) * PLD + C_DNQKV + k]; }
    for (long i = gtid; i < (long)DB * 3 * CONVD; i += gn) { const int b = (int)(i / (3 * CONVD)), w = (int)((i / CONVD) % 3), k = (int)(i % CONVD);
        c.out[O_CONVS + (size_t)l * DB * 3 * CONVD + i] = c.PROJ[(size_t)(TP + b * DSEQ + DSEQ - 3 + w) * PLD + C_DNQKV + k]; }
}
HD float dn_x(CREF c, int l, const Tok& k, int r, int back, int ch) {
    const int jj = k.j - back;
    if (jj >= 0) return c.PROJ[(size_t)(r - back) * PLD + C_DNQKV + ch];
    if (!k.smp) return 0.f;
    return c.st_conv[(((size_t)l * DB + k.b) * 3 + (3 + jj)) * CONVD + ch];
}
HD float dn_conv1(CREF c, int l, const Tok& k, int r, int ch) {
    const float* w = c.conv_w + ((size_t)l * CONVD + ch) * 4; float y = 0.f;
    for (int j = 0; j < 4; ++j) y += w[j] * dn_x(c, l, k, r, 3 - j, ch);
    return siluf_(y);
}
HD void ph_dn_conv(CREF c, int l, long gtid, long gn, int rbeg = 0) {
    for (long i = gtid + (long)rbeg * 3 * DNH; i < (long)TT * 3 * DNH; i += gn) { const int r = (int)(i / (3 * DNH)), part = (int)((i / DNH) % 3), h = (int)(i % DNH); const Tok k = tok_of(r);
        const int ch0 = part * DNW + h * 64; float ss = 0.f;
        if (part < 2) for (int d = 0; d < 64; ++d) { const float y = dn_conv1(c, l, k, r, ch0 + d); ss += y * y; }
        const float sc = part == 0 ? 0.125f / sqrtf(ss + 1e-6f) : (part == 1 ? 1.0f / sqrtf(ss + 1e-6f) : 1.0f);
        float* dst = (part == 0 ? c.QN : (part == 1 ? c.KN : c.VV)) + ((size_t)r * DNH + h) * 64;
        for (int d = 0; d < 64; ++d) dst[d] = dn_conv1(c, l, k, r, ch0 + d) * sc; }
    for (long i = gtid + (long)rbeg * DNH; i < (long)TT * DNH; i += gn) { const int r = (int)(i / DNH), h = (int)(i % DNH);
        c.BETA[i] = sigmoidf_(c.PROJ[(size_t)r * PLD + C_DNB + h]);
        c.GG[i] = -expf(c.a_log[l * DNH + h]) * softplusf_(c.PROJ[(size_t)r * PLD + C_DNA + h] + c.dt_bias[l * DNH + h]); }
}
HD void ph_pool(CREF c, int l, long gtid, long gn) {
    for (long i = gtid; i < (long)NSEQ * NBMAX * 128; i += gn) { const int seq = (int)(i / (NBMAX * 128)), n = (int)((i / 128) % NBMAX), g = (int)((i / 64) % 2), d = (int)(i % 64);
        const int smp = seq >= BATCH, b = smp ? seq - BATCH : seq; if (n >= (smp ? NBC_S : NBP)) continue;
        float sk = 0.f, sv = 0.f;
        for (int j = 0; j < 64; ++j) { sk += c.wck[(l * 2 + g) * 64 + j] * kv_ptr(c, l, smp, b, n * 64 + j, 0, g)[d]; sv += c.wcv[(l * 2 + g) * 64 + j] * kv_ptr(c, l, smp, b, n * 64 + j, 1, g)[d]; }
        c.KC[i] = sk; c.VC[i] = sv; }
}
HD void s5_scan(CREF c, int l, int g, int p, int r0, int len, float& hr, float& hi, bool store) {
    const float* K = c.S5K + ((size_t)(l * S5G + g) * S5P + p) * 4; const float ar = K[0], ai = K[1];
    const float* bb = c.S5BB + ((size_t)(l * S5G + g) * S5P + p) * S5C * 2;
    for (int t = 0; t < len; ++t) { const float* u = c.PROJ + (size_t)(r0 + t) * PLD + C_S5U + g * S5C; float br = 0.f, bi = 0.f;
        for (int ch = 0; ch < S5C; ++ch) { br += bb[ch * 2] * u[ch]; bi += bb[ch * 2 + 1] * u[ch]; }
        const float nr = ar * hr - ai * hi + br, ni = ar * hi + ai * hr + bi; hr = nr; hi = ni;
        if (store) { float* hs = c.S5HS + (((size_t)(r0 + t) * S5G + g) * S5P + p) * 2; hs[0] = hr; hs[1] = hi; } }
}
HD void ph_s5_passA(CREF c, int l, long gtid, long gn) {
    for (long i = gtid; i < (long)BATCH * NCH * S5G * S5P; i += gn) { const int p = (int)(i % S5P), g = (int)((i / S5P) % S5G), ch = (int)((i / (S5P * S5G)) % NCH), b = (int)(i / ((long)S5P * S5G * NCH));
        float hr = 0.f, hi = 0.f; s5_scan(c, l, g, p, b * SEQ + ch * 64, 64, hr, hi, false); c.S5E[i * 2] = hr; c.S5E[i * 2 + 1] = hi; }
}
HD void ph_dn_gc(CREF c, long gtid, long gn) {
    for (long i = gtid; i < NDU; i += gn) { const int ch = (int)(i % NCH), h = (int)((i / NCH) % DNH), b = (int)(i / (NCH * DNH)); float s = 0.f;
        for (int t = 0; t < 64; ++t) { s += c.GG[(size_t)(b * SEQ + ch * 64 + t) * DNH + h]; c.GC[i * 64 + t] = s; } }
}
HD void ph_cmp(CREF c, int l, long gtid, long gn, int rbeg = 0) {
    for (long i = gtid + (long)rbeg * NH; i < (long)TT * NH; i += gn) { const int r = (int)(i / NH), h = (int)(i % NH), g = h / NR; const Tok k = tok_of(r);
        const float slope = exp2f(-(float)(h + 1)); const int nbv = (k.t + 1) / 64;
        const float* q = c.PROJ + (size_t)r * PLD + C_Q + h * 64; float* pc = c.PC + (size_t)i * NBMAX; float* oc = c.OC + (size_t)i * 64;
        float m = -1e30f;
        for (int n = 0; n < nbv; ++n) { const float* kc = c.KC + (((size_t)k.seq * NBMAX + n) * 2 + g) * 64; float s = 0.f; for (int d = 0; d < 64; ++d) s += q[d] * kc[d];
            s = s * 0.125f - slope * ((float)k.t - ((float)(n * 64) + 31.5f)); pc[n] = s; m = s > m ? s : m; }
        float sum = 0.f; for (int n = 0; n < nbv; ++n) { const float e = expf(pc[n] - m); pc[n] = e; sum += e; }
        const float inv = 1.0f / (sum > 1e-30f ? sum : 1e-30f);
        for (int d = 0; d < 64; ++d) oc[d] = 0.f;
        for (int n = 0; n < nbv; ++n) { const float p = pc[n] * inv; pc[n] = p; const float* vc = c.VC + (((size_t)k.seq * NBMAX + n) * 2 + g) * 64; for (int d = 0; d < 64; ++d) oc[d] += p * vc[d]; }
        for (int n = nbv; n < NBMAX; ++n) pc[n] = 0.f; }
}
HD void ph_s5_carry(CREF c, int l, long gtid, long gn) {
    for (long i = gtid; i < (long)BATCH * S5G * S5P; i += gn) { const int p = (int)(i % S5P), g = (int)((i / S5P) % S5G), b = (int)(i / (S5P * S5G));
        const float* K = c.S5K + ((size_t)(l * S5G + g) * S5P + p) * 4; const float a64r = K[2], a64i = K[3]; float hr = 0.f, hi = 0.f;
        for (int ch = 0; ch < NCH; ++ch) { const size_t e = ((((size_t)b * NCH + ch) * S5G + g) * S5P + p) * 2; c.S5HIN[e] = hr; c.S5HIN[e + 1] = hi;
            const float nr = a64r * hr - a64i * hi + c.S5E[e], ni = a64r * hi + a64i * hr + c.S5E[e + 1]; hr = nr; hi = ni; }
        c.out[O_S5RP + ((size_t)l * BATCH + b) * 1024 + g * S5P + p] = hr; c.out[O_S5IP + ((size_t)l * BATCH + b) * 1024 + g * S5P + p] = hi; }
}
HD void ph_dn_mats(CREF c, long gtid, long gn) {
    for (long i = gtid; i < (long)NDU * 4096; i += gn) { const int u = (int)(i / 4096), ii = (int)((i / 64) % 64), jj = (int)(i % 64);
        const int ch = u % NCH, h = (u / NCH) % DNH, b = u / (NCH * DNH); const int r0 = b * SEQ + ch * 64;
        float am = 0.f, aq = 0.f;
        if (jj <= ii) { const float* ki = c.KN + ((size_t)(r0 + ii) * DNH + h) * 64; const float* kj = c.KN + ((size_t)(r0 + jj) * DNH + h) * 64; const float* qi = c.QN + ((size_t)(r0 + ii) * DNH + h) * 64;
            float kk = 0.f, qk = 0.f; for (int d = 0; d < 64; ++d) { kk += ki[d] * kj[d]; qk += qi[d] * kj[d]; }
            const float dec = expf(c.GC[(size_t)u * 64 + ii] - c.GC[(size_t)u * 64 + jj]);
            aq = qk * dec; if (jj < ii) am = c.BETA[(size_t)(r0 + ii) * DNH + h] * kk * dec; }
        c.AM[i] = am; c.AQK[i] = aq; }
    for (long i = gtid; i < (long)NDU * 64 * 128; i += gn) { const int u = (int)(i / 8192), ii = (int)((i / 128) % 64), col = (int)(i % 128);
        const int ch = u % NCH, h = (u / NCH) % DNH, b = u / (NCH * DNH); const int r = b * SEQ + ch * 64 + ii; const float be = c.BETA[(size_t)r * DNH + h];
        c.SOL[i] = col < 64 ? c.VV[((size_t)r * DNH + h) * 64 + col] * be : c.KN[((size_t)r * DNH + h) * 64 + (col - 64)] * be * expf(c.GC[(size_t)u * 64 + ii]); }
}
HD void ph_topk(CREF c, long gtid, long gn, int rbeg = 0) {
    for (long i = gtid + (long)rbeg * NG; i < (long)TT * NG; i += gn) { const int r = (int)(i / NG), g = (int)(i % NG); const Tok k = tok_of(r);
        const int cur = k.t / 64, nbs = k.smp ? NBS_S : NBP; const float* pc = c.PC + ((size_t)r * NH + g * NR) * NBMAX;
        unsigned long long tk0 = 0ull, tk1 = 0ull; int* idx = c.IDX + (size_t)i * TOPK;
        const int nsel = nbs < TOPK ? nbs : TOPK;
        for (int s = 0; s < TOPK; ++s) { int best = -1; float bv = 0.f;
            if (s < nsel) for (int n = 0; n < nbs; ++n) { const bool taken = n < 64 ? ((tk0 >> n) & 1ull) : ((tk1 >> (n - 64)) & 1ull); if (taken) continue;
                float sc; if (n > cur) sc = -1e9f; else if (n == 0 || n == cur || n == cur - 1) sc = 1e9f; else sc = (pc[n] + pc[NBMAX + n]) + (pc[2 * NBMAX + n] + pc[3 * NBMAX + n]);
                if (best < 0 || sc > bv) { best = n; bv = sc; } }
            if (best >= 0) { if (best < 64) tk0 |= 1ull << best; else tk1 |= 1ull << (best - 64); }
            idx[s] = (best >= 0 && best <= cur) ? best : -1; } }
}
HD void ph_s5_passB(CREF c, int l, long gtid, long gn) {
    for (long i = gtid; i < (long)BATCH * NCH * S5G * S5P; i += gn) { const int p = (int)(i % S5P), g = (int)((i / S5P) % S5G), ch = (int)((i / (S5P * S5G)) % NCH), b = (int)(i / ((long)S5P * S5G * NCH));
        float hr = c.S5HIN[i * 2], hi = c.S5HIN[i * 2 + 1]; s5_scan(c, l, g, p, b * SEQ + ch * 64, 64, hr, hi, true); }
    for (long i = gtid; i < (long)DB * S5G * S5P; i += gn) { const int p = (int)(i % S5P), g = (int)((i / S5P) % S5G), b = (int)(i / (S5P * S5G));
        float hr = c.st_s5re[(size_t)l * DB * 1024 + i], hi = c.st_s5im[(size_t)l * DB * 1024 + i]; s5_scan(c, l, g, p, TP + b * DSEQ, DSEQ, hr, hi, true);
        c.out[O_S5RS + (size_t)l * DB * 1024 + i] = hr; c.out[O_S5IS + (size_t)l * DB * 1024 + i] = hi; }
}
HD void ph_dn_solve(CREF c, long gtid, long gn) {
    for (long i = gtid; i < (long)NDU * 128; i += gn) { const int u = (int)(i / 128), col = (int)(i % 128); float* x = c.SOL + (size_t)u * 8192 + col; const float* A = c.AM + (size_t)u * 4096;
        for (int ii = 1; ii < 64; ++ii) { float s = x[ii * 128]; for (int jj = 0; jj < ii; ++jj) s -= A[ii * 64 + jj] * x[jj * 128]; x[ii * 128] = s; } }
}
HD void ph_attn(CREF c, int l, long gtid, long gn, int rbeg = 0) {
    for (long i = gtid + (long)rbeg * NH; i < (long)TT * NH; i += gn) { const int r = (int)(i / NH), h = (int)(i % NH), g = h / NR; const Tok k = tok_of(r);
        const float slope = exp2f(-(float)(h + 1));
        float q[64];
#pragma unroll
        for (int d = 0; d < 64; ++d) q[d] = c.PROJ[(size_t)r * PLD + C_Q + h * 64 + d] * 0.125f;
        const float* gp = c.PROJ + (size_t)r * PLD + C_GATE + h * 3; const float g0 = sigmoidf_(gp[0]), g1 = sigmoidf_(gp[1]), g2 = sigmoidf_(gp[2]);
        float* oc = c.OC + (size_t)i * 64;
        float o[64]; float m = -1e30f, lsum = 0.f;
#pragma unroll
        for (int d = 0; d < 64; ++d) o[d] = 0.f;
        const int* idx = c.IDX + ((size_t)r * NG + g) * TOPK;
        for (int s = 0; s < TOPK; ++s) { const int n = idx[s]; if (n < 0) continue;
            for (int j = 0; j < 64; ++j) { const int pos = n * 64 + j; if (pos > k.t) break;
                const float* kp = kv_ptr(c, l, k.smp, k.b, pos, 2, g); const float* vp = kv_ptr(c, l, k.smp, k.b, pos, 3, g);
                float sc = 0.f;
#pragma unroll
                for (int d = 0; d < 64; ++d) sc += q[d] * kp[d];
                sc -= slope * (float)(k.t - pos);
                const float mn = sc > m ? sc : m, al = expf(m - mn), p = expf(sc - mn); m = mn; lsum = lsum * al + p;
#pragma unroll
                for (int d = 0; d < 64; ++d) o[d] = o[d] * al + p * vp[d]; } }
        { const float inv = g1 / (lsum > 1e-30f ? lsum : 1e-30f);
#pragma unroll
          for (int d = 0; d < 64; ++d) oc[d] = g0 * oc[d] + inv * o[d]; }
        m = -1e30f; lsum = 0.f;
#pragma unroll
        for (int d = 0; d < 64; ++d) o[d] = 0.f;
        const int w0 = k.smp ? W0S : 0; int p0 = k.t - (WIN - 1); if (p0 < w0) p0 = w0;
        for (int pos = p0; pos <= k.t; ++pos) { const float* kp = kv_ptr(c, l, k.smp, k.b, pos, 4, g); const float* vp = kv_ptr(c, l, k.smp, k.b, pos, 5, g);
            float sc = 0.f;
#pragma unroll
            for (int d = 0; d < 64; ++d) sc += q[d] * kp[d];
            sc -= slope * (float)(k.t - pos);
            const float mn = sc > m ? sc : m, al = expf(m - mn), p = expf(sc - mn); m = mn; lsum = lsum * al + p;
#pragma unroll
            for (int d = 0; d < 64; ++d) o[d] = o[d] * al + p * vp[d]; }
        { const float inv = g2 / (lsum > 1e-30f ? lsum : 1e-30f);
#pragma unroll
          for (int d = 0; d < 64; ++d) c.MIXB[(size_t)r * DM + h * 64 + d] = tobf(oc[d] + inv * o[d]); } }
}
HD void ph_s5_y(CREF c, int l, long gtid, long gn) {
    for (long i = gtid; i < (long)TT * 256; i += gn) { const int r = (int)(i / 256), ch = (int)(i % 256), g = ch / S5C, cc = ch % S5C;
        const float* cr = c.c_re + (((size_t)l * S5G + g) * S5C + cc) * S5P; const float* ci = c.c_im + (((size_t)l * S5G + g) * S5C + cc) * S5P;
        const float* hs = c.S5HS + ((size_t)r * S5G + g) * S5P * 2; float y = 0.f;
        for (int p = 0; p < S5P; ++p) y += cr[p] * hs[2 * p] - ci[p] * hs[2 * p + 1];
        y += c.s5_d[l * 256 + ch] * c.PROJ[(size_t)r * PLD + C_S5U + ch]; c.GL[i] = geluf_(y); }
}
HD void ph_dn_scan_prompt(CREF c, int l, long gtid, long gn) {
    for (long i = gtid; i < (long)BATCH * DNH * 64; i += gn) { const int jc = (int)(i % 64), h = (int)((i / 64) % DNH), b = (int)(i / (64 * DNH));
        float S[64];
#pragma unroll
        for (int kk = 0; kk < 64; ++kk) S[kk] = 0.f;
        float* vn = c.VNEW + (size_t)(b * DNH + h) * 4096 + jc;
        for (int ch = 0; ch < NCH; ++ch) { const int u = (b * DNH + h) * NCH + ch; const int r0 = b * SEQ + ch * 64;
            const float* sol = c.SOL + (size_t)u * 8192; const float* gc = c.GC + (size_t)u * 64; const float* aqk = c.AQK + (size_t)u * 4096;
            for (int t = 0; t < 64; ++t) { const float* w = sol + t * 128 + 64; float s = sol[t * 128 + jc];
#pragma unroll
                for (int kk = 0; kk < 64; ++kk) s -= w[kk] * S[kk];
                vn[t * 64] = s; }
            for (int t = 0; t < 64; ++t) { const float* qq = c.QN + ((size_t)(r0 + t) * DNH + h) * 64; float s = 0.f;
#pragma unroll
                for (int kk = 0; kk < 64; ++kk) s += qq[kk] * S[kk];
                s *= expf(gc[t]);
                for (int t2 = 0; t2 <= t; ++t2) s += aqk[t * 64 + t2] * vn[t2 * 64];
                c.ODN[((size_t)(r0 + t) * DNH + h) * 64 + jc] = s; }
            const float gl = gc[63], eg = expf(gl);
#pragma unroll
            for (int kk = 0; kk < 64; ++kk) S[kk] *= eg;
            for (int t = 0; t < 64; ++t) { const float* kk_ = c.KN + ((size_t)(r0 + t) * DNH + h) * 64; const float f = expf(gl - gc[t]) * vn[t * 64];
#pragma unroll
                for (int kk = 0; kk < 64; ++kk) S[kk] += kk_[kk] * f; } }
#pragma unroll
        for (int kk = 0; kk < 64; ++kk) c.out[O_DNP + (((size_t)l * BATCH + b) * DNH + h) * 4096 + kk * 64 + jc] = S[kk]; }
}
HD void ph_dn_scan_sample(CREF c, int l, long gtid, long gn) {
    for (long i = gtid; i < (long)DB * DNH * 64; i += gn) { const int jc = (int)(i % 64), h = (int)((i / 64) % DNH), b = (int)(i / (64 * DNH));
        float S[64]; const float* s0 = c.st_dn + (((size_t)l * DB + b) * DNH + h) * 4096 + jc;
#pragma unroll
        for (int kk = 0; kk < 64; ++kk) S[kk] = s0[kk * 64];
        for (int t = 0; t < DSEQ; ++t) { const int r = TP + b * DSEQ + t; const float* kv = c.KN + ((size_t)r * DNH + h) * 64; const float* qq = c.QN + ((size_t)r * DNH + h) * 64;
            const float a = expf(c.GG[(size_t)r * DNH + h]), be = c.BETA[(size_t)r * DNH + h]; float ks = 0.f;
#pragma unroll
            for (int kk = 0; kk < 64; ++kk) { S[kk] *= a; ks += kv[kk] * S[kk]; }
            const float vnw = be * (c.VV[((size_t)r * DNH + h) * 64 + jc] - ks); float os = 0.f;
#pragma unroll
            for (int kk = 0; kk < 64; ++kk) { S[kk] += kv[kk] * vnw; os += qq[kk] * S[kk]; }
            c.ODN[((size_t)r * DNH + h) * 64 + jc] = os; }
#pragma unroll
        for (int kk = 0; kk < 64; ++kk) c.out[O_DNS + (((size_t)l * DB + b) * DNH + h) * 4096 + kk * 64 + jc] = S[kk]; }
}
HD void ph_s5_glu(CREF c, int l, long gtid, long gn) {
    for (long i = gtid; i < (long)TT * 256; i += gn) { const int r = (int)(i / 256), ch = (int)(i % 256); const float* gl = c.GL + (size_t)r * 256; const float* w = c.w_glu + (size_t)l * 65536 + ch; float z = 0.f;
        for (int kk = 0; kk < 256; ++kk) z += gl[kk] * w[kk * 256];
        c.MIXB[(size_t)r * DM + 768 + ch] = tobf(gl[ch] * sigmoidf_(z)); }
}
HD void ph_dn_out(CREF c, int l, long gtid, long gn) {
    for (long i = gtid; i < (long)TT * DNH; i += gn) { const int r = (int)(i / DNH), h = (int)(i % DNH); const float* o = c.ODN + (size_t)i * 64; float ss = 0.f;
        for (int d = 0; d < 64; ++d) ss += o[d] * o[d];
        const float rs = 1.0f / sqrtf(ss * (1.0f / 64.0f) + NEPS);
        for (int d = 0; d < 64; ++d) c.MIXB[(size_t)r * DM + 512 + h * 64 + d] = tobf(o[d] * rs * c.dn_norm_w[l * 64 + d] * siluf_(c.PROJ[(size_t)r * PLD + C_DNZ + h * 64 + d])); }
}
namespace pg8 {
#define PG8_LAS __attribute__((address_space(3)))
typedef unsigned short bf16_t;
typedef short bf16x8 __attribute__((ext_vector_type(8)));
typedef float f32x4 __attribute__((ext_vector_type(4)));
typedef unsigned u32x4 __attribute__((ext_vector_type(4)));
constexpr int BM = 256, BK = 64, HALF = 128, HTB = HALF * BK * 2  , STAGE_BYTES = 8 * HTB, NXCD = 8, WGM = 8;

__host__ __device__ __forceinline__ int lds_byte(int r, int c) { const int st = (r >> 4) * 2 + (c >> 5), rr = r & 15, cc = c & 31, ob = rr * 64 + cc * 2; return st * 1024 + (ob ^ (((ob >> 9) & 1) << 5)); }
__host__ __device__ __forceinline__ void stage_rc(int b, int& R, int& C) { const int st = b / 1024, sb = b % 1024, swz = sb ^ (((sb >> 9) & 1) << 5); R = (st >> 1) * 16 + swz / 64; C = (st & 1) * 32 + (swz % 64) / 2; }
__host__ __device__ __forceinline__ int perm32(int rho) { const int n = rho >> 4, i = rho & 15; return 8 * (i >> 2) + 4 * n + (i & 3); }

struct Unit { int pm, pn; };
struct Gemm { const bf16_t* A; const bf16_t* Bt; int M, N, K, ld; };

struct StaticOrder {
    int nM, nN, nwg, G, c;
    __host__ __device__ void init(int M, int N, int G_, int c_) { nM = M / BM; nN = N / BM; nwg = nM * nN; G = G_; c = c_; }
    __host__ __device__ bool next(int i, Unit& u) const {
        const long L = (long)i * G + c; if (L >= nwg) return false;
        int wgid = (int)L; { const int q = nwg / NXCD, r = nwg % NXCD, xcd = wgid % NXCD, off = wgid / NXCD; wgid = (xcd < r ? xcd * (q + 1) : r * (q + 1) + (xcd - r) * q) + off; }
        const int nig = WGM * nN, gid = wgid / nig, fm = gid * WGM, gsz = (nM - fm) < WGM ? (nM - fm) : WGM;
        u.pm = fm + ((wgid % nig) % gsz); u.pn = (wgid % nig) / gsz; return true;
    }
    __device__ __forceinline__ void a_ready(const Unit&) const {}
    __device__ __forceinline__ void done(const Unit&) const {}
};

__device__ __forceinline__ unsigned cvt_pk_bf16(float lo, float hi) { unsigned r; asm volatile("v_cvt_pk_bf16_f32 %0, %1, %2" : "=v"(r) : "v"(lo), "v"(hi)); return r; }
typedef float f32x2 __attribute__((ext_vector_type(2)));
template <class Epi, class Sched, bool ALIGN_EPI = false, bool SP2 = false>
__device__ __forceinline__ void gemm_phase(PG8_LAS unsigned char* lds, const Gemm g, const Sched& S, const Epi& E, int tid_) {
    asm volatile("" : "+v"(tid_));
    const int tid = tid_, wid = __builtin_amdgcn_readfirstlane(tid >> 6), lane = tid & 63, wr = wid >> 2, wc = wid & 3, fr = lane & 15, fq = lane >> 4;
    const int K = g.K, nt = K / BK;
    unsigned voffA[2], voffB[2];
#pragma unroll
    for (int i = 0; i < 2; ++i) { int R, C; stage_rc(tid * 16 + i * 8192, R, C); const int Rb = Epi::PERM ? ((R & ~31) + perm32(R & 31)) : R;
        voffA[i] = (unsigned)(R * g.ld + C) * 2u; voffB[i] = (unsigned)(Rb * g.ld + C) * 2u; }
    const size_t kstep = (size_t)(BK * 2);
    const size_t hstep = (size_t)HALF * g.ld * 2;
    const size_t tstep = 2 * hstep;
    const unsigned ldsw = (unsigned)wid * 1024u;
    const int aoff = lds_byte(wr * 64 + fr, fq * 8), boff = lds_byte(wc * 32 + fr, fq * 8);
#define PG8_SA(b, h) (((b) * 2 + (h)) * HTB)
#define PG8_SB(b, h) ((4 + (b) * 2 + (h)) * HTB)
#define PG8_STAGE(bufoff, gbase, voff) do { _Pragma("unroll") for (int _i = 0; _i < 2; ++_i) \
        __builtin_amdgcn_global_load_lds((const unsigned*)((const char*)(gbase) + (voff)[_i]), (PG8_LAS unsigned*)(lds + (bufoff) + ldsw + _i * 8192), 16, 0, 0); } while (0)
#define PG8_LDA(dst, b, h) do { _Pragma("unroll") for (int m = 0; m < 4; ++m) _Pragma("unroll") for (int k = 0; k < 2; ++k) dst[m][k] = *(const PG8_LAS bf16x8*)(lds + PG8_SA(b, h) + aoff + m * 2048 + k * 1024); } while (0)
#define PG8_LDB(dst, b, h) do { _Pragma("unroll") for (int n = 0; n < 2; ++n) _Pragma("unroll") for (int k = 0; k < 2; ++k) dst[n][k] = *(const PG8_LAS bf16x8*)(lds + PG8_SB(b, h) + boff + n * 2048 + k * 1024); } while (0)
#define PG8_MMA(ai, bj, At, Bt) do { __builtin_amdgcn_s_setprio(1); _Pragma("unroll") for (int m = 0; m < 4; ++m) _Pragma("unroll") for (int n = 0; n < 2; ++n) _Pragma("unroll") for (int k = 0; k < 2; ++k) \
        acc[ai][bj][m][n] = __builtin_amdgcn_mfma_f32_16x16x32_bf16(Bt[n][k], At[m][k], acc[ai][bj][m][n], 0, 0, 0); __builtin_amdgcn_s_setprio(0); } while (0)
#define PG8_WAIT_V(n) asm volatile("s_waitcnt vmcnt(" #n ")" ::: "memory")
#define PG8_WAIT_L(n) asm volatile("s_waitcnt lgkmcnt(" #n ")" ::: "memory")
#define PG8_BAR __builtin_amdgcn_s_barrier()
#define PG8_SCHED __builtin_amdgcn_sched_barrier(0)
    Unit cur, nxt; int ui = 0;
    if (!S.next(0, cur)) return;
    f32x4 acc[2][2][4][2];
#pragma unroll
    for (int a = 0; a < 2; ++a)
#pragma unroll
        for (int b = 0; b < 2; ++b)
#pragma unroll
            for (int m = 0; m < 4; ++m)
#pragma unroll
                for (int n = 0; n < 2; ++n) acc[a][b][m][n] = (f32x4){0.f, 0.f, 0.f, 0.f};
    bf16x8 At[4][2], B0[2][2], B1[2][2];
    const char* cA = (const char*)g.A + (size_t)cur.pm * tstep; const char* cB = (const char*)g.Bt + (size_t)cur.pn * tstep;
    S.a_ready(cur);
    if constexpr (SP2) {
        PG8_STAGE(PG8_SB(0, 0), cB, voffB); PG8_STAGE(PG8_SB(0, 1), cB + hstep, voffB); PG8_STAGE(PG8_SA(0, 0), cA, voffA); PG8_STAGE(PG8_SA(0, 1), cA + hstep, voffA);
        if (wr == 1) PG8_BAR;
        PG8_WAIT_V(2); PG8_BAR;
        PG8_STAGE(PG8_SB(1, 0), cB + kstep, voffB); PG8_STAGE(PG8_SA(1, 0), cA + kstep, voffA); PG8_STAGE(PG8_SB(1, 1), cB + hstep + kstep, voffB);
        PG8_WAIT_V(6); PG8_BAR;
    } else {
        PG8_STAGE(PG8_SB(0, 0), cB, voffB); PG8_STAGE(PG8_SA(0, 0), cA, voffA); PG8_STAGE(PG8_SB(0, 1), cB + hstep, voffB); PG8_STAGE(PG8_SA(0, 1), cA + hstep, voffA);
        if (wr == 1) PG8_BAR;
        PG8_WAIT_V(4); PG8_BAR;
        PG8_STAGE(PG8_SB(1, 0), cB + kstep, voffB); PG8_STAGE(PG8_SA(1, 0), cA + kstep, voffA); PG8_STAGE(PG8_SB(1, 1), cB + hstep + kstep, voffB);
        PG8_WAIT_V(6); PG8_BAR;
    }
    for (;;) {
        const bool has_next = S.next(ui + 1, nxt);
        const char* nA = has_next ? (const char*)g.A + (size_t)nxt.pm * tstep : cA; const char* nB = has_next ? (const char*)g.Bt + (size_t)nxt.pn * tstep : cB;
        for (int t = 0; t < nt; t += 2) {
            const bool last = (t == nt - 2);
            const char* a1 = cA + (size_t)(t + 1) * kstep;
            const char* a2 = last ? nA : cA + (size_t)(t + 2) * kstep; const char* b2 = last ? nB : cB + (size_t)(t + 2) * kstep;
            const char* a3 = a2 + kstep; const char* b3 = b2 + kstep;
            if (last && has_next) S.a_ready(nxt);
            if constexpr (SP2) {
            PG8_LDB(B0, 0, 0); PG8_LDB(B1, 0, 1); PG8_SCHED; PG8_LDA(At, 0, 0); PG8_STAGE(PG8_SA(1, 1), a1 + hstep, voffA);
            PG8_WAIT_V(8); PG8_WAIT_L(0); PG8_BAR; PG8_MMA(0, 0, At, B0); PG8_MMA(0, 1, At, B1); PG8_BAR; PG8_SCHED;
            PG8_LDA(At, 0, 1); PG8_STAGE(PG8_SB(0, 0), b2, voffB); PG8_STAGE(PG8_SB(0, 1), b2 + hstep, voffB); PG8_STAGE(PG8_SA(0, 0), a2, voffA);
            PG8_WAIT_V(8); PG8_WAIT_L(0); PG8_BAR; PG8_MMA(1, 0, At, B0); PG8_MMA(1, 1, At, B1); PG8_BAR; PG8_SCHED;
            PG8_LDB(B0, 1, 0); PG8_LDB(B1, 1, 1); PG8_SCHED; PG8_LDA(At, 1, 0); PG8_STAGE(PG8_SA(0, 1), a2 + hstep, voffA);
            PG8_WAIT_V(8); PG8_WAIT_L(0); PG8_BAR; PG8_MMA(0, 0, At, B0); PG8_MMA(0, 1, At, B1); PG8_BAR; PG8_SCHED;
            PG8_LDA(At, 1, 1); PG8_STAGE(PG8_SB(1, 0), b3, voffB); PG8_STAGE(PG8_SB(1, 1), b3 + hstep, voffB); PG8_STAGE(PG8_SA(1, 0), a3, voffA);
            PG8_WAIT_V(8); PG8_WAIT_L(0); PG8_BAR; PG8_MMA(1, 0, At, B0); PG8_MMA(1, 1, At, B1); PG8_BAR; PG8_SCHED;
            } else {
            PG8_LDB(B0, 0, 0); PG8_SCHED; PG8_LDA(At, 0, 0); PG8_STAGE(PG8_SA(1, 1), a1 + hstep, voffA);
            PG8_WAIT_L(8); PG8_BAR; PG8_WAIT_L(0); PG8_MMA(0, 0, At, B0); PG8_BAR; PG8_SCHED;
            PG8_LDB(B1, 0, 1); PG8_STAGE(PG8_SB(0, 0), b2, voffB);
            PG8_BAR; PG8_WAIT_L(0); PG8_MMA(0, 1, At, B1); PG8_BAR;
            PG8_LDA(At, 0, 1); PG8_STAGE(PG8_SA(0, 0), a2, voffA);
            PG8_BAR; PG8_WAIT_L(0); PG8_MMA(1, 0, At, B0); PG8_BAR; PG8_SCHED;
            PG8_STAGE(PG8_SB(0, 1), b2 + hstep, voffB);
            PG8_WAIT_V(6); PG8_BAR; PG8_MMA(1, 1, At, B1); PG8_BAR;
            PG8_LDB(B0, 1, 0); PG8_SCHED; PG8_LDA(At, 1, 0); PG8_STAGE(PG8_SA(0, 1), a2 + hstep, voffA);
            PG8_WAIT_L(8); PG8_BAR; PG8_WAIT_L(0); PG8_MMA(0, 0, At, B0); PG8_BAR; PG8_SCHED;
            PG8_LDB(B1, 1, 1); PG8_STAGE(PG8_SB(1, 0), b3, voffB);
            PG8_BAR; PG8_WAIT_L(0); PG8_MMA(0, 1, At, B1); PG8_BAR;
            PG8_LDA(At, 1, 1); PG8_STAGE(PG8_SA(1, 0), a3, voffA);
            PG8_BAR; PG8_WAIT_L(0); PG8_MMA(1, 0, At, B0); PG8_BAR; PG8_SCHED;
            PG8_STAGE(PG8_SB(1, 1), b3 + hstep, voffB);
            PG8_WAIT_V(6); PG8_BAR; PG8_MMA(1, 1, At, B1); PG8_BAR;
            }
        }
        if constexpr (ALIGN_EPI) { if (wr == 0) PG8_BAR; }
        if constexpr (!Epi::AFTER_DRAIN) { E(acc, cur, wr, wc, fr, fq); S.done(cur); }
        if (!has_next) break;
#pragma unroll
        for (int a = 0; a < 2; ++a)
#pragma unroll
            for (int b = 0; b < 2; ++b)
#pragma unroll
                for (int m = 0; m < 4; ++m)
#pragma unroll
                    for (int n = 0; n < 2; ++n) acc[a][b][m][n] = (f32x4){0.f, 0.f, 0.f, 0.f};
        cur = nxt; cA = nA; cB = nB; ++ui;
        if constexpr (ALIGN_EPI) { if (wr == 1) PG8_BAR; }
    }
    PG8_WAIT_V(0);
    if constexpr (!ALIGN_EPI) { if (wr == 0) PG8_BAR; }
    PG8_BAR;
    if constexpr (Epi::AFTER_DRAIN) { E.fused(acc, cur, wr, wc, fr, fq, lds, wid, lane); S.done(cur); }
#undef PG8_SA
#undef PG8_SB
#undef PG8_STAGE
#undef PG8_LDA
#undef PG8_LDB
#undef PG8_MMA
#undef PG8_WAIT_V
#undef PG8_WAIT_L
#undef PG8_BAR
#undef PG8_SCHED
}
}
#define LAS __attribute__((address_space(3)))
typedef short bf16x8_t __attribute__((ext_vector_type(8)));
typedef float f32x4_t __attribute__((ext_vector_type(4)));
typedef float f32x2_t __attribute__((ext_vector_type(2)));
typedef __bf16 bf16x2_t __attribute__((ext_vector_type(2)));
typedef unsigned u32x4_t __attribute__((ext_vector_type(4)));
typedef unsigned u32x2_t __attribute__((ext_vector_type(2)));
#define DEV __device__ __forceinline__
DEV unsigned cvtpk(float lo, float hi) { f32x2_t v = {lo, hi}; bf16x2_t b = __builtin_convertvector(v, bf16x2_t); return __builtin_bit_cast(unsigned, b); }
DEV bf16x8_t pack8(const f32x4_t a, const f32x4_t b) { u32x4_t p = {cvtpk(a[0], a[1]), cvtpk(a[2], a[3]), cvtpk(b[0], b[1]), cvtpk(b[2], b[3])}; return __builtin_bit_cast(bf16x8_t, p); }
#define MFMA16(a, b, c) __builtin_amdgcn_mfma_f32_16x16x32_bf16((a), (b), (c), 0, 0, 0)
template <int CTRL> DEV float dppf(float x) { return __builtin_bit_cast(float, __builtin_amdgcn_mov_dpp(__builtin_bit_cast(int, x), CTRL, 0xF, 0xF, true)); }
template <int CTRL> DEV int dppi(int x) { return __builtin_amdgcn_mov_dpp(x, CTRL, 0xF, 0xF, true); }
constexpr int DPP_X1 = 0xB1, DPP_X2 = 0x4E, DPP_HM = 0x141, DPP_RM = 0x140;

constexpr int DNS_FB = 8192, DNS_US = 68, DNS_EG = 4 * DNS_FB + 64 * DNS_US * 4, DNS_GT = DNS_EG + 16, DNS_BUF = DNS_GT + 64 * 136;
static_assert(2 * DNS_BUF + 2048 + 2 * 64 * 144 <= 147456 - 256, "DeltaNet scan LDS (the last 256 bytes are the control words)");
struct DnStage { u32x4_t fr[8]; f32x4_t ut[4]; u32x4_t gt[2]; float eg; };
DEV void dn_scan_load(CREF c, DnStage& st, int u, int pt) {
    const u32x4_t* f = (const u32x4_t*)(c.DNF + (size_t)u * 16384) + pt; const f32x4_t* uq = (const f32x4_t*)(c.DNU + (size_t)u * 4096) + pt;
#pragma unroll
    for (int k = 0; k < 8; ++k) st.fr[k] = f[256 * k];
#pragma unroll
    for (int k = 0; k < 4; ++k) st.ut[k] = uq[256 * k];
    const u32x4_t* gq = (const u32x4_t*)(c.DNG + (size_t)u * 4096) + pt; st.gt[0] = gq[0]; st.gt[1] = gq[256];
    st.eg = c.DNE[u];
}
DEV void dn_scan_store(const DnStage& st, LAS unsigned char* dst, int pt) {
#pragma unroll
    for (int k = 0; k < 8; ++k) *(LAS u32x4_t*)(dst + (pt + 256 * k) * 16) = st.fr[k];
#pragma unroll
    for (int k = 0; k < 4; ++k) { const int idx = pt + 256 * k, v = idx & 63, tq = idx >> 6; *(LAS f32x4_t*)(dst + 4 * DNS_FB + (v * DNS_US + 4 * tq) * 4) = st.ut[k]; }
#pragma unroll
    for (int k = 0; k < 2; ++k) { const int e = (pt + 256 * k) * 2, tq = e >> 6, v = e & 63;
        *(LAS u32x2_t*)(dst + DNS_GT + v * 136 + tq * 8) = (u32x2_t){st.gt[k][0], st.gt[k][1]}; *(LAS u32x2_t*)(dst + DNS_GT + (v + 1) * 136 + tq * 8) = (u32x2_t){st.gt[k][2], st.gt[k][3]}; }
    if (pt == 0) *(LAS float*)(dst + DNS_EG) = st.eg;
}
DEV void dn_scan_consume(const LAS unsigned char* buf, f32x4_t (&S)[4], f32x4_t (&O)[4], LAS float* ssw, int v, int lane, int kb) {
    const LAS unsigned char* fb = buf + lane * 16;
    const LAS float* ut = (const LAS float*)(buf + 4 * DNS_FB) + v * DNS_US + 4 * kb;
#define DNS_FR(mat, mt, ks) (*(const LAS bf16x8_t*)(fb + (mat) * DNS_FB + ((mt) * 2 + (ks)) * 1024))
    const float eg = *(const LAS float*)(buf + DNS_EG);
    const bf16x8_t Sb0 = pack8(S[0], S[1]), Sb1 = pack8(S[2], S[3]);
    f32x4_t ws[4], qs[4], ds[4], vn[4];
    const f32x4_t z4 = {0.f, 0.f, 0.f, 0.f};
#pragma unroll
    for (int mt = 0; mt < 4; ++mt) { ws[mt] = MFMA16(DNS_FR(0, mt, 0), Sb0, z4); ws[mt] = MFMA16(DNS_FR(0, mt, 1), Sb1, ws[mt]);
                                     qs[mt] = MFMA16(DNS_FR(1, mt, 0), Sb0, z4); qs[mt] = MFMA16(DNS_FR(1, mt, 1), Sb1, qs[mt]); }
#pragma unroll
    for (int mt = 0; mt < 4; ++mt) vn[mt] = *(const LAS f32x4_t*)(ut + 16 * mt) - ws[mt];
    const bf16x8_t Vb0 = pack8(vn[0], vn[1]), Vb1 = pack8(vn[2], vn[3]);
#pragma unroll
    for (int mt = 0; mt < 4; ++mt) { qs[mt] = MFMA16(DNS_FR(2, mt, 0), Vb0, qs[mt]); qs[mt] = MFMA16(DNS_FR(2, mt, 1), Vb1, qs[mt]);
                                     ds[mt] = MFMA16(DNS_FR(3, mt, 0), Vb0, z4); ds[mt] = MFMA16(DNS_FR(3, mt, 1), Vb1, ds[mt]); }
#pragma unroll
    for (int mt = 0; mt < 4; ++mt) { S[mt] = S[mt] * eg + ds[mt]; O[mt] = qs[mt];
        f32x4_t q2 = qs[mt] * qs[mt];
#pragma unroll
        for (int i = 0; i < 4; ++i) { float s = q2[i]; s += dppf<DPP_X1>(s); s += dppf<DPP_X2>(s); s += dppf<DPP_HM>(s); s += dppf<DPP_RM>(s); q2[i] = s; }
        if ((lane & 15) == 0) *(LAS f32x4_t*)(ssw + 16 * mt + 4 * kb) = q2; }
#undef DNS_FR
}
constexpr int DNS_OTS = 144, DNS_OT = 64 * DNS_OTS;
DEV void dn_scan_finish(const f32x4_t (&O)[4], const f32x4_t (&Z)[4], const LAS float* ss, LAS unsigned char* ot, int v, int kb) {
#pragma unroll
    for (int mt = 0; mt < 4; ++mt) { const LAS float* sp = ss + 16 * mt + 4 * kb;
        const f32x4_t tot = (*(const LAS f32x4_t*)sp + *(const LAS f32x4_t*)(sp + 64)) + (*(const LAS f32x4_t*)(sp + 128) + *(const LAS f32x4_t*)(sp + 192));
#pragma unroll
        for (int i = 0; i < 4; ++i) *(LAS bf16_t*)(ot + (16 * mt + 4 * kb + i) * DNS_OTS + v * 2) = tobf(O[mt][i] * __builtin_amdgcn_rsqf(tot[i] * (1.0f / 64.0f) + NEPS) * Z[mt][i]); }
}
DEV void dn_scan_flush(CREF c, const LAS unsigned char* ot, int r0, int h, int ct) {
#pragma unroll
    for (int k = 0; k < 2; ++k) { const int p = ct + 256 * k, tok = p >> 3, seg = p & 7;
        *(u32x4_t*)(c.MIXB + (size_t)(r0 + tok) * DM + 512 + h * 64 + seg * 8) = *(const LAS u32x4_t*)(ot + tok * DNS_OTS + seg * 16); }
}
DEV void dn_scan_mfma(CREF c, int l, LAS unsigned char* L, int bh, int tid) {
    asm volatile("" : "+v"(tid));
    const int b = bh / DNH, h = bh % DNH, wid = tid >> 6, lane = tid & 63, n = lane & 15, kb = lane >> 4;
    const bool producer = wid >= 4;
    const int v = 16 * (wid & 3) + n;
    f32x4_t S[4];
#pragma unroll
    for (int mt = 0; mt < 4; ++mt) S[mt] = (f32x4_t){0.f, 0.f, 0.f, 0.f};
    const int u0 = (b * DNH + h) * NCH, rb = b * SEQ, pt = tid - 256;
    if (producer) {
        DnStage s0, s1, s2;
        dn_scan_load(c, s0, u0, pt); dn_scan_store(s0, L, pt);
        dn_scan_load(c, s0, u0 + 1, pt); dn_scan_load(c, s1, u0 + 2, pt); dn_scan_load(c, s2, u0 + 3, pt);
#define DNS_STEP(st, ch_) { __syncthreads(); if ((ch_) + 1 < NCH) { dn_scan_store(st, L + (((ch_) + 1) & 1) * DNS_BUF, pt); if ((ch_) + 4 < NCH) dn_scan_load(c, st, u0 + (ch_) + 4, pt); } }
        static_assert(NCH % 6 == 2, "producer loop tail");
        for (int ch = 0; ch < NCH - 2; ch += 3) { DNS_STEP(s0, ch) DNS_STEP(s1, ch + 1) DNS_STEP(s2, ch + 2) }
        DNS_STEP(s0, NCH - 2) DNS_STEP(s1, NCH - 1)
#undef DNS_STEP
        __syncthreads(); __syncthreads();
    } else {
        LAS float* SS = (LAS float*)(L + 2 * DNS_BUF);
        LAS unsigned char* OT = L + 2 * DNS_BUF + 2048;
        f32x4_t O[4], Op[4], Z[4];
#define DNS_ZLOAD(bufoff_) { _Pragma("unroll") for (int mt = 0; mt < 4; ++mt) { const u32x2_t w = *(const LAS u32x2_t*)(L + (bufoff_) + DNS_GT + v * 136 + (4 * mt + kb) * 8); \
            Z[mt] = (f32x4_t){__uint_as_float(w[0] << 16), __uint_as_float(w[0] & 0xffff0000u), __uint_as_float(w[1] << 16), __uint_as_float(w[1] & 0xffff0000u)}; } }
#define DNS_CSTEP(ch_, bufoff) { __syncthreads(); \
            if ((ch_) > 1) dn_scan_flush(c, OT + ((ch_) & 1) * DNS_OT, rb + ((ch_) - 2) * 64, h, tid); \
            if ((ch_) > 0) dn_scan_finish(Op, Z, SS + (((ch_) - 1) & 1) * 256, OT + (((ch_) - 1) & 1) * DNS_OT, v, kb); \
            DNS_ZLOAD(bufoff) \
            dn_scan_consume(L + (bufoff), S, O, SS + ((ch_) & 1) * 256 + (wid & 3) * 64, v, lane, kb); \
            _Pragma("unroll") for (int mt = 0; mt < 4; ++mt) Op[mt] = O[mt]; }
        for (int ch = 0; ch < NCH; ch += 2) { DNS_CSTEP(ch, 0) DNS_CSTEP(ch + 1, DNS_BUF) }
        __syncthreads();
        dn_scan_flush(c, OT + (NCH & 1) * DNS_OT, rb + (NCH - 2) * 64, h, tid);
        dn_scan_finish(Op, Z, SS + ((NCH - 1) & 1) * 256, OT + ((NCH - 1) & 1) * DNS_OT, v, kb);
        __syncthreads();
        dn_scan_flush(c, OT + ((NCH - 1) & 1) * DNS_OT, rb + (NCH - 1) * 64, h, tid);
#undef DNS_CSTEP
#undef DNS_ZLOAD
    }
    if (!producer) {
#pragma unroll
        for (int mt = 0; mt < 4; ++mt)
#pragma unroll
            for (int i = 0; i < 4; ++i) c.out[O_DNP + (((size_t)l * BATCH + b) * DNH + h) * 4096 + (16 * mt + 4 * kb + i) * 64 + v] = S[mt][i];
    }
    __syncthreads();
}

DEV float wave_sum(float v) {
    v += dppf<DPP_X1>(v); v += dppf<DPP_X2>(v); v += dppf<DPP_HM>(v); v += dppf<DPP_RM>(v); v += __shfl_xor(v, 16); v += __shfl_xor(v, 32);
    return v;
}
DEV void transpose_item(const float* W, int K, int N, bf16_t* WT, LAS float* scr, int item, int lane) {
    const int nblk = N / 32, kb = item / nblk, nb = item % nblk, k0 = 64 * kb, n0 = 32 * nb;
#pragma unroll
    for (int i = 0; i < 32; ++i) { const int kk = 2 * i + (lane >> 5); scr[kk * 33 + (lane & 31)] = W[(size_t)(k0 + kk) * N + n0 + (lane & 31)]; }
    asm volatile("s_waitcnt lgkmcnt(0)" ::: "memory");
    const int cch = lane & 7;
#pragma unroll
    for (int j = 0; j < 4; ++j) { const int n = (lane >> 3) + 8 * j; const LAS float* s = scr + (8 * cch) * 33 + n;
        u32x4_t o; o.x = cvtpk(s[0 * 33], s[1 * 33]); o.y = cvtpk(s[2 * 33], s[3 * 33]); o.z = cvtpk(s[4 * 33], s[5 * 33]); o.w = cvtpk(s[6 * 33], s[7 * 33]);
        *(u32x4_t*)(WT + (size_t)(n0 + n) * K + k0 + 8 * cch) = o; }
    asm volatile("s_waitcnt lgkmcnt(0)" ::: "memory");
}
DEV void dev_s5_consts(CREF c, long gtid, long gn) {
    for (long t = gtid; t < (long)2 * S5G * S5P * S5C; t += gn) { const long i = t >> 4; const int ch = (int)(t & 15); const int l = (int)(i / (S5G * S5P)), g = (int)((i / S5P) % S5G), p = (int)(i % S5P); const size_t lg = (size_t)(i / S5P);
        const float lr = c.lam_re[i], li = c.lam_im[i], dt = expf(c.log_step[l * S5G + g]);
        const float zr = lr * dt, zi = li * dt, mag = expf(zr), cz = cosf(zi), sz = sinf(zi), sh = sinf(0.5f * zi);
        const float ar = mag * cz, ai = mag * sz, am1 = expm1f(zr) * cz - 2.0f * sh * sh, den = lr * lr + li * li;
        const float fr = (am1 * lr + ai * li) / den, fi = (ai * lr - am1 * li) / den;
        if (ch == 0) { float pr = ar, pi = ai;
#pragma unroll
            for (int s = 0; s < 6; ++s) { const float nr = pr * pr - pi * pi, ni = 2.0f * pr * pi; pr = nr; pi = ni; }
            c.S5K[i * 4 + 0] = ar; c.S5K[i * 4 + 1] = ai; c.S5K[i * 4 + 2] = pr; c.S5K[i * 4 + 3] = pi; }
        const float br = c.b_re[i * S5C + ch], bi = c.b_im[i * S5C + ch]; const float bbr = fr * br - fi * bi, bbi = fr * bi + fi * br;
        c.S5BB[(i * S5C + ch) * 2 + 0] = bbr; c.S5BB[(i * S5C + ch) * 2 + 1] = bbi;
#pragma unroll
        for (int comp = 0; comp < 2; ++comp) { const int s = 2 * p + comp, j = s >> 4, n = s & 15;
            c.S5BF[((lg * 8 + j) * 64 + n + 16 * (ch >> 3)) * 8 + (ch & 7)] = tobf(comp == 0 ? bbr : bbi);
            if (ch < 8) { c.S5BF[((lg * 8 + j) * 64 + n + 32) * 8 + ch] = 0; c.S5BF[((lg * 8 + j) * 64 + n + 48) * 8 + ch] = 0; }
            const int k = s, ks = k >> 5, kg = (k & 31) >> 3, jj = k & 7; const size_t ci = ((lg * S5C + ch) * S5P + p);
            c.S5CF[((lg * 4 + ks) * 64 + ch + 16 * kg) * 8 + jj] = tobf(comp == 0 ? c.c_re[ci] : -c.c_im[ci]); } }
}
DEV void dev_prologue(CREF c, LAS unsigned char* L, int bx, int tid, long gtid, long gn) {
    const int wave = tid >> 6, lane = tid & 63, gw = bx * 8 + wave, NGW = (int)gridDim.x * 8;
    LAS float* scr = (LAS float*)(L + wave * 16384);
    constexpr int I_IN = (DM / 64) * (INW / 32), I_OUT = (DM / 64) * (DM / 32), I_UP = (DM / 64) * (DFF / 32), I_DN = (DFF / 64) * (DM / 32), I_GL = (256 / 64) * (256 / 32), I_L = I_IN + I_OUT + I_UP + I_DN + I_GL;
    for (int it = gw; it < 2 * I_L; it += NGW) { const int l = it / I_L; int r = it % I_L;
        if (r < I_IN) { transpose_item(c.w_in + (size_t)l * DM * INW, DM, INW, c.WIN_T + (size_t)l * PLD * DM, scr, r, lane); continue; } r -= I_IN;
        if (r < I_OUT) { transpose_item(c.w_out + (size_t)l * DM * DM, DM, DM, c.WOUT_T + (size_t)l * DM * DM, scr, r, lane); continue; } r -= I_OUT;
        if (r < I_UP) { transpose_item(c.mlp_up + (size_t)l * DM * DFF, DM, DFF, c.WUP_T + (size_t)l * DFF * DM, scr, r, lane); continue; } r -= I_UP;
        if (r < I_DN) { transpose_item(c.mlp_down + (size_t)l * DFF * DM, DFF, DM, c.WDN_T + (size_t)l * DM * DFF, scr, r, lane); continue; } r -= I_DN;
        transpose_item(c.w_glu + (size_t)l * 65536, 256, 256, c.WGLU_T + (size_t)l * 65536, scr, r, lane); }
    for (long i = gtid; i < (long)2 * (PLD - INW) * DM / 8; i += gn) { const int l = (int)(i / ((PLD - INW) * DM / 8)); const long r = i % ((PLD - INW) * DM / 8);
        *(u32x4_t*)(c.WIN_T + ((size_t)l * PLD + INW) * DM + r * 8) = (u32x4_t){0u, 0u, 0u, 0u}; }
    { f32x4_t g[4];
#pragma unroll
      for (int j = 0; j < 4; ++j) g[j] = ((const f32x4_t*)c.ln1)[lane + 64 * j];
      for (int r = gw; r < TT; r += NGW) { const f32x4_t* xr = (const f32x4_t*)(r < TP ? c.x_prompt + (size_t)r * DM : c.x_sample + (size_t)(r - TP) * DM) + lane; f32x4_t v[4]; float s = 0.f;
#pragma unroll
        for (int j = 0; j < 4; ++j) { v[j] = xr[64 * j]; s += (v[j][0] * v[j][0] + v[j][1] * v[j][1]) + (v[j][2] * v[j][2] + v[j][3] * v[j][3]); ((f32x4_t*)(c.X + (size_t)r * DM))[lane + 64 * j] = v[j]; }
        const float rs = 1.0f / sqrtf(wave_sum(s) * (1.0f / DM) + NEPS);
#pragma unroll
        for (int j = 0; j < 4; ++j) { const f32x4_t o = v[j] * rs * g[j]; u32x2_t w = {cvtpk(o[0], o[1]), cvtpk(o[2], o[3])}; ((u32x2_t*)(c.XN + (size_t)r * DM))[lane + 64 * j] = w; } } }
}
template <bool FINAL> DEV void dev_rmsnorm(CREF c, const float* gain, int bx, int tid, int nsplit) {
    const int wave = tid >> 6, lane = tid & 63, gw = bx * 8 + wave, NGW = (int)gridDim.x * 8;
    f32x4_t g[4];
#pragma unroll
    for (int j = 0; j < 4; ++j) g[j] = ((const f32x4_t*)gain)[lane + 64 * j];
    for (int r = gw; r < TT; r += NGW) { f32x4_t* xr = (f32x4_t*)(c.X + (size_t)r * DM) + lane; f32x4_t v[4]; float s = 0.f;
#pragma unroll
        for (int j = 0; j < 4; ++j) v[j] = xr[64 * j];
        if (r >= TP) {
            for (int ks = 0; ks < nsplit; ++ks) { const f32x4_t* pr = (const f32x4_t*)(c.PART + ((size_t)ks * TS + (r - TP)) * DM) + lane;
#pragma unroll
                for (int j = 0; j < 4; ++j) v[j] += pr[64 * j]; }
            if (!FINAL) {
#pragma unroll
                for (int j = 0; j < 4; ++j) xr[64 * j] = v[j]; } }
#pragma unroll
        for (int j = 0; j < 4; ++j) s += (v[j][0] * v[j][0] + v[j][1] * v[j][1]) + (v[j][2] * v[j][2] + v[j][3] * v[j][3]);
        const float rs = 1.0f / sqrtf(wave_sum(s) * (1.0f / DM) + NEPS);
#pragma unroll
        for (int j = 0; j < 4; ++j) { const f32x4_t o = v[j] * rs * g[j];
            if (FINAL) ((f32x4_t*)(c.out + O_YP + (size_t)r * DM))[lane + 64 * j] = o;
            else { u32x2_t w = {cvtpk(o[0], o[1]), cvtpk(o[2], o[3])}; ((u32x2_t*)(c.XN + (size_t)r * DM))[lane + 64 * j] = w; } } }
}
DEV void dev_copy_out(CREF c, int l, long gtid, long gn) {
    for (long i = gtid; i < (long)TT * 128; i += gn) { const int r = (int)(i >> 7), k = (int)(i & 127); const f32x4_t v = *(const f32x4_t*)(c.PROJ + (size_t)r * PLD + C_KV + 4 * k);
        float* dst = r < TP ? c.out + O_KVP + ((size_t)l * TP + r) * 512 : c.out + O_KVS + ((size_t)l * TS + (r - TP)) * 512; *(f32x4_t*)(dst + 4 * k) = v; }
    for (long i = gtid; i < (long)BATCH * 512 * 64; i += gn) { const int b = (int)(i / (512 * 64)), w = (int)((i >> 6) & 511), k = (int)(i & 63);
        ((f32x4_t*)(c.out + O_WINP + (size_t)l * BATCH * 512 * 256))[i] = *(const f32x4_t*)(c.PROJ + (size_t)(b * SEQ + SEQ - 512 + w) * PLD + C_KV + 512 + 4 * k); }
    for (long i = gtid; i < (long)DB * 512 * 64; i += gn) { const int b = (int)(i / (512 * 64)), w = (int)((i >> 6) & 511), k = (int)(i & 63);
        ((f32x4_t*)(c.out + O_WINS + (size_t)l * DB * 512 * 256))[i] = (w < 512 - DSEQ) ? *(const f32x4_t*)(c.cache_win + (((size_t)l * DB + b) * 512 + w + DSEQ) * 256 + 4 * k)
                                                                                       : *(const f32x4_t*)(c.PROJ + (size_t)(TP + b * DSEQ + (w - (512 - DSEQ))) * PLD + C_KV + 512 + 4 * k); }
    for (long i = gtid; i < (long)BATCH * 3 * CONVD / 4; i += gn) { const int b = (int)(i / (3 * CONVD / 4)), w = (int)((i / (CONVD / 4)) % 3), k = (int)(i % (CONVD / 4));
        ((f32x4_t*)(c.out + O_CONVP + (size_t)l * BATCH * 3 * CONVD))[i] = *(const f32x4_t*)(c.PROJ + (size_t)(b * SEQ + SEQ - 3 + w) * PLD + C_DNQKV + 4 * k); }
    for (long i = gtid; i < (long)DB * 3 * CONVD / 4; i += gn) { const int b = (int)(i / (3 * CONVD / 4)), w = (int)((i / (CONVD / 4)) % 3), k = (int)(i % (CONVD / 4));
        ((f32x4_t*)(c.out + O_CONVS + (size_t)l * DB * 3 * CONVD))[i] = *(const f32x4_t*)(c.PROJ + (size_t)(TP + b * DSEQ + DSEQ - 3 + w) * PLD + C_DNQKV + 4 * k); }
}

constexpr int DP_YS = 65;
constexpr int DP_Y = 0, DP_AM = DP_Y + 3 * 64 * DP_YS * 4, DP_R = DP_AM + 64 * 64 * 4, DP_AQ = DP_R + 64 * 128 * 4, DP_SM = DP_AQ + 64 * 64 * 4, DP_END = DP_SM + 6 * 64 * 4;
static_assert(DP_END <= 131072, "DeltaNet prep LDS");
DEV void dn_prep_unit(CREF c, int l, LAS unsigned char* L, int u, int tid) {
    asm volatile("" : "+v"(tid));
    const int ch = u % NCH, h = (u / NCH) % DNH, b = u / (NCH * DNH), r0 = b * SEQ + ch * 64, lane = tid & 63, wid = tid >> 6;
    LAS float* Y = (LAS float*)(L + DP_Y); LAS float* AMs = (LAS float*)(L + DP_AM); LAS float* R = (LAS float*)(L + DP_R);
    LAS float* sm = (LAS float*)(L + DP_SM);
    LAS float* AQs = (LAS float*)(L + DP_AQ);
    if (tid < 384) { const int ci = tid % 192, tg = tid / 192, part = ci >> 6, d = ci & 63, cch = part * DNW + h * 64 + d;
        const f32x4_t w = *(const f32x4_t*)(c.conv_w + ((size_t)l * CONVD + cch) * 4); float x[35];
        const int tt0 = ch * 64 + 32 * tg - 3; const float* px = c.PROJ + (size_t)(b * SEQ) * PLD + C_DNQKV + cch;
#pragma unroll
        for (int k = 0; k < 35; ++k) { const int tt = tt0 + k; const float v = px[(size_t)(tt < 0 ? 0 : tt) * PLD]; x[k] = tt < 0 ? 0.f : v; }
#pragma unroll
        for (int t = 0; t < 32; ++t) { const float y = (w[0] * x[t] + w[1] * x[t + 1]) + (w[2] * x[t + 2] + w[3] * x[t + 3]); Y[(part * 64 + 32 * tg + t) * DP_YS + d] = y * __builtin_amdgcn_rcpf(1.0f + __expf(-y)); } }
    {
        const int tk = tid >> 3, v0 = (tid & 7) * 8; const float* zp = c.PROJ + (size_t)(r0 + tk) * PLD + C_DNZ + h * 64 + v0; const f32x4_t za = *(const f32x4_t*)zp, zb = *(const f32x4_t*)(zp + 4);
        const f32x4_t na = *(const f32x4_t*)(c.dn_norm_w + l * 64 + v0), nb = *(const f32x4_t*)(c.dn_norm_w + l * 64 + v0 + 4);
        bf16_t* gp = c.DNG + (size_t)u * 4096 + ((tk >> 2) * 64 + v0) * 4 + (tk & 3);
#pragma unroll
        for (int k = 0; k < 8; ++k) { const float z = k < 4 ? za[k] : zb[k - 4], nwv = k < 4 ? na[k] : nb[k - 4]; gp[4 * k] = tobf(z * __builtin_amdgcn_rcpf(1.0f + __expf(-z)) * nwv); } }
    if (tid >= 448) { const int t = tid - 448, r = r0 + t; sm[128 + t] = sigmoidf_(c.PROJ[(size_t)r * PLD + C_DNB + h]);
        sm[192 + t] = -expf(c.a_log[l * DNH + h]) * softplusf_(c.PROJ[(size_t)r * PLD + C_DNA + h] + c.dt_bias[l * DNH + h]); }
    __syncthreads();
    {   const int rr = tid >> 2, q4 = tid & 3; const LAS float* yr = Y + rr * DP_YS + 16 * q4; float ss = 0.f;
#pragma unroll
        for (int k = 0; k < 16; ++k) ss += yr[k] * yr[k];
        ss += dppf<DPP_X1>(ss); ss += dppf<DPP_X2>(ss);
        if (q4 == 0) sm[rr] = (rr < 64 ? 0.125f : 1.0f) / sqrtf(ss + 1e-6f); }
    if (wid == 7) { float s = sm[192 + lane];
#pragma unroll
        for (int o = 1; o < 64; o <<= 1) { const float t = __shfl_up(s, o); if (lane >= o) s += t; }
        sm[256 + lane] = s; const float gl = __shfl(s, 63); sm[320 + lane] = expf(gl - s); }
    __syncthreads();
    for (int idx = tid; idx < 128 * 64; idx += 512) { const int rr = idx >> 6, d = idx & 63; Y[rr * DP_YS + d] *= sm[rr]; }
    __syncthreads();
    {   const int mt = tid >> 7, ks = (tid >> 6) & 1, m16 = tid & 15, kb = (tid >> 4) & 3, row = 16 * mt + m16, k0 = 32 * ks + 4 * kb, k1 = k0 + 16;
        bf16_t* fo = c.DNF + (size_t)u * 16384 + tid * 8;
        { const float e = expf(sm[256 + row]); const LAS float* q = Y + row * DP_YS; const f32x4_t a = {q[k0] * e, q[k0 + 1] * e, q[k0 + 2] * e, q[k0 + 3] * e}, bq = {q[k1] * e, q[k1 + 1] * e, q[k1 + 2] * e, q[k1 + 3] * e};
          *(bf16x8_t*)(fo + 4096) = pack8(a, bq); }
        { const LAS float* kT = Y + 64 * DP_YS + row; f32x4_t a, bq;
#pragma unroll
          for (int i = 0; i < 4; ++i) { a[i] = kT[(k0 + i) * DP_YS] * sm[320 + k0 + i]; bq[i] = kT[(k1 + i) * DP_YS] * sm[320 + k1 + i]; }
          *(bf16x8_t*)(fo + 12288) = pack8(a, bq); }
    }
    for (int idx = tid; idx < 64 * 64; idx += 512) { const int t = idx >> 6, d = idx & 63; const float q = Y[t * DP_YS + d], k = Y[(64 + t) * DP_YS + d], vv = Y[(128 + t) * DP_YS + d], be = sm[128 + t];
        (void)q; R[t * 128 + d] = vv * be; R[t * 128 + 64 + d] = k * be * expf(sm[256 + t]); }

    {   const int m16 = lane & 15, kq = lane >> 4;
#pragma unroll 1
        for (int pi = wid; pi < 10; pi += 8) { const int mt = pi < 1 ? 0 : (pi < 3 ? 1 : (pi < 6 ? 2 : 3)), nt = pi - (mt * (mt + 1)) / 2;
            const LAS float* ka = Y + (64 + 16 * mt + m16) * DP_YS + kq; const LAS float* qa = Y + (16 * mt + m16) * DP_YS + kq; const LAS float* kb = Y + (64 + 16 * nt + m16) * DP_YS + kq;
            f32x4_t ck = {0.f, 0.f, 0.f, 0.f}, cq = {0.f, 0.f, 0.f, 0.f};
#pragma unroll
            for (int s = 0; s < 16; ++s) { const float bv = kb[4 * s]; ck = __builtin_amdgcn_mfma_f32_16x16x4f32(ka[4 * s], bv, ck, 0, 0, 0); cq = __builtin_amdgcn_mfma_f32_16x16x4f32(qa[4 * s], bv, cq, 0, 0, 0); }
            const int j = 16 * nt + m16; const float gj = sm[256 + j];
#pragma unroll
            for (int i = 0; i < 4; ++i) { const int ii = 16 * mt + 4 * kq + i; const float dec = j <= ii ? expf(sm[256 + ii] - gj) : 0.f;
                AMs[ii * 64 + j] = j < ii ? sm[128 + ii] * ck[i] * dec : 0.f; AQs[ii * 64 + j] = j <= ii ? cq[i] * dec : 0.f; } }
        if (wid >= 2) { const int pu = wid - 2, mt = pu < 3 ? 0 : (pu < 5 ? 1 : 2), nt = pu < 3 ? pu + 1 : (pu < 5 ? pu - 1 : 3);
#pragma unroll
            for (int i = 0; i < 4; ++i) AQs[(16 * mt + 4 * kq + i) * 64 + 16 * nt + m16] = 0.f; } }
    __syncthreads();
    {   const int col = tid >> 2, q = tid & 3; float xq[16];
#pragma unroll
        for (int jj = 0; jj < 16; ++jj) xq[jj] = 0.f;
#pragma unroll
        for (int i = 0; i < 64; ++i) { float s = 0.f;
#pragma unroll
            for (int jj = 0; jj < (i + 3) / 4; ++jj) s -= AMs[i * 64 + 4 * jj + q] * xq[jj];
            s += dppf<DPP_X1>(s); s += dppf<DPP_X2>(s); s += R[i * 128 + col];
            xq[i >> 2] = ((i & 3) == q) ? s : xq[i >> 2];
            if (q == 0) R[i * 128 + col] = s; } }
    __syncthreads();
    if (wid == 6) {
#pragma unroll
        for (int s8 = 0; s8 < 8; ++s8) { const int slot = lane + 64 * s8, mt = slot >> 7, ks = (slot >> 6) & 1, m16 = slot & 15, kb = (slot >> 4) & 3, row = 16 * mt + m16, k0 = 32 * ks + 4 * kb, k1 = k0 + 16;
            const f32x4_t a = *(const LAS f32x4_t*)(R + row * 128 + 64 + k0), bq = *(const LAS f32x4_t*)(R + row * 128 + 64 + k1); *(bf16x8_t*)(c.DNF + (size_t)u * 16384 + slot * 8) = pack8(a, bq);
            const f32x4_t a2 = *(const LAS f32x4_t*)(AQs + row * 64 + k0), b2 = *(const LAS f32x4_t*)(AQs + row * 64 + k1); *(bf16x8_t*)(c.DNF + (size_t)u * 16384 + 8192 + slot * 8) = pack8(a2, b2); }
#pragma unroll
        for (int s = 0; s < 16; ++s) { const int idx = lane + 64 * s, v = idx & 63, tq = idx >> 6; const f32x4_t uv = {R[(4 * tq) * 128 + v], R[(4 * tq + 1) * 128 + v], R[(4 * tq + 2) * 128 + v], R[(4 * tq + 3) * 128 + v]};
            *(f32x4_t*)(c.DNU + (size_t)u * 4096 + idx * 4) = uv; }
        if (lane == 0) c.DNE[u] = expf(sm[256 + 63]); }
}
DEV void dev_dn_out(CREF c, int l, int bx, int tid) {
    const int wave = tid >> 6, lane = tid & 63, gw = bx * 8 + wave, NGW = (int)gridDim.x * 8; const float nw = c.dn_norm_w[l * 64 + lane];
    for (int i0 = gw * 8; i0 < TP * DNH; i0 += NGW * 8) { float o[8], z[8];
#pragma unroll
        for (int k = 0; k < 8; ++k) { const int i = i0 + k, r = i / DNH, h = i % DNH; o[k] = c.ODN[(size_t)i * 64 + lane]; z[k] = c.PROJ[(size_t)r * PLD + C_DNZ + h * 64 + lane]; }
#pragma unroll
        for (int k = 0; k < 8; ++k) { const int i = i0 + k, r = i / DNH, h = i % DNH; const float ss = wave_sum(o[k] * o[k]);
            c.MIXB[(size_t)r * DM + 512 + h * 64 + lane] = tobf(o[k] * __builtin_amdgcn_rsqf(ss * (1.0f / 64.0f) + NEPS) * nw * (z[k] * __builtin_amdgcn_rcpf(1.0f + __expf(-z[k])))); } }
}

typedef float f32x16_t __attribute__((ext_vector_type(16)));
#define MFMA32(a, b, c) __builtin_amdgcn_mfma_f32_32x32x16_bf16((a), (b), (c), 0, 0, 0)
constexpr int NA_RS = 144;
constexpr int NA_T = 64 * NA_RS, NA_BUF = 2 * NA_T;
constexpr int NA_IMP = 2 * NA_BUF, NA_SELM = NA_IMP + 64 * 128 * 4, NA_UNI = NA_SELM + 64 * 16, NA_NIT = NA_UNI + 16, NA_ITEMS = NA_NIT + 16, NA_PT = NA_ITEMS + 160 * 4, NA_END = NA_PT + 64;
static_assert(NA_END <= 131072, "NSA LDS");
constexpr float LOG2E = 1.4426950408889634f;
DEV int crow32(int reg, int hh) { return (reg & 3) + 8 * (reg >> 2) + 4 * hh; }
struct NaStage { f32x4_t k0, k1, v0, v1; };
template <bool SMP> DEV void na_load(CREF c, NaStage& st, int l, int mode, int b, int g, int n, int tid, const LAS int* pt = nullptr) {
    const int key = tid >> 3, d0 = (tid & 7) * 8; const float* kp; bool zero = false;
    if (mode == 0) { kp = c.KC + (((size_t)((SMP ? BATCH : 0) + b) * NBMAX + 64 * n + key) * 2 + g) * 64 + d0;
        const float* vp = c.VC + (kp - c.KC); const bool zp = SMP && key >= NBC_S; const f32x4_t z0 = {0.f, 0.f, 0.f, 0.f};
        st.k0 = zp ? z0 : *(const f32x4_t*)kp; st.k1 = zp ? z0 : *(const f32x4_t*)(kp + 4); st.v0 = zp ? z0 : *(const f32x4_t*)vp; st.v1 = zp ? z0 : *(const f32x4_t*)(vp + 4); return; }
    const int slot = mode == 1 ? 2 : 4;
    if (!SMP) kp = c.PROJ + (size_t)(b * SEQ + 64 * n + key) * PLD + C_KV + slot * 128 + g * 64 + d0;
    else { const int pos = 64 * n + key;
        if (pos >= PAST) { const int j = pos - PAST; zero = j >= DSEQ; kp = c.PROJ + (size_t)(TP + b * DSEQ + (zero ? 0 : j)) * PLD + C_KV + slot * 128 + g * 64 + d0; }
        else if (mode == 1) { const int pg = pt[pos / PAGE]; kp = c.cache_nsa + ((((size_t)l * NPHYS + pg) * PAGE + (pos % PAGE)) * 4 + slot) * 128 + g * 64 + d0; }
        else kp = c.cache_win + ((((size_t)l * DB + b) * WIN + (pos - W0S)) * 2 + (slot - 4)) * 128 + g * 64 + d0; }
    const f32x4_t z = {0.f, 0.f, 0.f, 0.f};
    st.k0 = zero ? z : *(const f32x4_t*)kp; st.k1 = zero ? z : *(const f32x4_t*)(kp + 4); st.v0 = zero ? z : *(const f32x4_t*)(kp + 128); st.v1 = zero ? z : *(const f32x4_t*)(kp + 132);
}
DEV void na_store(const NaStage& st, LAS unsigned char* buf, int tid) {
    const int key = tid >> 3, d0 = (tid & 7) * 8;
    *(LAS bf16x8_t*)(buf + key * NA_RS + d0 * 2) = pack8(st.k0, st.k1);
    LAS unsigned short* vt = (LAS unsigned short*)(buf + NA_T);
    const unsigned a = cvtpk(st.v0[0], st.v0[1]), bb = cvtpk(st.v0[2], st.v0[3]), cc = cvtpk(st.v1[0], st.v1[1]), dd = cvtpk(st.v1[2], st.v1[3]);
    vt[(d0 + 0) * (NA_RS / 2) + key] = (unsigned short)a; vt[(d0 + 1) * (NA_RS / 2) + key] = (unsigned short)(a >> 16);
    vt[(d0 + 2) * (NA_RS / 2) + key] = (unsigned short)bb; vt[(d0 + 3) * (NA_RS / 2) + key] = (unsigned short)(bb >> 16);
    vt[(d0 + 4) * (NA_RS / 2) + key] = (unsigned short)cc; vt[(d0 + 5) * (NA_RS / 2) + key] = (unsigned short)(cc >> 16);
    vt[(d0 + 6) * (NA_RS / 2) + key] = (unsigned short)dd; vt[(d0 + 7) * (NA_RS / 2) + key] = (unsigned short)(dd >> 16);
}
DEV void na_scores(const LAS unsigned char* kb, const bf16x8_t (&qf)[4], int lane, f32x16_t& s0, f32x16_t& s1) {
    const int n = lane & 31, hh = lane >> 5;
#pragma unroll
    for (int i = 0; i < 16; ++i) { s0[i] = 0.f; s1[i] = 0.f; }
#pragma unroll
    for (int ks = 0; ks < 4; ++ks) { const bf16x8_t a0 = *(const LAS bf16x8_t*)(kb + n * NA_RS + (16 * ks + 8 * hh) * 2), a1 = *(const LAS bf16x8_t*)(kb + (32 + n) * NA_RS + (16 * ks + 8 * hh) * 2);
        s0 = MFMA32(a0, qf[ks], s0); s1 = MFMA32(a1, qf[ks], s1); }
}
DEV void na_pv(const LAS unsigned char* vb, const f32x16_t& p0, const f32x16_t& p1, int lane, f32x16_t& o0, f32x16_t& o1) {
    const int n = lane & 31, hh = lane >> 5;
#pragma unroll
    for (int s = 0; s < 4; ++s) { const f32x16_t& p = (s < 2) ? p0 : p1; const int e = 8 * (s & 1);
        const bf16x8_t pf = pack8((f32x4_t){p[e], p[e + 1], p[e + 2], p[e + 3]}, (f32x4_t){p[e + 4], p[e + 5], p[e + 6], p[e + 7]});
#pragma unroll
        for (int mt = 0; mt < 2; ++mt) { const LAS unsigned char* vp = vb + (32 * mt + n) * NA_RS + (16 * s + 4 * hh) * 2;
            const u32x2_t lo = *(const LAS u32x2_t*)vp, hi = *(const LAS u32x2_t*)(vp + 16); const u32x4_t w = {lo[0], lo[1], hi[0], hi[1]};
            if (mt == 0) o0 = MFMA32(__builtin_bit_cast(bf16x8_t, w), pf, o0); else o1 = MFMA32(__builtin_bit_cast(bf16x8_t, w), pf, o1); } }
}
template <bool SMP> DEV void nsa_unit(CREF c, int l, LAS unsigned char* L, int b, int qb, int g, int tid) {
    asm volatile("" : "+v"(tid));
    const int lane = tid & 63, wid = tid >> 6, n = lane & 31, hh = lane >> 5, tl = 8 * wid + (n >> 2), r = n & 3, h = 4 * g + r, t = 64 * qb + tl;
    const bool act = !SMP || wid == 0;
    const size_t row = SMP ? (size_t)(TP + b * DSEQ + (tl & 7)) : (size_t)(b * SEQ + t);
    LAS float* IMP = (LAS float*)(L + NA_IMP); LAS unsigned* SELM = (LAS unsigned*)(L + NA_SELM); LAS unsigned* UNI = (LAS unsigned*)(L + NA_UNI);
    LAS int* NIT = (LAS int*)(L + NA_NIT); LAS int* ITEMS = (LAS int*)(L + NA_ITEMS);
    const float slope2 = exp2f(-(float)(h + 1)) * LOG2E;
    bf16x8_t qf[4];
#pragma unroll
    for (int ks = 0; ks < 4; ++ks) { const float* qp = c.PROJ + row * PLD + C_Q + h * 64 + 16 * ks + 8 * hh; const f32x4_t a = *(const f32x4_t*)qp * (0.125f * LOG2E), bq = *(const f32x4_t*)(qp + 4) * (0.125f * LOG2E); qf[ks] = pack8(a, bq); }
    const float* gp = c.PROJ + row * PLD + C_GATE + h * 3; const float g0 = sigmoidf_(gp[0]), g1 = sigmoidf_(gp[1]), g2 = sigmoidf_(gp[2]);
    f32x16_t ot0, ot1, oa0, oa1;
    if (tid < 4) UNI[tid] = 0u;
    LAS int* PT = (LAS int*)(L + NA_PT);
    if (SMP && tid >= 64 && tid < 64 + NPAGES) PT[tid - 64] = c.page_table[b * NPAGES + (tid - 64)];
    const int nbc = (!SMP && qb >= 64) ? 2 : 1;
    { NaStage st; na_load<SMP>(c, st, l, 0, b, g, 0, tid); na_store(st, L, tid); if (nbc == 2) { na_load<SMP>(c, st, l, 0, b, g, 1, tid); na_store(st, L + NA_BUF, tid); } }
    __syncthreads();
    if (act) {
        f32x16_t sa0, sa1, sb0, sb1;
        na_scores(L, qf, lane, sa0, sa1);
        if (nbc == 2) na_scores(L + NA_BUF, qf, lane, sb0, sb1);
        else {
#pragma unroll
            for (int i = 0; i < 16; ++i) { sb0[i] = 0.f; sb1[i] = 0.f; } }
        float m = -1e30f;
#pragma unroll
        for (int i = 0; i < 16; ++i) { const int k0 = crow32(i, hh);
            { const int np = k0;       const bool ok = 64 * np + 63 <= t;              sa0[i] = ok ? sa0[i] - slope2 * ((float)(t - 64 * np) - 31.5f) : -1e30f; m = fmaxf(m, sa0[i]); }
            { const int np = 32 + k0;  const bool ok = 64 * np + 63 <= t;              sa1[i] = ok ? sa1[i] - slope2 * ((float)(t - 64 * np) - 31.5f) : -1e30f; m = fmaxf(m, sa1[i]); }
            { const int np = 64 + k0;  const bool ok = nbc == 2 && 64 * np + 63 <= t;  sb0[i] = ok ? sb0[i] - slope2 * ((float)(t - 64 * np) - 31.5f) : -1e30f; m = fmaxf(m, sb0[i]); }
            { const int np = 96 + k0;  const bool ok = nbc == 2 && 64 * np + 63 <= t;  sb1[i] = ok ? sb1[i] - slope2 * ((float)(t - 64 * np) - 31.5f) : -1e30f; m = fmaxf(m, sb1[i]); } }
        m = fmaxf(m, __shfl_xor(m, 32));
        float ls = 0.f;
#pragma unroll
        for (int i = 0; i < 16; ++i) { sa0[i] = sa0[i] > -1e29f ? exp2f(sa0[i] - m) : 0.f; sa1[i] = sa1[i] > -1e29f ? exp2f(sa1[i] - m) : 0.f;
                                       sb0[i] = sb0[i] > -1e29f ? exp2f(sb0[i] - m) : 0.f; sb1[i] = sb1[i] > -1e29f ? exp2f(sb1[i] - m) : 0.f; ls += (sa0[i] + sa1[i]) + (sb0[i] + sb1[i]); }
        ls += __shfl_xor(ls, 32);
        const float inv = 1.0f / fmaxf(ls, 1e-30f);
#pragma unroll
        for (int i = 0; i < 16; ++i) { sa0[i] *= inv; sa1[i] *= inv; sb0[i] *= inv; sb1[i] *= inv; }
#pragma unroll
        for (int i = 0; i < 16; ++i) { const int k0 = crow32(i, hh);
            float v0 = sa0[i], v1 = sa1[i], v2 = sb0[i], v3 = sb1[i];
            v0 += dppf<DPP_X1>(v0); v1 += dppf<DPP_X1>(v1); v2 += dppf<DPP_X1>(v2); v3 += dppf<DPP_X1>(v3);
            v0 += dppf<DPP_X2>(v0); v1 += dppf<DPP_X2>(v1); v2 += dppf<DPP_X2>(v2); v3 += dppf<DPP_X2>(v3);
            if (r == 0) { IMP[tl * 128 + k0] = v0; IMP[tl * 128 + 32 + k0] = v1; IMP[tl * 128 + 64 + k0] = v2; IMP[tl * 128 + 96 + k0] = v3; } }
#pragma unroll
        for (int i = 0; i < 16; ++i) { oa0[i] = 0.f; oa1[i] = 0.f; }
        na_pv(L + NA_T, sa0, sa1, lane, oa0, oa1);
        if (nbc == 2) na_pv(L + NA_BUF + NA_T, sb0, sb1, lane, oa0, oa1);
#pragma unroll
        for (int i = 0; i < 16; ++i) { ot0[i] = g0 * oa0[i]; ot1[i] = g0 * oa1[i]; }
    }
    __syncthreads();
    {
        const int tk = tid >> 3, s8 = tid & 7, cur = qb;
        if (!SMP || tk < DSEQ) {
        float v[16];
#pragma unroll
        for (int i = 0; i < 16; ++i) { const int nn = 16 * s8 + i; v[i] = (nn >= 1 && nn <= cur - 2) ? IMP[tk * 128 + nn] : -1.0f; }
        unsigned mk0 = 0u, mk1 = 0u, mk2 = 0u, mk3 = 0u;
        const int nforced = cur >= 2 ? 3 : cur + 1;
        for (int rd = 0; rd < TOPK - nforced; ++rd) {
            float bv = -0.5f; int bn = 1000;
#pragma unroll
            for (int i = 0; i < 16; ++i) if (v[i] > bv) { bv = v[i]; bn = 16 * s8 + i; }
            { const float ov = dppf<DPP_X1>(bv); const int on = dppi<DPP_X1>(bn); if (ov > bv || (ov == bv && on < bn)) { bv = ov; bn = on; } }
            { const float ov = dppf<DPP_X2>(bv); const int on = dppi<DPP_X2>(bn); if (ov > bv || (ov == bv && on < bn)) { bv = ov; bn = on; } }
            { const float ov = dppf<DPP_HM>(bv); const int on = dppi<DPP_HM>(bn); if (ov > bv || (ov == bv && on < bn)) { bv = ov; bn = on; } }
            if (bn >= 1000) break;
#pragma unroll
            for (int i = 0; i < 16; ++i) if (16 * s8 + i == bn) v[i] = -1.0f;
            const unsigned bit = 1u << (bn & 31); const int w = bn >> 5;
            mk0 |= w == 0 ? bit : 0u; mk1 |= w == 1 ? bit : 0u; mk2 |= w == 2 ? bit : 0u; mk3 |= w == 3 ? bit : 0u;
        }
#pragma unroll
        for (int f = 0; f < 3; ++f) { const int fn = f == 0 ? 0 : (f == 1 ? cur : cur - 1); if (fn >= 0) { const unsigned bit = 1u << (fn & 31); const int w = fn >> 5;
            mk0 |= w == 0 ? bit : 0u; mk1 |= w == 1 ? bit : 0u; mk2 |= w == 2 ? bit : 0u; mk3 |= w == 3 ? bit : 0u; } }
        if (s8 == 0) { SELM[tk * 4 + 0] = mk0; SELM[tk * 4 + 1] = mk1; SELM[tk * 4 + 2] = mk2; SELM[tk * 4 + 3] = mk3;
            atomicOr((unsigned*)&UNI[0], mk0); atomicOr((unsigned*)&UNI[1], mk1); atomicOr((unsigned*)&UNI[2], mk2); atomicOr((unsigned*)&UNI[3], mk3); }
        }
    }
    __syncthreads();
    int nit;
    {   const unsigned u0 = UNI[0], u1 = UNI[1], u2 = UNI[2], u3 = UNI[3];
        const int nn = qb - tid;
        const int sh = nn + 1;
        auto above = [&](unsigned w, int base) -> int { const int s = sh - base; return s <= 0 ? __popc(w) : (s >= 32 ? 0 : __popc(w >> s)); };
        const int nsel = __popc(u0) + __popc(u1) + __popc(u2) + __popc(u3), nwin = qb >= 8 ? 9 : qb + 1;
        if (nn >= 0) { const unsigned w = nn < 32 ? u0 : (nn < 64 ? u1 : (nn < 96 ? u2 : u3));
            if ((w >> (nn & 31)) & 1u) ITEMS[above(u0, 0) + above(u1, 32) + above(u2, 64) + above(u3, 96)] = nn; }
        if (tid < nwin) ITEMS[nsel + tid] = 256 + qb - tid;
        nit = nsel + nwin; }
    __syncthreads();
    const unsigned sm0 = SELM[tl * 4 + 0], sm1 = SELM[tl * 4 + 1], sm2 = SELM[tl * 4 + 2], sm3 = SELM[tl * 4 + 3];
    float m = -1e30f, ls = 0.f; int curmode = 0;
#pragma unroll
    for (int i = 0; i < 16; ++i) { oa0[i] = 0.f; oa1[i] = 0.f; }
    { NaStage st; const int it0 = ITEMS[0]; na_load<SMP>(c, st, l, 1 + (it0 >> 8), b, g, it0 & 255, tid, PT); na_store(st, L, tid); }
    __syncthreads();
    for (int it = 0; it < nit; ++it) {
        const int item = ITEMS[it], mode = item >> 8, nblk = item & 255;
        NaStage st; const bool more = it + 1 < nit;
        if (more) { const int nx = ITEMS[it + 1]; na_load<SMP>(c, st, l, 1 + (nx >> 8), b, g, nx & 255, tid, PT); }
        if (act) {
        if (mode != curmode) {
            const float lf = ls + __shfl_xor(ls, 32); const float sc = g1 / fmaxf(lf, 1e-30f);
#pragma unroll
            for (int i = 0; i < 16; ++i) { ot0[i] += sc * oa0[i]; ot1[i] += sc * oa1[i]; oa0[i] = 0.f; oa1[i] = 0.f; }
            m = -1e30f; ls = 0.f; curmode = mode; }
        const LAS unsigned char* buf = L + (it & 1) * NA_BUF;
        f32x16_t s0, s1; na_scores(buf, qf, lane, s0, s1);
        const int dbase = 64 * (qb - nblk) + tl;
        const unsigned smw = nblk < 32 ? sm0 : (nblk < 64 ? sm1 : (nblk < 96 ? sm2 : sm3));
        const bool blk_ok = mode == 1 ? true : ((smw >> (nblk & 31)) & 1u) != 0u;
        const bool full = (nblk == qb) || (mode == 1 && nblk == qb - 8);
        float mn, al, psum = 0.f;
        if (full) {
            float mloc = -1e30f;
#pragma unroll
            for (int i = 0; i < 16; ++i) { const int k0 = crow32(i, hh);
                { const int dist = dbase - k0;        const bool ok = blk_ok && dist >= 0 && (mode == 0 || dist < WIN); s0[i] = ok ? s0[i] - slope2 * (float)dist : -1e30f; mloc = fmaxf(mloc, s0[i]); }
                { const int dist = dbase - 32 - k0;   const bool ok = blk_ok && dist >= 0 && (mode == 0 || dist < WIN); s1[i] = ok ? s1[i] - slope2 * (float)dist : -1e30f; mloc = fmaxf(mloc, s1[i]); } }
            mloc = fmaxf(mloc, __shfl_xor(mloc, 32));
            mn = fmaxf(m, mloc); al = __builtin_amdgcn_exp2f(m - mn); m = mn;
#pragma unroll
            for (int i = 0; i < 16; ++i) { s0[i] = s0[i] > -1e29f ? __builtin_amdgcn_exp2f(s0[i] - mn) : 0.f; s1[i] = s1[i] > -1e29f ? __builtin_amdgcn_exp2f(s1[i] - mn) : 0.f; psum += s0[i] + s1[i]; }
        } else {
            const float c0 = -slope2 * (float)(dbase - 4 * hh);
            float tm = -1e30f;
#pragma unroll
            for (int i = 0; i < 16; ++i) { const float ci = (float)((i & 3) + 8 * (i >> 2));
                s0[i] = fmaf(slope2, ci, s0[i]); s1[i] = fmaf(slope2, ci + 32.0f, s1[i]); tm = fmaxf(tm, fmaxf(s0[i], s1[i])); }
            float mloc = blk_ok ? tm + c0 : -1e30f;
            mloc = fmaxf(mloc, __shfl_xor(mloc, 32));
            mn = fmaxf(m, mloc); al = __builtin_amdgcn_exp2f(m - mn); m = mn;
            const float mm = blk_ok ? mn - c0 : 1e30f;
#pragma unroll
            for (int i = 0; i < 16; ++i) { s0[i] = __builtin_amdgcn_exp2f(s0[i] - mm); s1[i] = __builtin_amdgcn_exp2f(s1[i] - mm); psum += s0[i] + s1[i]; }
        }
        ls = ls * al + psum;
        if (__builtin_amdgcn_ballot_w64(al != 1.0f) != 0ull) {
#pragma unroll
            for (int i = 0; i < 16; ++i) { oa0[i] *= al; oa1[i] *= al; } }
        na_pv(buf + NA_T, s0, s1, lane, oa0, oa1);
        }
        if (more) na_store(st, L + ((it + 1) & 1) * NA_BUF, tid);
        __syncthreads();
    }
    if (act) {
    {   const float lf = ls + __shfl_xor(ls, 32); const float sc = g2 / fmaxf(lf, 1e-30f);
#pragma unroll
        for (int i = 0; i < 16; ++i) { ot0[i] += sc * oa0[i]; ot1[i] += sc * oa1[i]; } }
    bf16_t* orow = c.MIXB + row * DM + h * 64;
#pragma unroll
    for (int q4 = 0; q4 < 4; ++q4) { const int d = 8 * q4 + 4 * hh;
        u32x2_t w0 = {cvtpk(ot0[4 * q4], ot0[4 * q4 + 1]), cvtpk(ot0[4 * q4 + 2], ot0[4 * q4 + 3])}; *(u32x2_t*)(orow + d) = w0;
        u32x2_t w1 = {cvtpk(ot1[4 * q4], ot1[4 * q4 + 1]), cvtpk(ot1[4 * q4 + 2], ot1[4 * q4 + 3])}; *(u32x2_t*)(orow + 32 + d) = w1; }
    }
    __syncthreads();
}

DEV void pool_unit(CREF c, int l, int seq, int n, int col) {
    const int slot = col >> 7, g = (col >> 6) & 1;
    const float* src; size_t stride;
    if (seq < BATCH) { src = c.PROJ + (size_t)(seq * SEQ + 64 * n) * PLD + C_KV + col; stride = PLD; }
    else { const int b = seq - BATCH, pg = c.page_table[b * NPAGES + (64 * n) / PAGE]; src = c.cache_nsa + (((size_t)l * NPHYS + pg) * PAGE + ((64 * n) % PAGE)) * 512 + col; stride = 512; }
    const float* w = (slot == 0 ? c.wck : c.wcv) + (l * 2 + g) * 64;
    float a0 = 0.f, a1 = 0.f;
#pragma unroll 16
    for (int j = 0; j < 64; j += 2) { a0 += w[j] * src[(size_t)j * stride]; a1 += w[j + 1] * src[(size_t)(j + 1) * stride]; }
    (slot == 0 ? c.KC : c.VC)[(((size_t)seq * NBMAX + n) * 2 + g) * 64 + (col & 63)] = a0 + a1;
}

DEV void dev_s5_y(CREF c, int l, long gtid, long gn) {
    for (long i = gtid; i < (long)TT * 256; i += gn) { const int r = (int)(i >> 8), ch = (int)(i & 255), g = ch / S5C, cc = ch % S5C;
        const float* cr = c.c_re + (((size_t)l * S5G + g) * S5C + cc) * S5P; const float* ci = c.c_im + (((size_t)l * S5G + g) * S5C + cc) * S5P;
        const f32x4_t* hs = (const f32x4_t*)(c.S5HS + ((size_t)r * S5G + g) * S5P * 2); float y = 0.f;
#pragma unroll 8
        for (int p2 = 0; p2 < S5P / 2; ++p2) { const f32x4_t hv = hs[p2]; y += cr[2 * p2] * hv[0] - ci[2 * p2] * hv[1] + cr[2 * p2 + 1] * hv[2] - ci[2 * p2 + 1] * hv[3]; }
        y += c.s5_d[l * 256 + ch] * c.PROJ[(size_t)r * PLD + C_S5U + ch]; c.GLB[i] = tobf(geluf_(y)); }
}

constexpr int S5_URS = 528, S5_HRS = 4112;
constexpr int S5_U = 0, S5_HT = 64 * S5_URS;
static_assert(S5_HT + 16 * S5_HRS <= 131072, "S5 LDS");
template <bool PASS_B, bool SMP> DEV void s5_unit(CREF c, int l, LAS unsigned char* L, int b, int ch, int tid) {
    asm volatile("" : "+v"(tid));
    constexpr int NT = SMP ? DSEQ : 64, NSB = SMP ? 1 : 4, TSB = SMP ? DSEQ : 16;
    const int r0 = SMP ? TP + b * DSEQ : b * SEQ + ch * 64, lane = tid & 63, wid = tid >> 6, n16 = lane & 15, kg = lane >> 4;
    LAS unsigned char* UB = L + S5_U; LAS unsigned char* BH = L + S5_HT;
    for (int i = tid; i < 16 * (SMP ? 1 : 4) * 64; i += 512) { const int t = i >> 6, q = i & 63; f32x4_t v = {0.f, 0.f, 0.f, 0.f}; if (t < NT) v = *(const f32x4_t*)(c.PROJ + (size_t)(r0 + t) * PLD + C_S5U + 4 * q);
        u32x2_t w = {cvtpk(v[0], v[1]), cvtpk(v[2], v[3])}; *(LAS u32x2_t*)(UB + t * S5_URS + q * 8) = w; }
    float ar[2], ai[2], hr[2], hi[2];
#pragma unroll
    for (int s = 0; s < 2; ++s) { const int idx = tid + 512 * s; const size_t gi = (size_t)l * S5G * S5P + idx;
        ar[s] = c.S5K[gi * 4]; ai[s] = c.S5K[gi * 4 + 1];
        if (SMP) { hr[s] = c.st_s5re[((size_t)l * DB + b) * 1024 + idx]; hi[s] = c.st_s5im[((size_t)l * DB + b) * 1024 + idx]; }
        else if (PASS_B) {
            const float a64r = c.S5K[gi * 4 + 2], a64i = c.S5K[gi * 4 + 3]; float cr_ = 0.f, ci_ = 0.f;
            for (int c0 = 0; c0 < ch; c0 += 16) { f32x2_t e[16];
#pragma unroll
                for (int k = 0; k < 16; ++k) e[k] = (c0 + k < ch) ? *(const f32x2_t*)(c.S5E + (((size_t)b * NCH + c0 + k) * 1024 + idx) * 2) : (f32x2_t){0.f, 0.f};
#pragma unroll
                for (int k = 0; k < 16; ++k) if (c0 + k < ch) { const float nr = a64r * cr_ - a64i * ci_ + e[k][0], ni = a64r * ci_ + a64i * cr_ + e[k][1]; cr_ = nr; ci_ = ni; } }
            hr[s] = cr_; hi[s] = ci_; }
        else { hr[s] = 0.f; hi[s] = 0.f; } }
    bf16x8_t bbf[2][8], ccf[2][4]; float dco[2];
#pragma unroll
    for (int gi2 = 0; gi2 < 2; ++gi2) { const size_t lg = (size_t)l * S5G + 2 * wid + gi2;
#pragma unroll
        for (int j = 0; j < 8; ++j) bbf[gi2][j] = *(const bf16x8_t*)(c.S5BF + ((lg * 8 + j) * 64 + lane) * 8);
        if (PASS_B) {
#pragma unroll
            for (int ks = 0; ks < 4; ++ks) ccf[gi2][ks] = *(const bf16x8_t*)(c.S5CF + ((lg * 4 + ks) * 64 + lane) * 8);
            dco[gi2] = c.s5_d[l * 256 + (2 * wid + gi2) * 16 + n16]; } }
    __syncthreads();
    const f32x4_t z4 = {0.f, 0.f, 0.f, 0.f}; const bf16x8_t zf = {0, 0, 0, 0, 0, 0, 0, 0};
    for (int sb = 0; sb < NSB; ++sb) {
#pragma unroll
        for (int gi2 = 0; gi2 < 2; ++gi2) { const int g = 2 * wid + gi2;
            const bf16x8_t af = kg < 2 ? *(const LAS bf16x8_t*)(UB + (16 * sb + n16) * S5_URS + (16 * g + 8 * kg) * 2) : zf;
#pragma unroll
            for (int j = 0; j < 8; ++j) { const f32x4_t acc = MFMA16(af, bbf[gi2][j], z4);
                LAS unsigned short* o = (LAS unsigned short*)(BH + (4 * kg) * S5_HRS + (g * 128 + 16 * j + n16) * 2);
                const unsigned p01 = cvtpk(acc[0], acc[1]), p23 = cvtpk(acc[2], acc[3]);
                o[0] = (unsigned short)p01; o[S5_HRS / 2] = (unsigned short)(p01 >> 16); o[S5_HRS] = (unsigned short)p23; o[3 * (S5_HRS / 2)] = (unsigned short)(p23 >> 16); } }
        __syncthreads();
#pragma unroll 4
        for (int tt = 0; tt < TSB; ++tt) {
#pragma unroll
            for (int s = 0; s < 2; ++s) { LAS unsigned* bp = (LAS unsigned*)(BH + tt * S5_HRS + (tid + 512 * s) * 4); const unsigned w = *bp;
                const float br = __uint_as_float(w << 16), bi = __uint_as_float(w & 0xffff0000u);
                const float nr = ar[s] * hr[s] - ai[s] * hi[s] + br, ni = ar[s] * hi[s] + ai[s] * hr[s] + bi; hr[s] = nr; hi[s] = ni;
                if (PASS_B) *bp = cvtpk(nr, ni); } }
        if (PASS_B) {
            __syncthreads();
#pragma unroll
            for (int gi2 = 0; gi2 < 2; ++gi2) { const int g = 2 * wid + gi2; f32x4_t y = z4;
#pragma unroll
                for (int ks = 0; ks < 4; ++ks) { const bf16x8_t hf = *(const LAS bf16x8_t*)(BH + n16 * S5_HRS + (g * 128 + 32 * ks + 8 * kg) * 2); y = MFMA16(hf, ccf[gi2][ks], y); }
#pragma unroll
                for (int i = 0; i < 4; ++i) { const int t = 16 * sb + 4 * kg + i;
                    if (t < NT) { const float uu = __uint_as_float(((unsigned)*(const LAS unsigned short*)(UB + t * S5_URS + (16 * g + n16) * 2)) << 16);
                        *(LAS unsigned short*)(UB + t * S5_URS + (16 * g + n16) * 2) = tobf(geluf_(y[i] + dco[gi2] * uu)); } } }
        }
        __syncthreads();
    }
    if (PASS_B) {
        bf16x8_t wf[2][8];
#pragma unroll
        for (int nt = 0; nt < 2; ++nt)
#pragma unroll
            for (int ks = 0; ks < 8; ++ks) wf[nt][ks] = *(const bf16x8_t*)(c.WGLU_T + (size_t)l * 65536 + (size_t)(32 * wid + 16 * nt + n16) * 256 + 32 * ks + 8 * kg);
#pragma unroll 1
        for (int mt = 0; mt < (SMP ? 1 : 4); ++mt) { f32x4_t a0 = z4, a1 = z4;
#pragma unroll
            for (int ks = 0; ks < 8; ++ks) { const bf16x8_t af = *(const LAS bf16x8_t*)(UB + (16 * mt + n16) * S5_URS + (32 * ks + 8 * kg) * 2); a0 = MFMA16(af, wf[0][ks], a0); a1 = MFMA16(af, wf[1][ks], a1); }
#pragma unroll
            for (int i = 0; i < 4; ++i) { const int t = 16 * mt + 4 * kg + i;
                if (t < NT) {
#pragma unroll
                    for (int nt = 0; nt < 2; ++nt) { const int col = 32 * wid + 16 * nt + n16; const float z = nt == 0 ? a0[i] : a1[i];
                        const float gl = __uint_as_float(((unsigned)*(const LAS unsigned short*)(UB + t * S5_URS + col * 2)) << 16);
                        c.MIXB[(size_t)(r0 + t) * DM + 768 + col] = tobf(gl * __builtin_amdgcn_rcpf(1.0f + __expf(-z))); } } } } }
#pragma unroll
    for (int s = 0; s < 2; ++s) { const int idx = tid + 512 * s;
        if (SMP) { c.out[O_S5RS + ((size_t)l * DB + b) * 1024 + idx] = hr[s]; c.out[O_S5IS + ((size_t)l * DB + b) * 1024 + idx] = hi[s]; }
        else if (!PASS_B) { const size_t e = (((size_t)b * NCH + ch) * 1024 + idx) * 2; c.S5E[e] = hr[s]; c.S5E[e + 1] = hi[s]; } }
    __syncthreads();
}

DEV void dn_sample_unit(CREF c, int l, LAS unsigned char* L, int b, int tid) {
    asm volatile("" : "+v"(tid));
    LAS float* Y = (LAS float*)L;
    LAS float* sm = Y + 8 * 768;
    const int r0 = TP + b * DSEQ, lane = tid & 63, wid = tid >> 6;
    for (int idx = tid; idx < 8 * 768; idx += 512) { const int t = idx / 768, cch = idx % 768; const f32x4_t w = *(const f32x4_t*)(c.conv_w + ((size_t)l * CONVD + cch) * 4); float y = 0.f;
#pragma unroll
        for (int j = 0; j < 4; ++j) { const int tt = t - 3 + j; y += w[j] * (tt >= 0 ? c.PROJ[(size_t)(r0 + tt) * PLD + C_DNQKV + cch] : c.st_conv[(((size_t)l * DB + b) * 3 + 3 + tt) * CONVD + cch]); }
        Y[idx] = y / (1.0f + expf(-y)); }
    if (tid < 32) { const int t = tid >> 2, h = tid & 3; sm[64 + tid] = sigmoidf_(c.PROJ[(size_t)(r0 + t) * PLD + C_DNB + h]);
        sm[96 + tid] = expf(-expf(c.a_log[l * DNH + h]) * softplusf_(c.PROJ[(size_t)(r0 + t) * PLD + C_DNA + h] + c.dt_bias[l * DNH + h])); }
    __syncthreads();
    for (int rr = wid * 8; rr < wid * 8 + 8; ++rr) { const int t = rr >> 3, part = (rr >> 2) & 1, h = rr & 3; const float y = Y[t * 768 + part * 256 + h * 64 + lane]; const float ss = wave_sum(y * y);
        if (lane == 0) sm[rr] = (part == 0 ? 0.125f : 1.0f) / sqrtf(ss + 1e-6f); }
    __syncthreads();
    if (tid < 256) { const int h = tid >> 6, jc = tid & 63; float S[64]; const float* s0 = c.st_dn + (((size_t)l * DB + b) * DNH + h) * 4096 + jc;
#pragma unroll
        for (int kk = 0; kk < 64; ++kk) S[kk] = s0[kk * 64];
        const float nw = c.dn_norm_w[l * 64 + jc];
        for (int t = 0; t < DSEQ; ++t) { const LAS float* qp = Y + t * 768 + h * 64; const LAS float* kp = qp + 256; const float qs = sm[t * 8 + h], ksc = sm[t * 8 + 4 + h], a = sm[96 + t * 4 + h], be = sm[64 + t * 4 + h];
            float ks = 0.f;
#pragma unroll
            for (int kk = 0; kk < 64; ++kk) { S[kk] *= a; ks += kp[kk] * S[kk]; }
            const float vn = be * (Y[t * 768 + 512 + h * 64 + jc] - ks * ksc), kv = vn * ksc; float os = 0.f;
#pragma unroll
            for (int kk = 0; kk < 64; ++kk) { S[kk] += kp[kk] * kv; os += qp[kk] * S[kk]; }
            os *= qs;
            const float ss = wave_sum(os * os); const float z = c.PROJ[(size_t)(r0 + t) * PLD + C_DNZ + h * 64 + jc];
            c.MIXB[(size_t)(r0 + t) * DM + 512 + h * 64 + jc] = tobf(os / sqrtf(ss * (1.0f / 64.0f) + NEPS) * nw * (z / (1.0f + expf(-z)))); }
#pragma unroll
        for (int kk = 0; kk < 64; ++kk) c.out[O_DNS + (((size_t)l * DB + b) * DNH + h) * 4096 + kk * 64 + jc] = S[kk]; }
    __syncthreads();
}
DEV void s5_carry_unit(CREF c, int l, int b, int tid) {
    for (int s = 0; s < 2; ++s) { const int idx = tid + 512 * s; const float* K = c.S5K + ((size_t)l * 1024 + idx) * 4; const float a64r = K[2], a64i = K[3]; float hr = 0.f, hi = 0.f;
        for (int c0 = 0; c0 < NCH; c0 += 16) { f32x2_t e[16];
#pragma unroll
            for (int k = 0; k < 16; ++k) e[k] = *(const f32x2_t*)(c.S5E + (((size_t)b * NCH + c0 + k) * 1024 + idx) * 2);
#pragma unroll
            for (int k = 0; k < 16; ++k) { *(f32x2_t*)(c.S5HIN + (((size_t)b * NCH + c0 + k) * 1024 + idx) * 2) = (f32x2_t){hr, hi};
                const float nr = a64r * hr - a64i * hi + e[k][0], ni = a64r * hi + a64i * hr + e[k][1]; hr = nr; hi = ni; } }
        c.out[O_S5RP + ((size_t)l * BATCH + b) * 1024 + idx] = hr; c.out[O_S5IP + ((size_t)l * BATCH + b) * 1024 + idx] = hi; }
}
#ifndef N_LAUNCH_MODE
#define N_LAUNCH_MODE 1
#endif
namespace pg8 {
template <bool ADD> struct EpiF32 {
    static constexpr bool PERM = false, AFTER_DRAIN = false;
    float* C; int ldc;
    __device__ __forceinline__ void operator()(const f32x4 (&acc)[2][2][4][2], const Unit& u, int wr, int wc, int fr, int fq) const {
        const int row0 = u.pm * BM + wr * 64 + fr, col0 = u.pn * BM + wc * 32 + 4 * fq;
#pragma unroll
        for (int ai = 0; ai < 2; ++ai)
#pragma unroll
            for (int m = 0; m < 4; ++m) { float* rowp = C + (size_t)(row0 + ai * HALF + m * 16) * ldc + col0;
#pragma unroll
                for (int bj = 0; bj < 2; ++bj)
#pragma unroll
                    for (int n = 0; n < 2; ++n) { f32x4 v = acc[ai][bj][m][n]; if (ADD) v += *(const f32x4*)(rowp + bj * HALF + n * 16); *(f32x4*)(rowp + bj * HALF + n * 16) = v; } }
    }
};
struct EpiSqReluBf16 {
    static constexpr bool PERM = true, AFTER_DRAIN = false;
    bf16_t* O; int ldc;
    __device__ __forceinline__ void operator()(const f32x4 (&acc)[2][2][4][2], const Unit& u, int wr, int wc, int fr, int fq) const {
        const int row0 = u.pm * BM + wr * 64 + fr, col0 = u.pn * BM + wc * 32 + 8 * fq;
#pragma unroll
        for (int ai = 0; ai < 2; ++ai)
#pragma unroll
            for (int m = 0; m < 4; ++m) { bf16_t* rowp = O + (size_t)(row0 + ai * HALF + m * 16) * ldc + col0;
#pragma unroll
                for (int bj = 0; bj < 2; ++bj) { f32x4 v0 = acc[ai][bj][m][0], v1 = acc[ai][bj][m][1];
#pragma unroll
                    for (int j = 0; j < 4; ++j) { const float a = v0[j] > 0.f ? v0[j] : 0.f, b = v1[j] > 0.f ? v1[j] : 0.f; v0[j] = a * a; v1[j] = b * b; }
                    u32x4 w; w.x = cvt_pk_bf16(v0[0], v0[1]); w.y = cvt_pk_bf16(v0[2], v0[3]); w.z = cvt_pk_bf16(v1[0], v1[1]); w.w = cvt_pk_bf16(v1[2], v1[3]);
                    *(u32x4*)(rowp + bj * HALF) = w; } }
    }
};
struct EpiGluBf16 {
    static constexpr bool PERM = true, AFTER_DRAIN = false;
    bf16_t* O; int ldc; const bf16_t* GLv;
    __device__ __forceinline__ void operator()(const f32x4 (&acc)[2][2][4][2], const Unit& u, int wr, int wc, int fr_, int fq_) const {
        int ln; asm volatile("v_mbcnt_lo_u32_b32 %0, -1, 0\n\tv_mbcnt_hi_u32_b32 %0, -1, %0" : "=v"(ln)); const int fr = ln & 15, fq = ln >> 4;
        const int row0 = u.pm * BM + wr * 64 + fr, col0 = u.pn * BM + wc * 32 + 8 * fq;
#pragma unroll
        for (int ai = 0; ai < 2; ++ai)
#pragma unroll
            for (int m = 0; m < 4; ++m) { const size_t r = (size_t)(row0 + ai * HALF + m * 16);
#pragma unroll
                for (int bj = 0; bj < 2; ++bj) { const u32x4 gv = *(const u32x4*)(GLv + r * 256 + col0 + bj * HALF); f32x4 v0 = acc[ai][bj][m][0], v1 = acc[ai][bj][m][1];
#pragma unroll
                    for (int j = 0; j < 4; ++j) { v0[j] = __builtin_amdgcn_rcpf(1.0f + __expf(-v0[j])); v1[j] = __builtin_amdgcn_rcpf(1.0f + __expf(-v1[j])); }
                    v0[0] *= __uint_as_float(gv[0] << 16); v0[1] *= __uint_as_float(gv[0] & 0xffff0000u); v0[2] *= __uint_as_float(gv[1] << 16); v0[3] *= __uint_as_float(gv[1] & 0xffff0000u);
                    v1[0] *= __uint_as_float(gv[2] << 16); v1[1] *= __uint_as_float(gv[2] & 0xffff0000u); v1[2] *= __uint_as_float(gv[3] << 16); v1[3] *= __uint_as_float(gv[3] & 0xffff0000u);
                    u32x4 w; w.x = cvt_pk_bf16(v0[0], v0[1]); w.y = cvt_pk_bf16(v0[2], v0[3]); w.z = cvt_pk_bf16(v1[0], v1[1]); w.w = cvt_pk_bf16(v1[2], v1[3]);
                    *(u32x4*)(O + r * ldc + col0 + bj * HALF) = w; } }
    }
};
}

#define XB_TMO      128
#define XB_XCNT(j)  (256  + 64 * (j))
#define XB_XSUB(j)  (1280 + 64 * (j))
#define XB_XGEN(j)  (2304 + 64 * (j))
#define XB_TOP      3328
#define XB_TOPGEN   3392
#define XCD_BAR_WORDS 3456
#define XB_SPIN_CAP (1u << 24)
__device__ __forceinline__ unsigned xb_ld(unsigned* p)              { return __hip_atomic_load(p, __ATOMIC_RELAXED, __HIP_MEMORY_SCOPE_AGENT); }
__device__ __forceinline__ unsigned xb_add(unsigned* p, unsigned v) { return __hip_atomic_fetch_add(p, v, __ATOMIC_RELAXED, __HIP_MEMORY_SCOPE_AGENT); }
__device__ __forceinline__ unsigned xb_xcc_id() { return (unsigned)__builtin_amdgcn_s_getreg((3 << 11) | 20) & 0xFu; }
#define XB_SPIN(cond, bar) do { unsigned _sp = 0; while (cond) { __builtin_amdgcn_s_sleep(1); \
    if ((++_sp & 255u) == 0u) { if (xb_ld(&(bar)[XB_TMO])) break; if (_sp > XB_SPIN_CAP) { atomicAdd(&(bar)[XB_TMO], 1u); break; } } } } while (0)
struct XcdBarrier { unsigned* bar; unsigned x; volatile LAS unsigned* st; };
__device__ __forceinline__ XcdBarrier xcd_barrier_post(unsigned* bar, volatile LAS unsigned* st) {
    XcdBarrier b; b.bar = bar; b.x = xb_xcc_id(); b.st = st;
    if (threadIdx.x == 0) (void)xb_add(&bar[XB_XCNT(b.x)], 1u);
    return b;
}
__device__ __forceinline__ void xcd_barrier_complete(unsigned* bar, unsigned x, unsigned& nloc, unsigned& nx) {
    const unsigned G = gridDim.x * gridDim.y * gridDim.z;
    unsigned sum, cnt, mine, sp = 0u;
    for (;;) {
        sum = 0u; cnt = 0u; mine = 0u;
#pragma unroll
        for (unsigned j = 0; j < 16; ++j) { const unsigned c = xb_ld(&bar[XB_XCNT(j)]); sum += c; cnt += (c > 0u) ? 1u : 0u; mine = (j == x) ? c : mine; }
        if (sum == G) break;
        __builtin_amdgcn_s_sleep(1);
        if ((++sp & 255u) == 0u) { if (xb_ld(&bar[XB_TMO])) break; if (sp > XB_SPIN_CAP) { atomicAdd(&bar[XB_TMO], 1u); break; } }
    }
    nloc = mine > 0u ? mine : 1u; nx = cnt > 0u ? cnt : 1u;
}
__device__ __forceinline__ void xcd_barrier(const XcdBarrier& b, const bool t0) {
    asm volatile("s_waitcnt vmcnt(0)" ::: "memory");
    __syncthreads();
    if (t0) {
        unsigned* bar = b.bar; unsigned bx = b.x; asm volatile("" : "+s"(bar), "+s"(bx));
        __builtin_amdgcn_s_waitcnt(0);
        unsigned nloc = b.st[0], nx = b.st[1];
        if (nloc == 0u) { xcd_barrier_complete(bar, bx, nloc, nx); b.st[0] = nloc; b.st[1] = nx; }
        const unsigned old = xb_add(&bar[XB_XSUB(bx)], 1u);
        const unsigned gen = old / nloc;
        if (old + 1u == (gen + 1u) * nloc) {
            __builtin_amdgcn_fence(__ATOMIC_RELEASE, "agent");
            asm volatile("s_waitcnt vmcnt(0)" ::: "memory");
            const unsigned og = xb_add(&bar[XB_TOP], 1u);
            const unsigned tg = og / nx;
            if (og + 1u == (tg + 1u) * nx) xb_add(&bar[XB_TOPGEN], 1u);
            else XB_SPIN(xb_ld(&bar[XB_TOPGEN]) == tg, bar);
            __builtin_amdgcn_fence(__ATOMIC_ACQUIRE, "agent");
            xb_add(&bar[XB_XGEN(bx)], 1u);
            asm volatile("s_waitcnt vmcnt(0)" ::: "memory");
        } else {
            XB_SPIN(xb_ld(&bar[XB_XGEN(bx)]) == gen, bar);
            __builtin_amdgcn_fence(__ATOMIC_ACQUIRE, "agent");
            asm volatile("s_waitcnt vmcnt(0)" ::: "memory");
        }
    }
    __syncthreads();
}

constexpr int RING_BYTES = 131072, LDS_BYTES = 147456, LDSCTL_OFF = LDS_BYTES - 256;
constexpr int NTHREADS = 512;
constexpr size_t al256(size_t x) { return (x + 255) & ~(size_t)255; }
constexpr size_t WS_CTL = 0, CTL_BYTES = 65536;
constexpr size_t WS_X = al256(WS_CTL + CTL_BYTES), WS_SSQ = al256(WS_X + (size_t)TT * DM * 4), WS_XN = al256(WS_SSQ + (size_t)TT * 64 * 4),
    WS_PROJ = al256(WS_XN + (size_t)TT * DM * 2), WS_MIXB = al256(WS_PROJ + (size_t)TT * PLD * 4), WS_UPB = al256(WS_MIXB + (size_t)TT * DM * 2),
    WS_WIN = al256(WS_UPB + (size_t)TT * DFF * 2), WS_WOUT = al256(WS_WIN + (size_t)2 * PLD * DM * 2), WS_WUP = al256(WS_WOUT + (size_t)2 * DM * DM * 2),
    WS_WDN = al256(WS_WUP + (size_t)2 * DFF * DM * 2), WS_KC = al256(WS_WDN + (size_t)2 * DM * DFF * 2), WS_VC = al256(WS_KC + (size_t)NSEQ * NBMAX * 128 * 4),
    WS_PC = al256(WS_VC + (size_t)NSEQ * NBMAX * 128 * 4), WS_OC = al256(WS_PC + (size_t)TT * NH * NBMAX * 4), WS_IDX = al256(WS_OC + (size_t)TT * NH * 64 * 4),
    WS_QN = al256(WS_IDX + (size_t)TT * NG * TOPK * 4), WS_KN = al256(WS_QN + (size_t)TT * 256 * 4), WS_VV = al256(WS_KN + (size_t)TT * 256 * 4),
    WS_GG = al256(WS_VV + (size_t)TT * 256 * 4), WS_BETA = al256(WS_GG + (size_t)TT * DNH * 4), WS_GC = al256(WS_BETA + (size_t)TT * DNH * 4),
    WS_AM = al256(WS_GC + (size_t)NDU * 64 * 4), WS_AQK = al256(WS_AM + (size_t)NDU * 4096 * 4), WS_SOL = al256(WS_AQK + (size_t)NDU * 4096 * 4),
    WS_VNEW = al256(WS_SOL + (size_t)NDU * 8192 * 4), WS_SDN = al256(WS_VNEW + (size_t)BATCH * DNH * 4096 * 4), WS_ODN = al256(WS_SDN + (size_t)BATCH * DNH * 4096 * 4),
    WS_S5K = al256(WS_ODN + (size_t)TT * 256 * 4), WS_S5BB = al256(WS_S5K + 2 * S5G * S5P * 4 * 4), WS_S5E = al256(WS_S5BB + 2 * S5G * S5P * S5C * 2 * 4),
    WS_S5HIN = al256(WS_S5E + (size_t)BATCH * NCH * 2048 * 4), WS_S5HS = al256(WS_S5HIN + (size_t)BATCH * NCH * 2048 * 4), WS_GL = al256(WS_S5HS + (size_t)TT * 2048 * 4),
    WS_GLB = al256(WS_GL + (size_t)TT * 256 * 4), WS_WGLU = al256(WS_GLB + (size_t)TT * 256 * 2), WS_PART = al256(WS_WGLU + (size_t)2 * 65536 * 2), WS_DNF = al256(WS_PART + (size_t)8 * TS * DM * 4), WS_DNU = al256(WS_DNF + (size_t)NDU * 16384 * 2), WS_DNE = al256(WS_DNU + (size_t)NDU * 4096 * 4), WS_DNG = al256(WS_DNE + (size_t)NDU * 4), WS_S5BF = al256(WS_DNG + (size_t)NDU * 4096 * 2), WS_S5CF = al256(WS_S5BF + (size_t)2 * 16 * 8 * 64 * 8 * 2), WS_END = al256(WS_S5CF + (size_t)2 * 16 * 4 * 64 * 8 * 2);

struct Args { Ctx c; unsigned* bar; int lo, hi; };
constexpr int NPH = 1 + 2 * 14 + 2;
typedef const __attribute__((address_space(4))) unsigned char* karg_t;
__device__ __forceinline__ int lane_id() { return (int)__builtin_amdgcn_mbcnt_hi(~0u, __builtin_amdgcn_mbcnt_lo(~0u, 0u)); }
__device__ __forceinline__ int lane_id_v() { int t; asm volatile("v_mbcnt_lo_u32_b32 %0, -1, 0\n\tv_mbcnt_hi_u32_b32 %0, -1, %0" : "=v"(t)); return t; }
#define TIDV (wv * 64 + lane_id_v())
template <int P> __device__ __forceinline__ void run_phase(const int l, LAS unsigned char* L, const int wv) {
    karg_t kp = (karg_t)__builtin_amdgcn_kernarg_segment_ptr(); asm volatile("" : "+s"(kp));
    CREF c = *(const __attribute__((address_space(4))) Ctx*)kp;
    int tx_ = wv * 64 + lane_id_v(), bx_ = blockIdx.x; asm volatile("" : "+v"(tx_), "+s"(bx_));
    const long gtid = (long)bx_ * NTHREADS + tx_, gn = (long)gridDim.x * NTHREADS;
    const int G = (int)gridDim.x;
    if constexpr (P == 0) { dev_prologue(c, L, bx_, tx_, gtid, gn); dev_s5_consts(c, (long)(G - 1 - bx_) * NTHREADS + tx_, gn);   }
    if constexpr (P == 2) dev_rmsnorm<false>(c, c.ln1 + l * DM, bx_, tx_, l == 0 ? 0 : 8);
    if constexpr (P == 3) { pg8::Gemm g{c.XN, c.WIN_T + (size_t)l * PLD * DM, TT, PLD, DM, DM}; pg8::StaticOrder S; S.init(TT, PLD, G, bx_);
        pg8::EpiF32<false> E{c.PROJ, PLD}; pg8::gemm_phase<pg8::EpiF32<false>, pg8::StaticOrder, true, true>(L, g, S, E, wv * 64 + lane_id_v()); }
    if constexpr (P == 4) { for (int u = bx_; u < NDU; u += G) dn_prep_unit(c, l, L, u, TIDV);
        for (int u = bx_; u < BATCH * NCH; u += G) s5_unit<false, false>(c, l, L, u / NCH, u % NCH, TIDV);
        constexpr int NPU = BATCH * NBP + DB * NBC_S;
        { const int t = TIDV; for (int u = 2 * bx_ + (t >> 8); u < NPU; u += 2 * G) { if (u < BATCH * NBP) pool_unit(c, l, u / NBP, u % NBP, t & 255); else pool_unit(c, l, BATCH + (u - BATCH * NBP) / NBC_S, (u - BATCH * NBP) % NBC_S, t & 255); } } }
    if constexpr (P == 5) {
        if (bx_ < BATCH * DNH) dn_scan_mfma(c, l, L, bx_, TIDV);
        constexpr int NU = BATCH * NG * NBP;
        volatile LAS int* qslot = (volatile LAS int*)(L + LDSCTL_OFF + 64);
#define QLOOP(qi, count, ...) for (;;) { if (wv == 0 && lane_id_v() == 0) qslot[0] = (int)__hip_atomic_fetch_add(c.QCTR + 64 * (8 * l + (qi)), 1u, __ATOMIC_RELAXED, __HIP_MEMORY_SCOPE_AGENT); \
            __syncthreads(); const int it = qslot[0]; __syncthreads(); if (it >= (count)) break; __VA_ARGS__; }
        QLOOP(0, NU, { const int qb = NBP - 1 - it / (BATCH * NG), bg = it % (BATCH * NG); nsa_unit<false>(c, l, L, bg / NG, qb, bg % NG, TIDV); })
        QLOOP(1, DB * NG, nsa_unit<true>(c, l, L, it / NG, PAST / 64, it % NG, TIDV))
        QLOOP(2, DB, dn_sample_unit(c, l, L, it, TIDV))
        QLOOP(3, BATCH, s5_carry_unit(c, l, it, TIDV))
        QLOOP(5, BATCH * NCH + DB, { if (it < BATCH * NCH) s5_unit<true, false>(c, l, L, it / NCH, it % NCH, TIDV); else s5_unit<true, true>(c, l, L, it - BATCH * NCH, 0, TIDV); })
        QLOOP(4, 256, dev_copy_out(c, l, (long)it * NTHREADS + TIDV, (long)256 * NTHREADS))
#undef QLOOP
    }
    if constexpr (P == 9) dev_dn_out(c, l, bx_, tx_);
    if constexpr (P == 10) {
        { pg8::Gemm g{c.MIXB, c.WOUT_T + (size_t)l * DM * DM, TP, DM, DM, DM}; pg8::StaticOrder S; S.init(TP, DM, G, bx_);
          pg8::EpiF32<true> E{c.X, DM}; pg8::gemm_phase<pg8::EpiF32<true>, pg8::StaticOrder, true, true>(L, g, S, E, wv * 64 + lane_id_v()); }
        if (bx_ < 64) { const int ks = bx_ >> 4; pg8::Gemm g{c.MIXB + (size_t)TP * DM + ks * 256, c.WOUT_T + (size_t)l * DM * DM + ks * 256, TS, DM, 256, DM}; pg8::StaticOrder S; S.init(TS, DM, 16, bx_ & 15);
          pg8::EpiF32<false> E{c.PART + (size_t)ks * TS * DM, DM}; pg8::gemm_phase<pg8::EpiF32<false>, pg8::StaticOrder, true, true>(L, g, S, E, wv * 64 + lane_id_v()); } }
    if constexpr (P == 11) dev_rmsnorm<false>(c, c.ln2 + l * DM, bx_, tx_, 4);
    if constexpr (P == 12) { pg8::Gemm g{c.XN, c.WUP_T + (size_t)l * DFF * DM, TT, DFF, DM, DM}; pg8::StaticOrder S; S.init(TT, DFF, G, bx_);
        pg8::EpiSqReluBf16 E{c.UPB, DFF}; pg8::gemm_phase<pg8::EpiSqReluBf16, pg8::StaticOrder, true, true>(L, g, S, E, wv * 64 + lane_id_v()); }
    if constexpr (P == 13) {
        { pg8::Gemm g{c.UPB, c.WDN_T + (size_t)l * DM * DFF, TP, DM, DFF, DFF}; pg8::StaticOrder S; S.init(TP, DM, G, bx_);
          pg8::EpiF32<true> E{c.X, DM}; pg8::gemm_phase<pg8::EpiF32<true>, pg8::StaticOrder, true, true>(L, g, S, E, wv * 64 + lane_id_v()); }
        if (bx_ < 128) { const int ks = bx_ >> 4; pg8::Gemm g{c.UPB + (size_t)TP * DFF + ks * 512, c.WDN_T + (size_t)l * DM * DFF + ks * 512, TS, DM, 512, DFF}; pg8::StaticOrder S; S.init(TS, DM, 16, bx_ & 15);
          pg8::EpiF32<false> E{c.PART + (size_t)ks * TS * DM, DM}; pg8::gemm_phase<pg8::EpiF32<false>, pg8::StaticOrder, true, true>(L, g, S, E, wv * 64 + lane_id_v()); } }
    if constexpr (P == 14) dev_rmsnorm<true>(c, c.ln_f, bx_, tx_, 8);
}
#if N_LAUNCH_MODE == 1
__global__ void __launch_bounds__(NTHREADS, 2) fwd_kernel(Args a) {
    extern __shared__ __attribute__((aligned(16))) unsigned char lds[];
    LAS unsigned char* L = (LAS unsigned char*)lds;
    volatile LAS unsigned* MISC = (volatile LAS unsigned*)(L + LDSCTL_OFF);
    for (int u = threadIdx.x; u < (LDS_BYTES - LDSCTL_OFF) / 4; u += NTHREADS) ((LAS unsigned*)(L + LDSCTL_OFF))[u] = 0u;
    __syncthreads();
    XcdBarrier bar = xcd_barrier_post(a.bar, MISC + 8);
    const int wv = __builtin_amdgcn_readfirstlane((int)threadIdx.x >> 6);
#define PHASE(P, l) do { run_phase<P>(l, L, wv); xcd_barrier(bar, wv == 0 && lane_id_v() == 0); } while (0)
    PHASE(0, 0);
#define LAYER(l) PHASE(2, l); PHASE(3, l); PHASE(4, l); PHASE(5, l); PHASE(10, l); PHASE(11, l); PHASE(12, l); PHASE(13, l)
#define LAYER0 PHASE(3, 0); PHASE(4, 0); PHASE(5, 0); PHASE(10, 0); PHASE(11, 0); PHASE(12, 0); PHASE(13, 0)
    LAYER0; LAYER(1);
#undef LAYER
    run_phase<14>(0, L, wv);
#undef PHASE
}
#else
template <int P> __global__ void __launch_bounds__(NTHREADS, 2) k_phase(Args a) {
    extern __shared__ __attribute__((aligned(16))) unsigned char lds[];
    run_phase<P>(a.lo, (LAS unsigned char*)lds, __builtin_amdgcn_readfirstlane((int)threadIdx.x >> 6));
}
template <int P> static void launch_phase(const Args& a, int grid, hipStream_t stream) {
    static bool attr = false;
    if (!attr) { (void)hipFuncSetAttribute((const void*)k_phase<P>, hipFuncAttributeMaxDynamicSharedMemorySize, LDS_BYTES); attr = true; }
    hipLaunchKernelGGL(k_phase<P>, dim3(grid), dim3(NTHREADS), LDS_BYTES, stream, a);
}
#endif

extern "C" void kernel_launch(void* const* d_in, const int* in_sizes, int n_in, void* d_out, int out_size, void* d_ws, size_t ws_size, hipStream_t stream) {
    static int grid = 0;
    if (grid == 0) {
        if (n_in != 31 || in_sizes[0] != TP * DM || (size_t)out_size != O_END || ws_size < WS_END) { fprintf(stderr, "kernel_launch: shape mismatch (n_in %d in0 %d out %d ws %zu need %zu)\n", n_in, n_in > 0 ? in_sizes[0] : -1, out_size, ws_size, (size_t)WS_END); grid = -1; return; }
        int dev = 0, cus = 0;
        if (hipGetDevice(&dev) != hipSuccess || hipDeviceGetAttribute(&cus, hipDeviceAttributeMultiprocessorCount, dev) != hipSuccess) { grid = -1; return; }
#if N_LAUNCH_MODE == 1
        int per_cu = 0;
        if (hipFuncSetAttribute((const void*)fwd_kernel, hipFuncAttributeMaxDynamicSharedMemorySize, LDS_BYTES) != hipSuccess) { fprintf(stderr, "kernel_launch: hipFuncSetAttribute failed\n"); grid = -1; return; }
        if (hipOccupancyMaxActiveBlocksPerMultiprocessor(&per_cu, (const void*)fwd_kernel, NTHREADS, LDS_BYTES) != hipSuccess || per_cu < 1) fprintf(stderr, "kernel_launch: occupancy query reports %d\n", per_cu);
        (void)hipGetLastError();
#endif
        grid = cus;
    }
    if (grid < 0) return;
    if (hipMemsetAsync((char*)d_ws + WS_CTL, 0, CTL_BYTES, stream) != hipSuccess) return;
    Args a{};
    Ctx& c = a.c;
    const float** fp[] = {&c.x_prompt, &c.x_sample, &c.cache_nsa, &c.cache_win, &c.st_conv, &c.st_dn, &c.st_s5re, &c.st_s5im, nullptr, &c.ln1, &c.ln2, &c.ln_f, &c.w_in, &c.w_out, &c.wck, &c.wcv, &c.conv_w, &c.a_log, &c.dt_bias,
                          &c.dn_norm_w, &c.lam_re, &c.lam_im, &c.log_step, &c.b_re, &c.b_im, &c.c_re, &c.c_im, &c.s5_d, &c.w_glu, &c.mlp_up, &c.mlp_down};
    for (int i = 0; i < 31; ++i) { if (i == 8) c.page_table = (const int*)d_in[i]; else *fp[i] = (const float*)d_in[i]; }
    c.out = (float*)d_out;
    char* w = (char*)d_ws;
    c.X = (float*)(w + WS_X); c.SSQ = (float*)(w + WS_SSQ); c.XN = (bf16_t*)(w + WS_XN); c.PROJ = (float*)(w + WS_PROJ); c.MIXB = (bf16_t*)(w + WS_MIXB); c.UPB = (bf16_t*)(w + WS_UPB);
    c.WIN_T = (bf16_t*)(w + WS_WIN); c.WOUT_T = (bf16_t*)(w + WS_WOUT); c.WUP_T = (bf16_t*)(w + WS_WUP); c.WDN_T = (bf16_t*)(w + WS_WDN);
    c.KC = (float*)(w + WS_KC); c.VC = (float*)(w + WS_VC); c.PC = (float*)(w + WS_PC); c.OC = (float*)(w + WS_OC); c.IDX = (int*)(w + WS_IDX);
    c.QN = (float*)(w + WS_QN); c.KN = (float*)(w + WS_KN); c.VV = (float*)(w + WS_VV); c.GG = (float*)(w + WS_GG); c.BETA = (float*)(w + WS_BETA);
    c.GC = (float*)(w + WS_GC); c.AM = (float*)(w + WS_AM); c.AQK = (float*)(w + WS_AQK); c.SOL = (float*)(w + WS_SOL); c.VNEW = (float*)(w + WS_VNEW); c.SDN = (float*)(w + WS_SDN); c.ODN = (float*)(w + WS_ODN);
    c.S5K = (float*)(w + WS_S5K); c.S5BB = (float*)(w + WS_S5BB); c.S5E = (float*)(w + WS_S5E); c.S5HIN = (float*)(w + WS_S5HIN); c.S5HS = (float*)(w + WS_S5HS); c.GL = (float*)(w + WS_GL); c.GLB = (bf16_t*)(w + WS_GLB); c.WGLU_T = (bf16_t*)(w + WS_WGLU); c.QCTR = (unsigned*)(w + WS_CTL) + 8192; c.PART = (float*)(w + WS_PART); c.DNF = (bf16_t*)(w + WS_DNF); c.DNU = (float*)(w + WS_DNU); c.DNE = (float*)(w + WS_DNE); c.DNG = (bf16_t*)(w + WS_DNG); c.S5BF = (bf16_t*)(w + WS_S5BF); c.S5CF = (bf16_t*)(w + WS_S5CF);
    a.bar = (unsigned*)(w + WS_CTL) + 1024;
#if N_LAUNCH_MODE == 1
    a.lo = 0; a.hi = NPH;
    hipLaunchKernelGGL(fwd_kernel, dim3(grid), dim3(NTHREADS), LDS_BYTES, stream, a);
#else
    a.hi = 0; a.lo = 0; launch_phase<0>(a, grid, stream);
    for (int l = 0; l < 2; ++l) { a.lo = l;
        launch_phase<1>(a, grid, stream); launch_phase<2>(a, grid, stream); launch_phase<3>(a, grid, stream); launch_phase<4>(a, grid, stream); launch_phase<5>(a, grid, stream);
        launch_phase<6>(a, grid, stream); launch_phase<7>(a, grid, stream); launch_phase<8>(a, grid, stream); launch_phase<9>(a, grid, stream); launch_phase<10>(a, grid, stream);
        launch_phase<1>(a, grid, stream); launch_phase<11>(a, grid, stream); launch_phase<12>(a, grid, stream); launch_phase<13>(a, grid, stream); }
    a.lo = 0; launch_phase<1>(a, grid, stream); launch_phase<14>(a, grid, stream);
#endif
}
```

```cpp
#include <hip/hip_runtime.h>
#include <cstdio>
#include <cstdint>
#define N_LAUNCH_MODE 1
#define HD __device__ __forceinline__
#ifndef CFG_SEQ
#define CFG_SEQ 8192
#endif
#ifndef CFG_BATCH
#define CFG_BATCH 2
#endif
#ifndef CFG_DB
#define CFG_DB 128
#endif
constexpr int DM = 1024, SEQ = CFG_SEQ, BATCH = CFG_BATCH, DB = CFG_DB, DSEQ = 8, PAST = 2048, PAGE = 128, NPAGES = PAST / PAGE;
constexpr int NUSED = DB * NPAGES, NPHYS = NUSED + (NUSED + 3) / 4;
constexpr int HD_ = 64, NH = 8, NG = 2, NR = 4, NBLK = 64, TOPK = 16, WIN = 512, W0S = PAST - WIN;
constexpr int DNH = 4, DNW = 256, CONVD = 768, S5G = 16, S5P = 64, S5C = 16, DFF = 4096, INW = 2592;
constexpr int TP = BATCH * SEQ, TS = DB * DSEQ, TT = TP + TS;
constexpr int PLD = 2816;
constexpr int C_Q = 0, C_KV = 512, C_GATE = 1280, C_DNQKV = 1304, C_DNA = 2072, C_DNB = 2076, C_DNZ = 2080, C_S5U = 2336;
constexpr int NBP = SEQ / NBLK;
constexpr int NBS_S = 33, NBC_S = 32;
constexpr int NBMAX = (NBP > 64 ? NBP : 64);
constexpr int NSEQ = BATCH + DB;
constexpr int NCH = SEQ / 64;
constexpr int NDU = BATCH * DNH * NCH;
constexpr float NEPS = 1e-6f;
static_assert(NBMAX <= 128, "selection bitmask is 128 bits");

constexpr size_t O_YP = 0, O_YS = O_YP + (size_t)TP * DM, O_KVP = O_YS + (size_t)TS * DM, O_KVS = O_KVP + (size_t)2 * TP * 512,
    O_WINP = O_KVS + (size_t)2 * TS * 512, O_WINS = O_WINP + (size_t)2 * BATCH * 512 * 256, O_CONVP = O_WINS + (size_t)2 * DB * 512 * 256,
    O_CONVS = O_CONVP + (size_t)2 * BATCH * 3 * CONVD, O_DNP = O_CONVS + (size_t)2 * DB * 3 * CONVD, O_DNS = O_DNP + (size_t)2 * BATCH * DNH * 4096,
    O_S5RP = O_DNS + (size_t)2 * DB * DNH * 4096, O_S5RS = O_S5RP + (size_t)2 * BATCH * 1024, O_S5IP = O_S5RS + (size_t)2 * DB * 1024,
    O_S5IS = O_S5IP + (size_t)2 * BATCH * 1024, O_END = O_S5IS + (size_t)2 * DB * 1024;

#ifdef HOST_EMU
typedef float bf16_t;
HD bf16_t tobf(float f) { return f; }
HD float frombf(bf16_t b) { return b; }
#else
typedef unsigned short bf16_t;
HD bf16_t tobf(float f) { unsigned u = __float_as_uint(f); u += 0x7fffu + ((u >> 16) & 1u); return (bf16_t)(u >> 16); }
HD float frombf(bf16_t b) { return __uint_as_float(((unsigned)b) << 16); }
#endif

struct Ctx {
    const float *x_prompt, *x_sample, *cache_nsa, *cache_win, *st_conv, *st_dn, *st_s5re, *st_s5im; const int* page_table;
    const float *ln1, *ln2, *ln_f, *w_in, *w_out, *wck, *wcv, *conv_w, *a_log, *dt_bias, *dn_norm_w, *lam_re, *lam_im, *log_step,
        *b_re, *b_im, *c_re, *c_im, *s5_d, *w_glu, *mlp_up, *mlp_down;
    float* out;
    float* X;
    float* SSQ;
    bf16_t* XN;
    float* PROJ;
    bf16_t* MIXB;
    bf16_t* UPB;
    bf16_t *WIN_T, *WOUT_T, *WUP_T, *WDN_T;
    float *KC, *VC;
    float* PC;
    float* OC;
    int* IDX;
    float *QN, *KN, *VV;
    float *GG, *BETA;
    float* GC;
    float* AM;
    float* AQK;
    float* SOL;
    float* VNEW;
    float* SDN;
    float* ODN;
    float* S5K;
    float* S5BB;
    float* S5E;
    float* S5HIN;
    float* S5HS;
    float* GL;
    bf16_t* GLB;
    bf16_t* WGLU_T;
    unsigned* QCTR;
    bf16_t* DNF;
    float* DNU;
    float* DNE;
    bf16_t* DNG;
    bf16_t* S5BF;
    bf16_t* S5CF;
    float* PART;
};

HD float sigmoidf_(float x) { return 1.0f / (1.0f + expf(-x)); }
HD float siluf_(float x) { return x * sigmoidf_(x); }
HD float softplusf_(float x) { return (x > 0.f ? x : 0.f) + log1pf(expf(-fabsf(x))); }
HD float geluf_(float x) { return 0.5f * x * (1.0f + tanhf(0.7978845608028654f * (x + 0.044715f * x * x * x))); }

#ifdef HOST_EMU
typedef const Ctx& CREF;
#else
typedef const __attribute__((address_space(4))) Ctx& CREF;
#endif
struct Tok { int smp, b, j, t, seq; };
HD Tok tok_of(int r) { Tok k; if (r < TP) { k.smp = 0; k.b = r / SEQ; k.j = r % SEQ; k.t = k.j; k.seq = k.b; } else { r -= TP; k.smp = 1; k.b = r / DSEQ; k.j = r % DSEQ; k.t = PAST + k.j; k.seq = BATCH + k.b; } return k; }

HD const float* kv_ptr(CREF c, int l, int smp, int b, int pos, int slot, int g) {
    if (!smp) return c.PROJ + (size_t)(b * SEQ + pos) * PLD + C_KV + slot * 128 + g * 64;
    if (pos >= PAST) return c.PROJ + (size_t)(TP + b * DSEQ + (pos - PAST)) * PLD + C_KV + slot * 128 + g * 64;
    if (slot < 4) { const int pg = c.page_table[b * NPAGES + pos / PAGE]; return c.cache_nsa + ((((size_t)l * NPHYS + pg) * PAGE + (pos % PAGE)) * 4 + slot) * 128 + g * 64; }
    return c.cache_win + ((((size_t)l * DB + b) * WIN + (pos - W0S)) * 2 + (slot - 4)) * 128 + g * 64;
}

HD void ph_prologue(CREF c, long gtid, long gn) {
    for (long i = gtid; i < (long)2 * PLD * DM; i += gn) { const int l = (int)(i / ((long)PLD * DM)); const long r = i % ((long)PLD * DM); const int n = (int)(r / DM), k = (int)(r % DM);
        c.WIN_T[i] = tobf(n < INW ? c.w_in[((size_t)l * DM + k) * INW + n] : 0.f); }
    for (long i = gtid; i < (long)2 * DM * DM; i += gn) { const int l = (int)(i / ((long)DM * DM)); const long r = i % ((long)DM * DM); const int n = (int)(r / DM), k = (int)(r % DM);
        c.WOUT_T[i] = tobf(c.w_out[((size_t)l * DM + k) * DM + n]); }
    for (long i = gtid; i < (long)2 * DFF * DM; i += gn) { const int l = (int)(i / ((long)DFF * DM)); const long r = i % ((long)DFF * DM); const int n = (int)(r / DM), k = (int)(r % DM);
        c.WUP_T[i] = tobf(c.mlp_up[((size_t)l * DM + k) * DFF + n]); }
    for (long i = gtid; i < (long)2 * DM * DFF; i += gn) { const int l = (int)(i / ((long)DM * DFF)); const long r = i % ((long)DM * DFF); const int n = (int)(r / DFF), k = (int)(r % DFF);
        c.WDN_T[i] = tobf(c.mlp_down[((size_t)l * DFF + k) * DM + n]); }
    for (long i = gtid; i < (long)TT * DM; i += gn) c.X[i] = i < (long)TP * DM ? c.x_prompt[i] : c.x_sample[i - (long)TP * DM];
}
HD void ph_s5_consts(CREF c, long gtid, long gn) {
    for (long i = gtid; i < 2 * S5G * S5P; i += gn) { const int l = (int)(i / (S5G * S5P)), g = (int)((i / S5P) % S5G);
        const double lr = c.lam_re[i], li = c.lam_im[i], dt = exp((double)c.log_step[l * S5G + g]);
        const double mag = exp(lr * dt), ar = mag * cos(li * dt), ai = mag * sin(li * dt), den = lr * lr + li * li;
        const double fr = ((ar - 1.0) * lr + ai * li) / den, fi = (ai * lr - (ar - 1.0) * li) / den;
        double pr = 1.0, pi = 0.0; for (int s = 0; s < 64; ++s) { const double nr = pr * ar - pi * ai, ni = pr * ai + pi * ar; pr = nr; pi = ni; }
        c.S5K[i * 4 + 0] = (float)ar; c.S5K[i * 4 + 1] = (float)ai; c.S5K[i * 4 + 2] = (float)pr; c.S5K[i * 4 + 3] = (float)pi;
        for (int ch = 0; ch < S5C; ++ch) { const double br = c.b_re[i * S5C + ch], bi = c.b_im[i * S5C + ch];
            c.S5BB[(i * S5C + ch) * 2 + 0] = (float)(fr * br - fi * bi); c.S5BB[(i * S5C + ch) * 2 + 1] = (float)(fr * bi + fi * br);
#ifndef HOST_EMU
            {
                const int p = (int)(i % S5P); const size_t lg = (size_t)(i / S5P);
#pragma unroll
                for (int comp = 0; comp < 2; ++comp) { const int s = 2 * p + comp, j = s >> 4, n = s & 15;
                    c.S5BF[((lg * 8 + j) * 64 + n + 16 * (ch >> 3)) * 8 + (ch & 7)] = tobf((float)(comp == 0 ? fr * br - fi * bi : fr * bi + fi * br));
                    if (ch < 8) { c.S5BF[((lg * 8 + j) * 64 + n + 32) * 8 + ch] = 0; c.S5BF[((lg * 8 + j) * 64 + n + 48) * 8 + ch] = 0; }
                    const int k = s, ks = k >> 5, kg = (k & 31) >> 3, jj = k & 7; const size_t ci = ((lg * S5C + ch) * S5P + p);
                    c.S5CF[((lg * 4 + ks) * 64 + ch + 16 * kg) * 8 + jj] = tobf(comp == 0 ? c.c_re[ci] : -c.c_im[ci]); } }
#endif
        } }
}

HD void ph_ssq(CREF c, long gtid, long gn) {
    for (long i = gtid; i < (long)TT * 64; i += gn) { const float* p = c.X + i * 16; float s = 0.f; for (int k = 0; k < 16; ++k) s += p[k] * p[k]; c.SSQ[i] = s; }
}
HD float row_rstd(CREF c, int r) { const float* p = c.SSQ + (size_t)r * 64; float s = 0.f; for (int k = 0; k < 64; ++k) s += p[k]; return 1.0f / sqrtf(s * (1.0f / DM) + NEPS); }
HD void ph_norm(CREF c, const float* gain, long gtid, long gn) {
    for (long i = gtid; i < (long)TT * (DM / 4); i += gn) { const int r = (int)(i / (DM / 4)), c4 = (int)(i % (DM / 4)) * 4; const float rs = row_rstd(c, r);
        for (int k = 0; k < 4; ++k) c.XN[(size_t)r * DM + c4 + k] = tobf(c.X[(size_t)r * DM + c4 + k] * rs * gain[c4 + k]); }
}
HD void ph_final(CREF c, long gtid, long gn) {
    for (long i = gtid; i < (long)TT * (DM / 4); i += gn) { const int r = (int)(i / (DM / 4)), c4 = (int)(i % (DM / 4)) * 4; const float rs = row_rstd(c, r);
        for (int k = 0; k < 4; ++k) c.out[O_YP + (size_t)r * DM + c4 + k] = c.X[(size_t)r * DM + c4 + k] * rs * c.ln_f[c4 + k]; }
}

HD void ph_copy_out(CREF c, int l, long gtid, long gn) {
    for (long i = gtid; i < (long)TT * 512; i += gn) { const int r = (int)(i / 512), k = (int)(i % 512); const float v = c.PROJ[(size_t)r * PLD + C_KV + k];
        if (r < TP) c.out[O_KVP + ((size_t)l * TP + r) * 512 + k] = v; else c.out[O_KVS + ((size_t)l * TS + (r - TP)) * 512 + k] = v; }
    for (long i = gtid; i < (long)BATCH * 512 * 256; i += gn) { const int b = (int)(i / (512 * 256)), w = (int)((i / 256) % 512), k = (int)(i % 256);
        c.out[O_WINP + (size_t)l * BATCH * 512 * 256 + i] = c.PROJ[(size_t)(b * SEQ + SEQ - 512 + w) * PLD + C_KV + 512 + k]; }
    for (long i = gtid; i < (long)DB * 512 * 256; i += gn) { const int b = (int)(i / (512 * 256)), w = (int)((i / 256) % 512), k = (int)(i % 256);
        c.out[O_WINS + (size_t)l * DB * 512 * 256 + i] = (w < 512 - DSEQ) ? c.cache_win[(((size_t)l * DB + b) * 512 + w + DSEQ) * 256 + k]
                                                                          : c.PROJ[(size_t)(TP + b * DSEQ + (w - (512 - DSEQ))) * PLD + C_KV + 512 + k]; }
    for (long i = gtid; i < (long)BATCH * 3 * CONVD; i += gn) { const int b = (int)(i / (3 * CONVD)), w = (int)((i / CONVD) % 3), k = (int)(i % CONVD);
        c.out[O_CONVP + (size_t)l * BATCH * 3 * CONVD + i] = c.PROJ[(size_t)(b * SEQ + SEQ - 3 + w) * PLD + C_DNQKV + k]; }
    for (long i = gtid; i < (long)DB * 3 * CONVD; i += gn) { const int b = (int)(i / (3 * CONVD)), w = (int)((i / CONVD) % 3), k = (int)(i % CONVD);
        c.out[O_CONVS + (size_t)l * DB * 3 * CONVD + i] = c.PROJ[(size_t)(TP + b * DSEQ + DSEQ - 3 + w) * PLD + C_DNQKV + k]; }
}
HD float dn_x(CREF c, int l, const Tok& k, int r, int back, int ch) {
    const int jj = k.j - back;
    if (jj >= 0) return c.PROJ[(size_t)(r - back) * PLD + C_DNQKV + ch];
    if (!k.smp) return 0.f;
    return c.st_conv[(((size_t)l * DB + k.b) * 3 + (3 + jj)) * CONVD + ch];
}
HD float dn_conv1(CREF c, int l, const Tok& k, int r, int ch) {
    const float* w = c.conv_w + ((size_t)l * CONVD + ch) * 4; float y = 0.f;
    for (int j = 0; j < 4; ++j) y += w[j] * dn_x(c, l, k, r, 3 - j, ch);
    return siluf_(y);
}
HD void ph_dn_conv(CREF c, int l, long gtid, long gn, int rbeg = 0) {
    for (long i = gtid + (long)rbeg * 3 * DNH; i < (long)TT * 3 * DNH; i += gn) { const int r = (int)(i / (3 * DNH)), part = (int)((i / DNH) % 3), h = (int)(i % DNH); const Tok k = tok_of(r);
        const int ch0 = part * DNW + h * 64; float ss = 0.f;
        if (part < 2) for (int d = 0; d < 64; ++d) { const float y = dn_conv1(c, l, k, r, ch0 + d); ss += y * y; }
        const float sc = part == 0 ? 0.125f / sqrtf(ss + 1e-6f) : (part == 1 ? 1.0f / sqrtf(ss + 1e-6f) : 1.0f);
        float* dst = (part == 0 ? c.QN : (part == 1 ? c.KN : c.VV)) + ((size_t)r * DNH + h) * 64;
        for (int d = 0; d < 64; ++d) dst[d] = dn_conv1(c, l, k, r, ch0 + d) * sc; }
    for (long i = gtid + (long)rbeg * DNH; i < (long)TT * DNH; i += gn) { const int r = (int)(i / DNH), h = (int)(i % DNH);
        c.BETA[i] = sigmoidf_(c.PROJ[(size_t)r * PLD + C_DNB + h]);
        c.GG[i] = -expf(c.a_log[l * DNH + h]) * softplusf_(c.PROJ[(size_t)r * PLD + C_DNA + h] + c.dt_bias[l * DNH + h]); }
}
HD void ph_pool(CREF c, int l, long gtid, long gn) {
    for (long i = gtid; i < (long)NSEQ * NBMAX * 128; i += gn) { const int seq = (int)(i / (NBMAX * 128)), n = (int)((i / 128) % NBMAX), g = (int)((i / 64) % 2), d = (int)(i % 64);
        const int smp = seq >= BATCH, b = smp ? seq - BATCH : seq; if (n >= (smp ? NBC_S : NBP)) continue;
        float sk = 0.f, sv = 0.f;
        for (int j = 0; j < 64; ++j) { sk += c.wck[(l * 2 + g) * 64 + j] * kv_ptr(c, l, smp, b, n * 64 + j, 0, g)[d]; sv += c.wcv[(l * 2 + g) * 64 + j] * kv_ptr(c, l, smp, b, n * 64 + j, 1, g)[d]; }
        c.KC[i] = sk; c.VC[i] = sv; }
}
HD void s5_scan(CREF c, int l, int g, int p, int r0, int len, float& hr, float& hi, bool store) {
    const float* K = c.S5K + ((size_t)(l * S5G + g) * S5P + p) * 4; const float ar = K[0], ai = K[1];
    const float* bb = c.S5BB + ((size_t)(l * S5G + g) * S5P + p) * S5C * 2;
    for (int t = 0; t < len; ++t) { const float* u = c.PROJ + (size_t)(r0 + t) * PLD + C_S5U + g * S5C; float br = 0.f, bi = 0.f;
        for (int ch = 0; ch < S5C; ++ch) { br += bb[ch * 2] * u[ch]; bi += bb[ch * 2 + 1] * u[ch]; }
        const float nr = ar * hr - ai * hi + br, ni = ar * hi + ai * hr + bi; hr = nr; hi = ni;
        if (store) { float* hs = c.S5HS + (((size_t)(r0 + t) * S5G + g) * S5P + p) * 2; hs[0] = hr; hs[1] = hi; } }
}
HD void ph_s5_passA(CREF c, int l, long gtid, long gn) {
    for (long i = gtid; i < (long)BATCH * NCH * S5G * S5P; i += gn) { const int p = (int)(i % S5P), g = (int)((i / S5P) % S5G), ch = (int)((i / (S5P * S5G)) % NCH), b = (int)(i / ((long)S5P * S5G * NCH));
        float hr = 0.f, hi = 0.f; s5_scan(c, l, g, p, b * SEQ + ch * 64, 64, hr, hi, false); c.S5E[i * 2] = hr; c.S5E[i * 2 + 1] = hi; }
}
HD void ph_dn_gc(CREF c, long gtid, long gn) {
    for (long i = gtid; i < NDU; i += gn) { const int ch = (int)(i % NCH), h = (int)((i / NCH) % DNH), b = (int)(i / (NCH * DNH)); float s = 0.f;
        for (int t = 0; t < 64; ++t) { s += c.GG[(size_t)(b * SEQ + ch * 64 + t) * DNH + h]; c.GC[i * 64 + t] = s; } }
}
HD void ph_cmp(CREF c, int l, long gtid, long gn, int rbeg = 0) {
    for (long i = gtid + (long)rbeg * NH; i < (long)TT * NH; i += gn) { const int r = (int)(i / NH), h = (int)(i % NH), g = h / NR; const Tok k = tok_of(r);
        const float slope = exp2f(-(float)(h + 1)); const int nbv = (k.t + 1) / 64;
        const float* q = c.PROJ + (size_t)r * PLD + C_Q + h * 64; float* pc = c.PC + (size_t)i * NBMAX; float* oc = c.OC + (size_t)i * 64;
        float m = -1e30f;
        for (int n = 0; n < nbv; ++n) { const float* kc = c.KC + (((size_t)k.seq * NBMAX + n) * 2 + g) * 64; float s = 0.f; for (int d = 0; d < 64; ++d) s += q[d] * kc[d];
            s = s * 0.125f - slope * ((float)k.t - ((float)(n * 64) + 31.5f)); pc[n] = s; m = s > m ? s : m; }
        float sum = 0.f; for (int n = 0; n < nbv; ++n) { const float e = expf(pc[n] - m); pc[n] = e; sum += e; }
        const float inv = 1.0f / (sum > 1e-30f ? sum : 1e-30f);
        for (int d = 0; d < 64; ++d) oc[d] = 0.f;
        for (int n = 0; n < nbv; ++n) { const float p = pc[n] * inv; pc[n] = p; const float* vc = c.VC + (((size_t)k.seq * NBMAX + n) * 2 + g) * 64; for (int d = 0; d < 64; ++d) oc[d] += p * vc[d]; }
        for (int n = nbv; n < NBMAX; ++n) pc[n] = 0.f; }
}
HD void ph_s5_carry(CREF c, int l, long gtid, long gn) {
    for (long i = gtid; i < (long)BATCH * S5G * S5P; i += gn) { const int p = (int)(i % S5P), g = (int)((i / S5P) % S5G), b = (int)(i / (S5P * S5G));
        const float* K = c.S5K + ((size_t)(l * S5G + g) * S5P + p) * 4; const float a64r = K[2], a64i = K[3]; float hr = 0.f, hi = 0.f;
        for (int ch = 0; ch < NCH; ++ch) { const size_t e = ((((size_t)b * NCH + ch) * S5G + g) * S5P + p) * 2; c.S5HIN[e] = hr; c.S5HIN[e + 1] = hi;
            const float nr = a64r * hr - a64i * hi + c.S5E[e], ni = a64r * hi + a64i * hr + c.S5E[e + 1]; hr = nr; hi = ni; }
        c.out[O_S5RP + ((size_t)l * BATCH + b) * 1024 + g * S5P + p] = hr; c.out[O_S5IP + ((size_t)l * BATCH + b) * 1024 + g * S5P + p] = hi; }
}
HD void ph_dn_mats(CREF c, long gtid, long gn) {
    for (long i = gtid; i < (long)NDU * 4096; i += gn) { const int u = (int)(i / 4096), ii = (int)((i / 64) % 64), jj = (int)(i % 64);
        const int ch = u % NCH, h = (u / NCH) % DNH, b = u / (NCH * DNH); const int r0 = b * SEQ + ch * 64;
        float am = 0.f, aq = 0.f;
        if (jj <= ii) { const float* ki = c.KN + ((size_t)(r0 + ii) * DNH + h) * 64; const float* kj = c.KN + ((size_t)(r0 + jj) * DNH + h) * 64; const float* qi = c.QN + ((size_t)(r0 + ii) * DNH + h) * 64;
            float kk = 0.f, qk = 0.f; for (int d = 0; d < 64; ++d) { kk += ki[d] * kj[d]; qk += qi[d] * kj[d]; }
            const float dec = expf(c.GC[(size_t)u * 64 + ii] - c.GC[(size_t)u * 64 + jj]);
            aq = qk * dec; if (jj < ii) am = c.BETA[(size_t)(r0 + ii) * DNH + h] * kk * dec; }
        c.AM[i] = am; c.AQK[i] = aq; }
    for (long i = gtid; i < (long)NDU * 64 * 128; i += gn) { const int u = (int)(i / 8192), ii = (int)((i / 128) % 64), col = (int)(i % 128);
        const int ch = u % NCH, h = (u / NCH) % DNH, b = u / (NCH * DNH); const int r = b * SEQ + ch * 64 + ii; const float be = c.BETA[(size_t)r * DNH + h];
        c.SOL[i] = col < 64 ? c.VV[((size_t)r * DNH + h) * 64 + col] * be : c.KN[((size_t)r * DNH + h) * 64 + (col - 64)] * be * expf(c.GC[(size_t)u * 64 + ii]); }
}
HD void ph_topk(CREF c, long gtid, long gn, int rbeg = 0) {
    for (long i = gtid + (long)rbeg * NG; i < (long)TT * NG; i += gn) { const int r = (int)(i / NG), g = (int)(i % NG); const Tok k = tok_of(r);
        const int cur = k.t / 64, nbs = k.smp ? NBS_S : NBP; const float* pc = c.PC + ((size_t)r * NH + g * NR) * NBMAX;
        unsigned long long tk0 = 0ull, tk1 = 0ull; int* idx = c.IDX + (size_t)i * TOPK;
        const int nsel = nbs < TOPK ? nbs : TOPK;
        for (int s = 0; s < TOPK; ++s) { int best = -1; float bv = 0.f;
            if (s < nsel) for (int n = 0; n < nbs; ++n) { const bool taken = n < 64 ? ((tk0 >> n) & 1ull) : ((tk1 >> (n - 64)) & 1ull); if (taken) continue;
                float sc; if (n > cur) sc = -1e9f; else if (n == 0 || n == cur || n == cur - 1) sc = 1e9f; else sc = (pc[n] + pc[NBMAX + n]) + (pc[2 * NBMAX + n] + pc[3 * NBMAX + n]);
                if (best < 0 || sc > bv) { best = n; bv = sc; } }
            if (best >= 0) { if (best < 64) tk0 |= 1ull << best; else tk1 |= 1ull << (best - 64); }
            idx[s] = (best >= 0 && best <= cur) ? best : -1; } }
}
HD void ph_s5_passB(CREF c, int l, long gtid, long gn) {
    for (long i = gtid; i < (long)BATCH * NCH * S5G * S5P; i += gn) { const int p = (int)(i % S5P), g = (int)((i / S5P) % S5G), ch = (int)((i / (S5P * S5G)) % NCH), b = (int)(i / ((long)S5P * S5G * NCH));
        float hr = c.S5HIN[i * 2], hi = c.S5HIN[i * 2 + 1]; s5_scan(c, l, g, p, b * SEQ + ch * 64, 64, hr, hi, true); }
    for (long i = gtid; i < (long)DB * S5G * S5P; i += gn) { const int p = (int)(i % S5P), g = (int)((i / S5P) % S5G), b = (int)(i / (S5P * S5G));
        float hr = c.st_s5re[(size_t)l * DB * 1024 + i], hi = c.st_s5im[(size_t)l * DB * 1024 + i]; s5_scan(c, l, g, p, TP + b * DSEQ, DSEQ, hr, hi, true);
        c.out[O_S5RS + (size_t)l * DB * 1024 + i] = hr; c.out[O_S5IS + (size_t)l * DB * 1024 + i] = hi; }
}
HD void ph_dn_solve(CREF c, long gtid, long gn) {
    for (long i = gtid; i < (long)NDU * 128; i += gn) { const int u = (int)(i / 128), col = (int)(i % 128); float* x = c.SOL + (size_t)u * 8192 + col; const float* A = c.AM + (size_t)u * 4096;
        for (int ii = 1; ii < 64; ++ii) { float s = x[ii * 128]; for (int jj = 0; jj < ii; ++jj) s -= A[ii * 64 + jj] * x[jj * 128]; x[ii * 128] = s; } }
}
HD void ph_attn(CREF c, int l, long gtid, long gn, int rbeg = 0) {
    for (long i = gtid + (long)rbeg * NH; i < (long)TT * NH; i += gn) { const int r = (int)(i / NH), h = (int)(i % NH), g = h / NR; const Tok k = tok_of(r);
        const float slope = exp2f(-(float)(h + 1));
        float q[64];
#pragma unroll
        for (int d = 0; d < 64; ++d) q[d] = c.PROJ[(size_t)r * PLD + C_Q + h * 64 + d] * 0.125f;
        const float* gp = c.PROJ + (size_t)r * PLD + C_GATE + h * 3; const float g0 = sigmoidf_(gp[0]), g1 = sigmoidf_(gp[1]), g2 = sigmoidf_(gp[2]);
        float* oc = c.OC + (size_t)i * 64;
        float o[64]; float m = -1e30f, lsum = 0.f;
#pragma unroll
        for (int d = 0; d < 64; ++d) o[d] = 0.f;
        const int* idx = c.IDX + ((size_t)r * NG + g) * TOPK;
        for (int s = 0; s < TOPK; ++s) { const int n = idx[s]; if (n < 0) continue;
            for (int j = 0; j < 64; ++j) { const int pos = n * 64 + j; if (pos > k.t) break;
                const float* kp = kv_ptr(c, l, k.smp, k.b, pos, 2, g); const float* vp = kv_ptr(c, l, k.smp, k.b, pos, 3, g);
                float sc = 0.f;
#pragma unroll
                for (int d = 0; d < 64; ++d) sc += q[d] * kp[d];
                sc -= slope * (float)(k.t - pos);
                const float mn = sc > m ? sc : m, al = expf(m - mn), p = expf(sc - mn); m = mn; lsum = lsum * al + p;
#pragma unroll
                for (int d = 0; d < 64; ++d) o[d] = o[d] * al + p * vp[d]; } }
        { const float inv = g1 / (lsum > 1e-30f ? lsum : 1e-30f);
#pragma unroll
          for (int d = 0; d < 64; ++d) oc[d] = g0 * oc[d] + inv * o[d]; }
        m = -1e30f; lsum = 0.f;
#pragma unroll
        for (int d = 0; d < 64; ++d) o[d] = 0.f;
        const int w0 = k.smp ? W0S : 0; int p0 = k.t - (WIN - 1); if (p0 < w0) p0 = w0;
        for (int pos = p0; pos <= k.t; ++pos) { const float* kp = kv_ptr(c, l, k.smp, k.b, pos, 4, g); const float* vp = kv_ptr(c, l, k.smp, k.b, pos, 5, g);
            float sc = 0.f;
#pragma unroll
            for (int d = 0; d < 64; ++d) sc += q[d] * kp[d];
            sc -= slope * (float)(k.t - pos);
            const float mn = sc > m ? sc : m, al = expf(m - mn), p = expf(sc - mn); m = mn; lsum = lsum * al + p;
#pragma unroll
            for (int d = 0; d < 64; ++d) o[d] = o[d] * al + p * vp[d]; }
        { const float inv = g2 / (lsum > 1e-30f ? lsum : 1e-30f);
#pragma unroll
          for (int d = 0; d < 64; ++d) c.MIXB[(size_t)r * DM + h * 64 + d] = tobf(oc[d] + inv * o[d]); } }
}
HD void ph_s5_y(CREF c, int l, long gtid, long gn) {
    for (long i = gtid; i < (long)TT * 256; i += gn) { const int r = (int)(i / 256), ch = (int)(i % 256), g = ch / S5C, cc = ch % S5C;
        const float* cr = c.c_re + (((size_t)l * S5G + g) * S5C + cc) * S5P; const float* ci = c.c_im + (((size_t)l * S5G + g) * S5C + cc) * S5P;
        const float* hs = c.S5HS + ((size_t)r * S5G + g) * S5P * 2; float y = 0.f;
        for (int p = 0; p < S5P; ++p) y += cr[p] * hs[2 * p] - ci[p] * hs[2 * p + 1];
        y += c.s5_d[l * 256 + ch] * c.PROJ[(size_t)r * PLD + C_S5U + ch]; c.GL[i] = geluf_(y); }
}
HD void ph_dn_scan_prompt(CREF c, int l, long gtid, long gn) {
    for (long i = gtid; i < (long)BATCH * DNH * 64; i += gn) { const int jc = (int)(i % 64), h = (int)((i / 64) % DNH), b = (int)(i / (64 * DNH));
        float S[64];
#pragma unroll
        for (int kk = 0; kk < 64; ++kk) S[kk] = 0.f;
        float* vn = c.VNEW + (size_t)(b * DNH + h) * 4096 + jc;
        for (int ch = 0; ch < NCH; ++ch) { const int u = (b * DNH + h) * NCH + ch; const int r0 = b * SEQ + ch * 64;
            const float* sol = c.SOL + (size_t)u * 8192; const float* gc = c.GC + (size_t)u * 64; const float* aqk = c.AQK + (size_t)u * 4096;
            for (int t = 0; t < 64; ++t) { const float* w = sol + t * 128 + 64; float s = sol[t * 128 + jc];
#pragma unroll
                for (int kk = 0; kk < 64; ++kk) s -= w[kk] * S[kk];
                vn[t * 64] = s; }
            for (int t = 0; t < 64; ++t) { const float* qq = c.QN + ((size_t)(r0 + t) * DNH + h) * 64; float s = 0.f;
#pragma unroll
                for (int kk = 0; kk < 64; ++kk) s += qq[kk] * S[kk];
                s *= expf(gc[t]);
                for (int t2 = 0; t2 <= t; ++t2) s += aqk[t * 64 + t2] * vn[t2 * 64];
                c.ODN[((size_t)(r0 + t) * DNH + h) * 64 + jc] = s; }
            const float gl = gc[63], eg = expf(gl);
#pragma unroll
            for (int kk = 0; kk < 64; ++kk) S[kk] *= eg;
            for (int t = 0; t < 64; ++t) { const float* kk_ = c.KN + ((size_t)(r0 + t) * DNH + h) * 64; const float f = expf(gl - gc[t]) * vn[t * 64];
#pragma unroll
                for (int kk = 0; kk < 64; ++kk) S[kk] += kk_[kk] * f; } }
#pragma unroll
        for (int kk = 0; kk < 64; ++kk) c.out[O_DNP + (((size_t)l * BATCH + b) * DNH + h) * 4096 + kk * 64 + jc] = S[kk]; }
}
HD void ph_dn_scan_sample(CREF c, int l, long gtid, long gn) {
    for (long i = gtid; i < (long)DB * DNH * 64; i += gn) { const int jc = (int)(i % 64), h = (int)((i / 64) % DNH), b = (int)(i / (64 * DNH));
        float S[64]; const float* s0 = c.st_dn + (((size_t)l * DB + b) * DNH + h) * 4096 + jc;
#pragma unroll
        for (int kk = 0; kk < 64; ++kk) S[kk] = s0[kk * 64];
        for (int t = 0; t < DSEQ; ++t) { const int r = TP + b * DSEQ + t; const float* kv = c.KN + ((size_t)r * DNH + h) * 64; const float* qq = c.QN + ((size_t)r * DNH + h) * 64;
            const float a = expf(c.GG[(size_t)r * DNH + h]), be = c.BETA[(size_t)r * DNH + h]; float ks = 0.f;
#pragma unroll
            for (int kk = 0; kk < 64; ++kk) { S[kk] *= a; ks += kv[kk] * S[kk]; }
            const float vnw = be * (c.VV[((size_t)r * DNH + h) * 64 + jc] - ks); float os = 0.f;
#pragma unroll
            for (int kk = 0; kk < 64; ++kk) { S[kk] += kv[kk] * vnw; os += qq[kk] * S[kk]; }
            c.ODN[((size_t)r * DNH + h) * 64 + jc] = os; }
#pragma unroll
        for (int kk = 0; kk < 64; ++kk) c.out[O_DNS + (((size_t)l * DB + b) * DNH + h) * 4096 + kk * 64 + jc] = S[kk]; }
}
HD void ph_s5_glu(CREF c, int l, long gtid, long gn) {
    for (long i = gtid; i < (long)TT * 256; i += gn) { const int r = (int)(i / 256), ch = (int)(i % 256); const float* gl = c.GL + (size_t)r * 256; const float* w = c.w_glu + (size_t)l * 65536 + ch; float z = 0.f;
        for (int kk = 0; kk < 256; ++kk) z += gl[kk] * w[kk * 256];
        c.MIXB[(size_t)r * DM + 768 + ch] = tobf(gl[ch] * sigmoidf_(z)); }
}
HD void ph_dn_out(CREF c, int l, long gtid, long gn) {
    for (long i = gtid; i < (long)TT * DNH; i += gn) { const int r = (int)(i / DNH), h = (int)(i % DNH); const float* o = c.ODN + (size_t)i * 64; float ss = 0.f;
        for (int d = 0; d < 64; ++d) ss += o[d] * o[d];
        const float rs = 1.0f / sqrtf(ss * (1.0f / 64.0f) + NEPS);
        for (int d = 0; d < 64; ++d) c.MIXB[(size_t)r * DM + 512 + h * 64 + d] = tobf(o[d] * rs * c.dn_norm_w[l * 64 + d] * siluf_(c.PROJ[(size_t)r * PLD + C_DNZ + h * 64 + d])); }
}
namespace pg8 {
#define PG8_LAS __attribute__((address_space(3)))
typedef unsigned short bf16_t;
typedef short bf16x8 __attribute__((ext_vector_type(8)));
typedef float f32x4 __attribute__((ext_vector_type(4)));
typedef unsigned u32x4 __attribute__((ext_vector_type(4)));
constexpr int BM = 256, BK = 64, HALF = 128, HTB = HALF * BK * 2  , STAGE_BYTES = 8 * HTB, NXCD = 8, WGM = 8;

__host__ __device__ __forceinline__ int lds_byte(int r, int c) { const int st = (r >> 4) * 2 + (c >> 5), rr = r & 15, cc = c & 31, ob = rr * 64 + cc * 2; return st * 1024 + (ob ^ (((ob >> 9) & 1) << 5)); }
__host__ __device__ __forceinline__ void stage_rc(int b, int& R, int& C) { const int st = b / 1024, sb = b % 1024, swz = sb ^ (((sb >> 9) & 1) << 5); R = (st >> 1) * 16 + swz / 64; C = (st & 1) * 32 + (swz % 64) / 2; }
__host__ __device__ __forceinline__ int perm32(int rho) { const int n = rho >> 4, i = rho & 15; return 8 * (i >> 2) + 4 * n + (i & 3); }

struct Unit { int pm, pn; };
struct Gemm { const bf16_t* A; const bf16_t* Bt; int M, N, K, ld; };

struct StaticOrder {
    int nM, nN, nwg, G, c;
    __host__ __device__ void init(int M, int N, int G_, int c_) { nM = M / BM; nN = N / BM; nwg = nM * nN; G = G_; c = c_; }
    __host__ __device__ bool next(int i, Unit& u) const {
        const long L = (long)i * G + c; if (L >= nwg) return false;
        int wgid = (int)L; { const int q = nwg / NXCD, r = nwg % NXCD, xcd = wgid % NXCD, off = wgid / NXCD; wgid = (xcd < r ? xcd * (q + 1) : r * (q + 1) + (xcd - r) * q) + off; }
        const int nig = WGM * nN, gid = wgid / nig, fm = gid * WGM, gsz = (nM - fm) < WGM ? (nM - fm) : WGM;
        u.pm = fm + ((wgid % nig) % gsz); u.pn = (wgid % nig) / gsz; return true;
    }
    __device__ __forceinline__ void a_ready(const Unit&) const {}
    __device__ __forceinline__ void done(const Unit&) const {}
};

__device__ __forceinline__ unsigned cvt_pk_bf16(float lo, float hi) { unsigned r; asm volatile("v_cvt_pk_bf16_f32 %0, %1, %2" : "=v"(r) : "v"(lo), "v"(hi)); return r; }
typedef float f32x2 __attribute__((ext_vector_type(2)));
template <class Epi, class Sched, bool ALIGN_EPI = false, bool SP2 = false>
__device__ __forceinline__ void gemm_phase(PG8_LAS unsigned char* lds, const Gemm g, const Sched& S, const Epi& E, int tid_) {
    asm volatile("" : "+v"(tid_));
    const int tid = tid_, wid = __builtin_amdgcn_readfirstlane(tid >> 6), lane = tid & 63, wr = wid >> 2, wc = wid & 3, fr = lane & 15, fq = lane >> 4;
    const int K = g.K, nt = K / BK;
    unsigned voffA[2], voffB[2];
#pragma unroll
    for (int i = 0; i < 2; ++i) { int R, C; stage_rc(tid * 16 + i * 8192, R, C); const int Rb = Epi::PERM ? ((R & ~31) + perm32(R & 31)) : R;
        voffA[i] = (unsigned)(R * g.ld + C) * 2u; voffB[i] = (unsigned)(Rb * g.ld + C) * 2u; }
    const size_t kstep = (size_t)(BK * 2);
    const size_t hstep = (size_t)HALF * g.ld * 2;
    const size_t tstep = 2 * hstep;
    const unsigned ldsw = (unsigned)wid * 1024u;
    const int aoff = lds_byte(wr * 64 + fr, fq * 8), boff = lds_byte(wc * 32 + fr, fq * 8);
#define PG8_SA(b, h) (((b) * 2 + (h)) * HTB)
#define PG8_SB(b, h) ((4 + (b) * 2 + (h)) * HTB)
#define PG8_STAGE(bufoff, gbase, voff) do { _Pragma("unroll") for (int _i = 0; _i < 2; ++_i) \
        __builtin_amdgcn_global_load_lds((const unsigned*)((const char*)(gbase) + (voff)[_i]), (PG8_LAS unsigned*)(lds + (bufoff) + ldsw + _i * 8192), 16, 0, 0); } while (0)
#define PG8_LDA(dst, b, h) do { _Pragma("unroll") for (int m = 0; m < 4; ++m) _Pragma("unroll") for (int k = 0; k < 2; ++k) dst[m][k] = *(const PG8_LAS bf16x8*)(lds + PG8_SA(b, h) + aoff + m * 2048 + k * 1024); } while (0)
#define PG8_LDB(dst, b, h) do { _Pragma("unroll") for (int n = 0; n < 2; ++n) _Pragma("unroll") for (int k = 0; k < 2; ++k) dst[n][k] = *(const PG8_LAS bf16x8*)(lds + PG8_SB(b, h) + boff + n * 2048 + k * 1024); } while (0)
#define PG8_MMA(ai, bj, At, Bt) do { __builtin_amdgcn_s_setprio(1); _Pragma("unroll") for (int m = 0; m < 4; ++m) _Pragma("unroll") for (int n = 0; n < 2; ++n) _Pragma("unroll") for (int k = 0; k < 2; ++k) \
        acc[ai][bj][m][n] = __builtin_amdgcn_mfma_f32_16x16x32_bf16(Bt[n][k], At[m][k], acc[ai][bj][m][n], 0, 0, 0); __builtin_amdgcn_s_setprio(0); } while (0)
#define PG8_WAIT_V(n) asm volatile("s_waitcnt vmcnt(" #n ")" ::: "memory")
#define PG8_WAIT_L(n) asm volatile("s_waitcnt lgkmcnt(" #n ")" ::: "memory")
#define PG8_BAR __builtin_amdgcn_s_barrier()
#define PG8_SCHED __builtin_amdgcn_sched_barrier(0)
    Unit cur, nxt; int ui = 0;
    if (!S.next(0, cur)) return;
    f32x4 acc[2][2][4][2];
#pragma unroll
    for (int a = 0; a < 2; ++a)
#pragma unroll
        for (int b = 0; b < 2; ++b)
#pragma unroll
            for (int m = 0; m < 4; ++m)
#pragma unroll
                for (int n = 0; n < 2; ++n) acc[a][b][m][n] = (f32x4){0.f, 0.f, 0.f, 0.f};
    bf16x8 At[4][2], B0[2][2], B1[2][2];
    const char* cA = (const char*)g.A + (size_t)cur.pm * tstep; const char* cB = (const char*)g.Bt + (size_t)cur.pn * tstep;
    S.a_ready(cur);
    if constexpr (SP2) {
        PG8_STAGE(PG8_SB(0, 0), cB, voffB); PG8_STAGE(PG8_SB(0, 1), cB + hstep, voffB); PG8_STAGE(PG8_SA(0, 0), cA, voffA); PG8_STAGE(PG8_SA(0, 1), cA + hstep, voffA);
        if (wr == 1) PG8_BAR;
        PG8_WAIT_V(2); PG8_BAR;
        PG8_STAGE(PG8_SB(1, 0), cB + kstep, voffB); PG8_STAGE(PG8_SA(1, 0), cA + kstep, voffA); PG8_STAGE(PG8_SB(1, 1), cB + hstep + kstep, voffB);
        PG8_WAIT_V(6); PG8_BAR;
    } else {
        PG8_STAGE(PG8_SB(0, 0), cB, voffB); PG8_STAGE(PG8_SA(0, 0), cA, voffA); PG8_STAGE(PG8_SB(0, 1), cB + hstep, voffB); PG8_STAGE(PG8_SA(0, 1), cA + hstep, voffA);
        if (wr == 1) PG8_BAR;
        PG8_WAIT_V(4); PG8_BAR;
        PG8_STAGE(PG8_SB(1, 0), cB + kstep, voffB); PG8_STAGE(PG8_SA(1, 0), cA + kstep, voffA); PG8_STAGE(PG8_SB(1, 1), cB + hstep + kstep, voffB);
        PG8_WAIT_V(6); PG8_BAR;
    }
    for (;;) {
        const bool has_next = S.next(ui + 1, nxt);
        const char* nA = has_next ? (const char*)g.A + (size_t)nxt.pm * tstep : cA; const char* nB = has_next ? (const char*)g.Bt + (size_t)nxt.pn * tstep : cB;
        for (int t = 0; t < nt; t += 2) {
            const bool last = (t == nt - 2);
            const char* a1 = cA + (size_t)(t + 1) * kstep;
            const char* a2 = last ? nA : cA + (size_t)(t + 2) * kstep; const char* b2 = last ? nB : cB + (size_t)(t + 2) * kstep;
            const char* a3 = a2 + kstep; const char* b3 = b2 + kstep;
            if (last && has_next) S.a_ready(nxt);
            if constexpr (SP2) {
            PG8_LDB(B0, 0, 0); PG8_LDB(B1, 0, 1); PG8_SCHED; PG8_LDA(At, 0, 0); PG8_STAGE(PG8_SA(1, 1), a1 + hstep, voffA);
            PG8_WAIT_V(8); PG8_WAIT_L(0); PG8_BAR; PG8_MMA(0, 0, At, B0); PG8_MMA(0, 1, At, B1); PG8_BAR; PG8_SCHED;
            PG8_LDA(At, 0, 1); PG8_STAGE(PG8_SB(0, 0), b2, voffB); PG8_STAGE(PG8_SB(0, 1), b2 + hstep, voffB); PG8_STAGE(PG8_SA(0, 0), a2, voffA);
            PG8_WAIT_V(8); PG8_WAIT_L(0); PG8_BAR; PG8_MMA(1, 0, At, B0); PG8_MMA(1, 1, At, B1); PG8_BAR; PG8_SCHED;
            PG8_LDB(B0, 1, 0); PG8_LDB(B1, 1, 1); PG8_SCHED; PG8_LDA(At, 1, 0); PG8_STAGE(PG8_SA(0, 1), a2 + hstep, voffA);
            PG8_WAIT_V(8); PG8_WAIT_L(0); PG8_BAR; PG8_MMA(0, 0, At, B0); PG8_MMA(0, 1, At, B1); PG8_BAR; PG8_SCHED;
            PG8_LDA(At, 1, 1); PG8_STAGE(PG8_SB(1, 0), b3, voffB); PG8_STAGE(PG8_SB(1, 1), b3 + hstep, voffB); PG8_STAGE(PG8_SA(1, 0), a3, voffA);
            PG8_WAIT_V(8); PG8_WAIT_L(0); PG8_BAR; PG8_MMA(1, 0, At, B0); PG8_MMA(1, 1, At, B1); PG8_BAR; PG8_SCHED;
            } else {
            PG8_LDB(B0, 0, 0); PG8_SCHED; PG8_LDA(At, 0, 0); PG8_STAGE(PG8_SA(1, 1), a1 + hstep, voffA);
            PG8_WAIT_L(8); PG8_BAR; PG8_WAIT_L(0); PG8_MMA(0, 0, At, B0); PG8_BAR; PG8_SCHED;
            PG8_LDB(B1, 0, 1); PG8_STAGE(PG8_SB(0, 0), b2, voffB);
            PG8_BAR; PG8_WAIT_L(0); PG8_MMA(0, 1, At, B1); PG8_BAR;
            PG8_LDA(At, 0, 1); PG8_STAGE(PG8_SA(0, 0), a2, voffA);
            PG8_BAR; PG8_WAIT_L(0); PG8_MMA(1, 0, At, B0); PG8_BAR; PG8_SCHED;
            PG8_STAGE(PG8_SB(0, 1), b2 + hstep, voffB);
            PG8_WAIT_V(6); PG8_BAR; PG8_MMA(1, 1, At, B1); PG8_BAR;
            PG8_LDB(B0, 1, 0); PG8_SCHED; PG8_LDA(At, 1, 0); PG8_STAGE(PG8_SA(0, 1), a2 + hstep, voffA);
            PG8_WAIT_L(8); PG8_BAR; PG8_WAIT_L(0); PG8_MMA(0, 0, At, B0); PG8_BAR; PG8_SCHED;
            PG8_LDB(B1, 1, 1); PG8_STAGE(PG8_SB(1, 0), b3, voffB);
            PG8_BAR; PG8_WAIT_L(0); PG8_MMA(0, 1, At, B1); PG8_BAR;
            PG8_LDA(At, 1, 1); PG8_STAGE(PG8_SA(1, 0), a3, voffA);
            PG8_BAR; PG8_WAIT_L(0); PG8_MMA(1, 0, At, B0); PG8_BAR; PG8_SCHED;
            PG8_STAGE(PG8_SB(1, 1), b3 + hstep, voffB);
            PG8_WAIT_V(6); PG8_BAR; PG8_MMA(1, 1, At, B1); PG8_BAR;
            }
        }
        if constexpr (ALIGN_EPI) { if (wr == 0) PG8_BAR; }
        if constexpr (!Epi::AFTER_DRAIN) { E(acc, cur, wr, wc, fr, fq); S.done(cur); }
        if (!has_next) break;
#pragma unroll
        for (int a = 0; a < 2; ++a)
#pragma unroll
            for (int b = 0; b < 2; ++b)
#pragma unroll
                for (int m = 0; m < 4; ++m)
#pragma unroll
                    for (int n = 0; n < 2; ++n) acc[a][b][m][n] = (f32x4){0.f, 0.f, 0.f, 0.f};
        cur = nxt; cA = nA; cB = nB; ++ui;
        if constexpr (ALIGN_EPI) { if (wr == 1) PG8_BAR; }
    }
    PG8_WAIT_V(0);
    if constexpr (!ALIGN_EPI) { if (wr == 0) PG8_BAR; }
    PG8_BAR;
    if constexpr (Epi::AFTER_DRAIN) { E.fused(acc, cur, wr, wc, fr, fq, lds, wid, lane); S.done(cur); }
#undef PG8_SA
#undef PG8_SB
#undef PG8_STAGE
#undef PG8_LDA
#undef PG8_LDB
#undef PG8_MMA
#undef PG8_WAIT_V
#undef PG8_WAIT_L
#undef PG8_BAR
#undef PG8_SCHED
}
}
#define LAS __attribute__((address_space(3)))
typedef short bf16x8_t __attribute__((ext_vector_type(8)));
typedef float f32x4_t __attribute__((ext_vector_type(4)));
typedef float f32x2_t __attribute__((ext_vector_type(2)));
typedef __bf16 bf16x2_t __attribute__((ext_vector_type(2)));
typedef unsigned u32x4_t __attribute__((ext_vector_type(4)));
typedef unsigned u32x2_t __attribute__((ext_vector_type(2)));
#define DEV __device__ __forceinline__
DEV unsigned cvtpk(float lo, float hi) { f32x2_t v = {lo, hi}; bf16x2_t b = __builtin_convertvector(v, bf16x2_t); return __builtin_bit_cast(unsigned, b); }
DEV bf16x8_t pack8(const f32x4_t a, const f32x4_t b) { u32x4_t p = {cvtpk(a[0], a[1]), cvtpk(a[2], a[3]), cvtpk(b[0], b[1]), cvtpk(b[2], b[3])}; return __builtin_bit_cast(bf16x8_t, p); }
#define MFMA16(a, b, c) __builtin_amdgcn_mfma_f32_16x16x32_bf16((a), (b), (c), 0, 0, 0)
template <int CTRL> DEV float dppf(float x) { return __builtin_bit_cast(float, __builtin_amdgcn_mov_dpp(__builtin_bit_cast(int, x), CTRL, 0xF, 0xF, true)); }
template <int CTRL> DEV int dppi(int x) { return __builtin_amdgcn_mov_dpp(x, CTRL, 0xF, 0xF, true); }
constexpr int DPP_X1 = 0xB1, DPP_X2 = 0x4E, DPP_HM = 0x141, DPP_RM = 0x140;

constexpr int DNS_FB = 8192, DNS_US = 68, DNS_EG = 4 * DNS_FB + 64 * DNS_US * 4, DNS_GT = DNS_EG + 16, DNS_BUF = DNS_GT + 64 * 136;
static_assert(2 * DNS_BUF + 2048 + 2 * 64 * 144 <= 147456 - 256, "DeltaNet scan LDS (the last 256 bytes are the control words)");
struct DnStage { u32x4_t fr[8]; f32x4_t ut[4]; u32x4_t gt[2]; float eg; };
DEV void dn_scan_load(CREF c, DnStage& st, int u, int pt) {
    const u32x4_t* f = (const u32x4_t*)(c.DNF + (size_t)u * 16384) + pt; const f32x4_t* uq = (const f32x4_t*)(c.DNU + (size_t)u * 4096) + pt;
#pragma unroll
    for (int k = 0; k < 8; ++k) st.fr[k] = f[256 * k];
#pragma unroll
    for (int k = 0; k < 4; ++k) st.ut[k] = uq[256 * k];
    const u32x4_t* gq = (const u32x4_t*)(c.DNG + (size_t)u * 4096) + pt; st.gt[0] = gq[0]; st.gt[1] = gq[256];
    st.eg = c.DNE[u];
}
DEV void dn_scan_store(const DnStage& st, LAS unsigned char* dst, int pt) {
#pragma unroll
    for (int k = 0; k < 8; ++k) *(LAS u32x4_t*)(dst + (pt + 256 * k) * 16) = st.fr[k];
#pragma unroll
    for (int k = 0; k < 4; ++k) { const int idx = pt + 256 * k, v = idx & 63, tq = idx >> 6; *(LAS f32x4_t*)(dst + 4 * DNS_FB + (v * DNS_US + 4 * tq) * 4) = st.ut[k]; }
#pragma unroll
    for (int k = 0; k < 2; ++k) { const int e = (pt + 256 * k) * 2, tq = e >> 6, v = e & 63;
        *(LAS u32x2_t*)(dst + DNS_GT + v * 136 + tq * 8) = (u32x2_t){st.gt[k][0], st.gt[k][1]}; *(LAS u32x2_t*)(dst + DNS_GT + (v + 1) * 136 + tq * 8) = (u32x2_t){st.gt[k][2], st.gt[k][3]}; }
    if (pt == 0) *(LAS float*)(dst + DNS_EG) = st.eg;
}
DEV void dn_scan_consume(const LAS unsigned char* buf, f32x4_t (&S)[4], f32x4_t (&O)[4], LAS float* ssw, int v, int lane, int kb) {
    const LAS unsigned char* fb = buf + lane * 16;
    const LAS float* ut = (const LAS float*)(buf + 4 * DNS_FB) + v * DNS_US + 4 * kb;
#define DNS_FR(mat, mt, ks) (*(const LAS bf16x8_t*)(fb + (mat) * DNS_FB + ((mt) * 2 + (ks)) * 1024))
    const float eg = *(const LAS float*)(buf + DNS_EG);
    const bf16x8_t Sb0 = pack8(S[0], S[1]), Sb1 = pack8(S[2], S[3]);
    f32x4_t ws[4], qs[4], ds[4], vn[4];
    const f32x4_t z4 = {0.f, 0.f, 0.f, 0.f};
#pragma unroll
    for (int mt = 0; mt < 4; ++mt) { ws[mt] = MFMA16(DNS_FR(0, mt, 0), Sb0, z4); ws[mt] = MFMA16(DNS_FR(0, mt, 1), Sb1, ws[mt]);
                                     qs[mt] = MFMA16(DNS_FR(1, mt, 0), Sb0, z4); qs[mt] = MFMA16(DNS_FR(1, mt, 1), Sb1, qs[mt]); }
#pragma unroll
    for (int mt = 0; mt < 4; ++mt) vn[mt] = *(const LAS f32x4_t*)(ut + 16 * mt) - ws[mt];
    const bf16x8_t Vb0 = pack8(vn[0], vn[1]), Vb1 = pack8(vn[2], vn[3]);
#pragma unroll
    for (int mt = 0; mt < 4; ++mt) { qs[mt] = MFMA16(DNS_FR(2, mt, 0), Vb0, qs[mt]); qs[mt] = MFMA16(DNS_FR(2, mt, 1), Vb1, qs[mt]);
                                     ds[mt] = MFMA16(DNS_FR(3, mt, 0), Vb0, z4); ds[mt] = MFMA16(DNS_FR(3, mt, 1), Vb1, ds[mt]); }
#pragma unroll
    for (int mt = 0; mt < 4; ++mt) { S[mt] = S[mt] * eg + ds[mt]; O[mt] = qs[mt];
        f32x4_t q2 = qs[mt] * qs[mt];
#pragma unroll
        for (int i = 0; i < 4; ++i) { float s = q2[i]; s += dppf<DPP_X1>(s); s += dppf<DPP_X2>(s); s += dppf<DPP_HM>(s); s += dppf<DPP_RM>(s); q2[i] = s; }
        if ((lane & 15) == 0) *(LAS f32x4_t*)(ssw + 16 * mt + 4 * kb) = q2; }
#undef DNS_FR
}
constexpr int DNS_OTS = 144, DNS_OT = 64 * DNS_OTS;
DEV void dn_scan_finish(const f32x4_t (&O)[4], const f32x4_t (&Z)[4], const LAS float* ss, LAS unsigned char* ot, int v, int kb) {
#pragma unroll
    for (int mt = 0; mt < 4; ++mt) { const LAS float* sp = ss + 16 * mt + 4 * kb;
        const f32x4_t tot = (*(const LAS f32x4_t*)sp + *(const LAS f32x4_t*)(sp + 64)) + (*(const LAS f32x4_t*)(sp + 128) + *(const LAS f32x4_t*)(sp + 192));
#pragma unroll
        for (int i = 0; i < 4; ++i) *(LAS bf16_t*)(ot + (16 * mt + 4 * kb + i) * DNS_OTS + v * 2) = tobf(O[mt][i] * __builtin_amdgcn_rsqf(tot[i] * (1.0f / 64.0f) + NEPS) * Z[mt][i]); }
}
DEV void dn_scan_flush(CREF c, const LAS unsigned char* ot, int r0, int h, int ct) {
#pragma unroll
    for (int k = 0; k < 2; ++k) { const int p = ct + 256 * k, tok = p >> 3, seg = p & 7;
        *(u32x4_t*)(c.MIXB + (size_t)(r0 + tok) * DM + 512 + h * 64 + seg * 8) = *(const LAS u32x4_t*)(ot + tok * DNS_OTS + seg * 16); }
}
DEV void dn_scan_mfma(CREF c, int l, LAS unsigned char* L, int bh, int tid) {
    asm volatile("" : "+v"(tid));
    const int b = bh / DNH, h = bh % DNH, wid = tid >> 6, lane = tid & 63, n = lane & 15, kb = lane >> 4;
    const bool producer = wid >= 4;
    const int v = 16 * (wid & 3) + n;
    f32x4_t S[4];
#pragma unroll
    for (int mt = 0; mt < 4; ++mt) S[mt] = (f32x4_t){0.f, 0.f, 0.f, 0.f};
    const int u0 = (b * DNH + h) * NCH, rb = b * SEQ, pt = tid - 256;
    if (producer) {
        DnStage s0, s1, s2;
        dn_scan_load(c, s0, u0, pt); dn_scan_store(s0, L, pt);
        dn_scan_load(c, s0, u0 + 1, pt); dn_scan_load(c, s1, u0 + 2, pt); dn_scan_load(c, s2, u0 + 3, pt);
#define DNS_STEP(st, ch_) { __syncthreads(); if ((ch_) + 1 < NCH) { dn_scan_store(st, L + (((ch_) + 1) & 1) * DNS_BUF, pt); if ((ch_) + 4 < NCH) dn_scan_load(c, st, u0 + (ch_) + 4, pt); } }
        static_assert(NCH % 6 == 2, "producer loop tail");
        for (int ch = 0; ch < NCH - 2; ch += 3) { DNS_STEP(s0, ch) DNS_STEP(s1, ch + 1) DNS_STEP(s2, ch + 2) }
        DNS_STEP(s0, NCH - 2) DNS_STEP(s1, NCH - 1)
#undef DNS_STEP
        __syncthreads(); __syncthreads();
    } else {
        LAS float* SS = (LAS float*)(L + 2 * DNS_BUF);
        LAS unsigned char* OT = L + 2 * DNS_BUF + 2048;
        f32x4_t O[4], Op[4], Z[4];
#define DNS_ZLOAD(bufoff_) { _Pragma("unroll") for (int mt = 0; mt < 4; ++mt) { const u32x2_t w = *(const LAS u32x2_t*)(L + (bufoff_) + DNS_GT + v * 136 + (4 * mt + kb) * 8); \
            Z[mt] = (f32x4_t){__uint_as_float(w[0] << 16), __uint_as_float(w[0] & 0xffff0000u), __uint_as_float(w[1] << 16), __uint_as_float(w[1] & 0xffff0000u)}; } }
#define DNS_CSTEP(ch_, bufoff) { __syncthreads(); \
            if ((ch_) > 1) dn_scan_flush(c, OT + ((ch_) & 1) * DNS_OT, rb + ((ch_) - 2) * 64, h, tid); \
            if ((ch_) > 0) dn_scan_finish(Op, Z, SS + (((ch_) - 1) & 1) * 256, OT + (((ch_) - 1) & 1) * DNS_OT, v, kb); \
            DNS_ZLOAD(bufoff) \
            dn_scan_consume(L + (bufoff), S, O, SS + ((ch_) & 1) * 256 + (wid & 3) * 64, v, lane, kb); \
            _Pragma("unroll") for (int mt = 0; mt < 4; ++mt) Op[mt] = O[mt]; }
        for (int ch = 0; ch < NCH; ch += 2) { DNS_CSTEP(ch, 0) DNS_CSTEP(ch + 1, DNS_BUF) }
        __syncthreads();
        dn_scan_flush(c, OT + (NCH & 1) * DNS_OT, rb + (NCH - 2) * 64, h, tid);
        dn_scan_finish(Op, Z, SS + ((NCH - 1) & 1) * 256, OT + ((NCH - 1) & 1) * DNS_OT, v, kb);
        __syncthreads();
        dn_scan_flush(c, OT + ((NCH - 1) & 1) * DNS_OT, rb + (NCH - 1) * 64, h, tid);
#undef DNS_CSTEP
#undef DNS_ZLOAD
    }
    if (!producer) {
#pragma unroll
        for (int mt = 0; mt < 4; ++mt)
#pragma unroll
            for (int i = 0; i < 4; ++i) c.out[O_DNP + (((size_t)l * BATCH + b) * DNH + h) * 4096 + (16 * mt + 4 * kb + i) * 64 + v] = S[mt][i];
    }
    __syncthreads();
}

DEV float wave_sum(float v) {
    v += dppf<DPP_X1>(v); v += dppf<DPP_X2>(v); v += dppf<DPP_HM>(v); v += dppf<DPP_RM>(v); v += __shfl_xor(v, 16); v += __shfl_xor(v, 32);
    return v;
}
DEV void transpose_item(const float* W, int K, int N, bf16_t* WT, LAS float* scr, int item, int lane) {
    const int nblk = N / 32, kb = item / nblk, nb = item % nblk, k0 = 64 * kb, n0 = 32 * nb;
#pragma unroll
    for (int i = 0; i < 32; ++i) { const int kk = 2 * i + (lane >> 5); scr[kk * 33 + (lane & 31)] = W[(size_t)(k0 + kk) * N + n0 + (lane & 31)]; }
    asm volatile("s_waitcnt lgkmcnt(0)" ::: "memory");
    const int cch = lane & 7;
#pragma unroll
    for (int j = 0; j < 4; ++j) { const int n = (lane >> 3) + 8 * j; const LAS float* s = scr + (8 * cch) * 33 + n;
        u32x4_t o; o.x = cvtpk(s[0 * 33], s[1 * 33]); o.y = cvtpk(s[2 * 33], s[3 * 33]); o.z = cvtpk(s[4 * 33], s[5 * 33]); o.w = cvtpk(s[6 * 33], s[7 * 33]);
        *(u32x4_t*)(WT + (size_t)(n0 + n) * K + k0 + 8 * cch) = o; }
    asm volatile("s_waitcnt lgkmcnt(0)" ::: "memory");
}
DEV void dev_s5_consts(CREF c, long gtid, long gn) {
    for (long t = gtid; t < (long)2 * S5G * S5P * S5C; t += gn) { const long i = t >> 4; const int ch = (int)(t & 15); const int l = (int)(i / (S5G * S5P)), g = (int)((i / S5P) % S5G), p = (int)(i % S5P); const size_t lg = (size_t)(i / S5P);
        const float lr = c.lam_re[i], li = c.lam_im[i], dt = expf(c.log_step[l * S5G + g]);
        const float zr = lr * dt, zi = li * dt, mag = expf(zr), cz = cosf(zi), sz = sinf(zi), sh = sinf(0.5f * zi);
        const float ar = mag * cz, ai = mag * sz, am1 = expm1f(zr) * cz - 2.0f * sh * sh, den = lr * lr + li * li;
        const float fr = (am1 * lr + ai * li) / den, fi = (ai * lr - am1 * li) / den;
        if (ch == 0) { float pr = ar, pi = ai;
#pragma unroll
            for (int s = 0; s < 6; ++s) { const float nr = pr * pr - pi * pi, ni = 2.0f * pr * pi; pr = nr; pi = ni; }
            c.S5K[i * 4 + 0] = ar; c.S5K[i * 4 + 1] = ai; c.S5K[i * 4 + 2] = pr; c.S5K[i * 4 + 3] = pi; }
        const float br = c.b_re[i * S5C + ch], bi = c.b_im[i * S5C + ch]; const float bbr = fr * br - fi * bi, bbi = fr * bi + fi * br;
        c.S5BB[(i * S5C + ch) * 2 + 0] = bbr; c.S5BB[(i * S5C + ch) * 2 + 1] = bbi;
#pragma unroll
        for (int comp = 0; comp < 2; ++comp) { const int s = 2 * p + comp, j = s >> 4, n = s & 15;
            c.S5BF[((lg * 8 + j) * 64 + n + 16 * (ch >> 3)) * 8 + (ch & 7)] = tobf(comp == 0 ? bbr : bbi);
            if (ch < 8) { c.S5BF[((lg * 8 + j) * 64 + n + 32) * 8 + ch] = 0; c.S5BF[((lg * 8 + j) * 64 + n + 48) * 8 + ch] = 0; }
            const int k = s, ks = k >> 5, kg = (k & 31) >> 3, jj = k & 7; const size_t ci = ((lg * S5C + ch) * S5P + p);
            c.S5CF[((lg * 4 + ks) * 64 + ch + 16 * kg) * 8 + jj] = tobf(comp == 0 ? c.c_re[ci] : -c.c_im[ci]); } }
}
DEV void dev_prologue(CREF c, LAS unsigned char* L, int bx, int tid, long gtid, long gn) {
    const int wave = tid >> 6, lane = tid & 63, gw = bx * 8 + wave, NGW = (int)gridDim.x * 8;
    LAS float* scr = (LAS float*)(L + wave * 16384);
    constexpr int I_IN = (DM / 64) * (INW / 32), I_OUT = (DM / 64) * (DM / 32), I_UP = (DM / 64) * (DFF / 32), I_DN = (DFF / 64) * (DM / 32), I_GL = (256 / 64) * (256 / 32), I_L = I_IN + I_OUT + I_UP + I_DN + I_GL;
    for (int it = gw; it < 2 * I_L; it += NGW) { const int l = it / I_L; int r = it % I_L;
        if (r < I_IN) { transpose_item(c.w_in + (size_t)l * DM * INW, DM, INW, c.WIN_T + (size_t)l * PLD * DM, scr, r, lane); continue; } r -= I_IN;
        if (r < I_OUT) { transpose_item(c.w_out + (size_t)l * DM * DM, DM, DM, c.WOUT_T + (size_t)l * DM * DM, scr, r, lane); continue; } r -= I_OUT;
        if (r < I_UP) { transpose_item(c.mlp_up + (size_t)l * DM * DFF, DM, DFF, c.WUP_T + (size_t)l * DFF * DM, scr, r, lane); continue; } r -= I_UP;
        if (r < I_DN) { transpose_item(c.mlp_down + (size_t)l * DFF * DM, DFF, DM, c.WDN_T + (size_t)l * DM * DFF, scr, r, lane); continue; } r -= I_DN;
        transpose_item(c.w_glu + (size_t)l * 65536, 256, 256, c.WGLU_T + (size_t)l * 65536, scr, r, lane); }
    for (long i = gtid; i < (long)2 * (PLD - INW) * DM / 8; i += gn) { const int l = (int)(i / ((PLD - INW) * DM / 8)); const long r = i % ((PLD - INW) * DM / 8);
        *(u32x4_t*)(c.WIN_T + ((size_t)l * PLD + INW) * DM + r * 8) = (u32x4_t){0u, 0u, 0u, 0u}; }
    { f32x4_t g[4];
#pragma unroll
      for (int j = 0; j < 4; ++j) g[j] = ((const f32x4_t*)c.ln1)[lane + 64 * j];
      for (int r = gw; r < TT; r += NGW) { const f32x4_t* xr = (const f32x4_t*)(r < TP ? c.x_prompt + (size_t)r * DM : c.x_sample + (size_t)(r - TP) * DM) + lane; f32x4_t v[4]; float s = 0.f;
#pragma unroll
        for (int j = 0; j < 4; ++j) { v[j] = xr[64 * j]; s += (v[j][0] * v[j][0] + v[j][1] * v[j][1]) + (v[j][2] * v[j][2] + v[j][3] * v[j][3]); ((f32x4_t*)(c.X + (size_t)r * DM))[lane + 64 * j] = v[j]; }
        const float rs = 1.0f / sqrtf(wave_sum(s) * (1.0f / DM) + NEPS);
#pragma unroll
        for (int j = 0; j < 4; ++j) { const f32x4_t o = v[j] * rs * g[j]; u32x2_t w = {cvtpk(o[0], o[1]), cvtpk(o[2], o[3])}; ((u32x2_t*)(c.XN + (size_t)r * DM))[lane + 64 * j] = w; } } }
}
template <bool FINAL> DEV void dev_rmsnorm(CREF c, const float* gain, int bx, int tid, int nsplit) {
    const int wave = tid >> 6, lane = tid & 63, gw = bx * 8 + wave, NGW = (int)gridDim.x * 8;
    f32x4_t g[4];
#pragma unroll
    for (int j = 0; j < 4; ++j) g[j] = ((const f32x4_t*)gain)[lane + 64 * j];
    for (int r = gw; r < TT; r += NGW) { f32x4_t* xr = (f32x4_t*)(c.X + (size_t)r * DM) + lane; f32x4_t v[4]; float s = 0.f;
#pragma unroll
        for (int j = 0; j < 4; ++j) v[j] = xr[64 * j];
        if (r >= TP) {
            for (int ks = 0; ks < nsplit; ++ks) { const f32x4_t* pr = (const f32x4_t*)(c.PART + ((size_t)ks * TS + (r - TP)) * DM) + lane;
#pragma unroll
                for (int j = 0; j < 4; ++j) v[j] += pr[64 * j]; }
            if (!FINAL) {
#pragma unroll
                for (int j = 0; j < 4; ++j) xr[64 * j] = v[j]; } }
#pragma unroll
        for (int j = 0; j < 4; ++j) s += (v[j][0] * v[j][0] + v[j][1] * v[j][1]) + (v[j][2] * v[j][2] + v[j][3] * v[j][3]);
        const float rs = 1.0f / sqrtf(wave_sum(s) * (1.0f / DM) + NEPS);
#pragma unroll
        for (int j = 0; j < 4; ++j) { const f32x4_t o = v[j] * rs * g[j];
            if (FINAL) ((f32x4_t*)(c.out + O_YP + (size_t)r * DM))[lane + 64 * j] = o;
            else { u32x2_t w = {cvtpk(o[0], o[1]), cvtpk(o[2], o[3])}; ((u32x2_t*)(c.XN + (size_t)r * DM))[lane + 64 * j] = w; } } }
}
DEV void dev_copy_out(CREF c, int l, long gtid, long gn) {
    for (long i = gtid; i < (long)TT * 128; i += gn) { const int r = (int)(i >> 7), k = (int)(i & 127); const f32x4_t v = *(const f32x4_t*)(c.PROJ + (size_t)r * PLD + C_KV + 4 * k);
        float* dst = r < TP ? c.out + O_KVP + ((size_t)l * TP + r) * 512 : c.out + O_KVS + ((size_t)l * TS + (r - TP)) * 512; *(f32x4_t*)(dst + 4 * k) = v; }
    for (long i = gtid; i < (long)BATCH * 512 * 64; i += gn) { const int b = (int)(i / (512 * 64)), w = (int)((i >> 6) & 511), k = (int)(i & 63);
        ((f32x4_t*)(c.out + O_WINP + (size_t)l * BATCH * 512 * 256))[i] = *(const f32x4_t*)(c.PROJ + (size_t)(b * SEQ + SEQ - 512 + w) * PLD + C_KV + 512 + 4 * k); }
    for (long i = gtid; i < (long)DB * 512 * 64; i += gn) { const int b = (int)(i / (512 * 64)), w = (int)((i >> 6) & 511), k = (int)(i & 63);
        ((f32x4_t*)(c.out + O_WINS + (size_t)l * DB * 512 * 256))[i] = (w < 512 - DSEQ) ? *(const f32x4_t*)(c.cache_win + (((size_t)l * DB + b) * 512 + w + DSEQ) * 256 + 4 * k)
                                                                                       : *(const f32x4_t*)(c.PROJ + (size_t)(TP + b * DSEQ + (w - (512 - DSEQ))) * PLD + C_KV + 512 + 4 * k); }
    for (long i = gtid; i < (long)BATCH * 3 * CONVD / 4; i += gn) { const int b = (int)(i / (3 * CONVD / 4)), w = (int)((i / (CONVD / 4)) % 3), k = (int)(i % (CONVD / 4));
        ((f32x4_t*)(c.out + O_CONVP + (size_t)l * BATCH * 3 * CONVD))[i] = *(const f32x4_t*)(c.PROJ + (size_t)(b * SEQ + SEQ - 3 + w) * PLD + C_DNQKV + 4 * k); }
    for (long i = gtid; i < (long)DB * 3 * CONVD / 4; i += gn) { const int b = (int)(i / (3 * CONVD / 4)), w = (int)((i / (CONVD / 4)) % 3), k = (int)(i % (CONVD / 4));
        ((f32x4_t*)(c.out + O_CONVS + (size_t)l * DB * 3 * CONVD))[i] = *(const f32x4_t*)(c.PROJ + (size_t)(TP + b * DSEQ + DSEQ - 3 + w) * PLD + C_DNQKV + 4 * k); }
}

constexpr int DP_YS = 65;
constexpr int DP_Y = 0, DP_AM = DP_Y + 3 * 64 * DP_YS * 4, DP_R = DP_AM + 64 * 64 * 4, DP_AQ = DP_R + 64 * 128 * 4, DP_SM = DP_AQ + 64 * 64 * 4, DP_END = DP_SM + 6 * 64 * 4;
static_assert(DP_END <= 131072, "DeltaNet prep LDS");
DEV void dn_prep_unit(CREF c, int l, LAS unsigned char* L, int u, int tid) {
    asm volatile("" : "+v"(tid));
    const int ch = u % NCH, h = (u / NCH) % DNH, b = u / (NCH * DNH), r0 = b * SEQ + ch * 64, lane = tid & 63, wid = tid >> 6;
    LAS float* Y = (LAS float*)(L + DP_Y); LAS float* AMs = (LAS float*)(L + DP_AM); LAS float* R = (LAS float*)(L + DP_R);
    LAS float* sm = (LAS float*)(L + DP_SM);
    LAS float* AQs = (LAS float*)(L + DP_AQ);
    if (tid < 384) { const int ci = tid % 192, tg = tid / 192, part = ci >> 6, d = ci & 63, cch = part * DNW + h * 64 + d;
        const f32x4_t w = *(const f32x4_t*)(c.conv_w + ((size_t)l * CONVD + cch) * 4); float x[35];
        const int tt0 = ch * 64 + 32 * tg - 3; const float* px = c.PROJ + (size_t)(b * SEQ) * PLD + C_DNQKV + cch;
#pragma unroll
        for (int k = 0; k < 35; ++k) { const int tt = tt0 + k; const float v = px[(size_t)(tt < 0 ? 0 : tt) * PLD]; x[k] = tt < 0 ? 0.f : v; }
#pragma unroll
        for (int t = 0; t < 32; ++t) { const float y = (w[0] * x[t] + w[1] * x[t + 1]) + (w[2] * x[t + 2] + w[3] * x[t + 3]); Y[(part * 64 + 32 * tg + t) * DP_YS + d] = y * __builtin_amdgcn_rcpf(1.0f + __expf(-y)); } }
    {
        const int tk = tid >> 3, v0 = (tid & 7) * 8; const float* zp = c.PROJ + (size_t)(r0 + tk) * PLD + C_DNZ + h * 64 + v0; const f32x4_t za = *(const f32x4_t*)zp, zb = *(const f32x4_t*)(zp + 4);
        const f32x4_t na = *(const f32x4_t*)(c.dn_norm_w + l * 64 + v0), nb = *(const f32x4_t*)(c.dn_norm_w + l * 64 + v0 + 4);
        bf16_t* gp = c.DNG + (size_t)u * 4096 + ((tk >> 2) * 64 + v0) * 4 + (tk & 3);
#pragma unroll
        for (int k = 0; k < 8; ++k) { const float z = k < 4 ? za[k] : zb[k - 4], nwv = k < 4 ? na[k] : nb[k - 4]; gp[4 * k] = tobf(z * __builtin_amdgcn_rcpf(1.0f + __expf(-z)) * nwv); } }
    if (tid >= 448) { const int t = tid - 448, r = r0 + t; sm[128 + t] = sigmoidf_(c.PROJ[(size_t)r * PLD + C_DNB + h]);
        sm[192 + t] = -expf(c.a_log[l * DNH + h]) * softplusf_(c.PROJ[(size_t)r * PLD + C_DNA + h] + c.dt_bias[l * DNH + h]); }
    __syncthreads();
    {   const int rr = tid >> 2, q4 = tid & 3; const LAS float* yr = Y + rr * DP_YS + 16 * q4; float ss = 0.f;
#pragma unroll
        for (int k = 0; k < 16; ++k) ss += yr[k] * yr[k];
        ss += dppf<DPP_X1>(ss); ss += dppf<DPP_X2>(ss);
        if (q4 == 0) sm[rr] = (rr < 64 ? 0.125f : 1.0f) / sqrtf(ss + 1e-6f); }
    if (wid == 7) { float s = sm[192 + lane];
#pragma unroll
        for (int o = 1; o < 64; o <<= 1) { const float t = __shfl_up(s, o); if (lane >= o) s += t; }
        sm[256 + lane] = s; const float gl = __shfl(s, 63); sm[320 + lane] = expf(gl - s); }
    __syncthreads();
    for (int idx = tid; idx < 128 * 64; idx += 512) { const int rr = idx >> 6, d = idx & 63; Y[rr * DP_YS + d] *= sm[rr]; }
    __syncthreads();
    {   const int mt = tid >> 7, ks = (tid >> 6) & 1, m16 = tid & 15, kb = (tid >> 4) & 3, row = 16 * mt + m16, k0 = 32 * ks + 4 * kb, k1 = k0 + 16;
        bf16_t* fo = c.DNF + (size_t)u * 16384 + tid * 8;
        { const float e = expf(sm[256 + row]); const LAS float* q = Y + row * DP_YS; const f32x4_t a = {q[k0] * e, q[k0 + 1] * e, q[k0 + 2] * e, q[k0 + 3] * e}, bq = {q[k1] * e, q[k1 + 1] * e, q[k1 + 2] * e, q[k1 + 3] * e};
          *(bf16x8_t*)(fo + 4096) = pack8(a, bq); }
        { const LAS float* kT = Y + 64 * DP_YS + row; f32x4_t a, bq;
#pragma unroll
          for (int i = 0; i < 4; ++i) { a[i] = kT[(k0 + i) * DP_YS] * sm[320 + k0 + i]; bq[i] = kT[(k1 + i) * DP_YS] * sm[320 + k1 + i]; }
          *(bf16x8_t*)(fo + 12288) = pack8(a, bq); }
    }
    for (int idx = tid; idx < 64 * 64; idx += 512) { const int t = idx >> 6, d = idx & 63; const float q = Y[t * DP_YS + d], k = Y[(64 + t) * DP_YS + d], vv = Y[(128 + t) * DP_YS + d], be = sm[128 + t];
        (void)q; R[t * 128 + d] = vv * be; R[t * 128 + 64 + d] = k * be * expf(sm[256 + t]); }

    {   const int m16 = lane & 15, kq = lane >> 4;
#pragma unroll 1
        for (int pi = wid; pi < 10; pi += 8) { const int mt = pi < 1 ? 0 : (pi < 3 ? 1 : (pi < 6 ? 2 : 3)), nt = pi - (mt * (mt + 1)) / 2;
            const LAS float* ka = Y + (64 + 16 * mt + m16) * DP_YS + kq; const LAS float* qa = Y + (16 * mt + m16) * DP_YS + kq; const LAS float* kb = Y + (64 + 16 * nt + m16) * DP_YS + kq;
            f32x4_t ck = {0.f, 0.f, 0.f, 0.f}, cq = {0.f, 0.f, 0.f, 0.f};
#pragma unroll
            for (int s = 0; s < 16; ++s) { const float bv = kb[4 * s]; ck = __builtin_amdgcn_mfma_f32_16x16x4f32(ka[4 * s], bv, ck, 0, 0, 0); cq = __builtin_amdgcn_mfma_f32_16x16x4f32(qa[4 * s], bv, cq, 0, 0, 0); }
            const int j = 16 * nt + m16; const float gj = sm[256 + j];
#pragma unroll
            for (int i = 0; i < 4; ++i) { const int ii = 16 * mt + 4 * kq + i; const float dec = j <= ii ? expf(sm[256 + ii] - gj) : 0.f;
                AMs[ii * 64 + j] = j < ii ? sm[128 + ii] * ck[i] * dec : 0.f; AQs[ii * 64 + j] = j <= ii ? cq[i] * dec : 0.f; } }
        if (wid >= 2) { const int pu = wid - 2, mt = pu < 3 ? 0 : (pu < 5 ? 1 : 2), nt = pu < 3 ? pu + 1 : (pu < 5 ? pu - 1 : 3);
#pragma unroll
            for (int i = 0; i < 4; ++i) AQs[(16 * mt + 4 * kq + i) * 64 + 16 * nt + m16] = 0.f; } }
    __syncthreads();
    {   const int col = tid >> 2, q = tid & 3; float xq[16];
#pragma unroll
        for (int jj = 0; jj < 16; ++jj) xq[jj] = 0.f;
#pragma unroll
        for (int i = 0; i < 64; ++i) { float s = 0.f;
#pragma unroll
            for (int jj = 0; jj < (i + 3) / 4; ++jj) s -= AMs[i * 64 + 4 * jj + q] * xq[jj];
            s += dppf<DPP_X1>(s); s += dppf<DPP_X2>(s); s += R[i * 128 + col];
            xq[i >> 2] = ((i & 3) == q) ? s : xq[i >> 2];
            if (q == 0) R[i * 128 + col] = s; } }
    __syncthreads();
    if (wid == 6) {
#pragma unroll
        for (int s8 = 0; s8 < 8; ++s8) { const int slot = lane + 64 * s8, mt = slot >> 7, ks = (slot >> 6) & 1, m16 = slot & 15, kb = (slot >> 4) & 3, row = 16 * mt + m16, k0 = 32 * ks + 4 * kb, k1 = k0 + 16;
            const f32x4_t a = *(const LAS f32x4_t*)(R + row * 128 + 64 + k0), bq = *(const LAS f32x4_t*)(R + row * 128 + 64 + k1); *(bf16x8_t*)(c.DNF + (size_t)u * 16384 + slot * 8) = pack8(a, bq);
            const f32x4_t a2 = *(const LAS f32x4_t*)(AQs + row * 64 + k0), b2 = *(const LAS f32x4_t*)(AQs + row * 64 + k1); *(bf16x8_t*)(c.DNF + (size_t)u * 16384 + 8192 + slot * 8) = pack8(a2, b2); }
#pragma unroll
        for (int s = 0; s < 16; ++s) { const int idx = lane + 64 * s, v = idx & 63, tq = idx >> 6; const f32x4_t uv = {R[(4 * tq) * 128 + v], R[(4 * tq + 1) * 128 + v], R[(4 * tq + 2) * 128 + v], R[(4 * tq + 3) * 128 + v]};
            *(f32x4_t*)(c.DNU + (size_t)u * 4096 + idx * 4) = uv; }
        if (lane == 0) c.DNE[u] = expf(sm[256 + 63]); }
}
DEV void dev_dn_out(CREF c, int l, int bx, int tid) {
    const int wave = tid >> 6, lane = tid & 63, gw = bx * 8 + wave, NGW = (int)gridDim.x * 8; const float nw = c.dn_norm_w[l * 64 + lane];
    for (int i0 = gw * 8; i0 < TP * DNH; i0 += NGW * 8) { float o[8], z[8];
#pragma unroll
        for (int k = 0; k < 8; ++k) { const int i = i0 + k, r = i / DNH, h = i % DNH; o[k] = c.ODN[(size_t)i * 64 + lane]; z[k] = c.PROJ[(size_t)r * PLD + C_DNZ + h * 64 + lane]; }
#pragma unroll
        for (int k = 0; k < 8; ++k) { const int i = i0 + k, r = i / DNH, h = i % DNH; const float ss = wave_sum(o[k] * o[k]);
            c.MIXB[(size_t)r * DM + 512 + h * 64 + lane] = tobf(o[k] * __builtin_amdgcn_rsqf(ss * (1.0f / 64.0f) + NEPS) * nw * (z[k] * __builtin_amdgcn_rcpf(1.0f + __expf(-z[k])))); } }
}

typedef float f32x16_t __attribute__((ext_vector_type(16)));
#define MFMA32(a, b, c) __builtin_amdgcn_mfma_f32_32x32x16_bf16((a), (b), (c), 0, 0, 0)
constexpr int NA_RS = 144;
constexpr int NA_T = 64 * NA_RS, NA_BUF = 2 * NA_T;
constexpr int NA_IMP = 2 * NA_BUF, NA_SELM = NA_IMP + 64 * 128 * 4, NA_UNI = NA_SELM + 64 * 16, NA_NIT = NA_UNI + 16, NA_ITEMS = NA_NIT + 16, NA_PT = NA_ITEMS + 160 * 4, NA_END = NA_PT + 64;
static_assert(NA_END <= 131072, "NSA LDS");
constexpr float LOG2E = 1.4426950408889634f;
DEV int crow32(int reg, int hh) { return (reg & 3) + 8 * (reg >> 2) + 4 * hh; }
struct NaStage { f32x4_t k0, k1, v0, v1; };
template <bool SMP> DEV void na_load(CREF c, NaStage& st, int l, int mode, int b, int g, int n, int tid, const LAS int* pt = nullptr) {
    const int key = tid >> 3, d0 = (tid & 7) * 8; const float* kp; bool zero = false;
    if (mode == 0) { kp = c.KC + (((size_t)((SMP ? BATCH : 0) + b) * NBMAX + 64 * n + key) * 2 + g) * 64 + d0;
        const float* vp = c.VC + (kp - c.KC); const bool zp = SMP && key >= NBC_S; const f32x4_t z0 = {0.f, 0.f, 0.f, 0.f};
        st.k0 = zp ? z0 : *(const f32x4_t*)kp; st.k1 = zp ? z0 : *(const f32x4_t*)(kp + 4); st.v0 = zp ? z0 : *(const f32x4_t*)vp; st.v1 = zp ? z0 : *(const f32x4_t*)(vp + 4); return; }
    const int slot = mode == 1 ? 2 : 4;
    if (!SMP) kp = c.PROJ + (size_t)(b * SEQ + 64 * n + key) * PLD + C_KV + slot * 128 + g * 64 + d0;
    else { const int pos = 64 * n + key;
        if (pos >= PAST) { const int j = pos - PAST; zero = j >= DSEQ; kp = c.PROJ + (size_t)(TP + b * DSEQ + (zero ? 0 : j)) * PLD + C_KV + slot * 128 + g * 64 + d0; }
        else if (mode == 1) { const int pg = pt[pos / PAGE]; kp = c.cache_nsa + ((((size_t)l * NPHYS + pg) * PAGE + (pos % PAGE)) * 4 + slot) * 128 + g * 64 + d0; }
        else kp = c.cache_win + ((((size_t)l * DB + b) * WIN + (pos - W0S)) * 2 + (slot - 4)) * 128 + g * 64 + d0; }
    const f32x4_t z = {0.f, 0.f, 0.f, 0.f};
    st.k0 = zero ? z : *(const f32x4_t*)kp; st.k1 = zero ? z : *(const f32x4_t*)(kp + 4); st.v0 = zero ? z : *(const f32x4_t*)(kp + 128); st.v1 = zero ? z : *(const f32x4_t*)(kp + 132);
}
DEV void na_store(const NaStage& st, LAS unsigned char* buf, int tid) {
    const int key = tid >> 3, d0 = (tid & 7) * 8;
    *(LAS bf16x8_t*)(buf + key * NA_RS + d0 * 2) = pack8(st.k0, st.k1);
    LAS unsigned short* vt = (LAS unsigned short*)(buf + NA_T);
    const unsigned a = cvtpk(st.v0[0], st.v0[1]), bb = cvtpk(st.v0[2], st.v0[3]), cc = cvtpk(st.v1[0], st.v1[1]), dd = cvtpk(st.v1[2], st.v1[3]);
    vt[(d0 + 0) * (NA_RS / 2) + key] = (unsigned short)a; vt[(d0 + 1) * (NA_RS / 2) + key] = (unsigned short)(a >> 16);
    vt[(d0 + 2) * (NA_RS / 2) + key] = (unsigned short)bb; vt[(d0 + 3) * (NA_RS / 2) + key] = (unsigned short)(bb >> 16);
    vt[(d0 + 4) * (NA_RS / 2) + key] = (unsigned short)cc; vt[(d0 + 5) * (NA_RS / 2) + key] = (unsigned short)(cc >> 16);
    vt[(d0 + 6) * (NA_RS / 2) + key] = (unsigned short)dd; vt[(d0 + 7) * (NA_RS / 2) + key] = (unsigned short)(dd >> 16);
}
DEV void na_scores(const LAS unsigned char* kb, const bf16x8_t (&qf)[4], int lane, f32x16_t& s0, f32x16_t& s1) {
    const int n = lane & 31, hh = lane >> 5;
#pragma unroll
    for (int i = 0; i < 16; ++i) { s0[i] = 0.f; s1[i] = 0.f; }
#pragma unroll
    for (int ks = 0; ks < 4; ++ks) { const bf16x8_t a0 = *(const LAS bf16x8_t*)(kb + n * NA_RS + (16 * ks + 8 * hh) * 2), a1 = *(const LAS bf16x8_t*)(kb + (32 + n) * NA_RS + (16 * ks + 8 * hh) * 2);
        s0 = MFMA32(a0, qf[ks], s0); s1 = MFMA32(a1, qf[ks], s1); }
}
DEV void na_pv(const LAS unsigned char* vb, const f32x16_t& p0, const f32x16_t& p1, int lane, f32x16_t& o0, f32x16_t& o1) {
    const int n = lane & 31, hh = lane >> 5;
#pragma unroll
    for (int s = 0; s < 4; ++s) { const f32x16_t& p = (s < 2) ? p0 : p1; const int e = 8 * (s & 1);
        const bf16x8_t pf = pack8((f32x4_t){p[e], p[e + 1], p[e + 2], p[e + 3]}, (f32x4_t){p[e + 4], p[e + 5], p[e + 6], p[e + 7]});
#pragma unroll
        for (int mt = 0; mt < 2; ++mt) { const LAS unsigned char* vp = vb + (32 * mt + n) * NA_RS + (16 * s + 4 * hh) * 2;
            const u32x2_t lo = *(const LAS u32x2_t*)vp, hi = *(const LAS u32x2_t*)(vp + 16); const u32x4_t w = {lo[0], lo[1], hi[0], hi[1]};
            if (mt == 0) o0 = MFMA32(__builtin_bit_cast(bf16x8_t, w), pf, o0); else o1 = MFMA32(__builtin_bit_cast(bf16x8_t, w), pf, o1); } }
}
template <bool SMP> DEV void nsa_unit(CREF c, int l, LAS unsigned char* L, int b, int qb, int g, int tid) {
    asm volatile("" : "+v"(tid));
    const int lane = tid & 63, wid = tid >> 6, n = lane & 31, hh = lane >> 5, tl = 8 * wid + (n >> 2), r = n & 3, h = 4 * g + r, t = 64 * qb + tl;
    const bool act = !SMP || wid == 0;
    const size_t row = SMP ? (size_t)(TP + b * DSEQ + (tl & 7)) : (size_t)(b * SEQ + t);
    LAS float* IMP = (LAS float*)(L + NA_IMP); LAS unsigned* SELM = (LAS unsigned*)(L + NA_SELM); LAS unsigned* UNI = (LAS unsigned*)(L + NA_UNI);
    LAS int* NIT = (LAS int*)(L + NA_NIT); LAS int* ITEMS = (LAS int*)(L + NA_ITEMS);
    const float slope2 = exp2f(-(float)(h + 1)) * LOG2E;
    bf16x8_t qf[4];
#pragma unroll
    for (int ks = 0; ks < 4; ++ks) { const float* qp = c.PROJ + row * PLD + C_Q + h * 64 + 16 * ks + 8 * hh; const f32x4_t a = *(const f32x4_t*)qp * (0.125f * LOG2E), bq = *(const f32x4_t*)(qp + 4) * (0.125f * LOG2E); qf[ks] = pack8(a, bq); }
    const float* gp = c.PROJ + row * PLD + C_GATE + h * 3; const float g0 = sigmoidf_(gp[0]), g1 = sigmoidf_(gp[1]), g2 = sigmoidf_(gp[2]);
    f32x16_t ot0, ot1, oa0, oa1;
    if (tid < 4) UNI[tid] = 0u;
    LAS int* PT = (LAS int*)(L + NA_PT);
    if (SMP && tid >= 64 && tid < 64 + NPAGES) PT[tid - 64] = c.page_table[b * NPAGES + (tid - 64)];
    const int nbc = (!SMP && qb >= 64) ? 2 : 1;
    { NaStage st; na_load<SMP>(c, st, l, 0, b, g, 0, tid); na_store(st, L, tid); if (nbc == 2) { na_load<SMP>(c, st, l, 0, b, g, 1, tid); na_store(st, L + NA_BUF, tid); } }
    __syncthreads();
    if (act) {
        f32x16_t sa0, sa1, sb0, sb1;
        na_scores(L, qf, lane, sa0, sa1);
        if (nbc == 2) na_scores(L + NA_BUF, qf, lane, sb0, sb1);
        else {
#pragma unroll
            for (int i = 0; i < 16; ++i) { sb0[i] = 0.f; sb1[i] = 0.f; } }
        float m = -1e30f;
#pragma unroll
        for (int i = 0; i < 16; ++i) { const int k0 = crow32(i, hh);
            { const int np = k0;       const bool ok = 64 * np + 63 <= t;              sa0[i] = ok ? sa0[i] - slope2 * ((float)(t - 64 * np) - 31.5f) : -1e30f; m = fmaxf(m, sa0[i]); }
            { const int np = 32 + k0;  const bool ok = 64 * np + 63 <= t;              sa1[i] = ok ? sa1[i] - slope2 * ((float)(t - 64 * np) - 31.5f) : -1e30f; m = fmaxf(m, sa1[i]); }
            { const int np = 64 + k0;  const bool ok = nbc == 2 && 64 * np + 63 <= t;  sb0[i] = ok ? sb0[i] - slope2 * ((float)(t - 64 * np) - 31.5f) : -1e30f; m = fmaxf(m, sb0[i]); }
            { const int np = 96 + k0;  const bool ok = nbc == 2 && 64 * np + 63 <= t;  sb1[i] = ok ? sb1[i] - slope2 * ((float)(t - 64 * np) - 31.5f) : -1e30f; m = fmaxf(m, sb1[i]); } }
        m = fmaxf(m, __shfl_xor(m, 32));
        float ls = 0.f;
#pragma unroll
        for (int i = 0; i < 16; ++i) { sa0[i] = sa0[i] > -1e29f ? exp2f(sa0[i] - m) : 0.f; sa1[i] = sa1[i] > -1e29f ? exp2f(sa1[i] - m) : 0.f;
                                       sb0[i] = sb0[i] > -1e29f ? exp2f(sb0[i] - m) : 0.f; sb1[i] = sb1[i] > -1e29f ? exp2f(sb1[i] - m) : 0.f; ls += (sa0[i] + sa1[i]) + (sb0[i] + sb1[i]); }
        ls += __shfl_xor(ls, 32);
        const float inv = 1.0f / fmaxf(ls, 1e-30f);
#pragma unroll
        for (int i = 0; i < 16; ++i) { sa0[i] *= inv; sa1[i] *= inv; sb0[i] *= inv; sb1[i] *= inv; }
#pragma unroll
        for (int i = 0; i < 16; ++i) { const int k0 = crow32(i, hh);
            float v0 = sa0[i], v1 = sa1[i], v2 = sb0[i], v3 = sb1[i];
            v0 += dppf<DPP_X1>(v0); v1 += dppf<DPP_X1>(v1); v2 += dppf<DPP_X1>(v2); v3 += dppf<DPP_X1>(v3);
            v0 += dppf<DPP_X2>(v0); v1 += dppf<DPP_X2>(v1); v2 += dppf<DPP_X2>(v2); v3 += dppf<DPP_X2>(v3);
            if (r == 0) { IMP[tl * 128 + k0] = v0; IMP[tl * 128 + 32 + k0] = v1; IMP[tl * 128 + 64 + k0] = v2; IMP[tl * 128 + 96 + k0] = v3; } }
#pragma unroll
        for (int i = 0; i < 16; ++i) { oa0[i] = 0.f; oa1[i] = 0.f; }
        na_pv(L + NA_T, sa0, sa1, lane, oa0, oa1);
        if (nbc == 2) na_pv(L + NA_BUF + NA_T, sb0, sb1, lane, oa0, oa1);
#pragma unroll
        for (int i = 0; i < 16; ++i) { ot0[i] = g0 * oa0[i]; ot1[i] = g0 * oa1[i]; }
    }
    __syncthreads();
    {
        const int tk = tid >> 3, s8 = tid & 7, cur = qb;
        if (!SMP || tk < DSEQ) {
        float v[16];
#pragma unroll
        for (int i = 0; i < 16; ++i) { const int nn = 16 * s8 + i; v[i] = (nn >= 1 && nn <= cur - 2) ? IMP[tk * 128 + nn] : -1.0f; }
        unsigned mk0 = 0u, mk1 = 0u, mk2 = 0u, mk3 = 0u;
        const int nforced = cur >= 2 ? 3 : cur + 1;
        for (int rd = 0; rd < TOPK - nforced; ++rd) {
            float bv = -0.5f; int bn = 1000;
#pragma unroll
            for (int i = 0; i < 16; ++i) if (v[i] > bv) { bv = v[i]; bn = 16 * s8 + i; }
            { const float ov = dppf<DPP_X1>(bv); const int on = dppi<DPP_X1>(bn); if (ov > bv || (ov == bv && on < bn)) { bv = ov; bn = on; } }
            { const float ov = dppf<DPP_X2>(bv); const int on = dppi<DPP_X2>(bn); if (ov > bv || (ov == bv && on < bn)) { bv = ov; bn = on; } }
            { const float ov = dppf<DPP_HM>(bv); const int on = dppi<DPP_HM>(bn); if (ov > bv || (ov == bv && on < bn)) { bv = ov; bn = on; } }
            if (bn >= 1000) break;
#pragma unroll
            for (int i = 0; i < 16; ++i) if (16 * s8 + i == bn) v[i] = -1.0f;
            const unsigned bit = 1u << (bn & 31); const int w = bn >> 5;
            mk0 |= w == 0 ? bit : 0u; mk1 |= w == 1 ? bit : 0u; mk2 |= w == 2 ? bit : 0u; mk3 |= w == 3 ? bit : 0u;
        }
#pragma unroll
        for (int f = 0; f < 3; ++f) { const int fn = f == 0 ? 0 : (f == 1 ? cur : cur - 1); if (fn >= 0) { const unsigned bit = 1u << (fn & 31); const int w = fn >> 5;
            mk0 |= w == 0 ? bit : 0u; mk1 |= w == 1 ? bit : 0u; mk2 |= w == 2 ? bit : 0u; mk3 |= w == 3 ? bit : 0u; } }
        if (s8 == 0) { SELM[tk * 4 + 0] = mk0; SELM[tk * 4 + 1] = mk1; SELM[tk * 4 + 2] = mk2; SELM[tk * 4 + 3] = mk3;
            atomicOr((unsigned*)&UNI[0], mk0); atomicOr((unsigned*)&UNI[1], mk1); atomicOr((unsigned*)&UNI[2], mk2); atomicOr((unsigned*)&UNI[3], mk3); }
        }
    }
    __syncthreads();
    int nit;
    {   const unsigned u0 = UNI[0], u1 = UNI[1], u2 = UNI[2], u3 = UNI[3];
        const int nn = qb - tid;
        const int sh = nn + 1;
        auto above = [&](unsigned w, int base) -> int { const int s = sh - base; return s <= 0 ? __popc(w) : (s >= 32 ? 0 : __popc(w >> s)); };
        const int nsel = __popc(u0) + __popc(u1) + __popc(u2) + __popc(u3), nwin = qb >= 8 ? 9 : qb + 1;
        if (nn >= 0) { const unsigned w = nn < 32 ? u0 : (nn < 64 ? u1 : (nn < 96 ? u2 : u3));
            if ((w >> (nn & 31)) & 1u) ITEMS[above(u0, 0) + above(u1, 32) + above(u2, 64) + above(u3, 96)] = nn; }
        if (tid < nwin) ITEMS[nsel + tid] = 256 + qb - tid;
        nit = nsel + nwin; }
    __syncthreads();
    const unsigned sm0 = SELM[tl * 4 + 0], sm1 = SELM[tl * 4 + 1], sm2 = SELM[tl * 4 + 2], sm3 = SELM[tl * 4 + 3];
    float m = -1e30f, ls = 0.f; int curmode = 0;
#pragma unroll
    for (int i = 0; i < 16; ++i) { oa0[i] = 0.f; oa1[i] = 0.f; }
    { NaStage st; const int it0 = ITEMS[0]; na_load<SMP>(c, st, l, 1 + (it0 >> 8), b, g, it0 & 255, tid, PT); na_store(st, L, tid); }
    __syncthreads();
    for (int it = 0; it < nit; ++it) {
        const int item = ITEMS[it], mode = item >> 8, nblk = item & 255;
        NaStage st; const bool more = it + 1 < nit;
        if (more) { const int nx = ITEMS[it + 1]; na_load<SMP>(c, st, l, 1 + (nx >> 8), b, g, nx & 255, tid, PT); }
        if (act) {
        if (mode != curmode) {
            const float lf = ls + __shfl_xor(ls, 32); const float sc = g1 / fmaxf(lf, 1e-30f);
#pragma unroll
            for (int i = 0; i < 16; ++i) { ot0[i] += sc * oa0[i]; ot1[i] += sc * oa1[i]; oa0[i] = 0.f; oa1[i] = 0.f; }
            m = -1e30f; ls = 0.f; curmode = mode; }
        const LAS unsigned char* buf = L + (it & 1) * NA_BUF;
        f32x16_t s0, s1; na_scores(buf, qf, lane, s0, s1);
        const int dbase = 64 * (qb - nblk) + tl;
        const unsigned smw = nblk < 32 ? sm0 : (nblk < 64 ? sm1 : (nblk < 96 ? sm2 : sm3));
        const bool blk_ok = mode == 1 ? true : ((smw >> (nblk & 31)) & 1u) != 0u;
        const bool full = (nblk == qb) || (mode == 1 && nblk == qb - 8);
        float mn, al, psum = 0.f;
        if (full) {
            float mloc = -1e30f;
#pragma unroll
            for (int i = 0; i < 16; ++i) { const int k0 = crow32(i, hh);
                { const int dist = dbase - k0;        const bool ok = blk_ok && dist >= 0 && (mode == 0 || dist < WIN); s0[i] = ok ? s0[i] - slope2 * (float)dist : -1e30f; mloc = fmaxf(mloc, s0[i]); }
                { const int dist = dbase - 32 - k0;   const bool ok = blk_ok && dist >= 0 && (mode == 0 || dist < WIN); s1[i] = ok ? s1[i] - slope2 * (float)dist : -1e30f; mloc = fmaxf(mloc, s1[i]); } }
            mloc = fmaxf(mloc, __shfl_xor(mloc, 32));
            mn = fmaxf(m, mloc); al = __builtin_amdgcn_exp2f(m - mn); m = mn;
#pragma unroll
            for (int i = 0; i < 16; ++i) { s0[i] = s0[i] > -1e29f ? __builtin_amdgcn_exp2f(s0[i] - mn) : 0.f; s1[i] = s1[i] > -1e29f ? __builtin_amdgcn_exp2f(s1[i] - mn) : 0.f; psum += s0[i] + s1[i]; }
        } else {
            const float c0 = -slope2 * (float)(dbase - 4 * hh);
            float tm = -1e30f;
#pragma unroll
            for (int i = 0; i < 16; ++i) { const float ci = (float)((i & 3) + 8 * (i >> 2));
                s0[i] = fmaf(slope2, ci, s0[i]); s1[i] = fmaf(slope2, ci + 32.0f, s1[i]); tm = fmaxf(tm, fmaxf(s0[i], s1[i])); }
            float mloc = blk_ok ? tm + c0 : -1e30f;
            mloc = fmaxf(mloc, __shfl_xor(mloc, 32));
            mn = fmaxf(m, mloc); al = __builtin_amdgcn_exp2f(m - mn); m = mn;
            const float mm = blk_ok ? mn - c0 : 1e30f;
#pragma unroll
            for (int i = 0; i < 16; ++i) { s0[i] = __builtin_amdgcn_exp2f(s0[i] - mm); s1[i] = __builtin_amdgcn_exp2f(s1[i] - mm); psum += s0[i] + s1[i]; }
        }
        ls = ls * al + psum;
        if (__builtin_amdgcn_ballot_w64(al != 1.0f) != 0ull) {
#pragma unroll
            for (int i = 0; i < 16; ++i) { oa0[i] *= al; oa1[i] *= al; } }
        na_pv(buf + NA_T, s0, s1, lane, oa0, oa1);
        }
        if (more) na_store(st, L + ((it + 1) & 1) * NA_BUF, tid);
        __syncthreads();
    }
    if (act) {
    {   const float lf = ls + __shfl_xor(ls, 32); const float sc = g2 / fmaxf(lf, 1e-30f);
#pragma unroll
        for (int i = 0; i < 16; ++i) { ot0[i] += sc * oa0[i]; ot1[i] += sc * oa1[i]; } }
    bf16_t* orow = c.MIXB + row * DM + h * 64;
#pragma unroll
    for (int q4 = 0; q4 < 4; ++q4) { const int d = 8 * q4 + 4 * hh;
        u32x2_t w0 = {cvtpk(ot0[4 * q4], ot0[4 * q4 + 1]), cvtpk(ot0[4 * q4 + 2], ot0[4 * q4 + 3])}; *(u32x2_t*)(orow + d) = w0;
        u32x2_t w1 = {cvtpk(ot1[4 * q4], ot1[4 * q4 + 1]), cvtpk(ot1[4 * q4 + 2], ot1[4 * q4 + 3])}; *(u32x2_t*)(orow + 32 + d) = w1; }
    }
    __syncthreads();
}

DEV void pool_unit(CREF c, int l, int seq, int n, int col) {
    const int slot = col >> 7, g = (col >> 6) & 1;
    const float* src; size_t stride;
    if (seq < BATCH) { src = c.PROJ + (size_t)(seq * SEQ + 64 * n) * PLD + C_KV + col; stride = PLD; }
    else { const int b = seq - BATCH, pg = c.page_table[b * NPAGES + (64 * n) / PAGE]; src = c.cache_nsa + (((size_t)l * NPHYS + pg) * PAGE + ((64 * n) % PAGE)) * 512 + col; stride = 512; }
    const float* w = (slot == 0 ? c.wck : c.wcv) + (l * 2 + g) * 64;
    float a0 = 0.f, a1 = 0.f;
#pragma unroll 16
    for (int j = 0; j < 64; j += 2) { a0 += w[j] * src[(size_t)j * stride]; a1 += w[j + 1] * src[(size_t)(j + 1) * stride]; }
    (slot == 0 ? c.KC : c.VC)[(((size_t)seq * NBMAX + n) * 2 + g) * 64 + (col & 63)] = a0 + a1;
}

DEV void dev_s5_y(CREF c, int l, long gtid, long gn) {
    for (long i = gtid; i < (long)TT * 256; i += gn) { const int r = (int)(i >> 8), ch = (int)(i & 255), g = ch / S5C, cc = ch % S5C;
        const float* cr = c.c_re + (((size_t)l * S5G + g) * S5C + cc) * S5P; const float* ci = c.c_im + (((size_t)l * S5G + g) * S5C + cc) * S5P;
        const f32x4_t* hs = (const f32x4_t*)(c.S5HS + ((size_t)r * S5G + g) * S5P * 2); float y = 0.f;
#pragma unroll 8
        for (int p2 = 0; p2 < S5P / 2; ++p2) { const f32x4_t hv = hs[p2]; y += cr[2 * p2] * hv[0] - ci[2 * p2] * hv[1] + cr[2 * p2 + 1] * hv[2] - ci[2 * p2 + 1] * hv[3]; }
        y += c.s5_d[l * 256 + ch] * c.PROJ[(size_t)r * PLD + C_S5U + ch]; c.GLB[i] = tobf(geluf_(y)); }
}

constexpr int S5_URS = 528, S5_HRS = 4112;
constexpr int S5_U = 0, S5_HT = 64 * S5_URS;
static_assert(S5_HT + 16 * S5_HRS <= 131072, "S5 LDS");
template <bool PASS_B, bool SMP> DEV void s5_unit(CREF c, int l, LAS unsigned char* L, int b, int ch, int tid) {
    asm volatile("" : "+v"(tid));
    constexpr int NT = SMP ? DSEQ : 64, NSB = SMP ? 1 : 4, TSB = SMP ? DSEQ : 16;
    const int r0 = SMP ? TP + b * DSEQ : b * SEQ + ch * 64, lane = tid & 63, wid = tid >> 6, n16 = lane & 15, kg = lane >> 4;
    LAS unsigned char* UB = L + S5_U; LAS unsigned char* BH = L + S5_HT;
    for (int i = tid; i < 16 * (SMP ? 1 : 4) * 64; i += 512) { const int t = i >> 6, q = i & 63; f32x4_t v = {0.f, 0.f, 0.f, 0.f}; if (t < NT) v = *(const f32x4_t*)(c.PROJ + (size_t)(r0 + t) * PLD + C_S5U + 4 * q);
        u32x2_t w = {cvtpk(v[0], v[1]), cvtpk(v[2], v[3])}; *(LAS u32x2_t*)(UB + t * S5_URS + q * 8) = w; }
    float ar[2], ai[2], hr[2], hi[2];
#pragma unroll
    for (int s = 0; s < 2; ++s) { const int idx = tid + 512 * s; const size_t gi = (size_t)l * S5G * S5P + idx;
        ar[s] = c.S5K[gi * 4]; ai[s] = c.S5K[gi * 4 + 1];
        if (SMP) { hr[s] = c.st_s5re[((size_t)l * DB + b) * 1024 + idx]; hi[s] = c.st_s5im[((size_t)l * DB + b) * 1024 + idx]; }
        else if (PASS_B) {
            const float a64r = c.S5K[gi * 4 + 2], a64i = c.S5K[gi * 4 + 3]; float cr_ = 0.f, ci_ = 0.f;
            for (int c0 = 0; c0 < ch; c0 += 16) { f32x2_t e[16];
#pragma unroll
                for (int k = 0; k < 16; ++k) e[k] = (c0 + k < ch) ? *(const f32x2_t*)(c.S5E + (((size_t)b * NCH + c0 + k) * 1024 + idx) * 2) : (f32x2_t){0.f, 0.f};
#pragma unroll
                for (int k = 0; k < 16; ++k) if (c0 + k < ch) { const float nr = a64r * cr_ - a64i * ci_ + e[k][0], ni = a64r * ci_ + a64i * cr_ + e[k][1]; cr_ = nr; ci_ = ni; } }
            hr[s] = cr_; hi[s] = ci_; }
        else { hr[s] = 0.f; hi[s] = 0.f; } }
    bf16x8_t bbf[2][8], ccf[2][4]; float dco[2];
#pragma unroll
    for (int gi2 = 0; gi2 < 2; ++gi2) { const size_t lg = (size_t)l * S5G + 2 * wid + gi2;
#pragma unroll
        for (int j = 0; j < 8; ++j) bbf[gi2][j] = *(const bf16x8_t*)(c.S5BF + ((lg * 8 + j) * 64 + lane) * 8);
        if (PASS_B) {
#pragma unroll
            for (int ks = 0; ks < 4; ++ks) ccf[gi2][ks] = *(const bf16x8_t*)(c.S5CF + ((lg * 4 + ks) * 64 + lane) * 8);
            dco[gi2] = c.s5_d[l * 256 + (2 * wid + gi2) * 16 + n16]; } }
    __syncthreads();
    const f32x4_t z4 = {0.f, 0.f, 0.f, 0.f}; const bf16x8_t zf = {0, 0, 0, 0, 0, 0, 0, 0};
    for (int sb = 0; sb < NSB; ++sb) {
#pragma unroll
        for (int gi2 = 0; gi2 < 2; ++gi2) { const int g = 2 * wid + gi2;
            const bf16x8_t af = kg < 2 ? *(const LAS bf16x8_t*)(UB + (16 * sb + n16) * S5_URS + (16 * g + 8 * kg) * 2) : zf;
#pragma unroll
            for (int j = 0; j < 8; ++j) { const f32x4_t acc = MFMA16(af, bbf[gi2][j], z4);
                LAS unsigned short* o = (LAS unsigned short*)(BH + (4 * kg) * S5_HRS + (g * 128 + 16 * j + n16) * 2);
                const unsigned p01 = cvtpk(acc[0], acc[1]), p23 = cvtpk(acc[2], acc[3]);
                o[0] = (unsigned short)p01; o[S5_HRS / 2] = (unsigned short)(p01 >> 16); o[S5_HRS] = (unsigned short)p23; o[3 * (S5_HRS / 2)] = (unsigned short)(p23 >> 16); } }
        __syncthreads();
#pragma unroll 4
        for (int tt = 0; tt < TSB; ++tt) {
#pragma unroll
            for (int s = 0; s < 2; ++s) { LAS unsigned* bp = (LAS unsigned*)(BH + tt * S5_HRS + (tid + 512 * s) * 4); const unsigned w = *bp;
                const float br = __uint_as_float(w << 16), bi = __uint_as_float(w & 0xffff0000u);
                const float nr = ar[s] * hr[s] - ai[s] * hi[s] + br, ni = ar[s] * hi[s] + ai[s] * hr[s] + bi; hr[s] = nr; hi[s] = ni;
                if (PASS_B) *bp = cvtpk(nr, ni); } }
        if (PASS_B) {
            __syncthreads();
#pragma unroll
            for (int gi2 = 0; gi2 < 2; ++gi2) { const int g = 2 * wid + gi2; f32x4_t y = z4;
#pragma unroll
                for (int ks = 0; ks < 4; ++ks) { const bf16x8_t hf = *(const LAS bf16x8_t*)(BH + n16 * S5_HRS + (g * 128 + 32 * ks + 8 * kg) * 2); y = MFMA16(hf, ccf[gi2][ks], y); }
#pragma unroll
                for (int i = 0; i < 4; ++i) { const int t = 16 * sb + 4 * kg + i;
                    if (t < NT) { const float uu = __uint_as_float(((unsigned)*(const LAS unsigned short*)(UB + t * S5_URS + (16 * g + n16) * 2)) << 16);
                        *(LAS unsigned short*)(UB + t * S5_URS + (16 * g + n16) * 2) = tobf(geluf_(y[i] + dco[gi2] * uu)); } } }
        }
        __syncthreads();
    }
    if (PASS_B) {
        bf16x8_t wf[2][8];
#pragma unroll
        for (int nt = 0; nt < 2; ++nt)
#pragma unroll
            for (int ks = 0; ks < 8; ++ks) wf[nt][ks] = *(const bf16x8_t*)(c.WGLU_T + (size_t)l * 65536 + (size_t)(32 * wid + 16 * nt + n16) * 256 + 32 * ks + 8 * kg);
#pragma unroll 1
        for (int mt = 0; mt < (SMP ? 1 : 4); ++mt) { f32x4_t a0 = z4, a1 = z4;
#pragma unroll
            for (int ks = 0; ks < 8; ++ks) { const bf16x8_t af = *(const LAS bf16x8_t*)(UB + (16 * mt + n16) * S5_URS + (32 * ks + 8 * kg) * 2); a0 = MFMA16(af, wf[0][ks], a0); a1 = MFMA16(af, wf[1][ks], a1); }
#pragma unroll
            for (int i = 0; i < 4; ++i) { const int t = 16 * mt + 4 * kg + i;
                if (t < NT) {
#pragma unroll
                    for (int nt = 0; nt < 2; ++nt) { const int col = 32 * wid + 16 * nt + n16; const float z = nt == 0 ? a0[i] : a1[i];
                        const float gl = __uint_as_float(((unsigned)*(const LAS unsigned short*)(UB + t * S5_URS + col * 2)) << 16);
                        c.MIXB[(size_t)(r0 + t) * DM + 768 + col] = tobf(gl * __builtin_amdgcn_rcpf(1.0f + __expf(-z))); } } } } }
#pragma unroll
    for (int s = 0; s < 2; ++s) { const int idx = tid + 512 * s;
        if (SMP) { c.out[O_S5RS + ((size_t)l * DB + b) * 1024 + idx] = hr[s]; c.out[O_S5IS + ((size_t)l * DB + b) * 1024 + idx] = hi[s]; }
        else if (!PASS_B) { const size_t e = (((size_t)b * NCH + ch) * 1024 + idx) * 2; c.S5E[e] = hr[s]; c.S5E[e + 1] = hi[s]; } }
    __syncthreads();
}

DEV void dn_sample_unit(CREF c, int l, LAS unsigned char* L, int b, int tid) {
    asm volatile("" : "+v"(tid));
    LAS float* Y = (LAS float*)L;
    LAS float* sm = Y + 8 * 768;
    const int r0 = TP + b * DSEQ, lane = tid & 63, wid = tid >> 6;
    for (int idx = tid; idx < 8 * 768; idx += 512) { const int t = idx / 768, cch = idx % 768; const f32x4_t w = *(const f32x4_t*)(c.conv_w + ((size_t)l * CONVD + cch) * 4); float y = 0.f;
#pragma unroll
        for (int j = 0; j < 4; ++j) { const int tt = t - 3 + j; y += w[j] * (tt >= 0 ? c.PROJ[(size_t)(r0 + tt) * PLD + C_DNQKV + cch] : c.st_conv[(((size_t)l * DB + b) * 3 + 3 + tt) * CONVD + cch]); }
        Y[idx] = y / (1.0f + expf(-y)); }
    if (tid < 32) { const int t = tid >> 2, h = tid & 3; sm[64 + tid] = sigmoidf_(c.PROJ[(size_t)(r0 + t) * PLD + C_DNB + h]);
        sm[96 + tid] = expf(-expf(c.a_log[l * DNH + h]) * softplusf_(c.PROJ[(size_t)(r0 + t) * PLD + C_DNA + h] + c.dt_bias[l * DNH + h])); }
    __syncthreads();
    for (int rr = wid * 8; rr < wid * 8 + 8; ++rr) { const int t = rr >> 3, part = (rr >> 2) & 1, h = rr & 3; const float y = Y[t * 768 + part * 256 + h * 64 + lane]; const float ss = wave_sum(y * y);
        if (lane == 0) sm[rr] = (part == 0 ? 0.125f : 1.0f) / sqrtf(ss + 1e-6f); }
    __syncthreads();
    if (tid < 256) { const int h = tid >> 6, jc = tid & 63; float S[64]; const float* s0 = c.st_dn + (((size_t)l * DB + b) * DNH + h) * 4096 + jc;
#pragma unroll
        for (int kk = 0; kk < 64; ++kk) S[kk] = s0[kk * 64];
        const float nw = c.dn_norm_w[l * 64 + jc];
        for (int t = 0; t < DSEQ; ++t) { const LAS float* qp = Y + t * 768 + h * 64; const LAS float* kp = qp + 256; const float qs = sm[t * 8 + h], ksc = sm[t * 8 + 4 + h], a = sm[96 + t * 4 + h], be = sm[64 + t * 4 + h];
            float ks = 0.f;
#pragma unroll
            for (int kk = 0; kk < 64; ++kk) { S[kk] *= a; ks += kp[kk] * S[kk]; }
            const float vn = be * (Y[t * 768 + 512 + h * 64 + jc] - ks * ksc), kv = vn * ksc; float os = 0.f;
#pragma unroll
            for (int kk = 0; kk < 64; ++kk) { S[kk] += kp[kk] * kv; os += qp[kk] * S[kk]; }
            os *= qs;
            const float ss = wave_sum(os * os); const float z = c.PROJ[(size_t)(r0 + t) * PLD + C_DNZ + h * 64 + jc];
            c.MIXB[(size_t)(r0 + t) * DM + 512 + h * 64 + jc] = tobf(os / sqrtf(ss * (1.0f / 64.0f) + NEPS) * nw * (z / (1.0f + expf(-z)))); }
#pragma unroll
        for (int kk = 0; kk < 64; ++kk) c.out[O_DNS + (((size_t)l * DB + b) * DNH + h) * 4096 + kk * 64 + jc] = S[kk]; }
    __syncthreads();
}
DEV void s5_carry_unit(CREF c, int l, int b, int tid) {
    for (int s = 0; s < 2; ++s) { const int idx = tid + 512 * s; const float* K = c.S5K + ((size_t)l * 1024 + idx) * 4; const float a64r = K[2], a64i = K[3]; float hr = 0.f, hi = 0.f;
        for (int c0 = 0; c0 < NCH; c0 += 16) { f32x2_t e[16];
#pragma unroll
            for (int k = 0; k < 16; ++k) e[k] = *(const f32x2_t*)(c.S5E + (((size_t)b * NCH + c0 + k) * 1024 + idx) * 2);
#pragma unroll
            for (int k = 0; k < 16; ++k) { *(f32x2_t*)(c.S5HIN + (((size_t)b * NCH + c0 + k) * 1024 + idx) * 2) = (f32x2_t){hr, hi};
                const float nr = a64r * hr - a64i * hi + e[k][0], ni = a64r * hi + a64i * hr + e[k][1]; hr = nr; hi = ni; } }
        c.out[O_S5RP + ((size_t)l * BATCH + b) * 1024 + idx] = hr; c.out[O_S5IP + ((size_t)l * BATCH + b) * 1024 + idx] = hi; }
}
#ifndef N_LAUNCH_MODE
#define N_LAUNCH_MODE 1
#endif
namespace pg8 {
template <bool ADD> struct EpiF32 {
    static constexpr bool PERM = false, AFTER_DRAIN = false;
    float* C; int ldc;
    __device__ __forceinline__ void operator()(const f32x4 (&acc)[2][2][4][2], const Unit& u, int wr, int wc, int fr, int fq) const {
        const int row0 = u.pm * BM + wr * 64 + fr, col0 = u.pn * BM + wc * 32 + 4 * fq;
#pragma unroll
        for (int ai = 0; ai < 2; ++ai)
#pragma unroll
            for (int m = 0; m < 4; ++m) { float* rowp = C + (size_t)(row0 + ai * HALF + m * 16) * ldc + col0;
#pragma unroll
                for (int bj = 0; bj < 2; ++bj)
#pragma unroll
                    for (int n = 0; n < 2; ++n) { f32x4 v = acc[ai][bj][m][n]; if (ADD) v += *(const f32x4*)(rowp + bj * HALF + n * 16); *(f32x4*)(rowp + bj * HALF + n * 16) = v; } }
    }
};
struct EpiSqReluBf16 {
    static constexpr bool PERM = true, AFTER_DRAIN = false;
    bf16_t* O; int ldc;
    __device__ __forceinline__ void operator()(const f32x4 (&acc)[2][2][4][2], const Unit& u, int wr, int wc, int fr, int fq) const {
        const int row0 = u.pm * BM + wr * 64 + fr, col0 = u.pn * BM + wc * 32 + 8 * fq;
#pragma unroll
        for (int ai = 0; ai < 2; ++ai)
#pragma unroll
            for (int m = 0; m < 4; ++m) { bf16_t* rowp = O + (size_t)(row0 + ai * HALF + m * 16) * ldc + col0;
#pragma unroll
                for (int bj = 0; bj < 2; ++bj) { f32x4 v0 = acc[ai][bj][m][0], v1 = acc[ai][bj][m][1];
#pragma unroll
                    for (int j = 0; j < 4; ++j) { const float a = v0[j] > 0.f ? v0[j] : 0.f, b = v1[j] > 0.f ? v1[j] : 0.f; v0[j] = a * a; v1[j] = b * b; }
                    u32x4 w; w.x = cvt_pk_bf16(v0[0], v0[1]); w.y = cvt_pk_bf16(v0[2], v0[3]); w.z = cvt_pk_bf16(v1[0], v1[1]); w.w = cvt_pk_bf16(v1[2], v1[3]);
                    *(u32x4*)(rowp + bj * HALF) = w; } }
    }
};
struct EpiGluBf16 {
    static constexpr bool PERM = true, AFTER_DRAIN = false;
    bf16_t* O; int ldc; const bf16_t* GLv;
    __device__ __forceinline__ void operator()(const f32x4 (&acc)[2][2][4][2], const Unit& u, int wr, int wc, int fr_, int fq_) const {
        int ln; asm volatile("v_mbcnt_lo_u32_b32 %0, -1, 0\n\tv_mbcnt_hi_u32_b32 %0, -1, %0" : "=v"(ln)); const int fr = ln & 15, fq = ln >> 4;
        const int row0 = u.pm * BM + wr * 64 + fr, col0 = u.pn * BM + wc * 32 + 8 * fq;
#pragma unroll
        for (int ai = 0; ai < 2; ++ai)
#pragma unroll
            for (int m = 0; m < 4; ++m) { const size_t r = (size_t)(row0 + ai * HALF + m * 16);
#pragma unroll
                for (int bj = 0; bj < 2; ++bj) { const u32x4 gv = *(const u32x4*)(GLv + r * 256 + col0 + bj * HALF); f32x4 v0 = acc[ai][bj][m][0], v1 = acc[ai][bj][m][1];
#pragma unroll
                    for (int j = 0; j < 4; ++j) { v0[j] = __builtin_amdgcn_rcpf(1.0f + __expf(-v0[j])); v1[j] = __builtin_amdgcn_rcpf(1.0f + __expf(-v1[j])); }
                    v0[0] *= __uint_as_float(gv[0] << 16); v0[1] *= __uint_as_float(gv[0] & 0xffff0000u); v0[2] *= __uint_as_float(gv[1] << 16); v0[3] *= __uint_as_float(gv[1] & 0xffff0000u);
                    v1[0] *= __uint_as_float(gv[2] << 16); v1[1] *= __uint_as_float(gv[2] & 0xffff0000u); v1[2] *= __uint_as_float(gv[3] << 16); v1[3] *= __uint_as_float(gv[3] & 0xffff0000u);
                    u32x4 w; w.x = cvt_pk_bf16(v0[0], v0[1]); w.y = cvt_pk_bf16(v0[2], v0[3]); w.z = cvt_pk_bf16(v1[0], v1[1]); w.w = cvt_pk_bf16(v1[2], v1[3]);
                    *(u32x4*)(O + r * ldc + col0 + bj * HALF) = w; } }
    }
};
}

#define XB_TMO      128
#define XB_XCNT(j)  (256  + 64 * (j))
#define XB_XSUB(j)  (1280 + 64 * (j))
#define XB_XGEN(j)  (2304 + 64 * (j))
#define XB_TOP      3328
#define XB_TOPGEN   3392
#define XCD_BAR_WORDS 3456
#define XB_SPIN_CAP (1u << 24)
__device__ __forceinline__ unsigned xb_ld(unsigned* p)              { return __hip_atomic_load(p, __ATOMIC_RELAXED, __HIP_MEMORY_SCOPE_AGENT); }
__device__ __forceinline__ unsigned xb_add(unsigned* p, unsigned v) { return __hip_atomic_fetch_add(p, v, __ATOMIC_RELAXED, __HIP_MEMORY_SCOPE_AGENT); }
__device__ __forceinline__ unsigned xb_xcc_id() { return (unsigned)__builtin_amdgcn_s_getreg((3 << 11) | 20) & 0xFu; }
#define XB_SPIN(cond, bar) do { unsigned _sp = 0; while (cond) { __builtin_amdgcn_s_sleep(1); \
    if ((++_sp & 255u) == 0u) { if (xb_ld(&(bar)[XB_TMO])) break; if (_sp > XB_SPIN_CAP) { atomicAdd(&(bar)[XB_TMO], 1u); break; } } } } while (0)
struct XcdBarrier { unsigned* bar; unsigned x; volatile LAS unsigned* st; };
__device__ __forceinline__ XcdBarrier xcd_barrier_post(unsigned* bar, volatile LAS unsigned* st) {
    XcdBarrier b; b.bar = bar; b.x = xb_xcc_id(); b.st = st;
    if (threadIdx.x == 0) (void)xb_add(&bar[XB_XCNT(b.x)], 1u);
    return b;
}
__device__ __forceinline__ void xcd_barrier_complete(unsigned* bar, unsigned x, unsigned& nloc, unsigned& nx) {
    const unsigned G = gridDim.x * gridDim.y * gridDim.z;
    unsigned sum, cnt, mine, sp = 0u;
    for (;;) {
        sum = 0u; cnt = 0u; mine = 0u;
#pragma unroll
        for (unsigned j = 0; j < 16; ++j) { const unsigned c = xb_ld(&bar[XB_XCNT(j)]); sum += c; cnt += (c > 0u) ? 1u : 0u; mine = (j == x) ? c : mine; }
        if (sum == G) break;
        __builtin_amdgcn_s_sleep(1);
        if ((++sp & 255u) == 0u) { if (xb_ld(&bar[XB_TMO])) break; if (sp > XB_SPIN_CAP) { atomicAdd(&bar[XB_TMO], 1u); break; } }
    }
    nloc = mine > 0u ? mine : 1u; nx = cnt > 0u ? cnt : 1u;
}
__device__ __forceinline__ void xcd_barrier(const XcdBarrier& b, const bool t0) {
    asm volatile("s_waitcnt vmcnt(0)" ::: "memory");
    __syncthreads();
    if (t0) {
        unsigned* bar = b.bar; unsigned bx = b.x; asm volatile("" : "+s"(bar), "+s"(bx));
        __builtin_amdgcn_s_waitcnt(0);
        unsigned nloc = b.st[0], nx = b.st[1];
        if (nloc == 0u) { xcd_barrier_complete(bar, bx, nloc, nx); b.st[0] = nloc; b.st[1] = nx; }
        const unsigned old = xb_add(&bar[XB_XSUB(bx)], 1u);
        const unsigned gen = old / nloc;
        if (old + 1u == (gen + 1u) * nloc) {
            __builtin_amdgcn_fence(__ATOMIC_RELEASE, "agent");
            asm volatile("s_waitcnt vmcnt(0)" ::: "memory");
            const unsigned og = xb_add(&bar[XB_TOP], 1u);
            const unsigned tg = og / nx;
            if (og + 1u == (tg + 1u) * nx) xb_add(&bar[XB_TOPGEN], 1u);
            else XB_SPIN(xb_ld(&bar[XB_TOPGEN]) == tg, bar);
            __builtin_amdgcn_fence(__ATOMIC_ACQUIRE, "agent");
            xb_add(&bar[XB_XGEN(bx)], 1u);
            asm volatile("s_waitcnt vmcnt(0)" ::: "memory");
        } else {
            XB_SPIN(xb_ld(&bar[XB_XGEN(bx)]) == gen, bar);
            __builtin_amdgcn_fence(__ATOMIC_ACQUIRE, "agent");
            asm volatile("s_waitcnt vmcnt(0)" ::: "memory");
        }
    }
    __syncthreads();
}

constexpr int RING_BYTES = 131072, LDS_BYTES = 147456, LDSCTL_OFF = LDS_BYTES - 256;
constexpr int NTHREADS = 512;
constexpr size_t al256(size_t x) { return (x + 255) & ~(size_t)255; }
constexpr size_t WS_CTL = 0, CTL_BYTES = 65536;
constexpr size_t WS_X = al256(WS_CTL + CTL_BYTES), WS_SSQ = al256(WS_X + (size_t)TT * DM * 4), WS_XN = al256(WS_SSQ + (size_t)TT * 64 * 4),
    WS_PROJ = al256(WS_XN + (size_t)TT * DM * 2), WS_MIXB = al256(WS_PROJ + (size_t)TT * PLD * 4), WS_UPB = al256(WS_MIXB + (size_t)TT * DM * 2),
    WS_WIN = al256(WS_UPB + (size_t)TT * DFF * 2), WS_WOUT = al256(WS_WIN + (size_t)2 * PLD * DM * 2), WS_WUP = al256(WS_WOUT + (size_t)2 * DM * DM * 2),
    WS_WDN = al256(WS_WUP + (size_t)2 * DFF * DM * 2), WS_KC = al256(WS_WDN + (size_t)2 * DM * DFF * 2), WS_VC = al256(WS_KC + (size_t)NSEQ * NBMAX * 128 * 4),
    WS_PC = al256(WS_VC + (size_t)NSEQ * NBMAX * 128 * 4), WS_OC = al256(WS_PC + (size_t)TT * NH * NBMAX * 4), WS_IDX = al256(WS_OC + (size_t)TT * NH * 64 * 4),
    WS_QN = al256(WS_IDX + (size_t)TT * NG * TOPK * 4), WS_KN = al256(WS_QN + (size_t)TT * 256 * 4), WS_VV = al256(WS_KN + (size_t)TT * 256 * 4),
    WS_GG = al256(WS_VV + (size_t)TT * 256 * 4), WS_BETA = al256(WS_GG + (size_t)TT * DNH * 4), WS_GC = al256(WS_BETA + (size_t)TT * DNH * 4),
    WS_AM = al256(WS_GC + (size_t)NDU * 64 * 4), WS_AQK = al256(WS_AM + (size_t)NDU * 4096 * 4), WS_SOL = al256(WS_AQK + (size_t)NDU * 4096 * 4),
    WS_VNEW = al256(WS_SOL + (size_t)NDU * 8192 * 4), WS_SDN = al256(WS_VNEW + (size_t)BATCH * DNH * 4096 * 4), WS_ODN = al256(WS_SDN + (size_t)BATCH * DNH * 4096 * 4),
    WS_S5K = al256(WS_ODN + (size_t)TT * 256 * 4), WS_S5BB = al256(WS_S5K + 2 * S5G * S5P * 4 * 4), WS_S5E = al256(WS_S5BB + 2 * S5G * S5P * S5C * 2 * 4),
    WS_S5HIN = al256(WS_S5E + (size_t)BATCH * NCH * 2048 * 4), WS_S5HS = al256(WS_S5HIN + (size_t)BATCH * NCH * 2048 * 4), WS_GL = al256(WS_S5HS + (size_t)TT * 2048 * 4),
    WS_GLB = al256(WS_GL + (size_t)TT * 256 * 4), WS_WGLU = al256(WS_GLB + (size_t)TT * 256 * 2), WS_PART = al256(WS_WGLU + (size_t)2 * 65536 * 2), WS_DNF = al256(WS_PART + (size_t)8 * TS * DM * 4), WS_DNU = al256(WS_DNF + (size_t)NDU * 16384 * 2), WS_DNE = al256(WS_DNU + (size_t)NDU * 4096 * 4), WS_DNG = al256(WS_DNE + (size_t)NDU * 4), WS_S5BF = al256(WS_DNG + (size_t)NDU * 4096 * 2), WS_S5CF = al256(WS_S5BF + (size_t)2 * 16 * 8 * 64 * 8 * 2), WS_END = al256(WS_S5CF + (size_t)2 * 16 * 4 * 64 * 8 * 2);

struct Args { Ctx c; unsigned* bar; int lo, hi; };
constexpr int NPH = 1 + 2 * 14 + 2;
typedef const __attribute__((address_space(4))) unsigned char* karg_t;
__device__ __forceinline__ int lane_id() { return (int)__builtin_amdgcn_mbcnt_hi(~0u, __builtin_amdgcn_mbcnt_lo(~0u, 0u)); }
__device__ __forceinline__ int lane_id_v() { int t; asm volatile("v_mbcnt_lo_u32_b32 %0, -1, 0\n\tv_mbcnt_hi_u32_b32 %0, -1, %0" : "=v"(t)); return t; }
#define TIDV (wv * 64 + lane_id_v())
template <int P> __device__ __forceinline__ void run_phase(const int l, LAS unsigned char* L, const int wv) {
    karg_t kp = (karg_t)__builtin_amdgcn_kernarg_segment_ptr(); asm volatile("" : "+s"(kp));
    CREF c = *(const __attribute__((address_space(4))) Ctx*)kp;
    int tx_ = wv * 64 + lane_id_v(), bx_ = blockIdx.x; asm volatile("" : "+v"(tx_), "+s"(bx_));
    const long gtid = (long)bx_ * NTHREADS + tx_, gn = (long)gridDim.x * NTHREADS;
    const int G = (int)gridDim.x;
    if constexpr (P == 0) { dev_prologue(c, L, bx_, tx_, gtid, gn); dev_s5_consts(c, (long)(G - 1 - bx_) * NTHREADS + tx_, gn);   }
    if constexpr (P == 2) dev_rmsnorm<false>(c, c.ln1 + l * DM, bx_, tx_, l == 0 ? 0 : 8);
    if constexpr (P == 3) { pg8::Gemm g{c.XN, c.WIN_T + (size_t)l * PLD * DM, TT, PLD, DM, DM}; pg8::StaticOrder S; S.init(TT, PLD, G, bx_);
        pg8::EpiF32<false> E{c.PROJ, PLD}; pg8::gemm_phase<pg8::EpiF32<false>, pg8::StaticOrder, true, true>(L, g, S, E, wv * 64 + lane_id_v()); }
    if constexpr (P == 4) { for (int u = bx_; u < NDU; u += G) dn_prep_unit(c, l, L, u, TIDV);
        for (int u = bx_; u < BATCH * NCH; u += G) s5_unit<false, false>(c, l, L, u / NCH, u % NCH, TIDV);
        constexpr int NPU = BATCH * NBP + DB * NBC_S;
        { const int t = TIDV; for (int u = 2 * bx_ + (t >> 8); u < NPU; u += 2 * G) { if (u < BATCH * NBP) pool_unit(c, l, u / NBP, u % NBP, t & 255); else pool_unit(c, l, BATCH + (u - BATCH * NBP) / NBC_S, (u - BATCH * NBP) % NBC_S, t & 255); } } }
    if constexpr (P == 5) {
        if (bx_ < BATCH * DNH) dn_scan_mfma(c, l, L, bx_, TIDV);
        constexpr int NU = BATCH * NG * NBP;
        volatile LAS int* qslot = (volatile LAS int*)(L + LDSCTL_OFF + 64);
#define QLOOP(qi, count, ...) for (;;) { if (wv == 0 && lane_id_v() == 0) qslot[0] = (int)__hip_atomic_fetch_add(c.QCTR + 64 * (8 * l + (qi)), 1u, __ATOMIC_RELAXED, __HIP_MEMORY_SCOPE_AGENT); \
            __syncthreads(); const int it = qslot[0]; __syncthreads(); if (it >= (count)) break; __VA_ARGS__; }
        const int grp = (bx_ >> 3) & 7; const bool memfirst = grp == 1 || grp == 3 || grp == 5;
        if (memfirst) { QLOOP(4, 256, dev_copy_out(c, l, (long)it * NTHREADS + TIDV, (long)256 * NTHREADS)) }
        for (;;) { if (wv == 0 && lane_id_v() == 0) qslot[0] = memfirst ? 0x7fffffff : (int)__hip_atomic_fetch_add(c.QCTR + 64 * (8 * l + 0), 1u, __ATOMIC_RELAXED, __HIP_MEMORY_SCOPE_AGENT);
            __syncthreads(); const int it = qslot[0]; __syncthreads(); if (it >= NU) break;
            const int qb = NBP - 1 - it / (BATCH * NG), bg = it % (BATCH * NG); nsa_unit<false>(c, l, L, bg / NG, qb, bg % NG, TIDV); }
        QLOOP(1, DB * NG, nsa_unit<true>(c, l, L, it / NG, PAST / 64, it % NG, TIDV))
        QLOOP(2, DB, dn_sample_unit(c, l, L, it, TIDV))
        QLOOP(3, BATCH, s5_carry_unit(c, l, it, TIDV))
        QLOOP(5, BATCH * NCH + DB, { if (it < BATCH * NCH) s5_unit<true, false>(c, l, L, it / NCH, it % NCH, TIDV); else s5_unit<true, true>(c, l, L, it - BATCH * NCH, 0, TIDV); })
        QLOOP(4, 256, dev_copy_out(c, l, (long)it * NTHREADS + TIDV, (long)256 * NTHREADS))
#undef QLOOP
    }
    if constexpr (P == 9) dev_dn_out(c, l, bx_, tx_);
    if constexpr (P == 10) {
        { pg8::Gemm g{c.MIXB, c.WOUT_T + (size_t)l * DM * DM, TP, DM, DM, DM}; pg8::StaticOrder S; S.init(TP, DM, G, bx_);
          pg8::EpiF32<true> E{c.X, DM}; pg8::gemm_phase<pg8::EpiF32<true>, pg8::StaticOrder, true, true>(L, g, S, E, wv * 64 + lane_id_v()); }
        if (bx_ < 64) { const int ks = bx_ >> 4; pg8::Gemm g{c.MIXB + (size_t)TP * DM + ks * 256, c.WOUT_T + (size_t)l * DM * DM + ks * 256, TS, DM, 256, DM}; pg8::StaticOrder S; S.init(TS, DM, 16, bx_ & 15);
          pg8::EpiF32<false> E{c.PART + (size_t)ks * TS * DM, DM}; pg8::gemm_phase<pg8::EpiF32<false>, pg8::StaticOrder, true, true>(L, g, S, E, wv * 64 + lane_id_v()); } }
    if constexpr (P == 11) dev_rmsnorm<false>(c, c.ln2 + l * DM, bx_, tx_, 4);
    if constexpr (P == 12) { pg8::Gemm g{c.XN, c.WUP_T + (size_t)l * DFF * DM, TT, DFF, DM, DM}; pg8::StaticOrder S; S.init(TT, DFF, G, bx_);
        pg8::EpiSqReluBf16 E{c.UPB, DFF}; pg8::gemm_phase<pg8::EpiSqReluBf16, pg8::StaticOrder, true, true>(L, g, S, E, wv * 64 + lane_id_v()); }
    if constexpr (P == 13) {
        { pg8::Gemm g{c.UPB, c.WDN_T + (size_t)l * DM * DFF, TP, DM, DFF, DFF}; pg8::StaticOrder S; S.init(TP, DM, G, bx_);
          pg8::EpiF32<true> E{c.X, DM}; pg8::gemm_phase<pg8::EpiF32<true>, pg8::StaticOrder, true, true>(L, g, S, E, wv * 64 + lane_id_v()); }
        if (bx_ < 128) { const int ks = bx_ >> 4; pg8::Gemm g{c.UPB + (size_t)TP * DFF + ks * 512, c.WDN_T + (size_t)l * DM * DFF + ks * 512, TS, DM, 512, DFF}; pg8::StaticOrder S; S.init(TS, DM, 16, bx_ & 15);
          pg8::EpiF32<false> E{c.PART + (size_t)ks * TS * DM, DM}; pg8::gemm_phase<pg8::EpiF32<false>, pg8::StaticOrder, true, true>(L, g, S, E, wv * 64 + lane_id_v()); } }
    if constexpr (P == 14) dev_rmsnorm<true>(c, c.ln_f, bx_, tx_, 8);
}
#if N_LAUNCH_MODE == 1
__global__ void __launch_bounds__(NTHREADS, 2) fwd_kernel(Args a) {
    extern __shared__ __attribute__((aligned(16))) unsigned char lds[];
    LAS unsigned char* L = (LAS unsigned char*)lds;
    volatile LAS unsigned* MISC = (volatile LAS unsigned*)(L + LDSCTL_OFF);
    for (int u = threadIdx.x; u < (LDS_BYTES - LDSCTL_OFF) / 4; u += NTHREADS) ((LAS unsigned*)(L + LDSCTL_OFF))[u] = 0u;
    __syncthreads();
    XcdBarrier bar = xcd_barrier_post(a.bar, MISC + 8);
    const int wv = __builtin_amdgcn_readfirstlane((int)threadIdx.x >> 6);
#define PHASE(P, l) do { run_phase<P>(l, L, wv); xcd_barrier(bar, wv == 0 && lane_id_v() == 0); } while (0)
    PHASE(0, 0);
#define LAYER(l) PHASE(2, l); PHASE(3, l); PHASE(4, l); PHASE(5, l); PHASE(10, l); PHASE(11, l); PHASE(12, l); PHASE(13, l)
#define LAYER0 PHASE(3, 0); PHASE(4, 0); PHASE(5, 0); PHASE(10, 0); PHASE(11, 0); PHASE(12, 0); PHASE(13, 0)
    LAYER0; LAYER(1);
#undef LAYER
    run_phase<14>(0, L, wv);
#undef PHASE
}
#else
template <int P> __global__ void __launch_bounds__(NTHREADS, 2) k_phase(Args a) {
    extern __shared__ __attribute__((aligned(16))) unsigned char lds[];
    run_phase<P>(a.lo, (LAS unsigned char*)lds, __builtin_amdgcn_readfirstlane((int)threadIdx.x >> 6));
}
template <int P> static void launch_phase(const Args& a, int grid, hipStream_t stream) {
    static bool attr = false;
    if (!attr) { (void)hipFuncSetAttribute((const void*)k_phase<P>, hipFuncAttributeMaxDynamicSharedMemorySize, LDS_BYTES); attr = true; }
    hipLaunchKernelGGL(k_phase<P>, dim3(grid), dim3(NTHREADS), LDS_BYTES, stream, a);
}
#endif

extern "C" void kernel_launch(void* const* d_in, const int* in_sizes, int n_in, void* d_out, int out_size, void* d_ws, size_t ws_size, hipStream_t stream) {
    static int grid = 0;
    if (grid == 0) {
        if (n_in != 31 || in_sizes[0] != TP * DM || (size_t)out_size != O_END || ws_size < WS_END) { fprintf(stderr, "kernel_launch: shape mismatch (n_in %d in0 %d out %d ws %zu need %zu)\n", n_in, n_in > 0 ? in_sizes[0] : -1, out_size, ws_size, (size_t)WS_END); grid = -1; return; }
        int dev = 0, cus = 0;
        if (hipGetDevice(&dev) != hipSuccess || hipDeviceGetAttribute(&cus, hipDeviceAttributeMultiprocessorCount, dev) != hipSuccess) { grid = -1; return; }
#if N_LAUNCH_MODE == 1
        int per_cu = 0;
        if (hipFuncSetAttribute((const void*)fwd_kernel, hipFuncAttributeMaxDynamicSharedMemorySize, LDS_BYTES) != hipSuccess) { fprintf(stderr, "kernel_launch: hipFuncSetAttribute failed\n"); grid = -1; return; }
        if (hipOccupancyMaxActiveBlocksPerMultiprocessor(&per_cu, (const void*)fwd_kernel, NTHREADS, LDS_BYTES) != hipSuccess || per_cu < 1) fprintf(stderr, "kernel_launch: occupancy query reports %d\n", per_cu);
        (void)hipGetLastError();
#endif
        grid = cus;
    }
    if (grid < 0) return;
    if (hipMemsetAsync((char*)d_ws + WS_CTL, 0, CTL_BYTES, stream) != hipSuccess) return;
    Args a{};
    Ctx& c = a.c;
    const float** fp[] = {&c.x_prompt, &c.x_sample, &c.cache_nsa, &c.cache_win, &c.st_conv, &c.st_dn, &c.st_s5re, &c.st_s5im, nullptr, &c.ln1, &c.ln2, &c.ln_f, &c.w_in, &c.w_out, &c.wck, &c.wcv, &c.conv_w, &c.a_log, &c.dt_bias,
                          &c.dn_norm_w, &c.lam_re, &c.lam_im, &c.log_step, &c.b_re, &c.b_im, &c.c_re, &c.c_im, &c.s5_d, &c.w_glu, &c.mlp_up, &c.mlp_down};
    for (int i = 0; i < 31; ++i) { if (i == 8) c.page_table = (const int*)d_in[i]; else *fp[i] = (const float*)d_in[i]; }
    c.out = (float*)d_out;
    char* w = (char*)d_ws;
    c.X = (float*)(w + WS_X); c.SSQ = (float*)(w + WS_SSQ); c.XN = (bf16_t*)(w + WS_XN); c.PROJ = (float*)(w + WS_PROJ); c.MIXB = (bf16_t*)(w + WS_MIXB); c.UPB = (bf16_t*)(w + WS_UPB);
    c.WIN_T = (bf16_t*)(w + WS_WIN); c.WOUT_T = (bf16_t*)(w + WS_WOUT); c.WUP_T = (bf16_t*)(w + WS_WUP); c.WDN_T = (bf16_t*)(w + WS_WDN);
    c.KC = (float*)(w + WS_KC); c.VC = (float*)(w + WS_VC); c.PC = (float*)(w + WS_PC); c.OC = (float*)(w + WS_OC); c.IDX = (int*)(w + WS_IDX);
    c.QN = (float*)(w + WS_QN); c.KN = (float*)(w + WS_KN); c.VV = (float*)(w + WS_VV); c.GG = (float*)(w + WS_GG); c.BETA = (float*)(w + WS_BETA);
    c.GC = (float*)(w + WS_GC); c.AM = (float*)(w + WS_AM); c.AQK = (float*)(w + WS_AQK); c.SOL = (float*)(w + WS_SOL); c.VNEW = (float*)(w + WS_VNEW); c.SDN = (float*)(w + WS_SDN); c.ODN = (float*)(w + WS_ODN);
    c.S5K = (float*)(w + WS_S5K); c.S5BB = (float*)(w + WS_S5BB); c.S5E = (float*)(w + WS_S5E); c.S5HIN = (float*)(w + WS_S5HIN); c.S5HS = (float*)(w + WS_S5HS); c.GL = (float*)(w + WS_GL); c.GLB = (bf16_t*)(w + WS_GLB); c.WGLU_T = (bf16_t*)(w + WS_WGLU); c.QCTR = (unsigned*)(w + WS_CTL) + 8192; c.PART = (float*)(w + WS_PART); c.DNF = (bf16_t*)(w + WS_DNF); c.DNU = (float*)(w + WS_DNU); c.DNE = (float*)(w + WS_DNE); c.DNG = (bf16_t*)(w + WS_DNG); c.S5BF = (bf16_t*)(w + WS_S5BF); c.S5CF = (bf16_t*)(w + WS_S5CF);
    a.bar = (unsigned*)(w + WS_CTL) + 1024;
#if N_LAUNCH_MODE == 1
    a.lo = 0; a.hi = NPH;
    hipLaunchKernelGGL(fwd_kernel, dim3(grid), dim3(NTHREADS), LDS_BYTES, stream, a);
#else
    a.hi = 0; a.lo = 0; launch_phase<0>(a, grid, stream);
    for (int l = 0; l < 2; ++l) { a.lo = l;
        launch_phase<1>(a, grid, stream); launch_phase<2>(a, grid, stream); launch_phase<3>(a, grid, stream); launch_phase<4>(a, grid, stream); launch_phase<5>(a, grid, stream);
        launch_phase<6>(a, grid, stream); launch_phase<7>(a, grid, stream); launch_phase<8>(a, grid, stream); launch_phase<9>(a, grid, stream); launch_phase<10>(a, grid, stream);
        launch_phase<1>(a, grid, stream); launch_phase<11>(a, grid, stream); launch_phase<12>(a, grid, stream); launch_phase<13>(a, grid, stream); }
    a.lo = 0; launch_phase<1>(a, grid, stream); launch_phase<14>(a, grid, stream);
#endif
}
```

```cpp
#include <hip/hip_runtime.h>
#include <cstdio>
#include <cstdint>
#define N_LAUNCH_MODE 1
#define HD __device__ __forceinline__
#ifndef CFG_SEQ
#define CFG_SEQ 8192
#endif
#ifndef CFG_BATCH
#define CFG_BATCH 2
#endif
#ifndef CFG_DB
#define CFG_DB 128
#endif
constexpr int DM = 1024, SEQ = CFG_SEQ, BATCH = CFG_BATCH, DB = CFG_DB, DSEQ = 8, PAST = 2048, PAGE = 128, NPAGES = PAST / PAGE;
constexpr int NUSED = DB * NPAGES, NPHYS = NUSED + (NUSED + 3) / 4;
constexpr int HD_ = 64, NH = 8, NG = 2, NR = 4, NBLK = 64, TOPK = 16, WIN = 512, W0S = PAST - WIN;
constexpr int DNH = 4, DNW = 256, CONVD = 768, S5G = 16, S5P = 64, S5C = 16, DFF = 4096, INW = 2592;
constexpr int TP = BATCH * SEQ, TS = DB * DSEQ, TT = TP + TS;
constexpr int PLD = 2816;
constexpr int C_Q = 0, C_KV = 512, C_GATE = 1280, C_DNQKV = 1304, C_DNA = 2072, C_DNB = 2076, C_DNZ = 2080, C_S5U = 2336;
constexpr int NBP = SEQ / NBLK;
constexpr int NBS_S = 33, NBC_S = 32;
constexpr int NBMAX = (NBP > 64 ? NBP : 64);
constexpr int NSEQ = BATCH + DB;
constexpr int NCH = SEQ / 64;
constexpr int NDU = BATCH * DNH * NCH;
constexpr float NEPS = 1e-6f;
static_assert(NBMAX <= 128, "selection bitmask is 128 bits");

constexpr size_t O_YP = 0, O_YS = O_YP + (size_t)TP * DM, O_KVP = O_YS + (size_t)TS * DM, O_KVS = O_KVP + (size_t)2 * TP * 512,
    O_WINP = O_KVS + (size_t)2 * TS * 512, O_WINS = O_WINP + (size_t)2 * BATCH * 512 * 256, O_CONVP = O_WINS + (size_t)2 * DB * 512 * 256,
    O_CONVS = O_CONVP + (size_t)2 * BATCH * 3 * CONVD, O_DNP = O_CONVS + (size_t)2 * DB * 3 * CONVD, O_DNS = O_DNP + (size_t)2 * BATCH * DNH * 4096,
    O_S5RP = O_DNS + (size_t)2 * DB * DNH * 4096, O_S5RS = O_S5RP + (size_t)2 * BATCH * 1024, O_S5IP = O_S5RS + (size_t)2 * DB * 1024,
    O_S5IS = O_S5IP + (size_t)2 * BATCH * 1024, O_END = O_S5IS + (size_t)2 * DB * 1024;

#ifdef HOST_EMU
typedef float bf16_t;
HD bf16_t tobf(float f) { return f; }
HD float frombf(bf16_t b) { return b; }
#else
typedef unsigned short bf16_t;
HD bf16_t tobf(float f) { unsigned u = __float_as_uint(f); u += 0x7fffu + ((u >> 16) & 1u); return (bf16_t)(u >> 16); }
HD float frombf(bf16_t b) { return __uint_as_float(((unsigned)b) << 16); }
#endif

struct Ctx {
    const float *x_prompt, *x_sample, *cache_nsa, *cache_win, *st_conv, *st_dn, *st_s5re, *st_s5im; const int* page_table;
    const float *ln1, *ln2, *ln_f, *w_in, *w_out, *wck, *wcv, *conv_w, *a_log, *dt_bias, *dn_norm_w, *lam_re, *lam_im, *log_step,
        *b_re, *b_im, *c_re, *c_im, *s5_d, *w_glu, *mlp_up, *mlp_down;
    float* out;
    float* X;
    float* SSQ;
    bf16_t* XN;
    float* PROJ;
    bf16_t* MIXB;
    bf16_t* UPB;
    bf16_t *WIN_T, *WOUT_T, *WUP_T, *WDN_T;
    float *KC, *VC;
    float* PC;
    float* OC;
    int* IDX;
    float *QN, *KN, *VV;
    float *GG, *BETA;
    float* GC;
    float* AM;
    float* AQK;
    float* SOL;
    float* VNEW;
    float* SDN;
    float* ODN;
    float* S5K;
    float* S5BB;
    float* S5E;
    float* S5HIN;
    float* S5HS;
    float* GL;
    bf16_t* GLB;
    bf16_t* WGLU_T;
    unsigned* QCTR;
    bf16_t* DNF;
    float* DNU;
    float* DNE;
    bf16_t* DNG;
    bf16_t* S5BF;
    bf16_t* S5CF;
    float* PART;
};

HD float sigmoidf_(float x) { return 1.0f / (1.0f + expf(-x)); }
HD float siluf_(float x) { return x * sigmoidf_(x); }
HD float softplusf_(float x) { return (x > 0.f ? x : 0.f) + log1pf(expf(-fabsf(x))); }
HD float geluf_(float x) { return 0.5f * x * (1.0f + tanhf(0.7978845608028654f * (x + 0.044715f * x * x * x))); }

#ifdef HOST_EMU
typedef const Ctx& CREF;
#else
typedef const __attribute__((address_space(4))) Ctx& CREF;
#endif
struct Tok { int smp, b, j, t, seq; };
HD Tok tok_of(int r) { Tok k; if (r < TP) { k.smp = 0; k.b = r / SEQ; k.j = r % SEQ; k.t = k.j; k.seq = k.b; } else { r -= TP; k.smp = 1; k.b = r / DSEQ; k.j = r % DSEQ; k.t = PAST + k.j; k.seq = BATCH + k.b; } return k; }

HD const float* kv_ptr(CREF c, int l, int smp, int b, int pos, int slot, int g) {
    if (!smp) return c.PROJ + (size_t)(b * SEQ + pos) * PLD + C_KV + slot * 128 + g * 64;
    if (pos >= PAST) return c.PROJ + (size_t)(TP + b * DSEQ + (pos - PAST)) * PLD + C_KV + slot * 128 + g * 64;
    if (slot < 4) { const int pg = c.page_table[b * NPAGES + pos / PAGE]; return c.cache_nsa + ((((size_t)l * NPHYS + pg) * PAGE + (pos % PAGE)) * 4 + slot) * 128 + g * 64; }
    return c.cache_win + ((((size_t)l * DB + b) * WIN + (pos - W0S)) * 2 + (slot - 4)) * 128 + g * 64;
}

HD void ph_prologue(CREF c, long gtid, long gn) {
    for (long i = gtid; i < (long)2 * PLD * DM; i += gn) { const int l = (int)(i / ((long)PLD * DM)); const long r = i % ((long)PLD * DM); const int n = (int)(r / DM), k = (int)(r % DM);
        c.WIN_T[i] = tobf(n < INW ? c.w_in[((size_t)l * DM + k) * INW + n] : 0.f); }
    for (long i = gtid; i < (long)2 * DM * DM; i += gn) { const int l = (int)(i / ((long)DM * DM)); const long r = i % ((long)DM * DM); const int n = (int)(r / DM), k = (int)(r % DM);
        c.WOUT_T[i] = tobf(c.w_out[((size_t)l * DM + k) * DM + n]); }
    for (long i = gtid; i < (long)2 * DFF * DM; i += gn) { const int l = (int)(i / ((long)DFF * DM)); const long r = i % ((long)DFF * DM); const int n = (int)(r / DM), k = (int)(r % DM);
        c.WUP_T[i] = tobf(c.mlp_up[((size_t)l * DM + k) * DFF + n]); }
    for (long i = gtid; i < (long)2 * DM * DFF; i += gn) { const int l = (int)(i / ((long)DM * DFF)); const long r = i % ((long)DM * DFF); const int n = (int)(r / DFF), k = (int)(r % DFF);
        c.WDN_T[i] = tobf(c.mlp_down[((size_t)l * DFF + k) * DM + n]); }
    for (long i = gtid; i < (long)TT * DM; i += gn) c.X[i] = i < (long)TP * DM ? c.x_prompt[i] : c.x_sample[i - (long)TP * DM];
}
HD void ph_s5_consts(CREF c, long gtid, long gn) {
    for (long i = gtid; i < 2 * S5G * S5P; i += gn) { const int l = (int)(i / (S5G * S5P)), g = (int)((i / S5P) % S5G);
        const double lr = c.lam_re[i], li = c.lam_im[i], dt = exp((double)c.log_step[l * S5G + g]);
        const double mag = exp(lr * dt), ar = mag * cos(li * dt), ai = mag * sin(li * dt), den = lr * lr + li * li;
        const double fr = ((ar - 1.0) * lr + ai * li) / den, fi = (ai * lr - (ar - 1.0) * li) / den;
        double pr = 1.0, pi = 0.0; for (int s = 0; s < 64; ++s) { const double nr = pr * ar - pi * ai, ni = pr * ai + pi * ar; pr = nr; pi = ni; }
        c.S5K[i * 4 + 0] = (float)ar; c.S5K[i * 4 + 1] = (float)ai; c.S5K[i * 4 + 2] = (float)pr; c.S5K[i * 4 + 3] = (float)pi;
        for (int ch = 0; ch < S5C; ++ch) { const double br = c.b_re[i * S5C + ch], bi = c.b_im[i * S5C + ch];
            c.S5BB[(i * S5C + ch) * 2 + 0] = (float)(fr * br - fi * bi); c.S5BB[(i * S5C + ch) * 2 + 1] = (float)(fr * bi + fi * br);
#ifndef HOST_EMU
            {
                const int p = (int)(i % S5P); const size_t lg = (size_t)(i / S5P);
#pragma unroll
                for (int comp = 0; comp < 2; ++comp) { const int s = 2 * p + comp, j = s >> 4, n = s & 15;
                    c.S5BF[((lg * 8 + j) * 64 + n + 16 * (ch >> 3)) * 8 + (ch & 7)] = tobf((float)(comp == 0 ? fr * br - fi * bi : fr * bi + fi * br));
                    if (ch < 8) { c.S5BF[((lg * 8 + j) * 64 + n + 32) * 8 + ch] = 0; c.S5BF[((lg * 8 + j) * 64 + n + 48) * 8 + ch] = 0; }
                    const int k = s, ks = k >> 5, kg = (k & 31) >> 3, jj = k & 7; const size_t ci = ((lg * S5C + ch) * S5P + p);
                    c.S5CF[((lg * 4 + ks) * 64 + ch + 16 * kg) * 8 + jj] = tobf(comp == 0 ? c.c_re[ci] : -c.c_im[ci]); } }
#endif
        } }
}

HD void ph_ssq(CREF c, long gtid, long gn) {
    for (long i = gtid; i < (long)TT * 64; i += gn) { const float* p = c.X + i * 16; float s = 0.f; for (int k = 0; k < 16; ++k) s += p[k] * p[k]; c.SSQ[i] = s; }
}
HD float row_rstd(CREF c, int r) { const float* p = c.SSQ + (size_t)r * 64; float s = 0.f; for (int k = 0; k < 64; ++k) s += p[k]; return 1.0f / sqrtf(s * (1.0f / DM) + NEPS); }
HD void ph_norm(CREF c, const float* gain, long gtid, long gn) {
    for (long i = gtid; i < (long)TT * (DM / 4); i += gn) { const int r = (int)(i / (DM / 4)), c4 = (int)(i % (DM / 4)) * 4; const float rs = row_rstd(c, r);
        for (int k = 0; k < 4; ++k) c.XN[(size_t)r * DM + c4 + k] = tobf(c.X[(size_t)r * DM + c4 + k] * rs * gain[c4 + k]); }
}
HD void ph_final(CREF c, long gtid, long gn) {
    for (long i = gtid; i < (long)TT * (DM / 4); i += gn) { const int r = (int)(i / (DM / 4)), c4 = (int)(i % (DM / 4)) * 4; const float rs = row_rstd(c, r);
        for (int k = 0; k < 4; ++k) c.out[O_YP + (size_t)r * DM + c4 + k] = c.X[(size_t)r * DM + c4 + k] * rs * c.ln_f[c4 + k]; }
}

HD void ph_copy_out(CREF c, int l, long gtid, long gn) {
    for (long i = gtid; i < (long)TT * 512; i += gn) { const int r = (int)(i / 512), k = (int)(i % 512); const float v = c.PROJ[(size_t)r * PLD + C_KV + k];
        if (r < TP) c.out[O_KVP + ((size_t)l * TP + r) * 512 + k] = v; else c.out[O_KVS + ((size_t)l * TS + (r - TP)) * 512 + k] = v; }
    for (long i = gtid; i < (long)BATCH * 512 * 256; i += gn) { const int b = (int)(i / (512 * 256)), w = (int)((i / 256) % 512), k = (int)(i % 256);
        c.out[O_WINP + (size_t)l * BATCH * 512 * 256 + i] = c.PROJ[(size_t)(b * SEQ + SEQ - 512 + w) * PLD + C_KV + 512 + k]; }
    for (long i = gtid; i < (long)DB * 512 * 256; i += gn) { const int b = (int)(i / (512 * 256)), w = (int)((i / 256) % 512), k = (int)(i % 256);
        c.out[O_WINS + (size_t)l * DB * 512 * 256 + i] = (w < 512 - DSEQ) ? c.cache_win[(((size_t)l * DB + b) * 512 + w + DSEQ) * 256 + k]
                                                                          : c.PROJ[(size_t)(TP + b * DSEQ + (w - (512 - DSEQ))) * PLD + C_KV + 512 + k]; }
    for (long i = gtid; i < (long)BATCH * 3 * CONVD; i += gn) { const int b = (int)(i / (3 * CONVD)), w = (int)((i / CONVD) % 3), k = (int)(i % CONVD);
        c.out[O_CONVP + (size_t)l * BATCH * 3 * CONVD + i] = c.PROJ[(size_t)(b * SEQ + SEQ - 3 + w) * PLD + C_DNQKV + k]; }
    for (long i = gtid; i < (long)DB * 3 * CONVD; i += gn) { const int b = (int)(i / (3 * CONVD)), w = (int)((i / CONVD) % 3), k = (int)(i % CONVD);
        c.out[O_CONVS + (size_t)l * DB * 3 * CONVD + i] = c.PROJ[(size_t)(TP + b * DSEQ + DSEQ - 3 + w) * PLD + C_DNQKV + k]; }
}
HD float dn_x(CREF c, int l, const Tok& k, int r, int back, int ch) {
    const int jj = k.j - back;
    if (jj >= 0) return c.PROJ[(size_t)(r - back) * PLD + C_DNQKV + ch];
    if (!k.smp) return 0.f;
    return c.st_conv[(((size_t)l * DB + k.b) * 3 + (3 + jj)) * CONVD + ch];
}
HD float dn_conv1(CREF c, int l, const Tok& k, int r, int ch) {
    const float* w = c.conv_w + ((size_t)l * CONVD + ch) * 4; float y = 0.f;
    for (int j = 0; j < 4; ++j) y += w[j] * dn_x(c, l, k, r, 3 - j, ch);
    return siluf_(y);
}
HD void ph_dn_conv(CREF c, int l, long gtid, long gn, int rbeg = 0) {
    for (long i = gtid + (long)rbeg * 3 * DNH; i < (long)TT * 3 * DNH; i += gn) { const int r = (int)(i / (3 * DNH)), part = (int)((i / DNH) % 3), h = (int)(i % DNH); const Tok k = tok_of(r);
        const int ch0 = part * DNW + h * 64; float ss = 0.f;
        if (part < 2) for (int d = 0; d < 64; ++d) { const float y = dn_conv1(c, l, k, r, ch0 + d); ss += y * y; }
        const float sc = part == 0 ? 0.125f / sqrtf(ss + 1e-6f) : (part == 1 ? 1.0f / sqrtf(ss + 1e-6f) : 1.0f);
        float* dst = (part == 0 ? c.QN : (part == 1 ? c.KN : c.VV)) + ((size_t)r * DNH + h) * 64;
        for (int d = 0; d < 64; ++d) dst[d] = dn_conv1(c, l, k, r, ch0 + d) * sc; }
    for (long i = gtid + (long)rbeg * DNH; i < (long)TT * DNH; i += gn) { const int r = (int)(i / DNH), h = (int)(i % DNH);
        c.BETA[i] = sigmoidf_(c.PROJ[(size_t)r * PLD + C_DNB + h]);
        c.GG[i] = -expf(c.a_log[l * DNH + h]) * softplusf_(c.PROJ[(size_t)r * PLD + C_DNA + h] + c.dt_bias[l * DNH + h]); }
}
HD void ph_pool(CREF c, int l, long gtid, long gn) {
    for (long i = gtid; i < (long)NSEQ * NBMAX * 128; i += gn) { const int seq = (int)(i / (NBMAX * 128)), n = (int)((i / 128) % NBMAX), g = (int)((i / 64) % 2), d = (int)(i % 64);
        const int smp = seq >= BATCH, b = smp ? seq - BATCH : seq; if (n >= (smp ? NBC_S : NBP)) continue;
        float sk = 0.f, sv = 0.f;
        for (int j = 0; j < 64; ++j) { sk += c.wck[(l * 2 + g) * 64 + j] * kv_ptr(c, l, smp, b, n * 64 + j, 0, g)[d]; sv += c.wcv[(l * 2 + g) * 64 + j] * kv_ptr(c, l, smp, b, n * 64 + j, 1, g)[d]; }
        c.KC[i] = sk; c.VC[i] = sv; }
}
HD void s5_scan(CREF c, int l, int g, int p, int r0, int len, float& hr, float& hi, bool store) {
    const float* K = c.S5K + ((size_t)(l * S5G + g) * S5P + p) * 4; const float ar = K[0], ai = K[1];
    const float* bb = c.S5BB + ((size_t)(l * S5G + g) * S5P + p) * S5C * 2;
    for (int t = 0; t < len; ++t) { const float* u = c.PROJ + (size_t)(r0 + t) * PLD + C_S5U + g * S5C; float br = 0.f, bi = 0.f;
        for (int ch = 0; ch < S5C; ++ch) { br += bb[ch * 2] * u[ch]; bi += bb[ch * 2 + 1] * u[ch]; }
        const float nr = ar * hr - ai * hi + br, ni = ar * hi + ai * hr + bi; hr = nr; hi = ni;
        if (store) { float* hs = c.S5HS + (((size_t)(r0 + t) * S5G + g) * S5P + p) * 2; hs[0] = hr; hs[1] = hi; } }
}
HD void ph_s5_passA(CREF c, int l, long gtid, long gn) {
    for (long i = gtid; i < (long)BATCH * NCH * S5G * S5P; i += gn) { const int p = (int)(i % S5P), g = (int)((i / S5P) % S5G), ch = (int)((i / (S5P * S5G)) % NCH), b = (int)(i / ((long)S5P * S5G * NCH));
        float hr = 0.f, hi = 0.f; s5_scan(c, l, g, p, b * SEQ + ch * 64, 64, hr, hi, false); c.S5E[i * 2] = hr; c.S5E[i * 2 + 1] = hi; }
}
HD void ph_dn_gc(CREF c, long gtid, long gn) {
    for (long i = gtid; i < NDU; i += gn) { const int ch = (int)(i % NCH), h = (int)((i / NCH) % DNH), b = (int)(i / (NCH * DNH)); float s = 0.f;
        for (int t = 0; t < 64; ++t) { s += c.GG[(size_t)(b * SEQ + ch * 64 + t) * DNH + h]; c.GC[i * 64 + t] = s; } }
}
HD void ph_cmp(CREF c, int l, long gtid, long gn, int rbeg = 0) {
    for (long i = gtid + (long)rbeg * NH; i < (long)TT * NH; i += gn) { const int r = (int)(i / NH), h = (int)(i % NH), g = h / NR; const Tok k = tok_of(r);
        const float slope = exp2f(-(float)(h + 1)); const int nbv = (k.t + 1) / 64;
        const float* q = c.PROJ + (size_t)r * PLD + C_Q + h * 64; float* pc = c.PC + (size_t)i * NBMAX; float* oc = c.OC + (size_t)i * 64;
        float m = -1e30f;
        for (int n = 0; n < nbv; ++n) { const float* kc = c.KC + (((size_t)k.seq * NBMAX + n) * 2 + g) * 64; float s = 0.f; for (int d = 0; d < 64; ++d) s += q[d] * kc[d];
            s = s * 0.125f - slope * ((float)k.t - ((float)(n * 64) + 31.5f)); pc[n] = s; m = s > m ? s : m; }
        float sum = 0.f; for (int n = 0; n < nbv; ++n) { const float e = expf(pc[n] - m); pc[n] = e; sum += e; }
        const float inv = 1.0f / (sum > 1e-30f ? sum : 1e-30f);
        for (int d = 0; d < 64; ++d) oc[d] = 0.f;
        for (int n = 0; n < nbv; ++n) { const float p = pc[n] * inv; pc[n] = p; const float* vc = c.VC + (((size_t)k.seq * NBMAX + n) * 2 + g) * 64; for (int d = 0; d < 64; ++d) oc[d] += p * vc[d]; }
        for (int n = nbv; n < NBMAX; ++n) pc[n] = 0.f; }
}
HD void ph_s5_carry(CREF c, int l, long gtid, long gn) {
    for (long i = gtid; i < (long)BATCH * S5G * S5P; i += gn) { const int p = (int)(i % S5P), g = (int)((i / S5P) % S5G), b = (int)(i / (S5P * S5G));
        const float* K = c.S5K + ((size_t)(l * S5G + g) * S5P + p) * 4; const float a64r = K[2], a64i = K[3]; float hr = 0.f, hi = 0.f;
        for (int ch = 0; ch < NCH; ++ch) { const size_t e = ((((size_t)b * NCH + ch) * S5G + g) * S5P + p) * 2; c.S5HIN[e] = hr; c.S5HIN[e + 1] = hi;
            const float nr = a64r * hr - a64i * hi + c.S5E[e], ni = a64r * hi + a64i * hr + c.S5E[e + 1]; hr = nr; hi = ni; }
        c.out[O_S5RP + ((size_t)l * BATCH + b) * 1024 + g * S5P + p] = hr; c.out[O_S5IP + ((size_t)l * BATCH + b) * 1024 + g * S5P + p] = hi; }
}
HD void ph_dn_mats(CREF c, long gtid, long gn) {
    for (long i = gtid; i < (long)NDU * 4096; i += gn) { const int u = (int)(i / 4096), ii = (int)((i / 64) % 64), jj = (int)(i % 64);
        const int ch = u % NCH, h = (u / NCH) % DNH, b = u / (NCH * DNH); const int r0 = b * SEQ + ch * 64;
        float am = 0.f, aq = 0.f;
        if (jj <= ii) { const float* ki = c.KN + ((size_t)(r0 + ii) * DNH + h) * 64; const float* kj = c.KN + ((size_t)(r0 + jj) * DNH + h) * 64; const float* qi = c.QN + ((size_t)(r0 + ii) * DNH + h) * 64;
            float kk = 0.f, qk = 0.f; for (int d = 0; d < 64; ++d) { kk += ki[d] * kj[d]; qk += qi[d] * kj[d]; }
            const float dec = expf(c.GC[(size_t)u * 64 + ii] - c.GC[(size_t)u * 64 + jj]);
            aq = qk * dec; if (jj < ii) am = c.BETA[(size_t)(r0 + ii) * DNH + h] * kk * dec; }
        c.AM[i] = am; c.AQK[i] = aq; }
    for (long i = gtid; i < (long)NDU * 64 * 128; i += gn) { const int u = (int)(i / 8192), ii = (int)((i / 128) % 64), col = (int)(i % 128);
        const int ch = u % NCH, h = (u / NCH) % DNH, b = u / (NCH * DNH); const int r = b * SEQ + ch * 64 + ii; const float be = c.BETA[(size_t)r * DNH + h];
        c.SOL[i] = col < 64 ? c.VV[((size_t)r * DNH + h) * 64 + col] * be : c.KN[((size_t)r * DNH + h) * 64 + (col - 64)] * be * expf(c.GC[(size_t)u * 64 + ii]); }
}
HD void ph_topk(CREF c, long gtid, long gn, int rbeg = 0) {
    for (long i = gtid + (long)rbeg * NG; i < (long)TT * NG; i += gn) { const int r = (int)(i / NG), g = (int)(i % NG); const Tok k = tok_of(r);
        const int cur = k.t / 64, nbs = k.smp ? NBS_S : NBP; const float* pc = c.PC + ((size_t)r * NH + g * NR) * NBMAX;
        unsigned long long tk0 = 0ull, tk1 = 0ull; int* idx = c.IDX + (size_t)i * TOPK;
        const int nsel = nbs < TOPK ? nbs : TOPK;
        for (int s = 0; s < TOPK; ++s) { int best = -1; float bv = 0.f;
            if (s < nsel) for (int n = 0; n < nbs; ++n) { const bool taken = n < 64 ? ((tk0 >> n) & 1ull) : ((tk1 >> (n - 64)) & 1ull); if (taken) continue;
                float sc; if (n > cur) sc = -1e9f; else if (n == 0 || n == cur || n == cur - 1) sc = 1e9f; else sc = (pc[n] + pc[NBMAX + n]) + (pc[2 * NBMAX + n] + pc[3 * NBMAX + n]);
                if (best < 0 || sc > bv) { best = n; bv = sc; } }
            if (best >= 0) { if (best < 64) tk0 |= 1ull << best; else tk1 |= 1ull << (best - 64); }
            idx[s] = (best >= 0 && best <= cur) ? best : -1; } }
}
HD void ph_s5_passB(CREF c, int l, long gtid, long gn) {
    for (long i = gtid; i < (long)BATCH * NCH * S5G * S5P; i += gn) { const int p = (int)(i % S5P), g = (int)((i / S5P) % S5G), ch = (int)((i / (S5P * S5G)) % NCH), b = (int)(i / ((long)S5P * S5G * NCH));
        float hr = c.S5HIN[i * 2], hi = c.S5HIN[i * 2 + 1]; s5_scan(c, l, g, p, b * SEQ + ch * 64, 64, hr, hi, true); }
    for (long i = gtid; i < (long)DB * S5G * S5P; i += gn) { const int p = (int)(i % S5P), g = (int)((i / S5P) % S5G), b = (int)(i / (S5P * S5G));
        float hr = c.st_s5re[(size_t)l * DB * 1024 + i], hi = c.st_s5im[(size_t)l * DB * 1024 + i]; s5_scan(c, l, g, p, TP + b * DSEQ, DSEQ, hr, hi, true);
        c.out[O_S5RS + (size_t)l * DB * 1024 + i] = hr; c.out[O_S5IS + (size_t)l * DB * 1024 + i] = hi; }
}
HD void ph_dn_solve(CREF c, long gtid, long gn) {
    for (long i = gtid; i < (long)NDU * 128; i += gn) { const int u = (int)(i / 128), col = (int)(i % 128); float* x = c.SOL + (size_t)u * 8192 + col; const float* A = c.AM + (size_t)u * 4096;
        for (int ii = 1; ii < 64; ++ii) { float s = x[ii * 128]; for (int jj = 0; jj < ii; ++jj) s -= A[ii * 64 + jj] * x[jj * 128]; x[ii * 128] = s; } }
}
HD void ph_attn(CREF c, int l, long gtid, long gn, int rbeg = 0) {
    for (long i = gtid + (long)rbeg * NH; i < (long)TT * NH; i += gn) { const int r = (int)(i / NH), h = (int)(i % NH), g = h / NR; const Tok k = tok_of(r);
        const float slope = exp2f(-(float)(h + 1));
        float q[64];
#pragma unroll
        for (int d = 0; d < 64; ++d) q[d] = c.PROJ[(size_t)r * PLD + C_Q + h * 64 + d] * 0.125f;
        const float* gp = c.PROJ + (size_t)r * PLD + C_GATE + h * 3; const float g0 = sigmoidf_(gp[0]), g1 = sigmoidf_(gp[1]), g2 = sigmoidf_(gp[2]);
        float* oc = c.OC + (size_t)i * 64;
        float o[64]; float m = -1e30f, lsum = 0.f;
#pragma unroll
        for (int d = 0; d < 64; ++d) o[d] = 0.f;
        const int* idx = c.IDX + ((size_t)r * NG + g) * TOPK;
        for (int s = 0; s < TOPK; ++s) { const int n = idx[s]; if (n < 0) continue;
            for (int j = 0; j < 64; ++j) { const int pos = n * 64 + j; if (pos > k.t) break;
                const float* kp = kv_ptr(c, l, k.smp, k.b, pos, 2, g); const float* vp = kv_ptr(c, l, k.smp, k.b, pos, 3, g);
                float sc = 0.f;
#pragma unroll
                for (int d = 0; d < 64; ++d) sc += q[d] * kp[d];
                sc -= slope * (float)(k.t - pos);
                const float mn = sc > m ? sc : m, al = expf(m - mn), p = expf(sc - mn); m = mn; lsum = lsum * al + p;
#pragma unroll
                for (int d = 0; d < 64; ++d) o[d] = o[d] * al + p * vp[d]; } }
        { const float inv = g1 / (lsum > 1e-30f ? lsum : 1e-30f);
#pragma unroll
          for (int d = 0; d < 64; ++d) oc[d] = g0 * oc[d] + inv * o[d]; }
        m = -1e30f; lsum = 0.f;
#pragma unroll
        for (int d = 0; d < 64; ++d) o[d] = 0.f;
        const int w0 = k.smp ? W0S : 0; int p0 = k.t - (WIN - 1); if (p0 < w0) p0 = w0;
        for (int pos = p0; pos <= k.t; ++pos) { const float* kp = kv_ptr(c, l, k.smp, k.b, pos, 4, g); const float* vp = kv_ptr(c, l, k.smp, k.b, pos, 5, g);
            float sc = 0.f;
#pragma unroll
            for (int d = 0; d < 64; ++d) sc += q[d] * kp[d];
            sc -= slope * (float)(k.t - pos);
            const float mn = sc > m ? sc : m, al = expf(m - mn), p = expf(sc - mn); m = mn; lsum = lsum * al + p;
#pragma unroll
            for (int d = 0; d < 64; ++d) o[d] = o[d] * al + p * vp[d]; }
        { const float inv = g2 / (lsum > 1e-30f ? lsum : 1e-30f);
#pragma unroll
          for (int d = 0; d < 64; ++d) c.MIXB[(size_t)r * DM + h * 64 + d] = tobf(oc[d] + inv * o[d]); } }
}
HD void ph_s5_y(CREF c, int l, long gtid, long gn) {
    for (long i = gtid; i < (long)TT * 256; i += gn) { const int r = (int)(i / 256), ch = (int)(i % 256), g = ch / S5C, cc = ch % S5C;
        const float* cr = c.c_re + (((size_t)l * S5G + g) * S5C + cc) * S5P; const float* ci = c.c_im + (((size_t)l * S5G + g) * S5C + cc) * S5P;
        const float* hs = c.S5HS + ((size_t)r * S5G + g) * S5P * 2; float y = 0.f;
        for (int p = 0; p < S5P; ++p) y += cr[p] * hs[2 * p] - ci[p] * hs[2 * p + 1];
        y += c.s5_d[l * 256 + ch] * c.PROJ[(size_t)r * PLD + C_S5U + ch]; c.GL[i] = geluf_(y); }
}
HD void ph_dn_scan_prompt(CREF c, int l, long gtid, long gn) {
    for (long i = gtid; i < (long)BATCH * DNH * 64; i += gn) { const int jc = (int)(i % 64), h = (int)((i / 64) % DNH), b = (int)(i / (64 * DNH));
        float S[64];
#pragma unroll
        for (int kk = 0; kk < 64; ++kk) S[kk] = 0.f;
        float* vn = c.VNEW + (size_t)(b * DNH + h) * 4096 + jc;
        for (int ch = 0; ch < NCH; ++ch) { const int u = (b * DNH + h) * NCH + ch; const int r0 = b * SEQ + ch * 64;
            const float* sol = c.SOL + (size_t)u * 8192; const float* gc = c.GC + (size_t)u * 64; const float* aqk = c.AQK + (size_t)u * 4096;
            for (int t = 0; t < 64; ++t) { const float* w = sol + t * 128 + 64; float s = sol[t * 128 + jc];
#pragma unroll
                for (int kk = 0; kk < 64; ++kk) s -= w[kk] * S[kk];
                vn[t * 64] = s; }
            for (int t = 0; t < 64; ++t) { const float* qq = c.QN + ((size_t)(r0 + t) * DNH + h) * 64; float s = 0.f;
#pragma unroll
                for (int kk = 0; kk < 64; ++kk) s += qq[kk] * S[kk];
                s *= expf(gc[t]);
                for (int t2 = 0; t2 <= t; ++t2) s += aqk[t * 64 + t2] * vn[t2 * 64];
                c.ODN[((size_t)(r0 + t) * DNH + h) * 64 + jc] = s; }
            const float gl = gc[63], eg = expf(gl);
#pragma unroll
            for (int kk = 0; kk < 64; ++kk) S[kk] *= eg;
            for (int t = 0; t < 64; ++t) { const float* kk_ = c.KN + ((size_t)(r0 + t) * DNH + h) * 64; const float f = expf(gl - gc[t]) * vn[t * 64];
#pragma unroll
                for (int kk = 0; kk < 64; ++kk) S[kk] += kk_[kk] * f; } }
#pragma unroll
        for (int kk = 0; kk < 64; ++kk) c.out[O_DNP + (((size_t)l * BATCH + b) * DNH + h) * 4096 + kk * 64 + jc] = S[kk]; }
}
HD void ph_dn_scan_sample(CREF c, int l, long gtid, long gn) {
    for (long i = gtid; i < (long)DB * DNH * 64; i += gn) { const int jc = (int)(i % 64), h = (int)((i / 64) % DNH), b = (int)(i / (64 * DNH));
        float S[64]; const float* s0 = c.st_dn + (((size_t)l * DB + b) * DNH + h) * 4096 + jc;
#pragma unroll
        for (int kk = 0; kk < 64; ++kk) S[kk] = s0[kk * 64];
        for (int t = 0; t < DSEQ; ++t) { const int r = TP + b * DSEQ + t; const float* kv = c.KN + ((size_t)r * DNH + h) * 64; const float* qq = c.QN + ((size_t)r * DNH + h) * 64;
            const float a = expf(c.GG[(size_t)r * DNH + h]), be = c.BETA[(size_t)r * DNH + h]; float ks = 0.f;
#pragma unroll
            for (int kk = 0; kk < 64; ++kk) { S[kk] *= a; ks += kv[kk] * S[kk]; }
            const float vnw = be * (c.VV[((size_t)r * DNH + h) * 64 + jc] - ks); float os = 0.f;
#pragma unroll
            for (int kk = 0; kk < 64; ++kk) { S[kk] += kv[kk] * vnw; os += qq[kk] * S[kk]; }
            c.ODN[((size_t)r * DNH + h) * 64 + jc] = os; }
#pragma unroll
        for (int kk = 0; kk < 64; ++kk) c.out[O_DNS + (((size_t)l * DB + b) * DNH + h) * 4096 + kk * 64 + jc] = S[kk]; }
}
HD void ph_s5_glu(CREF c, int l, long gtid, long gn) {
    for (long i = gtid; i < (long)TT * 256; i += gn) { const int r = (int)(i / 256), ch = (int)(i % 256); const float* gl = c.GL + (size_t)r * 256; const float* w = c.w_glu + (size_t)l * 65536 + ch; float z = 0.f;
        for (int kk = 0; kk < 256; ++kk) z += gl[kk] * w[kk * 256];
        c.MIXB[(size_t)r * DM + 768 + ch] = tobf(gl[ch] * sigmoidf_(z)); }
}
HD void ph_dn_out(CREF c, int l, long gtid, long gn) {
    for (long i = gtid; i < (long)TT * DNH; i += gn) { const int r = (int)(i / DNH), h = (int)(i % DNH); const float* o = c.ODN + (size_t)i * 64; float ss = 0.f;
        for (int d = 0; d < 64; ++d) ss += o[d] * o[d];
        const float rs = 1.0f / sqrtf(ss * (1.0f / 64.0f) + NEPS);
        for (int d = 0; d < 64; ++d) c.MIXB[(size_t)r * DM + 512 + h * 64 + d] = tobf(o[d] * rs * c.dn_norm_w[l * 64 + d] * siluf_(c.PROJ[(size_t)r * PLD + C_DNZ + h * 64 + d])); }
}
namespace pg8 {
#define PG8_LAS __attribute__((address_space(3)))
typedef unsigned short bf16_t;
typedef short bf16x8 __attribute__((ext_vector_type(8)));
typedef float f32x4 __attribute__((ext_vector_type(4)));
typedef unsigned u32x4 __attribute__((ext_vector_type(4)));
constexpr int BM = 256, BK = 64, HALF = 128, HTB = HALF * BK * 2  , STAGE_BYTES = 8 * HTB, NXCD = 8, WGM = 8;

__host__ __device__ __forceinline__ int lds_byte(int r, int c) { const int st = (r >> 4) * 2 + (c >> 5), rr = r & 15, cc = c & 31, ob = rr * 64 + cc * 2; return st * 1024 + (ob ^ (((ob >> 9) & 1) << 5)); }
__host__ __device__ __forceinline__ void stage_rc(int b, int& R, int& C) { const int st = b / 1024, sb = b % 1024, swz = sb ^ (((sb >> 9) & 1) << 5); R = (st >> 1) * 16 + swz / 64; C = (st & 1) * 32 + (swz % 64) / 2; }
__host__ __device__ __forceinline__ int perm32(int rho) { const int n = rho >> 4, i = rho & 15; return 8 * (i >> 2) + 4 * n + (i & 3); }

struct Unit { int pm, pn; };
struct Gemm { const bf16_t* A; const bf16_t* Bt; int M, N, K, ld; };

struct StaticOrder {
    int nM, nN, nwg, G, c;
    __host__ __device__ void init(int M, int N, int G_, int c_) { nM = M / BM; nN = N / BM; nwg = nM * nN; G = G_; c = c_; }
    __host__ __device__ bool next(int i, Unit& u) const {
        const long L = (long)i * G + c; if (L >= nwg) return false;
        int wgid = (int)L; { const int q = nwg / NXCD, r = nwg % NXCD, xcd = wgid % NXCD, off = wgid / NXCD; wgid = (xcd < r ? xcd * (q + 1) : r * (q + 1) + (xcd - r) * q) + off; }
        const int nig = WGM * nN, gid = wgid / nig, fm = gid * WGM, gsz = (nM - fm) < WGM ? (nM - fm) : WGM;
        u.pm = fm + ((wgid % nig) % gsz); u.pn = (wgid % nig) / gsz; return true;
    }
    __device__ __forceinline__ void a_ready(const Unit&) const {}
    __device__ __forceinline__ void done(const Unit&) const {}
};

__device__ __forceinline__ unsigned cvt_pk_bf16(float lo, float hi) { unsigned r; asm volatile("v_cvt_pk_bf16_f32 %0, %1, %2" : "=v"(r) : "v"(lo), "v"(hi)); return r; }
typedef float f32x2 __attribute__((ext_vector_type(2)));
template <class Epi, class Sched, bool ALIGN_EPI = false, bool SP2 = false>
__device__ __forceinline__ void gemm_phase(PG8_LAS unsigned char* lds, const Gemm g, const Sched& S, const Epi& E, int tid_) {
    asm volatile("" : "+v"(tid_));
    const int tid = tid_, wid = __builtin_amdgcn_readfirstlane(tid >> 6), lane = tid & 63, wr = wid >> 2, wc = wid & 3, fr = lane & 15, fq = lane >> 4;
    const int K = g.K, nt = K / BK;
    unsigned voffA[2], voffB[2];
#pragma unroll
    for (int i = 0; i < 2; ++i) { int R, C; stage_rc(tid * 16 + i * 8192, R, C); const int Rb = Epi::PERM ? ((R & ~31) + perm32(R & 31)) : R;
        voffA[i] = (unsigned)(R * g.ld + C) * 2u; voffB[i] = (unsigned)(Rb * g.ld + C) * 2u; }
    const size_t kstep = (size_t)(BK * 2);
    const size_t hstep = (size_t)HALF * g.ld * 2;
    const size_t tstep = 2 * hstep;
    const unsigned ldsw = (unsigned)wid * 1024u;
    const int aoff = lds_byte(wr * 64 + fr, fq * 8), boff = lds_byte(wc * 32 + fr, fq * 8);
#define PG8_SA(b, h) (((b) * 2 + (h)) * HTB)
#define PG8_SB(b, h) ((4 + (b) * 2 + (h)) * HTB)
#define PG8_STAGE(bufoff, gbase, voff) do { _Pragma("unroll") for (int _i = 0; _i < 2; ++_i) \
        __builtin_amdgcn_global_load_lds((const unsigned*)((const char*)(gbase) + (voff)[_i]), (PG8_LAS unsigned*)(lds + (bufoff) + ldsw + _i * 8192), 16, 0, 0); } while (0)
#define PG8_LDA(dst, b, h) do { _Pragma("unroll") for (int m = 0; m < 4; ++m) _Pragma("unroll") for (int k = 0; k < 2; ++k) dst[m][k] = *(const PG8_LAS bf16x8*)(lds + PG8_SA(b, h) + aoff + m * 2048 + k * 1024); } while (0)
#define PG8_LDB(dst, b, h) do { _Pragma("unroll") for (int n = 0; n < 2; ++n) _Pragma("unroll") for (int k = 0; k < 2; ++k) dst[n][k] = *(const PG8_LAS bf16x8*)(lds + PG8_SB(b, h) + boff + n * 2048 + k * 1024); } while (0)
#define PG8_MMA(ai, bj, At, Bt) do { __builtin_amdgcn_s_setprio(1); _Pragma("unroll") for (int m = 0; m < 4; ++m) _Pragma("unroll") for (int n = 0; n < 2; ++n) _Pragma("unroll") for (int k = 0; k < 2; ++k) \
        acc[ai][bj][m][n] = __builtin_amdgcn_mfma_f32_16x16x32_bf16(Bt[n][k], At[m][k], acc[ai][bj][m][n], 0, 0, 0); __builtin_amdgcn_s_setprio(0); } while (0)
#define PG8_WAIT_V(n) asm volatile("s_waitcnt vmcnt(" #n ")" ::: "memory")
#define PG8_WAIT_L(n) asm volatile("s_waitcnt lgkmcnt(" #n ")" ::: "memory")
#define PG8_BAR __builtin_amdgcn_s_barrier()
#define PG8_SCHED __builtin_amdgcn_sched_barrier(0)
    Unit cur, nxt; int ui = 0;
    if (!S.next(0, cur)) return;
    f32x4 acc[2][2][4][2];
#pragma unroll
    for (int a = 0; a < 2; ++a)
#pragma unroll
        for (int b = 0; b < 2; ++b)
#pragma unroll
            for (int m = 0; m < 4; ++m)
#pragma unroll
                for (int n = 0; n < 2; ++n) acc[a][b][m][n] = (f32x4){0.f, 0.f, 0.f, 0.f};
    bf16x8 At[4][2], B0[2][2], B1[2][2];
    const char* cA = (const char*)g.A + (size_t)cur.pm * tstep; const char* cB = (const char*)g.Bt + (size_t)cur.pn * tstep;
    S.a_ready(cur);
    if constexpr (SP2) {
        PG8_STAGE(PG8_SB(0, 0), cB, voffB); PG8_STAGE(PG8_SB(0, 1), cB + hstep, voffB); PG8_STAGE(PG8_SA(0, 0), cA, voffA); PG8_STAGE(PG8_SA(0, 1), cA + hstep, voffA);
        if (wr == 1) PG8_BAR;
        PG8_WAIT_V(2); PG8_BAR;
        PG8_STAGE(PG8_SB(1, 0), cB + kstep, voffB); PG8_STAGE(PG8_SA(1, 0), cA + kstep, voffA); PG8_STAGE(PG8_SB(1, 1), cB + hstep + kstep, voffB);
        PG8_WAIT_V(6); PG8_BAR;
    } else {
        PG8_STAGE(PG8_SB(0, 0), cB, voffB); PG8_STAGE(PG8_SA(0, 0), cA, voffA); PG8_STAGE(PG8_SB(0, 1), cB + hstep, voffB); PG8_STAGE(PG8_SA(0, 1), cA + hstep, voffA);
        if (wr == 1) PG8_BAR;
        PG8_WAIT_V(4); PG8_BAR;
        PG8_STAGE(PG8_SB(1, 0), cB + kstep, voffB); PG8_STAGE(PG8_SA(1, 0), cA + kstep, voffA); PG8_STAGE(PG8_SB(1, 1), cB + hstep + kstep, voffB);
        PG8_WAIT_V(6); PG8_BAR;
    }
    for (;;) {
        const bool has_next = S.next(ui + 1, nxt);
        const char* nA = has_next ? (const char*)g.A + (size_t)nxt.pm * tstep : cA; const char* nB = has_next ? (const char*)g.Bt + (size_t)nxt.pn * tstep : cB;
        for (int t = 0; t < nt; t += 2) {
            const bool last = (t == nt - 2);
            const char* a1 = cA + (size_t)(t + 1) * kstep;
            const char* a2 = last ? nA : cA + (size_t)(t + 2) * kstep; const char* b2 = last ? nB : cB + (size_t)(t + 2) * kstep;
            const char* a3 = a2 + kstep; const char* b3 = b2 + kstep;
            if (last && has_next) S.a_ready(nxt);
            if constexpr (SP2) {
            PG8_LDB(B0, 0, 0); PG8_LDB(B1, 0, 1); PG8_SCHED; PG8_LDA(At, 0, 0); PG8_STAGE(PG8_SA(1, 1), a1 + hstep, voffA);
            PG8_WAIT_V(8); PG8_WAIT_L(0); PG8_BAR; PG8_MMA(0, 0, At, B0); PG8_MMA(0, 1, At, B1); PG8_BAR; PG8_SCHED;
            PG8_LDA(At, 0, 1); PG8_STAGE(PG8_SB(0, 0), b2, voffB); PG8_STAGE(PG8_SB(0, 1), b2 + hstep, voffB); PG8_STAGE(PG8_SA(0, 0), a2, voffA);
            PG8_WAIT_V(8); PG8_WAIT_L(0); PG8_BAR; PG8_MMA(1, 0, At, B0); PG8_MMA(1, 1, At, B1); PG8_BAR; PG8_SCHED;
            PG8_LDB(B0, 1, 0); PG8_LDB(B1, 1, 1); PG8_SCHED; PG8_LDA(At, 1, 0); PG8_STAGE(PG8_SA(0, 1), a2 + hstep, voffA);
            PG8_WAIT_V(8); PG8_WAIT_L(0); PG8_BAR; PG8_MMA(0, 0, At, B0); PG8_MMA(0, 1, At, B1); PG8_BAR; PG8_SCHED;
            PG8_LDA(At, 1, 1); PG8_STAGE(PG8_SB(1, 0), b3, voffB); PG8_STAGE(PG8_SB(1, 1), b3 + hstep, voffB); PG8_STAGE(PG8_SA(1, 0), a3, voffA);
            PG8_WAIT_V(8); PG8_WAIT_L(0); PG8_BAR; PG8_MMA(1, 0, At, B0); PG8_MMA(1, 1, At, B1); PG8_BAR; PG8_SCHED;
            } else {
            PG8_LDB(B0, 0, 0); PG8_SCHED; PG8_LDA(At, 0, 0); PG8_STAGE(PG8_SA(1, 1), a1 + hstep, voffA);
            PG8_WAIT_L(8); PG8_BAR; PG8_WAIT_L(0); PG8_MMA(0, 0, At, B0); PG8_BAR; PG8_SCHED;
            PG8_LDB(B1, 0, 1); PG8_STAGE(PG8_SB(0, 0), b2, voffB);
            PG8_BAR; PG8_WAIT_L(0); PG8_MMA(0, 1, At, B1); PG8_BAR;
            PG8_LDA(At, 0, 1); PG8_STAGE(PG8_SA(0, 0), a2, voffA);
            PG8_BAR; PG8_WAIT_L(0); PG8_MMA(1, 0, At, B0); PG8_BAR; PG8_SCHED;
            PG8_STAGE(PG8_SB(0, 1), b2 + hstep, voffB);
            PG8_WAIT_V(6); PG8_BAR; PG8_MMA(1, 1, At, B1); PG8_BAR;
            PG8_LDB(B0, 1, 0); PG8_SCHED; PG8_LDA(At, 1, 0); PG8_STAGE(PG8_SA(0, 1), a2 + hstep, voffA);
            PG8_WAIT_L(8); PG8_BAR; PG8_WAIT_L(0); PG8_MMA(0, 0, At, B0); PG8_BAR; PG8_SCHED;
            PG8_LDB(B1, 1, 1); PG8_STAGE(PG8_SB(1, 0), b3, voffB);
            PG8_BAR; PG8_WAIT_L(0); PG8_MMA(0, 1, At, B1); PG8_BAR;
            PG8_LDA(At, 1, 1); PG8_STAGE(PG8_SA(1, 0), a3, voffA);
            PG8_BAR; PG8_WAIT_L(0); PG8_MMA(1, 0, At, B0); PG8_BAR; PG8_SCHED;
            PG8_STAGE(PG8_SB(1, 1), b3 + hstep, voffB);
            PG8_WAIT_V(6); PG8_BAR; PG8_MMA(1, 1, At, B1); PG8_BAR;
            }
        }
        if constexpr (ALIGN_EPI) { if (wr == 0) PG8_BAR; }
        if constexpr (!Epi::AFTER_DRAIN) { E(acc, cur, wr, wc, fr, fq); S.done(cur); }
        if (!has_next) break;
#pragma unroll
        for (int a = 0; a < 2; ++a)
#pragma unroll
            for (int b = 0; b < 2; ++b)
#pragma unroll
                for (int m = 0; m < 4; ++m)
#pragma unroll
                    for (int n = 0; n < 2; ++n) acc[a][b][m][n] = (f32x4){0.f, 0.f, 0.f, 0.f};
        cur = nxt; cA = nA; cB = nB; ++ui;
        if constexpr (ALIGN_EPI) { if (wr == 1) PG8_BAR; }
    }
    PG8_WAIT_V(0);
    if constexpr (!ALIGN_EPI) { if (wr == 0) PG8_BAR; }
    PG8_BAR;
    if constexpr (Epi::AFTER_DRAIN) { E.fused(acc, cur, wr, wc, fr, fq, lds, wid, lane); S.done(cur); }
#undef PG8_SA
#undef PG8_SB
#undef PG8_STAGE
#undef PG8_LDA
#undef PG8_LDB
#undef PG8_MMA
#undef PG8_WAIT_V
#undef PG8_WAIT_L
#undef PG8_BAR
#undef PG8_SCHED
}
}
#define LAS __attribute__((address_space(3)))
typedef short bf16x8_t __attribute__((ext_vector_type(8)));
typedef float f32x4_t __attribute__((ext_vector_type(4)));
typedef float f32x2_t __attribute__((ext_vector_type(2)));
typedef __bf16 bf16x2_t __attribute__((ext_vector_type(2)));
typedef unsigned u32x4_t __attribute__((ext_vector_type(4)));
typedef unsigned u32x2_t __attribute__((ext_vector_type(2)));
#define DEV __device__ __forceinline__
DEV unsigned cvtpk(float lo, float hi) { f32x2_t v = {lo, hi}; bf16x2_t b = __builtin_convertvector(v, bf16x2_t); return __builtin_bit_cast(unsigned, b); }
DEV bf16x8_t pack8(const f32x4_t a, const f32x4_t b) { u32x4_t p = {cvtpk(a[0], a[1]), cvtpk(a[2], a[3]), cvtpk(b[0], b[1]), cvtpk(b[2], b[3])}; return __builtin_bit_cast(bf16x8_t, p); }
#define MFMA16(a, b, c) __builtin_amdgcn_mfma_f32_16x16x32_bf16((a), (b), (c), 0, 0, 0)
template <int CTRL> DEV float dppf(float x) { return __builtin_bit_cast(float, __builtin_amdgcn_mov_dpp(__builtin_bit_cast(int, x), CTRL, 0xF, 0xF, true)); }
template <int CTRL> DEV int dppi(int x) { return __builtin_amdgcn_mov_dpp(x, CTRL, 0xF, 0xF, true); }
constexpr int DPP_X1 = 0xB1, DPP_X2 = 0x4E, DPP_HM = 0x141, DPP_RM = 0x140;

constexpr int DNS_FB = 8192, DNS_US = 68, DNS_EG = 4 * DNS_FB + 64 * DNS_US * 4, DNS_GT = DNS_EG + 16, DNS_BUF = DNS_GT + 64 * 136;
static_assert(2 * DNS_BUF + 2048 + 2 * 64 * 144 <= 147456 - 256, "DeltaNet scan LDS (the last 256 bytes are the control words)");
struct DnStage { u32x4_t fr[8]; f32x4_t ut[4]; u32x4_t gt[2]; float eg; };
DEV void dn_scan_load(CREF c, DnStage& st, int u, int pt) {
    const u32x4_t* f = (const u32x4_t*)(c.DNF + (size_t)u * 16384) + pt; const f32x4_t* uq = (const f32x4_t*)(c.DNU + (size_t)u * 4096) + pt;
#pragma unroll
    for (int k = 0; k < 8; ++k) st.fr[k] = f[256 * k];
#pragma unroll
    for (int k = 0; k < 4; ++k) st.ut[k] = uq[256 * k];
    const u32x4_t* gq = (const u32x4_t*)(c.DNG + (size_t)u * 4096) + pt; st.gt[0] = gq[0]; st.gt[1] = gq[256];
    st.eg = c.DNE[u];
}
DEV void dn_scan_store(const DnStage& st, LAS unsigned char* dst, int pt) {
#pragma unroll
    for (int k = 0; k < 8; ++k) *(LAS u32x4_t*)(dst + (pt + 256 * k) * 16) = st.fr[k];
#pragma unroll
    for (int k = 0; k < 4; ++k) { const int idx = pt + 256 * k, v = idx & 63, tq = idx >> 6; *(LAS f32x4_t*)(dst + 4 * DNS_FB + (v * DNS_US + 4 * tq) * 4) = st.ut[k]; }
#pragma unroll
    for (int k = 0; k < 2; ++k) { const int e = (pt + 256 * k) * 2, tq = e >> 6, v = e & 63;
        *(LAS u32x2_t*)(dst + DNS_GT + v * 136 + tq * 8) = (u32x2_t){st.gt[k][0], st.gt[k][1]}; *(LAS u32x2_t*)(dst + DNS_GT + (v + 1) * 136 + tq * 8) = (u32x2_t){st.gt[k][2], st.gt[k][3]}; }
    if (pt == 0) *(LAS float*)(dst + DNS_EG) = st.eg;
}
DEV void dn_scan_consume(const LAS unsigned char* buf, f32x4_t (&S)[4], f32x4_t (&O)[4], LAS float* ssw, int v, int lane, int kb) {
    const LAS unsigned char* fb = buf + lane * 16;
    const LAS float* ut = (const LAS float*)(buf + 4 * DNS_FB) + v * DNS_US + 4 * kb;
#define DNS_FR(mat, mt, ks) (*(const LAS bf16x8_t*)(fb + (mat) * DNS_FB + ((mt) * 2 + (ks)) * 1024))
    const float eg = *(const LAS float*)(buf + DNS_EG);
    const bf16x8_t Sb0 = pack8(S[0], S[1]), Sb1 = pack8(S[2], S[3]);
    f32x4_t ws[4], qs[4], ds[4], vn[4];
    const f32x4_t z4 = {0.f, 0.f, 0.f, 0.f};
#pragma unroll
    for (int mt = 0; mt < 4; ++mt) { ws[mt] = MFMA16(DNS_FR(0, mt, 0), Sb0, z4); ws[mt] = MFMA16(DNS_FR(0, mt, 1), Sb1, ws[mt]);
                                     qs[mt] = MFMA16(DNS_FR(1, mt, 0), Sb0, z4); qs[mt] = MFMA16(DNS_FR(1, mt, 1), Sb1, qs[mt]); }
#pragma unroll
    for (int mt = 0; mt < 4; ++mt) vn[mt] = *(const LAS f32x4_t*)(ut + 16 * mt) - ws[mt];
    const bf16x8_t Vb0 = pack8(vn[0], vn[1]), Vb1 = pack8(vn[2], vn[3]);
#pragma unroll
    for (int mt = 0; mt < 4; ++mt) { qs[mt] = MFMA16(DNS_FR(2, mt, 0), Vb0, qs[mt]); qs[mt] = MFMA16(DNS_FR(2, mt, 1), Vb1, qs[mt]);
                                     ds[mt] = MFMA16(DNS_FR(3, mt, 0), Vb0, z4); ds[mt] = MFMA16(DNS_FR(3, mt, 1), Vb1, ds[mt]); }
#pragma unroll
    for (int mt = 0; mt < 4; ++mt) { S[mt] = S[mt] * eg + ds[mt]; O[mt] = qs[mt];
        f32x4_t q2 = qs[mt] * qs[mt];
#pragma unroll
        for (int i = 0; i < 4; ++i) { float s = q2[i]; s += dppf<DPP_X1>(s); s += dppf<DPP_X2>(s); s += dppf<DPP_HM>(s); s += dppf<DPP_RM>(s); q2[i] = s; }
        if ((lane & 15) == 0) *(LAS f32x4_t*)(ssw + 16 * mt + 4 * kb) = q2; }
#undef DNS_FR
}
constexpr int DNS_OTS = 144, DNS_OT = 64 * DNS_OTS;
DEV void dn_scan_finish(const f32x4_t (&O)[4], const f32x4_t (&Z)[4], const LAS float* ss, LAS unsigned char* ot, int v, int kb) {
#pragma unroll
    for (int mt = 0; mt < 4; ++mt) { const LAS float* sp = ss + 16 * mt + 4 * kb;
        const f32x4_t tot = (*(const LAS f32x4_t*)sp + *(const LAS f32x4_t*)(sp + 64)) + (*(const LAS f32x4_t*)(sp + 128) + *(const LAS f32x4_t*)(sp + 192));
#pragma unroll
        for (int i = 0; i < 4; ++i) *(LAS bf16_t*)(ot + (16 * mt + 4 * kb + i) * DNS_OTS + v * 2) = tobf(O[mt][i] * __builtin_amdgcn_rsqf(tot[i] * (1.0f / 64.0f) + NEPS) * Z[mt][i]); }
}
DEV void dn_scan_flush(CREF c, const LAS unsigned char* ot, int r0, int h, int ct) {
#pragma unroll
    for (int k = 0; k < 2; ++k) { const int p = ct + 256 * k, tok = p >> 3, seg = p & 7;
        *(u32x4_t*)(c.MIXB + (size_t)(r0 + tok) * DM + 512 + h * 64 + seg * 8) = *(const LAS u32x4_t*)(ot + tok * DNS_OTS + seg * 16); }
}
DEV void dn_scan_mfma(CREF c, int l, LAS unsigned char* L, int bh, int tid) {
    asm volatile("" : "+v"(tid));
    const int b = bh / DNH, h = bh % DNH, wid = tid >> 6, lane = tid & 63, n = lane & 15, kb = lane >> 4;
    const bool producer = wid >= 4;
    const int v = 16 * (wid & 3) + n;
    f32x4_t S[4];
#pragma unroll
    for (int mt = 0; mt < 4; ++mt) S[mt] = (f32x4_t){0.f, 0.f, 0.f, 0.f};
    const int u0 = (b * DNH + h) * NCH, rb = b * SEQ, pt = tid - 256;
    if (producer) {
        DnStage s0, s1, s2;
        dn_scan_load(c, s0, u0, pt); dn_scan_store(s0, L, pt);
        dn_scan_load(c, s0, u0 + 1, pt); dn_scan_load(c, s1, u0 + 2, pt); dn_scan_load(c, s2, u0 + 3, pt);
#define DNS_STEP(st, ch_) { __syncthreads(); if ((ch_) + 1 < NCH) { dn_scan_store(st, L + (((ch_) + 1) & 1) * DNS_BUF, pt); if ((ch_) + 4 < NCH) dn_scan_load(c, st, u0 + (ch_) + 4, pt); } }
        static_assert(NCH % 6 == 2, "producer loop tail");
        for (int ch = 0; ch < NCH - 2; ch += 3) { DNS_STEP(s0, ch) DNS_STEP(s1, ch + 1) DNS_STEP(s2, ch + 2) }
        DNS_STEP(s0, NCH - 2) DNS_STEP(s1, NCH - 1)
#undef DNS_STEP
        __syncthreads(); __syncthreads();
    } else {
        LAS float* SS = (LAS float*)(L + 2 * DNS_BUF);
        LAS unsigned char* OT = L + 2 * DNS_BUF + 2048;
        f32x4_t O[4], Op[4], Z[4];
#define DNS_ZLOAD(bufoff_) { _Pragma("unroll") for (int mt = 0; mt < 4; ++mt) { const u32x2_t w = *(const LAS u32x2_t*)(L + (bufoff_) + DNS_GT + v * 136 + (4 * mt + kb) * 8); \
            Z[mt] = (f32x4_t){__uint_as_float(w[0] << 16), __uint_as_float(w[0] & 0xffff0000u), __uint_as_float(w[1] << 16), __uint_as_float(w[1] & 0xffff0000u)}; } }
#define DNS_CSTEP(ch_, bufoff) { __syncthreads(); \
            if ((ch_) > 1) dn_scan_flush(c, OT + ((ch_) & 1) * DNS_OT, rb + ((ch_) - 2) * 64, h, tid); \
            if ((ch_) > 0) dn_scan_finish(Op, Z, SS + (((ch_) - 1) & 1) * 256, OT + (((ch_) - 1) & 1) * DNS_OT, v, kb); \
            DNS_ZLOAD(bufoff) \
            dn_scan_consume(L + (bufoff), S, O, SS + ((ch_) & 1) * 256 + (wid & 3) * 64, v, lane, kb); \
            _Pragma("unroll") for (int mt = 0; mt < 4; ++mt) Op[mt] = O[mt]; }
        for (int ch = 0; ch < NCH; ch += 2) { DNS_CSTEP(ch, 0) DNS_CSTEP(ch + 1, DNS_BUF) }
        __syncthreads();
        dn_scan_flush(c, OT + (NCH & 1) * DNS_OT, rb + (NCH - 2) * 64, h, tid);
        dn_scan_finish(Op, Z, SS + ((NCH - 1) & 1) * 256, OT + ((NCH - 1) & 1) * DNS_OT, v, kb);
        __syncthreads();
        dn_scan_flush(c, OT + ((NCH - 1) & 1) * DNS_OT, rb + (NCH - 1) * 64, h, tid);
#undef DNS_CSTEP
#undef DNS_ZLOAD
    }
    if (!producer) {
#pragma unroll
        for (int mt = 0; mt < 4; ++mt)
#pragma unroll
            for (int i = 0; i < 4; ++i) c.out[O_DNP + (((size_t)l * BATCH + b) * DNH + h) * 4096 + (16 * mt + 4 * kb + i) * 64 + v] = S[mt][i];
    }
    __syncthreads();
}

DEV float wave_sum(float v) {
    v += dppf<DPP_X1>(v); v += dppf<DPP_X2>(v); v += dppf<DPP_HM>(v); v += dppf<DPP_RM>(v); v += __shfl_xor(v, 16); v += __shfl_xor(v, 32);
    return v;
}
DEV void transpose_item(const float* W, int K, int N, bf16_t* WT, LAS float* scr, int item, int lane) {
    const int nblk = N / 32, kb = item / nblk, nb = item % nblk, k0 = 64 * kb, n0 = 32 * nb;
#pragma unroll
    for (int i = 0; i < 32; ++i) { const int kk = 2 * i + (lane >> 5); scr[kk * 33 + (lane & 31)] = W[(size_t)(k0 + kk) * N + n0 + (lane & 31)]; }
    asm volatile("s_waitcnt lgkmcnt(0)" ::: "memory");
    const int cch = lane & 7;
#pragma unroll
    for (int j = 0; j < 4; ++j) { const int n = (lane >> 3) + 8 * j; const LAS float* s = scr + (8 * cch) * 33 + n;
        u32x4_t o; o.x = cvtpk(s[0 * 33], s[1 * 33]); o.y = cvtpk(s[2 * 33], s[3 * 33]); o.z = cvtpk(s[4 * 33], s[5 * 33]); o.w = cvtpk(s[6 * 33], s[7 * 33]);
        *(u32x4_t*)(WT + (size_t)(n0 + n) * K + k0 + 8 * cch) = o; }
    asm volatile("s_waitcnt lgkmcnt(0)" ::: "memory");
}
DEV void dev_s5_consts(CREF c, long gtid, long gn) {
    for (long t = gtid; t < (long)2 * S5G * S5P * S5C; t += gn) { const long i = t >> 4; const int ch = (int)(t & 15); const int l = (int)(i / (S5G * S5P)), g = (int)((i / S5P) % S5G), p = (int)(i % S5P); const size_t lg = (size_t)(i / S5P);
        const float lr = c.lam_re[i], li = c.lam_im[i], dt = expf(c.log_step[l * S5G + g]);
        const float zr = lr * dt, zi = li * dt, mag = expf(zr), cz = cosf(zi), sz = sinf(zi), sh = sinf(0.5f * zi);
        const float ar = mag * cz, ai = mag * sz, am1 = expm1f(zr) * cz - 2.0f * sh * sh, den = lr * lr + li * li;
        const float fr = (am1 * lr + ai * li) / den, fi = (ai * lr - am1 * li) / den;
        if (ch == 0) { float pr = ar, pi = ai;
#pragma unroll
            for (int s = 0; s < 6; ++s) { const float nr = pr * pr - pi * pi, ni = 2.0f * pr * pi; pr = nr; pi = ni; }
            c.S5K[i * 4 + 0] = ar; c.S5K[i * 4 + 1] = ai; c.S5K[i * 4 + 2] = pr; c.S5K[i * 4 + 3] = pi; }
        const float br = c.b_re[i * S5C + ch], bi = c.b_im[i * S5C + ch]; const float bbr = fr * br - fi * bi, bbi = fr * bi + fi * br;
        c.S5BB[(i * S5C + ch) * 2 + 0] = bbr; c.S5BB[(i * S5C + ch) * 2 + 1] = bbi;
#pragma unroll
        for (int comp = 0; comp < 2; ++comp) { const int s = 2 * p + comp, j = s >> 4, n = s & 15;
            c.S5BF[((lg * 8 + j) * 64 + n + 16 * (ch >> 3)) * 8 + (ch & 7)] = tobf(comp == 0 ? bbr : bbi);
            if (ch < 8) { c.S5BF[((lg * 8 + j) * 64 + n + 32) * 8 + ch] = 0; c.S5BF[((lg * 8 + j) * 64 + n + 48) * 8 + ch] = 0; }
            const int k = s, ks = k >> 5, kg = (k & 31) >> 3, jj = k & 7; const size_t ci = ((lg * S5C + ch) * S5P + p);
            c.S5CF[((lg * 4 + ks) * 64 + ch + 16 * kg) * 8 + jj] = tobf(comp == 0 ? c.c_re[ci] : -c.c_im[ci]); } }
}
DEV void dev_transposes(CREF c, LAS unsigned char* L, int l, int gw, int NGW, int wave, int lane) {
    LAS float* scr = (LAS float*)(L + wave * 16384);
    constexpr int I_IN = (DM / 64) * (INW / 32), I_OUT = (DM / 64) * (DM / 32), I_UP = (DM / 64) * (DFF / 32), I_DN = (DFF / 64) * (DM / 32), I_GL = (256 / 64) * (256 / 32), I_L = I_IN + I_OUT + I_UP + I_DN + I_GL;
    for (int it = gw; it < I_L; it += NGW) { int r = it;
        if (r < I_IN) { transpose_item(c.w_in + (size_t)l * DM * INW, DM, INW, c.WIN_T + (size_t)l * PLD * DM, scr, r, lane); continue; } r -= I_IN;
        if (r < I_OUT) { transpose_item(c.w_out + (size_t)l * DM * DM, DM, DM, c.WOUT_T + (size_t)l * DM * DM, scr, r, lane); continue; } r -= I_OUT;
        if (r < I_UP) { transpose_item(c.mlp_up + (size_t)l * DM * DFF, DM, DFF, c.WUP_T + (size_t)l * DFF * DM, scr, r, lane); continue; } r -= I_UP;
        if (r < I_DN) { transpose_item(c.mlp_down + (size_t)l * DFF * DM, DFF, DM, c.WDN_T + (size_t)l * DM * DFF, scr, r, lane); continue; } r -= I_DN;
        transpose_item(c.w_glu + (size_t)l * 65536, 256, 256, c.WGLU_T + (size_t)l * 65536, scr, r, lane); }
}
DEV void dev_prologue(CREF c, LAS unsigned char* L, int bx, int tid, long gtid, long gn) {
    const int wave = tid >> 6, lane = tid & 63, gw = bx * 8 + wave, NGW = (int)gridDim.x * 8;
    dev_transposes(c, L, 0, gw, NGW, wave, lane);
    for (long i = gtid; i < (long)2 * (PLD - INW) * DM / 8; i += gn) { const int l = (int)(i / ((PLD - INW) * DM / 8)); const long r = i % ((PLD - INW) * DM / 8);
        *(u32x4_t*)(c.WIN_T + ((size_t)l * PLD + INW) * DM + r * 8) = (u32x4_t){0u, 0u, 0u, 0u}; }
    { f32x4_t g[4];
#pragma unroll
      for (int j = 0; j < 4; ++j) g[j] = ((const f32x4_t*)c.ln1)[lane + 64 * j];
      for (int r = gw; r < TT; r += NGW) { const f32x4_t* xr = (const f32x4_t*)(r < TP ? c.x_prompt + (size_t)r * DM : c.x_sample + (size_t)(r - TP) * DM) + lane; f32x4_t v[4]; float s = 0.f;
#pragma unroll
        for (int j = 0; j < 4; ++j) { v[j] = xr[64 * j]; s += (v[j][0] * v[j][0] + v[j][1] * v[j][1]) + (v[j][2] * v[j][2] + v[j][3] * v[j][3]); ((f32x4_t*)(c.X + (size_t)r * DM))[lane + 64 * j] = v[j]; }
        const float rs = 1.0f / sqrtf(wave_sum(s) * (1.0f / DM) + NEPS);
#pragma unroll
        for (int j = 0; j < 4; ++j) { const f32x4_t o = v[j] * rs * g[j]; u32x2_t w = {cvtpk(o[0], o[1]), cvtpk(o[2], o[3])}; ((u32x2_t*)(c.XN + (size_t)r * DM))[lane + 64 * j] = w; } } }
}
template <bool FINAL> DEV void dev_rmsnorm(CREF c, const float* gain, int bx, int tid, int nsplit) {
    const int wave = tid >> 6, lane = tid & 63, gw = bx * 8 + wave, NGW = (int)gridDim.x * 8;
    f32x4_t g[4];
#pragma unroll
    for (int j = 0; j < 4; ++j) g[j] = ((const f32x4_t*)gain)[lane + 64 * j];
    for (int r = gw; r < TT; r += NGW) { f32x4_t* xr = (f32x4_t*)(c.X + (size_t)r * DM) + lane; f32x4_t v[4]; float s = 0.f;
#pragma unroll
        for (int j = 0; j < 4; ++j) v[j] = xr[64 * j];
        if (r >= TP) {
            for (int ks = 0; ks < nsplit; ++ks) { const f32x4_t* pr = (const f32x4_t*)(c.PART + ((size_t)ks * TS + (r - TP)) * DM) + lane;
#pragma unroll
                for (int j = 0; j < 4; ++j) v[j] += pr[64 * j]; }
            if (!FINAL) {
#pragma unroll
                for (int j = 0; j < 4; ++j) xr[64 * j] = v[j]; } }
#pragma unroll
        for (int j = 0; j < 4; ++j) s += (v[j][0] * v[j][0] + v[j][1] * v[j][1]) + (v[j][2] * v[j][2] + v[j][3] * v[j][3]);
        const float rs = 1.0f / sqrtf(wave_sum(s) * (1.0f / DM) + NEPS);
#pragma unroll
        for (int j = 0; j < 4; ++j) { const f32x4_t o = v[j] * rs * g[j];
            if (FINAL) ((f32x4_t*)(c.out + O_YP + (size_t)r * DM))[lane + 64 * j] = o;
            else { u32x2_t w = {cvtpk(o[0], o[1]), cvtpk(o[2], o[3])}; ((u32x2_t*)(c.XN + (size_t)r * DM))[lane + 64 * j] = w; } } }
}
DEV void dev_copy_out(CREF c, int l, long gtid, long gn) {
    for (long i = gtid; i < (long)TT * 128; i += gn) { const int r = (int)(i >> 7), k = (int)(i & 127); const f32x4_t v = *(const f32x4_t*)(c.PROJ + (size_t)r * PLD + C_KV + 4 * k);
        float* dst = r < TP ? c.out + O_KVP + ((size_t)l * TP + r) * 512 : c.out + O_KVS + ((size_t)l * TS + (r - TP)) * 512; *(f32x4_t*)(dst + 4 * k) = v; }
    for (long i = gtid; i < (long)BATCH * 512 * 64; i += gn) { const int b = (int)(i / (512 * 64)), w = (int)((i >> 6) & 511), k = (int)(i & 63);
        ((f32x4_t*)(c.out + O_WINP + (size_t)l * BATCH * 512 * 256))[i] = *(const f32x4_t*)(c.PROJ + (size_t)(b * SEQ + SEQ - 512 + w) * PLD + C_KV + 512 + 4 * k); }
    for (long i = gtid; i < (long)DB * 512 * 64; i += gn) { const int b = (int)(i / (512 * 64)), w = (int)((i >> 6) & 511), k = (int)(i & 63);
        ((f32x4_t*)(c.out + O_WINS + (size_t)l * DB * 512 * 256))[i] = (w < 512 - DSEQ) ? *(const f32x4_t*)(c.cache_win + (((size_t)l * DB + b) * 512 + w + DSEQ) * 256 + 4 * k)
                                                                                       : *(const f32x4_t*)(c.PROJ + (size_t)(TP + b * DSEQ + (w - (512 - DSEQ))) * PLD + C_KV + 512 + 4 * k); }
    for (long i = gtid; i < (long)BATCH * 3 * CONVD / 4; i += gn) { const int b = (int)(i / (3 * CONVD / 4)), w = (int)((i / (CONVD / 4)) % 3), k = (int)(i % (CONVD / 4));
        ((f32x4_t*)(c.out + O_CONVP + (size_t)l * BATCH * 3 * CONVD))[i] = *(const f32x4_t*)(c.PROJ + (size_t)(b * SEQ + SEQ - 3 + w) * PLD + C_DNQKV + 4 * k); }
    for (long i = gtid; i < (long)DB * 3 * CONVD / 4; i += gn) { const int b = (int)(i / (3 * CONVD / 4)), w = (int)((i / (CONVD / 4)) % 3), k = (int)(i % (CONVD / 4));
        ((f32x4_t*)(c.out + O_CONVS + (size_t)l * DB * 3 * CONVD))[i] = *(const f32x4_t*)(c.PROJ + (size_t)(TP + b * DSEQ + DSEQ - 3 + w) * PLD + C_DNQKV + 4 * k); }
}

constexpr int DP_YS = 65;
constexpr int DP_Y = 0, DP_AM = DP_Y + 3 * 64 * DP_YS * 4, DP_R = DP_AM + 64 * 64 * 4, DP_AQ = DP_R + 64 * 128 * 4, DP_SM = DP_AQ + 64 * 64 * 4, DP_END = DP_SM + 6 * 64 * 4;
static_assert(DP_END <= 131072, "DeltaNet prep LDS");
DEV void dn_prep_unit(CREF c, int l, LAS unsigned char* L, int u, int tid) {
    asm volatile("" : "+v"(tid));
    const int ch = u % NCH, h = (u / NCH) % DNH, b = u / (NCH * DNH), r0 = b * SEQ + ch * 64, lane = tid & 63, wid = tid >> 6;
    LAS float* Y = (LAS float*)(L + DP_Y); LAS float* AMs = (LAS float*)(L + DP_AM); LAS float* R = (LAS float*)(L + DP_R);
    LAS float* sm = (LAS float*)(L + DP_SM);
    LAS float* AQs = (LAS float*)(L + DP_AQ);
    if (tid < 384) { const int ci = tid % 192, tg = tid / 192, part = ci >> 6, d = ci & 63, cch = part * DNW + h * 64 + d;
        const f32x4_t w = *(const f32x4_t*)(c.conv_w + ((size_t)l * CONVD + cch) * 4); float x[35];
        const int tt0 = ch * 64 + 32 * tg - 3; const float* px = c.PROJ + (size_t)(b * SEQ) * PLD + C_DNQKV + cch;
#pragma unroll
        for (int k = 0; k < 35; ++k) { const int tt = tt0 + k; const float v = px[(size_t)(tt < 0 ? 0 : tt) * PLD]; x[k] = tt < 0 ? 0.f : v; }
#pragma unroll
        for (int t = 0; t < 32; ++t) { const float y = (w[0] * x[t] + w[1] * x[t + 1]) + (w[2] * x[t + 2] + w[3] * x[t + 3]); Y[(part * 64 + 32 * tg + t) * DP_YS + d] = y * __builtin_amdgcn_rcpf(1.0f + __expf(-y)); } }
    {
        const int tk = tid >> 3, v0 = (tid & 7) * 8; const float* zp = c.PROJ + (size_t)(r0 + tk) * PLD + C_DNZ + h * 64 + v0; const f32x4_t za = *(const f32x4_t*)zp, zb = *(const f32x4_t*)(zp + 4);
        const f32x4_t na = *(const f32x4_t*)(c.dn_norm_w + l * 64 + v0), nb = *(const f32x4_t*)(c.dn_norm_w + l * 64 + v0 + 4);
        bf16_t* gp = c.DNG + (size_t)u * 4096 + ((tk >> 2) * 64 + v0) * 4 + (tk & 3);
#pragma unroll
        for (int k = 0; k < 8; ++k) { const float z = k < 4 ? za[k] : zb[k - 4], nwv = k < 4 ? na[k] : nb[k - 4]; gp[4 * k] = tobf(z * __builtin_amdgcn_rcpf(1.0f + __expf(-z)) * nwv); } }
    if (tid >= 448) { const int t = tid - 448, r = r0 + t; sm[128 + t] = sigmoidf_(c.PROJ[(size_t)r * PLD + C_DNB + h]);
        sm[192 + t] = -expf(c.a_log[l * DNH + h]) * softplusf_(c.PROJ[(size_t)r * PLD + C_DNA + h] + c.dt_bias[l * DNH + h]); }
    __syncthreads();
    {   const int rr = tid >> 2, q4 = tid & 3; const LAS float* yr = Y + rr * DP_YS + 16 * q4; float ss = 0.f;
#pragma unroll
        for (int k = 0; k < 16; ++k) ss += yr[k] * yr[k];
        ss += dppf<DPP_X1>(ss); ss += dppf<DPP_X2>(ss);
        if (q4 == 0) sm[rr] = (rr < 64 ? 0.125f : 1.0f) / sqrtf(ss + 1e-6f); }
    if (wid == 7) { float s = sm[192 + lane];
#pragma unroll
        for (int o = 1; o < 64; o <<= 1) { const float t = __shfl_up(s, o); if (lane >= o) s += t; }
        sm[256 + lane] = s; const float gl = __shfl(s, 63); sm[320 + lane] = expf(gl - s); }
    __syncthreads();
    for (int idx = tid; idx < 128 * 64; idx += 512) { const int rr = idx >> 6, d = idx & 63; Y[rr * DP_YS + d] *= sm[rr]; }
    __syncthreads();
    {   const int mt = tid >> 7, ks = (tid >> 6) & 1, m16 = tid & 15, kb = (tid >> 4) & 3, row = 16 * mt + m16, k0 = 32 * ks + 4 * kb, k1 = k0 + 16;
        bf16_t* fo = c.DNF + (size_t)u * 16384 + tid * 8;
        { const float e = expf(sm[256 + row]); const LAS float* q = Y + row * DP_YS; const f32x4_t a = {q[k0] * e, q[k0 + 1] * e, q[k0 + 2] * e, q[k0 + 3] * e}, bq = {q[k1] * e, q[k1 + 1] * e, q[k1 + 2] * e, q[k1 + 3] * e};
          *(bf16x8_t*)(fo + 4096) = pack8(a, bq); }
        { const LAS float* kT = Y + 64 * DP_YS + row; f32x4_t a, bq;
#pragma unroll
          for (int i = 0; i < 4; ++i) { a[i] = kT[(k0 + i) * DP_YS] * sm[320 + k0 + i]; bq[i] = kT[(k1 + i) * DP_YS] * sm[320 + k1 + i]; }
          *(bf16x8_t*)(fo + 12288) = pack8(a, bq); }
    }
    for (int idx = tid; idx < 64 * 64; idx += 512) { const int t = idx >> 6, d = idx & 63; const float q = Y[t * DP_YS + d], k = Y[(64 + t) * DP_YS + d], vv = Y[(128 + t) * DP_YS + d], be = sm[128 + t];
        (void)q; R[t * 128 + d] = vv * be; R[t * 128 + 64 + d] = k * be * expf(sm[256 + t]); }

    {   const int m16 = lane & 15, kq = lane >> 4;
#pragma unroll 1
        for (int pi = wid; pi < 10; pi += 8) { const int mt = pi < 1 ? 0 : (pi < 3 ? 1 : (pi < 6 ? 2 : 3)), nt = pi - (mt * (mt + 1)) / 2;
            const LAS float* ka = Y + (64 + 16 * mt + m16) * DP_YS + kq; const LAS float* qa = Y + (16 * mt + m16) * DP_YS + kq; const LAS float* kb = Y + (64 + 16 * nt + m16) * DP_YS + kq;
            f32x4_t ck = {0.f, 0.f, 0.f, 0.f}, cq = {0.f, 0.f, 0.f, 0.f};
#pragma unroll
            for (int s = 0; s < 16; ++s) { const float bv = kb[4 * s]; ck = __builtin_amdgcn_mfma_f32_16x16x4f32(ka[4 * s], bv, ck, 0, 0, 0); cq = __builtin_amdgcn_mfma_f32_16x16x4f32(qa[4 * s], bv, cq, 0, 0, 0); }
            const int j = 16 * nt + m16; const float gj = sm[256 + j];
#pragma unroll
            for (int i = 0; i < 4; ++i) { const int ii = 16 * mt + 4 * kq + i; const float dec = j <= ii ? expf(sm[256 + ii] - gj) : 0.f;
                AMs[ii * 64 + j] = j < ii ? sm[128 + ii] * ck[i] * dec : 0.f; AQs[ii * 64 + j] = j <= ii ? cq[i] * dec : 0.f; } }
        if (wid >= 2) { const int pu = wid - 2, mt = pu < 3 ? 0 : (pu < 5 ? 1 : 2), nt = pu < 3 ? pu + 1 : (pu < 5 ? pu - 1 : 3);
#pragma unroll
            for (int i = 0; i < 4; ++i) AQs[(16 * mt + 4 * kq + i) * 64 + 16 * nt + m16] = 0.f; } }
    __syncthreads();
    {   const int col = tid >> 2, q = tid & 3; float xq[16];
#pragma unroll
        for (int jj = 0; jj < 16; ++jj) xq[jj] = 0.f;
#pragma unroll
        for (int i = 0; i < 64; ++i) { float s = 0.f;
#pragma unroll
            for (int jj = 0; jj < (i + 3) / 4; ++jj) s -= AMs[i * 64 + 4 * jj + q] * xq[jj];
            s += dppf<DPP_X1>(s); s += dppf<DPP_X2>(s); s += R[i * 128 + col];
            xq[i >> 2] = ((i & 3) == q) ? s : xq[i >> 2];
            if (q == 0) R[i * 128 + col] = s; } }
    __syncthreads();
    if (wid == 6) {
#pragma unroll
        for (int s8 = 0; s8 < 8; ++s8) { const int slot = lane + 64 * s8, mt = slot >> 7, ks = (slot >> 6) & 1, m16 = slot & 15, kb = (slot >> 4) & 3, row = 16 * mt + m16, k0 = 32 * ks + 4 * kb, k1 = k0 + 16;
            const f32x4_t a = *(const LAS f32x4_t*)(R + row * 128 + 64 + k0), bq = *(const LAS f32x4_t*)(R + row * 128 + 64 + k1); *(bf16x8_t*)(c.DNF + (size_t)u * 16384 + slot * 8) = pack8(a, bq);
            const f32x4_t a2 = *(const LAS f32x4_t*)(AQs + row * 64 + k0), b2 = *(const LAS f32x4_t*)(AQs + row * 64 + k1); *(bf16x8_t*)(c.DNF + (size_t)u * 16384 + 8192 + slot * 8) = pack8(a2, b2); }
#pragma unroll
        for (int s = 0; s < 16; ++s) { const int idx = lane + 64 * s, v = idx & 63, tq = idx >> 6; const f32x4_t uv = {R[(4 * tq) * 128 + v], R[(4 * tq + 1) * 128 + v], R[(4 * tq + 2) * 128 + v], R[(4 * tq + 3) * 128 + v]};
            *(f32x4_t*)(c.DNU + (size_t)u * 4096 + idx * 4) = uv; }
        if (lane == 0) c.DNE[u] = expf(sm[256 + 63]); }
}
DEV void dev_dn_out(CREF c, int l, int bx, int tid) {
    const int wave = tid >> 6, lane = tid & 63, gw = bx * 8 + wave, NGW = (int)gridDim.x * 8; const float nw = c.dn_norm_w[l * 64 + lane];
    for (int i0 = gw * 8; i0 < TP * DNH; i0 += NGW * 8) { float o[8], z[8];
#pragma unroll
        for (int k = 0; k < 8; ++k) { const int i = i0 + k, r = i / DNH, h = i % DNH; o[k] = c.ODN[(size_t)i * 64 + lane]; z[k] = c.PROJ[(size_t)r * PLD + C_DNZ + h * 64 + lane]; }
#pragma unroll
        for (int k = 0; k < 8; ++k) { const int i = i0 + k, r = i / DNH, h = i % DNH; const float ss = wave_sum(o[k] * o[k]);
            c.MIXB[(size_t)r * DM + 512 + h * 64 + lane] = tobf(o[k] * __builtin_amdgcn_rsqf(ss * (1.0f / 64.0f) + NEPS) * nw * (z[k] * __builtin_amdgcn_rcpf(1.0f + __expf(-z[k])))); } }
}

typedef float f32x16_t __attribute__((ext_vector_type(16)));
#define MFMA32(a, b, c) __builtin_amdgcn_mfma_f32_32x32x16_bf16((a), (b), (c), 0, 0, 0)
constexpr int NA_RS = 144;
constexpr int NA_T = 64 * NA_RS, NA_BUF = 2 * NA_T;
constexpr int NA_IMP = 2 * NA_BUF, NA_SELM = NA_IMP + 64 * 128 * 4, NA_UNI = NA_SELM + 64 * 16, NA_NIT = NA_UNI + 16, NA_ITEMS = NA_NIT + 16, NA_PT = NA_ITEMS + 160 * 4, NA_END = NA_PT + 64;
static_assert(NA_END <= 131072, "NSA LDS");
constexpr float LOG2E = 1.4426950408889634f;
DEV int crow32(int reg, int hh) { return (reg & 3) + 8 * (reg >> 2) + 4 * hh; }
struct NaStage { f32x4_t k0, k1, v0, v1; };
template <bool SMP> DEV void na_load(CREF c, NaStage& st, int l, int mode, int b, int g, int n, int tid, const LAS int* pt = nullptr) {
    const int key = tid >> 3, d0 = (tid & 7) * 8; const float* kp; bool zero = false;
    if (mode == 0) { kp = c.KC + (((size_t)((SMP ? BATCH : 0) + b) * NBMAX + 64 * n + key) * 2 + g) * 64 + d0;
        const float* vp = c.VC + (kp - c.KC); const bool zp = SMP && key >= NBC_S; const f32x4_t z0 = {0.f, 0.f, 0.f, 0.f};
        st.k0 = zp ? z0 : *(const f32x4_t*)kp; st.k1 = zp ? z0 : *(const f32x4_t*)(kp + 4); st.v0 = zp ? z0 : *(const f32x4_t*)vp; st.v1 = zp ? z0 : *(const f32x4_t*)(vp + 4); return; }
    const int slot = mode == 1 ? 2 : 4;
    if (!SMP) kp = c.PROJ + (size_t)(b * SEQ + 64 * n + key) * PLD + C_KV + slot * 128 + g * 64 + d0;
    else { const int pos = 64 * n + key;
        if (pos >= PAST) { const int j = pos - PAST; zero = j >= DSEQ; kp = c.PROJ + (size_t)(TP + b * DSEQ + (zero ? 0 : j)) * PLD + C_KV + slot * 128 + g * 64 + d0; }
        else if (mode == 1) { const int pg = pt[pos / PAGE]; kp = c.cache_nsa + ((((size_t)l * NPHYS + pg) * PAGE + (pos % PAGE)) * 4 + slot) * 128 + g * 64 + d0; }
        else kp = c.cache_win + ((((size_t)l * DB + b) * WIN + (pos - W0S)) * 2 + (slot - 4)) * 128 + g * 64 + d0; }
    const f32x4_t z = {0.f, 0.f, 0.f, 0.f};
    st.k0 = zero ? z : *(const f32x4_t*)kp; st.k1 = zero ? z : *(const f32x4_t*)(kp + 4); st.v0 = zero ? z : *(const f32x4_t*)(kp + 128); st.v1 = zero ? z : *(const f32x4_t*)(kp + 132);
}
DEV void na_store(const NaStage& st, LAS unsigned char* buf, int tid) {
    const int key = tid >> 3, d0 = (tid & 7) * 8;
    *(LAS bf16x8_t*)(buf + key * NA_RS + d0 * 2) = pack8(st.k0, st.k1);
    LAS unsigned short* vt = (LAS unsigned short*)(buf + NA_T);
    const unsigned a = cvtpk(st.v0[0], st.v0[1]), bb = cvtpk(st.v0[2], st.v0[3]), cc = cvtpk(st.v1[0], st.v1[1]), dd = cvtpk(st.v1[2], st.v1[3]);
    vt[(d0 + 0) * (NA_RS / 2) + key] = (unsigned short)a; vt[(d0 + 1) * (NA_RS / 2) + key] = (unsigned short)(a >> 16);
    vt[(d0 + 2) * (NA_RS / 2) + key] = (unsigned short)bb; vt[(d0 + 3) * (NA_RS / 2) + key] = (unsigned short)(bb >> 16);
    vt[(d0 + 4) * (NA_RS / 2) + key] = (unsigned short)cc; vt[(d0 + 5) * (NA_RS / 2) + key] = (unsigned short)(cc >> 16);
    vt[(d0 + 6) * (NA_RS / 2) + key] = (unsigned short)dd; vt[(d0 + 7) * (NA_RS / 2) + key] = (unsigned short)(dd >> 16);
}
DEV void na_scores(const LAS unsigned char* kb, const bf16x8_t (&qf)[4], int lane, f32x16_t& s0, f32x16_t& s1) {
    const int n = lane & 31, hh = lane >> 5;
#pragma unroll
    for (int i = 0; i < 16; ++i) { s0[i] = 0.f; s1[i] = 0.f; }
#pragma unroll
    for (int ks = 0; ks < 4; ++ks) { const bf16x8_t a0 = *(const LAS bf16x8_t*)(kb + n * NA_RS + (16 * ks + 8 * hh) * 2), a1 = *(const LAS bf16x8_t*)(kb + (32 + n) * NA_RS + (16 * ks + 8 * hh) * 2);
        s0 = MFMA32(a0, qf[ks], s0); s1 = MFMA32(a1, qf[ks], s1); }
}
DEV void na_pv(const LAS unsigned char* vb, const f32x16_t& p0, const f32x16_t& p1, int lane, f32x16_t& o0, f32x16_t& o1) {
    const int n = lane & 31, hh = lane >> 5;
#pragma unroll
    for (int s = 0; s < 4; ++s) { const f32x16_t& p = (s < 2) ? p0 : p1; const int e = 8 * (s & 1);
        const bf16x8_t pf = pack8((f32x4_t){p[e], p[e + 1], p[e + 2], p[e + 3]}, (f32x4_t){p[e + 4], p[e + 5], p[e + 6], p[e + 7]});
#pragma unroll
        for (int mt = 0; mt < 2; ++mt) { const LAS unsigned char* vp = vb + (32 * mt + n) * NA_RS + (16 * s + 4 * hh) * 2;
            const u32x2_t lo = *(const LAS u32x2_t*)vp, hi = *(const LAS u32x2_t*)(vp + 16); const u32x4_t w = {lo[0], lo[1], hi[0], hi[1]};
            if (mt == 0) o0 = MFMA32(__builtin_bit_cast(bf16x8_t, w), pf, o0); else o1 = MFMA32(__builtin_bit_cast(bf16x8_t, w), pf, o1); } }
}
template <bool SMP> DEV void nsa_unit(CREF c, int l, LAS unsigned char* L, int b, int qb, int g, int tid) {
    asm volatile("" : "+v"(tid));
    const int lane = tid & 63, wid = tid >> 6, n = lane & 31, hh = lane >> 5, tl = 8 * wid + (n >> 2), r = n & 3, h = 4 * g + r, t = 64 * qb + tl;
    const bool act = !SMP || wid == 0;
    const size_t row = SMP ? (size_t)(TP + b * DSEQ + (tl & 7)) : (size_t)(b * SEQ + t);
    LAS float* IMP = (LAS float*)(L + NA_IMP); LAS unsigned* SELM = (LAS unsigned*)(L + NA_SELM); LAS unsigned* UNI = (LAS unsigned*)(L + NA_UNI);
    LAS int* NIT = (LAS int*)(L + NA_NIT); LAS int* ITEMS = (LAS int*)(L + NA_ITEMS);
    const float slope2 = exp2f(-(float)(h + 1)) * LOG2E;
    bf16x8_t qf[4];
#pragma unroll
    for (int ks = 0; ks < 4; ++ks) { const float* qp = c.PROJ + row * PLD + C_Q + h * 64 + 16 * ks + 8 * hh; const f32x4_t a = *(const f32x4_t*)qp * (0.125f * LOG2E), bq = *(const f32x4_t*)(qp + 4) * (0.125f * LOG2E); qf[ks] = pack8(a, bq); }
    const float* gp = c.PROJ + row * PLD + C_GATE + h * 3; const float g0 = sigmoidf_(gp[0]), g1 = sigmoidf_(gp[1]), g2 = sigmoidf_(gp[2]);
    f32x16_t ot0, ot1, oa0, oa1;
    if (tid < 4) UNI[tid] = 0u;
    LAS int* PT = (LAS int*)(L + NA_PT);
    if (SMP && tid >= 64 && tid < 64 + NPAGES) PT[tid - 64] = c.page_table[b * NPAGES + (tid - 64)];
    const int nbc = (!SMP && qb >= 64) ? 2 : 1;
    { NaStage st; na_load<SMP>(c, st, l, 0, b, g, 0, tid); na_store(st, L, tid); if (nbc == 2) { na_load<SMP>(c, st, l, 0, b, g, 1, tid); na_store(st, L + NA_BUF, tid); } }
    __syncthreads();
    if (act) {
        f32x16_t sa0, sa1, sb0, sb1;
        na_scores(L, qf, lane, sa0, sa1);
        if (nbc == 2) na_scores(L + NA_BUF, qf, lane, sb0, sb1);
        else {
#pragma unroll
            for (int i = 0; i < 16; ++i) { sb0[i] = 0.f; sb1[i] = 0.f; } }
        float m = -1e30f;
#pragma unroll
        for (int i = 0; i < 16; ++i) { const int k0 = crow32(i, hh);
            { const int np = k0;       const bool ok = 64 * np + 63 <= t;              sa0[i] = ok ? sa0[i] - slope2 * ((float)(t - 64 * np) - 31.5f) : -1e30f; m = fmaxf(m, sa0[i]); }
            { const int np = 32 + k0;  const bool ok = 64 * np + 63 <= t;              sa1[i] = ok ? sa1[i] - slope2 * ((float)(t - 64 * np) - 31.5f) : -1e30f; m = fmaxf(m, sa1[i]); }
            { const int np = 64 + k0;  const bool ok = nbc == 2 && 64 * np + 63 <= t;  sb0[i] = ok ? sb0[i] - slope2 * ((float)(t - 64 * np) - 31.5f) : -1e30f; m = fmaxf(m, sb0[i]); }
            { const int np = 96 + k0;  const bool ok = nbc == 2 && 64 * np + 63 <= t;  sb1[i] = ok ? sb1[i] - slope2 * ((float)(t - 64 * np) - 31.5f) : -1e30f; m = fmaxf(m, sb1[i]); } }
        m = fmaxf(m, __shfl_xor(m, 32));
        float ls = 0.f;
#pragma unroll
        for (int i = 0; i < 16; ++i) { sa0[i] = sa0[i] > -1e29f ? exp2f(sa0[i] - m) : 0.f; sa1[i] = sa1[i] > -1e29f ? exp2f(sa1[i] - m) : 0.f;
                                       sb0[i] = sb0[i] > -1e29f ? exp2f(sb0[i] - m) : 0.f; sb1[i] = sb1[i] > -1e29f ? exp2f(sb1[i] - m) : 0.f; ls += (sa0[i] + sa1[i]) + (sb0[i] + sb1[i]); }
        ls += __shfl_xor(ls, 32);
        const float inv = 1.0f / fmaxf(ls, 1e-30f);
#pragma unroll
        for (int i = 0; i < 16; ++i) { sa0[i] *= inv; sa1[i] *= inv; sb0[i] *= inv; sb1[i] *= inv; }
#pragma unroll
        for (int i = 0; i < 16; ++i) { const int k0 = crow32(i, hh);
            float v0 = sa0[i], v1 = sa1[i], v2 = sb0[i], v3 = sb1[i];
            v0 += dppf<DPP_X1>(v0); v1 += dppf<DPP_X1>(v1); v2 += dppf<DPP_X1>(v2); v3 += dppf<DPP_X1>(v3);
            v0 += dppf<DPP_X2>(v0); v1 += dppf<DPP_X2>(v1); v2 += dppf<DPP_X2>(v2); v3 += dppf<DPP_X2>(v3);
            if (r == 0) { IMP[tl * 128 + k0] = v0; IMP[tl * 128 + 32 + k0] = v1; IMP[tl * 128 + 64 + k0] = v2; IMP[tl * 128 + 96 + k0] = v3; } }
#pragma unroll
        for (int i = 0; i < 16; ++i) { oa0[i] = 0.f; oa1[i] = 0.f; }
        na_pv(L + NA_T, sa0, sa1, lane, oa0, oa1);
        if (nbc == 2) na_pv(L + NA_BUF + NA_T, sb0, sb1, lane, oa0, oa1);
#pragma unroll
        for (int i = 0; i < 16; ++i) { ot0[i] = g0 * oa0[i]; ot1[i] = g0 * oa1[i]; }
    }
    __syncthreads();
    {
        const int tk = tid >> 3, s8 = tid & 7, cur = qb;
        if (!SMP || tk < DSEQ) {
        float v[16];
#pragma unroll
        for (int i = 0; i < 16; ++i) { const int nn = 16 * s8 + i; v[i] = (nn >= 1 && nn <= cur - 2) ? IMP[tk * 128 + nn] : -1.0f; }
        unsigned mk0 = 0u, mk1 = 0u, mk2 = 0u, mk3 = 0u;
        const int nforced = cur >= 2 ? 3 : cur + 1;
        for (int rd = 0; rd < TOPK - nforced; ++rd) {
            float bv = -0.5f; int bn = 1000;
#pragma unroll
            for (int i = 0; i < 16; ++i) if (v[i] > bv) { bv = v[i]; bn = 16 * s8 + i; }
            { const float ov = dppf<DPP_X1>(bv); const int on = dppi<DPP_X1>(bn); if (ov > bv || (ov == bv && on < bn)) { bv = ov; bn = on; } }
            { const float ov = dppf<DPP_X2>(bv); const int on = dppi<DPP_X2>(bn); if (ov > bv || (ov == bv && on < bn)) { bv = ov; bn = on; } }
            { const float ov = dppf<DPP_HM>(bv); const int on = dppi<DPP_HM>(bn); if (ov > bv || (ov == bv && on < bn)) { bv = ov; bn = on; } }
            if (bn >= 1000) break;
#pragma unroll
            for (int i = 0; i < 16; ++i) if (16 * s8 + i == bn) v[i] = -1.0f;
            const unsigned bit = 1u << (bn & 31); const int w = bn >> 5;
            mk0 |= w == 0 ? bit : 0u; mk1 |= w == 1 ? bit : 0u; mk2 |= w == 2 ? bit : 0u; mk3 |= w == 3 ? bit : 0u;
        }
#pragma unroll
        for (int f = 0; f < 3; ++f) { const int fn = f == 0 ? 0 : (f == 1 ? cur : cur - 1); if (fn >= 0) { const unsigned bit = 1u << (fn & 31); const int w = fn >> 5;
            mk0 |= w == 0 ? bit : 0u; mk1 |= w == 1 ? bit : 0u; mk2 |= w == 2 ? bit : 0u; mk3 |= w == 3 ? bit : 0u; } }
        if (s8 == 0) { SELM[tk * 4 + 0] = mk0; SELM[tk * 4 + 1] = mk1; SELM[tk * 4 + 2] = mk2; SELM[tk * 4 + 3] = mk3;
            atomicOr((unsigned*)&UNI[0], mk0); atomicOr((unsigned*)&UNI[1], mk1); atomicOr((unsigned*)&UNI[2], mk2); atomicOr((unsigned*)&UNI[3], mk3); }
        }
    }
    __syncthreads();
    int nit;
    {   const unsigned u0 = UNI[0], u1 = UNI[1], u2 = UNI[2], u3 = UNI[3];
        const int nn = qb - tid;
        const int sh = nn + 1;
        auto above = [&](unsigned w, int base) -> int { const int s = sh - base; return s <= 0 ? __popc(w) : (s >= 32 ? 0 : __popc(w >> s)); };
        const int nsel = __popc(u0) + __popc(u1) + __popc(u2) + __popc(u3), nwin = qb >= 8 ? 9 : qb + 1;
        if (nn >= 0) { const unsigned w = nn < 32 ? u0 : (nn < 64 ? u1 : (nn < 96 ? u2 : u3));
            if ((w >> (nn & 31)) & 1u) ITEMS[above(u0, 0) + above(u1, 32) + above(u2, 64) + above(u3, 96)] = nn; }
        if (tid < nwin) ITEMS[nsel + tid] = 256 + qb - tid;
        nit = nsel + nwin; }
    __syncthreads();
    const unsigned sm0 = SELM[tl * 4 + 0], sm1 = SELM[tl * 4 + 1], sm2 = SELM[tl * 4 + 2], sm3 = SELM[tl * 4 + 3];
    float m = -1e30f, ls = 0.f; int curmode = 0;
#pragma unroll
    for (int i = 0; i < 16; ++i) { oa0[i] = 0.f; oa1[i] = 0.f; }
    { NaStage st; const int it0 = ITEMS[0]; na_load<SMP>(c, st, l, 1 + (it0 >> 8), b, g, it0 & 255, tid, PT); na_store(st, L, tid); }
    __syncthreads();
    for (int it = 0; it < nit; ++it) {
        const int item = ITEMS[it], mode = item >> 8, nblk = item & 255;
        NaStage st; const bool more = it + 1 < nit;
        if (more) { const int nx = ITEMS[it + 1]; na_load<SMP>(c, st, l, 1 + (nx >> 8), b, g, nx & 255, tid, PT); }
        if (act) {
        if (mode != curmode) {
            const float lf = ls + __shfl_xor(ls, 32); const float sc = g1 / fmaxf(lf, 1e-30f);
#pragma unroll
            for (int i = 0; i < 16; ++i) { ot0[i] += sc * oa0[i]; ot1[i] += sc * oa1[i]; oa0[i] = 0.f; oa1[i] = 0.f; }
            m = -1e30f; ls = 0.f; curmode = mode; }
        const LAS unsigned char* buf = L + (it & 1) * NA_BUF;
        f32x16_t s0, s1; na_scores(buf, qf, lane, s0, s1);
        const int dbase = 64 * (qb - nblk) + tl;
        const unsigned smw = nblk < 32 ? sm0 : (nblk < 64 ? sm1 : (nblk < 96 ? sm2 : sm3));
        const bool blk_ok = mode == 1 ? true : ((smw >> (nblk & 31)) & 1u) != 0u;
        const bool full = (nblk == qb) || (mode == 1 && nblk == qb - 8);
        float mn, al, psum = 0.f;
        if (full) {
            float mloc = -1e30f;
#pragma unroll
            for (int i = 0; i < 16; ++i) { const int k0 = crow32(i, hh);
                { const int dist = dbase - k0;        const bool ok = blk_ok && dist >= 0 && (mode == 0 || dist < WIN); s0[i] = ok ? s0[i] - slope2 * (float)dist : -1e30f; mloc = fmaxf(mloc, s0[i]); }
                { const int dist = dbase - 32 - k0;   const bool ok = blk_ok && dist >= 0 && (mode == 0 || dist < WIN); s1[i] = ok ? s1[i] - slope2 * (float)dist : -1e30f; mloc = fmaxf(mloc, s1[i]); } }
            mloc = fmaxf(mloc, __shfl_xor(mloc, 32));
            mn = fmaxf(m, mloc); al = __builtin_amdgcn_exp2f(m - mn); m = mn;
#pragma unroll
            for (int i = 0; i < 16; ++i) { s0[i] = s0[i] > -1e29f ? __builtin_amdgcn_exp2f(s0[i] - mn) : 0.f; s1[i] = s1[i] > -1e29f ? __builtin_amdgcn_exp2f(s1[i] - mn) : 0.f; psum += s0[i] + s1[i]; }
        } else {
            const float c0 = -slope2 * (float)(dbase - 4 * hh);
            float tm = -1e30f;
#pragma unroll
            for (int i = 0; i < 16; ++i) { const float ci = (float)((i & 3) + 8 * (i >> 2));
                s0[i] = fmaf(slope2, ci, s0[i]); s1[i] = fmaf(slope2, ci + 32.0f, s1[i]); tm = fmaxf(tm, fmaxf(s0[i], s1[i])); }
            float mloc = blk_ok ? tm + c0 : -1e30f;
            mloc = fmaxf(mloc, __shfl_xor(mloc, 32));
            mn = fmaxf(m, mloc); al = __builtin_amdgcn_exp2f(m - mn); m = mn;
            const float mm = blk_ok ? mn - c0 : 1e30f;
#pragma unroll
            for (int i = 0; i < 16; ++i) { s0[i] = __builtin_amdgcn_exp2f(s0[i] - mm); s1[i] = __builtin_amdgcn_exp2f(s1[i] - mm); psum += s0[i] + s1[i]; }
        }
        ls = ls * al + psum;
        if (__builtin_amdgcn_ballot_w64(al != 1.0f) != 0ull) {
#pragma unroll
            for (int i = 0; i < 16; ++i) { oa0[i] *= al; oa1[i] *= al; } }
        na_pv(buf + NA_T, s0, s1, lane, oa0, oa1);
        }
        if (more) na_store(st, L + ((it + 1) & 1) * NA_BUF, tid);
        __syncthreads();
    }
    if (act) {
    {   const float lf = ls + __shfl_xor(ls, 32); const float sc = g2 / fmaxf(lf, 1e-30f);
#pragma unroll
        for (int i = 0; i < 16; ++i) { ot0[i] += sc * oa0[i]; ot1[i] += sc * oa1[i]; } }
    bf16_t* orow = c.MIXB + row * DM + h * 64;
#pragma unroll
    for (int q4 = 0; q4 < 4; ++q4) { const int d = 8 * q4 + 4 * hh;
        u32x2_t w0 = {cvtpk(ot0[4 * q4], ot0[4 * q4 + 1]), cvtpk(ot0[4 * q4 + 2], ot0[4 * q4 + 3])}; *(u32x2_t*)(orow + d) = w0;
        u32x2_t w1 = {cvtpk(ot1[4 * q4], ot1[4 * q4 + 1]), cvtpk(ot1[4 * q4 + 2], ot1[4 * q4 + 3])}; *(u32x2_t*)(orow + 32 + d) = w1; }
    }
    __syncthreads();
}

DEV void pool_unit(CREF c, int l, int seq, int n, int col) {
    const int slot = col >> 7, g = (col >> 6) & 1;
    const float* src; size_t stride;
    if (seq < BATCH) { src = c.PROJ + (size_t)(seq * SEQ + 64 * n) * PLD + C_KV + col; stride = PLD; }
    else { const int b = seq - BATCH, pg = c.page_table[b * NPAGES + (64 * n) / PAGE]; src = c.cache_nsa + (((size_t)l * NPHYS + pg) * PAGE + ((64 * n) % PAGE)) * 512 + col; stride = 512; }
    const float* w = (slot == 0 ? c.wck : c.wcv) + (l * 2 + g) * 64;
    float a0 = 0.f, a1 = 0.f;
#pragma unroll 16
    for (int j = 0; j < 64; j += 2) { a0 += w[j] * src[(size_t)j * stride]; a1 += w[j + 1] * src[(size_t)(j + 1) * stride]; }
    (slot == 0 ? c.KC : c.VC)[(((size_t)seq * NBMAX + n) * 2 + g) * 64 + (col & 63)] = a0 + a1;
}

DEV void dev_s5_y(CREF c, int l, long gtid, long gn) {
    for (long i = gtid; i < (long)TT * 256; i += gn) { const int r = (int)(i >> 8), ch = (int)(i & 255), g = ch / S5C, cc = ch % S5C;
        const float* cr = c.c_re + (((size_t)l * S5G + g) * S5C + cc) * S5P; const float* ci = c.c_im + (((size_t)l * S5G + g) * S5C + cc) * S5P;
        const f32x4_t* hs = (const f32x4_t*)(c.S5HS + ((size_t)r * S5G + g) * S5P * 2); float y = 0.f;
#pragma unroll 8
        for (int p2 = 0; p2 < S5P / 2; ++p2) { const f32x4_t hv = hs[p2]; y += cr[2 * p2] * hv[0] - ci[2 * p2] * hv[1] + cr[2 * p2 + 1] * hv[2] - ci[2 * p2 + 1] * hv[3]; }
        y += c.s5_d[l * 256 + ch] * c.PROJ[(size_t)r * PLD + C_S5U + ch]; c.GLB[i] = tobf(geluf_(y)); }
}

constexpr int S5_URS = 528, S5_HRS = 4112;
constexpr int S5_U = 0, S5_HT = 64 * S5_URS;
static_assert(S5_HT + 16 * S5_HRS <= 131072, "S5 LDS");
template <bool PASS_B, bool SMP> DEV void s5_unit(CREF c, int l, LAS unsigned char* L, int b, int ch, int tid) {
    asm volatile("" : "+v"(tid));
    constexpr int NT = SMP ? DSEQ : 64, NSB = SMP ? 1 : 4, TSB = SMP ? DSEQ : 16;
    const int r0 = SMP ? TP + b * DSEQ : b * SEQ + ch * 64, lane = tid & 63, wid = tid >> 6, n16 = lane & 15, kg = lane >> 4;
    LAS unsigned char* UB = L + S5_U; LAS unsigned char* BH = L + S5_HT;
    for (int i = tid; i < 16 * (SMP ? 1 : 4) * 64; i += 512) { const int t = i >> 6, q = i & 63; f32x4_t v = {0.f, 0.f, 0.f, 0.f}; if (t < NT) v = *(const f32x4_t*)(c.PROJ + (size_t)(r0 + t) * PLD + C_S5U + 4 * q);
        u32x2_t w = {cvtpk(v[0], v[1]), cvtpk(v[2], v[3])}; *(LAS u32x2_t*)(UB + t * S5_URS + q * 8) = w; }
    float ar[2], ai[2], hr[2], hi[2];
#pragma unroll
    for (int s = 0; s < 2; ++s) { const int idx = tid + 512 * s; const size_t gi = (size_t)l * S5G * S5P + idx;
        ar[s] = c.S5K[gi * 4]; ai[s] = c.S5K[gi * 4 + 1];
        if (SMP) { hr[s] = c.st_s5re[((size_t)l * DB + b) * 1024 + idx]; hi[s] = c.st_s5im[((size_t)l * DB + b) * 1024 + idx]; }
        else if (PASS_B) {
            const float a64r = c.S5K[gi * 4 + 2], a64i = c.S5K[gi * 4 + 3]; float cr_ = 0.f, ci_ = 0.f;
            for (int c0 = 0; c0 < ch; c0 += 16) { f32x2_t e[16];
#pragma unroll
                for (int k = 0; k < 16; ++k) e[k] = (c0 + k < ch) ? *(const f32x2_t*)(c.S5E + (((size_t)b * NCH + c0 + k) * 1024 + idx) * 2) : (f32x2_t){0.f, 0.f};
#pragma unroll
                for (int k = 0; k < 16; ++k) if (c0 + k < ch) { const float nr = a64r * cr_ - a64i * ci_ + e[k][0], ni = a64r * ci_ + a64i * cr_ + e[k][1]; cr_ = nr; ci_ = ni; } }
            hr[s] = cr_; hi[s] = ci_; }
        else { hr[s] = 0.f; hi[s] = 0.f; } }
    bf16x8_t bbf[2][8], ccf[2][4]; float dco[2];
#pragma unroll
    for (int gi2 = 0; gi2 < 2; ++gi2) { const size_t lg = (size_t)l * S5G + 2 * wid + gi2;
#pragma unroll
        for (int j = 0; j < 8; ++j) bbf[gi2][j] = *(const bf16x8_t*)(c.S5BF + ((lg * 8 + j) * 64 + lane) * 8);
        if (PASS_B) {
#pragma unroll
            for (int ks = 0; ks < 4; ++ks) ccf[gi2][ks] = *(const bf16x8_t*)(c.S5CF + ((lg * 4 + ks) * 64 + lane) * 8);
            dco[gi2] = c.s5_d[l * 256 + (2 * wid + gi2) * 16 + n16]; } }
    __syncthreads();
    const f32x4_t z4 = {0.f, 0.f, 0.f, 0.f}; const bf16x8_t zf = {0, 0, 0, 0, 0, 0, 0, 0};
    for (int sb = 0; sb < NSB; ++sb) {
#pragma unroll
        for (int gi2 = 0; gi2 < 2; ++gi2) { const int g = 2 * wid + gi2;
            const bf16x8_t af = kg < 2 ? *(const LAS bf16x8_t*)(UB + (16 * sb + n16) * S5_URS + (16 * g + 8 * kg) * 2) : zf;
#pragma unroll
            for (int j = 0; j < 8; ++j) { const f32x4_t acc = MFMA16(af, bbf[gi2][j], z4);
                LAS unsigned short* o = (LAS unsigned short*)(BH + (4 * kg) * S5_HRS + (g * 128 + 16 * j + n16) * 2);
                const unsigned p01 = cvtpk(acc[0], acc[1]), p23 = cvtpk(acc[2], acc[3]);
                o[0] = (unsigned short)p01; o[S5_HRS / 2] = (unsigned short)(p01 >> 16); o[S5_HRS] = (unsigned short)p23; o[3 * (S5_HRS / 2)] = (unsigned short)(p23 >> 16); } }
        __syncthreads();
#pragma unroll 4
        for (int tt = 0; tt < TSB; ++tt) {
#pragma unroll
            for (int s = 0; s < 2; ++s) { LAS unsigned* bp = (LAS unsigned*)(BH + tt * S5_HRS + (tid + 512 * s) * 4); const unsigned w = *bp;
                const float br = __uint_as_float(w << 16), bi = __uint_as_float(w & 0xffff0000u);
                const float nr = ar[s] * hr[s] - ai[s] * hi[s] + br, ni = ar[s] * hi[s] + ai[s] * hr[s] + bi; hr[s] = nr; hi[s] = ni;
                if (PASS_B) *bp = cvtpk(nr, ni); } }
        if (PASS_B) {
            __syncthreads();
#pragma unroll
            for (int gi2 = 0; gi2 < 2; ++gi2) { const int g = 2 * wid + gi2; f32x4_t y = z4;
#pragma unroll
                for (int ks = 0; ks < 4; ++ks) { const bf16x8_t hf = *(const LAS bf16x8_t*)(BH + n16 * S5_HRS + (g * 128 + 32 * ks + 8 * kg) * 2); y = MFMA16(hf, ccf[gi2][ks], y); }
#pragma unroll
                for (int i = 0; i < 4; ++i) { const int t = 16 * sb + 4 * kg + i;
                    if (t < NT) { const float uu = __uint_as_float(((unsigned)*(const LAS unsigned short*)(UB + t * S5_URS + (16 * g + n16) * 2)) << 16);
                        *(LAS unsigned short*)(UB + t * S5_URS + (16 * g + n16) * 2) = tobf(geluf_(y[i] + dco[gi2] * uu)); } } }
        }
        __syncthreads();
    }
    if (PASS_B) {
        bf16x8_t wf[2][8];
#pragma unroll
        for (int nt = 0; nt < 2; ++nt)
#pragma unroll
            for (int ks = 0; ks < 8; ++ks) wf[nt][ks] = *(const bf16x8_t*)(c.WGLU_T + (size_t)l * 65536 + (size_t)(32 * wid + 16 * nt + n16) * 256 + 32 * ks + 8 * kg);
#pragma unroll 1
        for (int mt = 0; mt < (SMP ? 1 : 4); ++mt) { f32x4_t a0 = z4, a1 = z4;
#pragma unroll
            for (int ks = 0; ks < 8; ++ks) { const bf16x8_t af = *(const LAS bf16x8_t*)(UB + (16 * mt + n16) * S5_URS + (32 * ks + 8 * kg) * 2); a0 = MFMA16(af, wf[0][ks], a0); a1 = MFMA16(af, wf[1][ks], a1); }
#pragma unroll
            for (int i = 0; i < 4; ++i) { const int t = 16 * mt + 4 * kg + i;
                if (t < NT) {
#pragma unroll
                    for (int nt = 0; nt < 2; ++nt) { const int col = 32 * wid + 16 * nt + n16; const float z = nt == 0 ? a0[i] : a1[i];
                        const float gl = __uint_as_float(((unsigned)*(const LAS unsigned short*)(UB + t * S5_URS + col * 2)) << 16);
                        c.MIXB[(size_t)(r0 + t) * DM + 768 + col] = tobf(gl * __builtin_amdgcn_rcpf(1.0f + __expf(-z))); } } } } }
#pragma unroll
    for (int s = 0; s < 2; ++s) { const int idx = tid + 512 * s;
        if (SMP) { c.out[O_S5RS + ((size_t)l * DB + b) * 1024 + idx] = hr[s]; c.out[O_S5IS + ((size_t)l * DB + b) * 1024 + idx] = hi[s]; }
        else if (!PASS_B) { const size_t e = (((size_t)b * NCH + ch) * 1024 + idx) * 2; c.S5E[e] = hr[s]; c.S5E[e + 1] = hi[s]; } }
    __syncthreads();
}

DEV void dn_sample_unit(CREF c, int l, LAS unsigned char* L, int b, int tid) {
    asm volatile("" : "+v"(tid));
    LAS float* Y = (LAS float*)L;
    LAS float* sm = Y + 8 * 768;
    const int r0 = TP + b * DSEQ, lane = tid & 63, wid = tid >> 6;
    for (int idx = tid; idx < 8 * 768; idx += 512) { const int t = idx / 768, cch = idx % 768; const f32x4_t w = *(const f32x4_t*)(c.conv_w + ((size_t)l * CONVD + cch) * 4); float y = 0.f;
#pragma unroll
        for (int j = 0; j < 4; ++j) { const int tt = t - 3 + j; y += w[j] * (tt >= 0 ? c.PROJ[(size_t)(r0 + tt) * PLD + C_DNQKV + cch] : c.st_conv[(((size_t)l * DB + b) * 3 + 3 + tt) * CONVD + cch]); }
        Y[idx] = y / (1.0f + expf(-y)); }
    if (tid < 32) { const int t = tid >> 2, h = tid & 3; sm[64 + tid] = sigmoidf_(c.PROJ[(size_t)(r0 + t) * PLD + C_DNB + h]);
        sm[96 + tid] = expf(-expf(c.a_log[l * DNH + h]) * softplusf_(c.PROJ[(size_t)(r0 + t) * PLD + C_DNA + h] + c.dt_bias[l * DNH + h])); }
    __syncthreads();
    for (int rr = wid * 8; rr < wid * 8 + 8; ++rr) { const int t = rr >> 3, part = (rr >> 2) & 1, h = rr & 3; const float y = Y[t * 768 + part * 256 + h * 64 + lane]; const float ss = wave_sum(y * y);
        if (lane == 0) sm[rr] = (part == 0 ? 0.125f : 1.0f) / sqrtf(ss + 1e-6f); }
    __syncthreads();
    if (tid < 256) { const int h = tid >> 6, jc = tid & 63; float S[64]; const float* s0 = c.st_dn + (((size_t)l * DB + b) * DNH + h) * 4096 + jc;
#pragma unroll
        for (int kk = 0; kk < 64; ++kk) S[kk] = s0[kk * 64];
        const float nw = c.dn_norm_w[l * 64 + jc];
        for (int t = 0; t < DSEQ; ++t) { const LAS float* qp = Y + t * 768 + h * 64; const LAS float* kp = qp + 256; const float qs = sm[t * 8 + h], ksc = sm[t * 8 + 4 + h], a = sm[96 + t * 4 + h], be = sm[64 + t * 4 + h];
            float ks = 0.f;
#pragma unroll
            for (int kk = 0; kk < 64; ++kk) { S[kk] *= a; ks += kp[kk] * S[kk]; }
            const float vn = be * (Y[t * 768 + 512 + h * 64 + jc] - ks * ksc), kv = vn * ksc; float os = 0.f;
#pragma unroll
            for (int kk = 0; kk < 64; ++kk) { S[kk] += kp[kk] * kv; os += qp[kk] * S[kk]; }
            os *= qs;
            const float ss = wave_sum(os * os); const float z = c.PROJ[(size_t)(r0 + t) * PLD + C_DNZ + h * 64 + jc];
            c.MIXB[(size_t)(r0 + t) * DM + 512 + h * 64 + jc] = tobf(os / sqrtf(ss * (1.0f / 64.0f) + NEPS) * nw * (z / (1.0f + expf(-z)))); }
#pragma unroll
        for (int kk = 0; kk < 64; ++kk) c.out[O_DNS + (((size_t)l * DB + b) * DNH + h) * 4096 + kk * 64 + jc] = S[kk]; }
    __syncthreads();
}
DEV void s5_carry_unit(CREF c, int l, int b, int tid) {
    for (int s = 0; s < 2; ++s) { const int idx = tid + 512 * s; const float* K = c.S5K + ((size_t)l * 1024 + idx) * 4; const float a64r = K[2], a64i = K[3]; float hr = 0.f, hi = 0.f;
        for (int c0 = 0; c0 < NCH; c0 += 16) { f32x2_t e[16];
#pragma unroll
            for (int k = 0; k < 16; ++k) e[k] = *(const f32x2_t*)(c.S5E + (((size_t)b * NCH + c0 + k) * 1024 + idx) * 2);
#pragma unroll
            for (int k = 0; k < 16; ++k) { *(f32x2_t*)(c.S5HIN + (((size_t)b * NCH + c0 + k) * 1024 + idx) * 2) = (f32x2_t){hr, hi};
                const float nr = a64r * hr - a64i * hi + e[k][0], ni = a64r * hi + a64i * hr + e[k][1]; hr = nr; hi = ni; } }
        c.out[O_S5RP + ((size_t)l * BATCH + b) * 1024 + idx] = hr; c.out[O_S5IP + ((size_t)l * BATCH + b) * 1024 + idx] = hi; }
}
#ifndef N_LAUNCH_MODE
#define N_LAUNCH_MODE 1
#endif
namespace pg8 {
template <bool ADD> struct EpiF32 {
    static constexpr bool PERM = false, AFTER_DRAIN = false;
    float* C; int ldc;
    __device__ __forceinline__ void operator()(const f32x4 (&acc)[2][2][4][2], const Unit& u, int wr, int wc, int fr, int fq) const {
        const int row0 = u.pm * BM + wr * 64 + fr, col0 = u.pn * BM + wc * 32 + 4 * fq;
#pragma unroll
        for (int ai = 0; ai < 2; ++ai)
#pragma unroll
            for (int m = 0; m < 4; ++m) { float* rowp = C + (size_t)(row0 + ai * HALF + m * 16) * ldc + col0;
#pragma unroll
                for (int bj = 0; bj < 2; ++bj)
#pragma unroll
                    for (int n = 0; n < 2; ++n) { f32x4 v = acc[ai][bj][m][n]; if (ADD) v += *(const f32x4*)(rowp + bj * HALF + n * 16); *(f32x4*)(rowp + bj * HALF + n * 16) = v; } }
    }
};
struct EpiSqReluBf16 {
    static constexpr bool PERM = true, AFTER_DRAIN = false;
    bf16_t* O; int ldc;
    __device__ __forceinline__ void operator()(const f32x4 (&acc)[2][2][4][2], const Unit& u, int wr, int wc, int fr, int fq) const {
        const int row0 = u.pm * BM + wr * 64 + fr, col0 = u.pn * BM + wc * 32 + 8 * fq;
#pragma unroll
        for (int ai = 0; ai < 2; ++ai)
#pragma unroll
            for (int m = 0; m < 4; ++m) { bf16_t* rowp = O + (size_t)(row0 + ai * HALF + m * 16) * ldc + col0;
#pragma unroll
                for (int bj = 0; bj < 2; ++bj) { f32x4 v0 = acc[ai][bj][m][0], v1 = acc[ai][bj][m][1];
#pragma unroll
                    for (int j = 0; j < 4; ++j) { const float a = v0[j] > 0.f ? v0[j] : 0.f, b = v1[j] > 0.f ? v1[j] : 0.f; v0[j] = a * a; v1[j] = b * b; }
                    u32x4 w; w.x = cvt_pk_bf16(v0[0], v0[1]); w.y = cvt_pk_bf16(v0[2], v0[3]); w.z = cvt_pk_bf16(v1[0], v1[1]); w.w = cvt_pk_bf16(v1[2], v1[3]);
                    *(u32x4*)(rowp + bj * HALF) = w; } }
    }
};
struct EpiGluBf16 {
    static constexpr bool PERM = true, AFTER_DRAIN = false;
    bf16_t* O; int ldc; const bf16_t* GLv;
    __device__ __forceinline__ void operator()(const f32x4 (&acc)[2][2][4][2], const Unit& u, int wr, int wc, int fr_, int fq_) const {
        int ln; asm volatile("v_mbcnt_lo_u32_b32 %0, -1, 0\n\tv_mbcnt_hi_u32_b32 %0, -1, %0" : "=v"(ln)); const int fr = ln & 15, fq = ln >> 4;
        const int row0 = u.pm * BM + wr * 64 + fr, col0 = u.pn * BM + wc * 32 + 8 * fq;
#pragma unroll
        for (int ai = 0; ai < 2; ++ai)
#pragma unroll
            for (int m = 0; m < 4; ++m) { const size_t r = (size_t)(row0 + ai * HALF + m * 16);
#pragma unroll
                for (int bj = 0; bj < 2; ++bj) { const u32x4 gv = *(const u32x4*)(GLv + r * 256 + col0 + bj * HALF); f32x4 v0 = acc[ai][bj][m][0], v1 = acc[ai][bj][m][1];
#pragma unroll
                    for (int j = 0; j < 4; ++j) { v0[j] = __builtin_amdgcn_rcpf(1.0f + __expf(-v0[j])); v1[j] = __builtin_amdgcn_rcpf(1.0f + __expf(-v1[j])); }
                    v0[0] *= __uint_as_float(gv[0] << 16); v0[1] *= __uint_as_float(gv[0] & 0xffff0000u); v0[2] *= __uint_as_float(gv[1] << 16); v0[3] *= __uint_as_float(gv[1] & 0xffff0000u);
                    v1[0] *= __uint_as_float(gv[2] << 16); v1[1] *= __uint_as_float(gv[2] & 0xffff0000u); v1[2] *= __uint_as_float(gv[3] << 16); v1[3] *= __uint_as_float(gv[3] & 0xffff0000u);
                    u32x4 w; w.x = cvt_pk_bf16(v0[0], v0[1]); w.y = cvt_pk_bf16(v0[2], v0[3]); w.z = cvt_pk_bf16(v1[0], v1[1]); w.w = cvt_pk_bf16(v1[2], v1[3]);
                    *(u32x4*)(O + r * ldc + col0 + bj * HALF) = w; } }
    }
};
}

#define XB_TMO      128
#define XB_XCNT(j)  (256  + 64 * (j))
#define XB_XSUB(j)  (1280 + 64 * (j))
#define XB_XGEN(j)  (2304 + 64 * (j))
#define XB_TOP      3328
#define XB_TOPGEN   3392
#define XCD_BAR_WORDS 3456
#define XB_SPIN_CAP (1u << 24)
__device__ __forceinline__ unsigned xb_ld(unsigned* p)              { return __hip_atomic_load(p, __ATOMIC_RELAXED, __HIP_MEMORY_SCOPE_AGENT); }
__device__ __forceinline__ unsigned xb_add(unsigned* p, unsigned v) { return __hip_atomic_fetch_add(p, v, __ATOMIC_RELAXED, __HIP_MEMORY_SCOPE_AGENT); }
__device__ __forceinline__ unsigned xb_xcc_id() { return (unsigned)__builtin_amdgcn_s_getreg((3 << 11) | 20) & 0xFu; }
#define XB_SPIN(cond, bar) do { unsigned _sp = 0; while (cond) { __builtin_amdgcn_s_sleep(1); \
    if ((++_sp & 255u) == 0u) { if (xb_ld(&(bar)[XB_TMO])) break; if (_sp > XB_SPIN_CAP) { atomicAdd(&(bar)[XB_TMO], 1u); break; } } } } while (0)
struct XcdBarrier { unsigned* bar; unsigned x; volatile LAS unsigned* st; };
__device__ __forceinline__ XcdBarrier xcd_barrier_post(unsigned* bar, volatile LAS unsigned* st) {
    XcdBarrier b; b.bar = bar; b.x = xb_xcc_id(); b.st = st;
    if (threadIdx.x == 0) (void)xb_add(&bar[XB_XCNT(b.x)], 1u);
    return b;
}
__device__ __forceinline__ void xcd_barrier_complete(unsigned* bar, unsigned x, unsigned& nloc, unsigned& nx) {
    const unsigned G = gridDim.x * gridDim.y * gridDim.z;
    unsigned sum, cnt, mine, sp = 0u;
    for (;;) {
        sum = 0u; cnt = 0u; mine = 0u;
#pragma unroll
        for (unsigned j = 0; j < 16; ++j) { const unsigned c = xb_ld(&bar[XB_XCNT(j)]); sum += c; cnt += (c > 0u) ? 1u : 0u; mine = (j == x) ? c : mine; }
        if (sum == G) break;
        __builtin_amdgcn_s_sleep(1);
        if ((++sp & 255u) == 0u) { if (xb_ld(&bar[XB_TMO])) break; if (sp > XB_SPIN_CAP) { atomicAdd(&bar[XB_TMO], 1u); break; } }
    }
    nloc = mine > 0u ? mine : 1u; nx = cnt > 0u ? cnt : 1u;
}
__device__ __forceinline__ void xcd_barrier(const XcdBarrier& b, const bool t0) {
    asm volatile("s_waitcnt vmcnt(0)" ::: "memory");
    __syncthreads();
    if (t0) {
        unsigned* bar = b.bar; unsigned bx = b.x; asm volatile("" : "+s"(bar), "+s"(bx));
        __builtin_amdgcn_s_waitcnt(0);
        unsigned nloc = b.st[0], nx = b.st[1];
        if (nloc == 0u) { xcd_barrier_complete(bar, bx, nloc, nx); b.st[0] = nloc; b.st[1] = nx; }
        const unsigned old = xb_add(&bar[XB_XSUB(bx)], 1u);
        const unsigned gen = old / nloc;
        if (old + 1u == (gen + 1u) * nloc) {
            __builtin_amdgcn_fence(__ATOMIC_RELEASE, "agent");
            asm volatile("s_waitcnt vmcnt(0)" ::: "memory");
            const unsigned og = xb_add(&bar[XB_TOP], 1u);
            const unsigned tg = og / nx;
            if (og + 1u == (tg + 1u) * nx) xb_add(&bar[XB_TOPGEN], 1u);
            else XB_SPIN(xb_ld(&bar[XB_TOPGEN]) == tg, bar);
            __builtin_amdgcn_fence(__ATOMIC_ACQUIRE, "agent");
            xb_add(&bar[XB_XGEN(bx)], 1u);
            asm volatile("s_waitcnt vmcnt(0)" ::: "memory");
        } else {
            XB_SPIN(xb_ld(&bar[XB_XGEN(bx)]) == gen, bar);
            __builtin_amdgcn_fence(__ATOMIC_ACQUIRE, "agent");
            asm volatile("s_waitcnt vmcnt(0)" ::: "memory");
        }
    }
    __syncthreads();
}

constexpr int RING_BYTES = 131072, LDS_BYTES = 147456, LDSCTL_OFF = LDS_BYTES - 256;
constexpr int NTHREADS = 512;
constexpr size_t al256(size_t x) { return (x + 255) & ~(size_t)255; }
constexpr size_t WS_CTL = 0, CTL_BYTES = 65536;
constexpr size_t WS_X = al256(WS_CTL + CTL_BYTES), WS_SSQ = al256(WS_X + (size_t)TT * DM * 4), WS_XN = al256(WS_SSQ + (size_t)TT * 64 * 4),
    WS_PROJ = al256(WS_XN + (size_t)TT * DM * 2), WS_MIXB = al256(WS_PROJ + (size_t)TT * PLD * 4), WS_UPB = al256(WS_MIXB + (size_t)TT * DM * 2),
    WS_WIN = al256(WS_UPB + (size_t)TT * DFF * 2), WS_WOUT = al256(WS_WIN + (size_t)2 * PLD * DM * 2), WS_WUP = al256(WS_WOUT + (size_t)2 * DM * DM * 2),
    WS_WDN = al256(WS_WUP + (size_t)2 * DFF * DM * 2), WS_KC = al256(WS_WDN + (size_t)2 * DM * DFF * 2), WS_VC = al256(WS_KC + (size_t)NSEQ * NBMAX * 128 * 4),
    WS_PC = al256(WS_VC + (size_t)NSEQ * NBMAX * 128 * 4), WS_OC = al256(WS_PC + (size_t)TT * NH * NBMAX * 4), WS_IDX = al256(WS_OC + (size_t)TT * NH * 64 * 4),
    WS_QN = al256(WS_IDX + (size_t)TT * NG * TOPK * 4), WS_KN = al256(WS_QN + (size_t)TT * 256 * 4), WS_VV = al256(WS_KN + (size_t)TT * 256 * 4),
    WS_GG = al256(WS_VV + (size_t)TT * 256 * 4), WS_BETA = al256(WS_GG + (size_t)TT * DNH * 4), WS_GC = al256(WS_BETA + (size_t)TT * DNH * 4),
    WS_AM = al256(WS_GC + (size_t)NDU * 64 * 4), WS_AQK = al256(WS_AM + (size_t)NDU * 4096 * 4), WS_SOL = al256(WS_AQK + (size_t)NDU * 4096 * 4),
    WS_VNEW = al256(WS_SOL + (size_t)NDU * 8192 * 4), WS_SDN = al256(WS_VNEW + (size_t)BATCH * DNH * 4096 * 4), WS_ODN = al256(WS_SDN + (size_t)BATCH * DNH * 4096 * 4),
    WS_S5K = al256(WS_ODN + (size_t)TT * 256 * 4), WS_S5BB = al256(WS_S5K + 2 * S5G * S5P * 4 * 4), WS_S5E = al256(WS_S5BB + 2 * S5G * S5P * S5C * 2 * 4),
    WS_S5HIN = al256(WS_S5E + (size_t)BATCH * NCH * 2048 * 4), WS_S5HS = al256(WS_S5HIN + (size_t)BATCH * NCH * 2048 * 4), WS_GL = al256(WS_S5HS + (size_t)TT * 2048 * 4),
    WS_GLB = al256(WS_GL + (size_t)TT * 256 * 4), WS_WGLU = al256(WS_GLB + (size_t)TT * 256 * 2), WS_PART = al256(WS_WGLU + (size_t)2 * 65536 * 2), WS_DNF = al256(WS_PART + (size_t)8 * TS * DM * 4), WS_DNU = al256(WS_DNF + (size_t)NDU * 16384 * 2), WS_DNE = al256(WS_DNU + (size_t)NDU * 4096 * 4), WS_DNG = al256(WS_DNE + (size_t)NDU * 4), WS_S5BF = al256(WS_DNG + (size_t)NDU * 4096 * 2), WS_S5CF = al256(WS_S5BF + (size_t)2 * 16 * 8 * 64 * 8 * 2), WS_END = al256(WS_S5CF + (size_t)2 * 16 * 4 * 64 * 8 * 2);

struct Args { Ctx c; unsigned* bar; int lo, hi; };
constexpr int NPH = 1 + 2 * 14 + 2;
typedef const __attribute__((address_space(4))) unsigned char* karg_t;
__device__ __forceinline__ int lane_id() { return (int)__builtin_amdgcn_mbcnt_hi(~0u, __builtin_amdgcn_mbcnt_lo(~0u, 0u)); }
__device__ __forceinline__ int lane_id_v() { int t; asm volatile("v_mbcnt_lo_u32_b32 %0, -1, 0\n\tv_mbcnt_hi_u32_b32 %0, -1, %0" : "=v"(t)); return t; }
#define TIDV (wv * 64 + lane_id_v())
template <int P> __device__ __forceinline__ void run_phase(const int l, LAS unsigned char* L, const int wv) {
    karg_t kp = (karg_t)__builtin_amdgcn_kernarg_segment_ptr(); asm volatile("" : "+s"(kp));
    CREF c = *(const __attribute__((address_space(4))) Ctx*)kp;
    int tx_ = wv * 64 + lane_id_v(), bx_ = blockIdx.x; asm volatile("" : "+v"(tx_), "+s"(bx_));
    const long gtid = (long)bx_ * NTHREADS + tx_, gn = (long)gridDim.x * NTHREADS;
    const int G = (int)gridDim.x;
    if constexpr (P == 0) { dev_prologue(c, L, bx_, tx_, gtid, gn); dev_s5_consts(c, (long)(G - 1 - bx_) * NTHREADS + tx_, gn);   }
    if constexpr (P == 2) dev_rmsnorm<false>(c, c.ln1 + l * DM, bx_, tx_, l == 0 ? 0 : 8);
    if constexpr (P == 3) { pg8::Gemm g{c.XN, c.WIN_T + (size_t)l * PLD * DM, TT, PLD, DM, DM}; pg8::StaticOrder S; S.init(TT, PLD, G, bx_);
        pg8::EpiF32<false> E{c.PROJ, PLD}; pg8::gemm_phase<pg8::EpiF32<false>, pg8::StaticOrder, true, true>(L, g, S, E, wv * 64 + lane_id_v()); }
    if constexpr (P == 4) { for (int u = bx_; u < NDU; u += G) dn_prep_unit(c, l, L, u, TIDV);
        for (int u = bx_; u < BATCH * NCH; u += G) s5_unit<false, false>(c, l, L, u / NCH, u % NCH, TIDV);
        constexpr int NPU = BATCH * NBP + DB * NBC_S;
        { const int t = TIDV; for (int u = 2 * bx_ + (t >> 8); u < NPU; u += 2 * G) { if (u < BATCH * NBP) pool_unit(c, l, u / NBP, u % NBP, t & 255); else pool_unit(c, l, BATCH + (u - BATCH * NBP) / NBC_S, (u - BATCH * NBP) % NBC_S, t & 255); } } }
    if constexpr (P == 5) {
        if (bx_ < BATCH * DNH) dn_scan_mfma(c, l, L, bx_, TIDV);
        constexpr int NU = BATCH * NG * NBP;
        volatile LAS int* qslot = (volatile LAS int*)(L + LDSCTL_OFF + 64);
#define QLOOP(qi, count, ...) for (;;) { if (wv == 0 && lane_id_v() == 0) qslot[0] = (int)__hip_atomic_fetch_add(c.QCTR + 64 * (8 * l + (qi)), 1u, __ATOMIC_RELAXED, __HIP_MEMORY_SCOPE_AGENT); \
            __syncthreads(); const int it = qslot[0]; __syncthreads(); if (it >= (count)) break; __VA_ARGS__; }
        const int grp = (bx_ >> 3) & 7; const bool memfirst = grp == 1 || grp == 3 || grp == 5;
        if (memfirst) { QLOOP(4, 256, dev_copy_out(c, l, (long)it * NTHREADS + TIDV, (long)256 * NTHREADS)) }
        for (;;) { if (wv == 0 && lane_id_v() == 0) qslot[0] = memfirst ? 0x7fffffff : (int)__hip_atomic_fetch_add(c.QCTR + 64 * (8 * l + 0), 1u, __ATOMIC_RELAXED, __HIP_MEMORY_SCOPE_AGENT);
            __syncthreads(); const int it = qslot[0]; __syncthreads(); if (it >= NU) break;
            const int qb = NBP - 1 - it / (BATCH * NG), bg = it % (BATCH * NG); nsa_unit<false>(c, l, L, bg / NG, qb, bg % NG, TIDV); }
        QLOOP(1, DB * NG, nsa_unit<true>(c, l, L, it / NG, PAST / 64, it % NG, TIDV))
        QLOOP(2, DB, dn_sample_unit(c, l, L, it, TIDV))
        QLOOP(3, BATCH, s5_carry_unit(c, l, it, TIDV))
        QLOOP(5, BATCH * NCH + DB, { if (it < BATCH * NCH) s5_unit<true, false>(c, l, L, it / NCH, it % NCH, TIDV); else s5_unit<true, true>(c, l, L, it - BATCH * NCH, 0, TIDV); })
        QLOOP(4, 256, dev_copy_out(c, l, (long)it * NTHREADS + TIDV, (long)256 * NTHREADS))
#undef QLOOP
    }
    if constexpr (P == 9) dev_dn_out(c, l, bx_, tx_);
    if constexpr (P == 10) {
        { pg8::Gemm g{c.MIXB, c.WOUT_T + (size_t)l * DM * DM, TP, DM, DM, DM}; pg8::StaticOrder S; S.init(TP, DM, G, bx_);
          pg8::EpiF32<true> E{c.X, DM}; pg8::gemm_phase<pg8::EpiF32<true>, pg8::StaticOrder, true, true>(L, g, S, E, wv * 64 + lane_id_v()); }
        if (bx_ < 64) { const int ks = bx_ >> 4; pg8::Gemm g{c.MIXB + (size_t)TP * DM + ks * 256, c.WOUT_T + (size_t)l * DM * DM + ks * 256, TS, DM, 256, DM}; pg8::StaticOrder S; S.init(TS, DM, 16, bx_ & 15);
          pg8::EpiF32<false> E{c.PART + (size_t)ks * TS * DM, DM}; pg8::gemm_phase<pg8::EpiF32<false>, pg8::StaticOrder, true, true>(L, g, S, E, wv * 64 + lane_id_v()); } }
    if constexpr (P == 11) dev_rmsnorm<false>(c, c.ln2 + l * DM, bx_, tx_, 4);
    if constexpr (P == 12) { pg8::Gemm g{c.XN, c.WUP_T + (size_t)l * DFF * DM, TT, DFF, DM, DM}; pg8::StaticOrder S; S.init(TT, DFF, G, bx_);
        pg8::EpiSqReluBf16 E{c.UPB, DFF}; pg8::gemm_phase<pg8::EpiSqReluBf16, pg8::StaticOrder, true, true>(L, g, S, E, wv * 64 + lane_id_v());
        if (l == 0) {
            const int nbusy = ((TT / 256) * (DFF / 256)) % G, first = nbusy < G ? nbusy : 0;
            __syncthreads();
            if (bx_ >= first) dev_transposes(c, L, 1, (bx_ - first) * 8 + wv, (G - first) * 8, wv, lane_id_v()); } }
    if constexpr (P == 13) {
        { pg8::Gemm g{c.UPB, c.WDN_T + (size_t)l * DM * DFF, TP, DM, DFF, DFF}; pg8::StaticOrder S; S.init(TP, DM, G, bx_);
          pg8::EpiF32<true> E{c.X, DM}; pg8::gemm_phase<pg8::EpiF32<true>, pg8::StaticOrder, true, true>(L, g, S, E, wv * 64 + lane_id_v()); }
        if (bx_ < 128) { const int ks = bx_ >> 4; pg8::Gemm g{c.UPB + (size_t)TP * DFF + ks * 512, c.WDN_T + (size_t)l * DM * DFF + ks * 512, TS, DM, 512, DFF}; pg8::StaticOrder S; S.init(TS, DM, 16, bx_ & 15);
          pg8::EpiF32<false> E{c.PART + (size_t)ks * TS * DM, DM}; pg8::gemm_phase<pg8::EpiF32<false>, pg8::StaticOrder, true, true>(L, g, S, E, wv * 64 + lane_id_v()); } }
    if constexpr (P == 14) dev_rmsnorm<true>(c, c.ln_f, bx_, tx_, 8);
}
#if N_LAUNCH_MODE == 1
__global__ void __launch_bounds__(NTHREADS, 2) fwd_kernel(Args a) {
    extern __shared__ __attribute__((aligned(16))) unsigned char lds[];
    LAS unsigned char* L = (LAS unsigned char*)lds;
    volatile LAS unsigned* MISC = (volatile LAS unsigned*)(L + LDSCTL_OFF);
    for (int u = threadIdx.x; u < (LDS_BYTES - LDSCTL_OFF) / 4; u += NTHREADS) ((LAS unsigned*)(L + LDSCTL_OFF))[u] = 0u;
    __syncthreads();
    XcdBarrier bar = xcd_barrier_post(a.bar, MISC + 8);
    const int wv = __builtin_amdgcn_readfirstlane((int)threadIdx.x >> 6);
#define PHASE(P, l) do { run_phase<P>(l, L, wv); xcd_barrier(bar, wv == 0 && lane_id_v() == 0); } while (0)
    PHASE(0, 0);
#define LAYER(l) PHASE(2, l); PHASE(3, l); PHASE(4, l); PHASE(5, l); PHASE(10, l); PHASE(11, l); PHASE(12, l); PHASE(13, l)
#define LAYER0 PHASE(3, 0); PHASE(4, 0); PHASE(5, 0); PHASE(10, 0); PHASE(11, 0); PHASE(12, 0); PHASE(13, 0)
    LAYER0; LAYER(1);
#undef LAYER
    run_phase<14>(0, L, wv);
#undef PHASE
}
#else
template <int P> __global__ void __launch_bounds__(NTHREADS, 2) k_phase(Args a) {
    extern __shared__ __attribute__((aligned(16))) unsigned char lds[];
    run_phase<P>(a.lo, (LAS unsigned char*)lds, __builtin_amdgcn_readfirstlane((int)threadIdx.x >> 6));
}
template <int P> static void launch_phase(const Args& a, int grid, hipStream_t stream) {
    static bool attr = false;
    if (!attr) { (void)hipFuncSetAttribute((const void*)k_phase<P>, hipFuncAttributeMaxDynamicSharedMemorySize, LDS_BYTES); attr = true; }
    hipLaunchKernelGGL(k_phase<P>, dim3(grid), dim3(NTHREADS), LDS_BYTES, stream, a);
}
#endif

extern "C" void kernel_launch(void* const* d_in, const int* in_sizes, int n_in, void* d_out, int out_size, void* d_ws, size_t ws_size, hipStream_t stream) {
    static int grid = 0;
    if (grid == 0) {
        if (n_in != 31 || in_sizes[0] != TP * DM || (size_t)out_size != O_END || ws_size < WS_END) { fprintf(stderr, "kernel_launch: shape mismatch (n_in %d in0 %d out %d ws %zu need %zu)\n", n_in, n_in > 0 ? in_sizes[0] : -1, out_size, ws_size, (size_t)WS_END); grid = -1; return; }
        int dev = 0, cus = 0;
        if (hipGetDevice(&dev) != hipSuccess || hipDeviceGetAttribute(&cus, hipDeviceAttributeMultiprocessorCount, dev) != hipSuccess) { grid = -1; return; }
#if N_LAUNCH_MODE == 1
        int per_cu = 0;
        if (hipFuncSetAttribute((const void*)fwd_kernel, hipFuncAttributeMaxDynamicSharedMemorySize, LDS_BYTES) != hipSuccess) { fprintf(stderr, "kernel_launch: hipFuncSetAttribute failed\n"); grid = -1; return; }
        if (hipOccupancyMaxActiveBlocksPerMultiprocessor(&per_cu, (const void*)fwd_kernel, NTHREADS, LDS_BYTES) != hipSuccess || per_cu < 1) fprintf(stderr, "kernel_launch: occupancy query reports %d\n", per_cu);
        (void)hipGetLastError();
#endif
        grid = cus;
    }
    if (grid < 0) return;
    if (hipMemsetAsync((char*)d_ws + WS_CTL, 0, CTL_BYTES, stream) != hipSuccess) return;
    Args a{};
    Ctx& c = a.c;
    const float** fp[] = {&c.x_prompt, &c.x_sample, &c.cache_nsa, &c.cache_win, &c.st_conv, &c.st_dn, &c.st_s5re, &c.st_s5im, nullptr, &c.ln1, &c.ln2, &c.ln_f, &c.w_in, &c.w_out, &c.wck, &c.wcv, &c.conv_w, &c.a_log, &c.dt_bias,
                          &c.dn_norm_w, &c.lam_re, &c.lam_im, &c.log_step, &c.b_re, &c.b_im, &c.c_re, &c.c_im, &c.s5_d, &c.w_glu, &c.mlp_up, &c.mlp_down};
    for (int i = 0; i < 31; ++i) { if (i == 8) c.page_table = (const int*)d_in[i]; else *fp[i] = (const float*)d_in[i]; }
    c.out = (float*)d_out;
    char* w = (char*)d_ws;
    c.X = (float*)(w + WS_X); c.SSQ = (float*)(w + WS_SSQ); c.XN = (bf16_t*)(w + WS_XN); c.PROJ = (float*)(w + WS_PROJ); c.MIXB = (bf16_t*)(w + WS_MIXB); c.UPB = (bf16_t*)(w + WS_UPB);
    c.WIN_T = (bf16_t*)(w + WS_WIN); c.WOUT_T = (bf16_t*)(w + WS_WOUT); c.WUP_T = (bf16_t*)(w + WS_WUP); c.WDN_T = (bf16_t*)(w + WS_WDN);
    c.KC = (float*)(w + WS_KC); c.VC = (float*)(w + WS_VC); c.PC = (float*)(w + WS_PC); c.OC = (float*)(w + WS_OC); c.IDX = (int*)(w + WS_IDX);
    c.QN = (float*)(w + WS_QN); c.KN = (float*)(w + WS_KN); c.VV = (float*)(w + WS_VV); c.GG = (float*)(w + WS_GG); c.BETA = (float*)(w + WS_BETA);
    c.GC = (float*)(w + WS_GC); c.AM = (float*)(w + WS_AM); c.AQK = (float*)(w + WS_AQK); c.SOL = (float*)(w + WS_SOL); c.VNEW = (float*)(w + WS_VNEW); c.SDN = (float*)(w + WS_SDN); c.ODN = (float*)(w + WS_ODN);
    c.S5K = (float*)(w + WS_S5K); c.S5BB = (float*)(w + WS_S5BB); c.S5E = (float*)(w + WS_S5E); c.S5HIN = (float*)(w + WS_S5HIN); c.S5HS = (float*)(w + WS_S5HS); c.GL = (float*)(w + WS_GL); c.GLB = (bf16_t*)(w + WS_GLB); c.WGLU_T = (bf16_t*)(w + WS_WGLU); c.QCTR = (unsigned*)(w + WS_CTL) + 8192; c.PART = (float*)(w + WS_PART); c.DNF = (bf16_t*)(w + WS_DNF); c.DNU = (float*)(w + WS_DNU); c.DNE = (float*)(w + WS_DNE); c.DNG = (bf16_t*)(w + WS_DNG); c.S5BF = (bf16_t*)(w + WS_S5BF); c.S5CF = (bf16_t*)(w + WS_S5CF);
    a.bar = (unsigned*)(w + WS_CTL) + 1024;
#if N_LAUNCH_MODE == 1
    a.lo = 0; a.hi = NPH;
    hipLaunchKernelGGL(fwd_kernel, dim3(grid), dim3(NTHREADS), LDS_BYTES, stream, a);
#else
    a.hi = 0; a.lo = 0; launch_phase<0>(a, grid, stream);
    for (int l = 0; l < 2; ++l) { a.lo = l;
        launch_phase<1>(a, grid, stream); launch_phase<2>(a, grid, stream); launch_phase<3>(a, grid, stream); launch_phase<4>(a, grid, stream); launch_phase<5>(a, grid, stream);
        launch_phase<6>(a, grid, stream); launch_phase<7>(a, grid, stream); launch_phase<8>(a, grid, stream); launch_phase<9>(a, grid, stream); launch_phase<10>(a, grid, stream);
        launch_phase<1>(a, grid, stream); launch_phase<11>(a, grid, stream); launch_phase<12>(a, grid, stream); launch_phase<13>(a, grid, stream); }
    a.lo = 0; launch_phase<1>(a, grid, stream); launch_phase<14>(a, grid, stream);
#endif
}
```
